# Optimizing an MI355X kernel written in HIP

```python
import jax, jax.numpy as jnp
from jax import lax
import numpy as np

D_MODEL = 1024
BATCH = 4
SEQ = 8192
DEPTH = 4

CHUNK = 64
N_A = DEPTH // 2
N_B = DEPTH - N_A
RET_HEADS = 4
RET_DK = D_MODEL // RET_HEADS
RET_DV = 2 * RET_DK
RET_V = RET_HEADS * RET_DV
MLA_HEADS = 8
QK_NOPE = 128
QK_ROPE = 64
V_HEAD = 128
Q_LORA = 256
KV_LORA = 128
Q_BLOCK = 128
N_EXPERTS = 16
N_GROUPS = 4
EXPERTS_PER_GROUP = N_EXPERTS // N_GROUPS
TOP_K = 2
D_EXPERT = 512
ROPE_THETA = 10000.0
EPS = 1e-6

kernel_name = "yoco_retention_mla_grouped_moe"


def rms_norm(x, g):
    xf = x.astype(jnp.float32)
    y = xf * lax.rsqrt(jnp.mean(xf * xf, axis=-1, keepdims=True) + EPS)
    return (y * g.astype(jnp.float32)).astype(x.dtype)


def modulate(xn, shift, scale):
    return xn * (1 + scale[:, None, :]) + shift[:, None, :]


def rope(x, pos):
    half = x.shape[-1] // 2
    inv = ROPE_THETA ** (-jnp.arange(half, dtype=jnp.float32) / half)
    ang = pos.astype(jnp.float32)[:, :, None] * inv
    cos = jnp.cos(ang)[:, :, None, :]
    sin = jnp.sin(ang)[:, :, None, :]
    xf = x.astype(jnp.float32)
    x1, x2 = xf[..., :half], xf[..., half:]
    return jnp.concatenate([x1 * cos - x2 * sin, x1 * sin + x2 * cos], axis=-1).astype(x.dtype)


def retention(q, k, v):
    B, S, H, dk = q.shape
    dv = v.shape[-1]
    n = S // CHUNK
    log_g = jnp.log1p(-(2.0 ** (-5.0 - jnp.arange(H, dtype=jnp.float32))))
    t = jnp.arange(CHUNK, dtype=jnp.float32)
    diff = t[:, None] - t[None, :]
    decay_intra = jnp.where(diff >= 0, jnp.exp(log_g[:, None, None] * jnp.maximum(diff, 0.0)), 0.0)
    decay_q = jnp.exp(log_g[:, None] * (t + 1.0))[None, :, :, None]
    decay_k = jnp.exp(log_g[:, None] * (CHUNK - 1.0 - t))[None, :, :, None]
    decay_chunk = jnp.exp(log_g * CHUNK)[None, :, None, None]

    def to_chunks(a):
        return a.reshape(B, n, CHUNK, H, a.shape[-1]).transpose(1, 0, 3, 2, 4)

    def step(state, inp):
        qc, kc, vc = inp
        inner = jnp.einsum('bhnd,bhmd->bhnm', qc, kc) * decay_intra
        out = jnp.einsum('bhnm,bhmv->bhnv', inner, vc) + \
            jnp.einsum('bhnd,bhdv->bhnv', qc, state) * decay_q
        state = state * decay_chunk + jnp.einsum('bhmd,bhmv->bhdv', kc * decay_k, vc)
        return state, out

    state0 = jnp.zeros((B, H, dk, dv), jnp.float32)
    _, o = lax.scan(step, state0, (to_chunks(q), to_chunks(k), to_chunks(v)))
    return o.transpose(1, 0, 3, 2, 4).reshape(B, S, H, dv)


def retention_mixer(xn, pos, w_in, w_out):
    B, S, _ = xn.shape
    proj = xn @ w_in
    q = proj[..., :D_MODEL].reshape(B, S, RET_HEADS, RET_DK)
    k = proj[..., D_MODEL:2 * D_MODEL].reshape(B, S, RET_HEADS, RET_DK)
    v = proj[..., 2 * D_MODEL:2 * D_MODEL + RET_V].reshape(B, S, RET_HEADS, RET_DV)
    g = proj[..., 2 * D_MODEL + RET_V:]
    q = rope(q, pos).astype(jnp.float32)
    k = rope(k, pos).astype(jnp.float32) * (RET_DK ** -0.5)
    o = retention(q, k, v.astype(jnp.float32))
    mu = jnp.mean(o, axis=-1, keepdims=True)
    var = jnp.mean(jnp.square(o - mu), axis=-1, keepdims=True)
    o = (o - mu) * lax.rsqrt(var + EPS)
    y = (jax.nn.silu(g.astype(jnp.float32)) * o.reshape(B, S, RET_V)).astype(xn.dtype)
    return y @ w_out


def mla_shared_kv(hn, pos, w_kv_a, kv_norm, w_kv_b):
    B, S, _ = hn.shape
    a = hn @ w_kv_a
    c_kv = rms_norm(a[..., :KV_LORA], kv_norm)
    k_rope = rope(a[..., KV_LORA:][:, :, None, :], pos)[:, :, 0, :]
    kv = (c_kv @ w_kv_b).reshape(B, S, MLA_HEADS, QK_NOPE + V_HEAD)
    return kv[..., :QK_NOPE], k_rope, kv[..., QK_NOPE:]


def mla_attention(xn, pos, w_q_a, q_norm, w_q_b, w_o, k_nope, k_rope, v):
    B, S, _ = xn.shape
    q = (rms_norm(xn @ w_q_a, q_norm) @ w_q_b).reshape(B, S, MLA_HEADS, QK_NOPE + QK_ROPE)
    q_nope = q[..., :QK_NOPE]
    q_rope = rope(q[..., QK_NOPE:], pos)
    scale = (QK_NOPE + QK_ROPE) ** -0.5
    nb = S // Q_BLOCK
    qn_b = q_nope.reshape(B, nb, Q_BLOCK, MLA_HEADS, QK_NOPE).transpose(1, 0, 2, 3, 4)
    qr_b = q_rope.reshape(B, nb, Q_BLOCK, MLA_HEADS, QK_ROPE).transpose(1, 0, 2, 3, 4)
    key_chunk = jnp.arange(S) // CHUNK

    def block(args):
        qn, qr, i = args
        s = (jnp.einsum('bqhd,bkhd->bhqk', qn, k_nope, preferred_element_type=jnp.float32)
             + jnp.einsum('bqhr,bkr->bhqk', qr, k_rope, preferred_element_type=jnp.float32)) * scale
        q_chunk = (i * Q_BLOCK + jnp.arange(Q_BLOCK)) // CHUNK
        mask = key_chunk[None, :] <= q_chunk[:, None]
        p = jax.nn.softmax(jnp.where(mask, s, -jnp.inf), axis=-1)
        return jnp.einsum('bhqk,bkhv->bqhv', p.astype(v.dtype), v)

    o = lax.map(block, (qn_b, qr_b, jnp.arange(nb)))
    o = o.transpose(1, 0, 2, 3, 4).reshape(B, S, MLA_HEADS * V_HEAD)
    return o @ w_o


def grouped_moe(xn, w_router, b_router, w_gate, w_up, w_down):
    B, S, D = xn.shape
    xt = xn.reshape(B * S, D)
    scores = jax.nn.sigmoid((xt @ w_router).astype(jnp.float32))
    biased = scores + b_router.astype(jnp.float32)
    grouped = biased.reshape(-1, N_GROUPS, EXPERTS_PER_GROUP)
    group_score = lax.top_k(grouped, TOP_K)[0].sum(-1)
    g_sel = jnp.argmax(group_score, axis=-1)
    in_group = jnp.take_along_axis(grouped, g_sel[:, None, None], axis=1)[:, 0]
    _, local = lax.top_k(in_group, TOP_K)
    idx = g_sel[:, None] * EXPERTS_PER_GROUP + local
    w = jnp.take_along_axis(scores, idx, axis=-1)
    w = w / jnp.sum(w, axis=-1, keepdims=True)
    combine = jnp.sum(jax.nn.one_hot(idx, N_EXPERTS, dtype=jnp.float32) * w[..., None], axis=1)
    y = jnp.zeros((B * S, D), jnp.float32)
    for e in range(N_EXPERTS):
        hdn = jax.nn.silu(xt @ w_gate[e]) * (xt @ w_up[e])
        y = y + combine[:, e:e + 1] * (hdn @ w_down[e]).astype(jnp.float32)
    return y.astype(xn.dtype).reshape(B, S, D)


def setup_inputs(seed: int = 0) -> dict:
    key = jax.random.key(seed)
    ks = jax.random.split(key, 32)
    f32 = jnp.float32
    D = D_MODEL

    def nrm(k, shape, fan_in, mult=1.0):
        return jax.random.normal(k, shape, f32) * (mult * fan_in ** -0.5)

    def gain(k, shape):
        return 1.0 + 0.02 * jax.random.normal(k, shape, f32)

    offset = jax.random.randint(ks[2], (BATCH, 1), 0, 4096, dtype=jnp.int32)
    positions = offset + jnp.arange(SEQ, dtype=jnp.int32)[None, :]
    return {
        "x": jax.random.normal(ks[0], (BATCH, SEQ, D), f32),
        "c": jax.random.normal(ks[1], (BATCH, D), f32),
        "positions": positions,
        "w_mod": nrm(ks[3], (DEPTH, D, 6 * D), D, 0.5),
        "b_mod": 0.02 * jax.random.normal(ks[4], (DEPTH, 6 * D), f32),
        "norm_mix": gain(ks[5], (DEPTH, D)),
        "norm_ffn": gain(ks[6], (DEPTH, D)),
        "ret_w_in": nrm(ks[7], (N_A, D, 2 * D + 2 * RET_V), D),
        "ret_w_out": nrm(ks[8], (N_A, RET_V, D), RET_V),
        "w_mod_kv": nrm(ks[9], (D, 2 * D), D, 0.5),
        "b_mod_kv": 0.02 * jax.random.normal(ks[10], (2 * D,), f32),
        "norm_kv": gain(ks[11], (D,)),
        "mla_w_kv_a": nrm(ks[12], (D, KV_LORA + QK_ROPE), D),
        "mla_kv_norm": gain(ks[13], (KV_LORA,)),
        "mla_w_kv_b": nrm(ks[14], (KV_LORA, MLA_HEADS * (QK_NOPE + V_HEAD)), KV_LORA),
        "mla_w_q_a": nrm(ks[15], (N_B, D, Q_LORA), D),
        "mla_q_norm": gain(ks[16], (N_B, Q_LORA)),
        "mla_w_q_b": nrm(ks[17], (N_B, Q_LORA, MLA_HEADS * (QK_NOPE + QK_ROPE)), Q_LORA),
        "mla_w_o": nrm(ks[18], (N_B, MLA_HEADS * V_HEAD, D), MLA_HEADS * V_HEAD),
        "router_w": nrm(ks[19], (D, N_EXPERTS), D),
        "router_b": 0.01 * jax.random.normal(ks[20], (N_EXPERTS,), f32),
        "moe_w_gate": nrm(ks[21], (DEPTH, N_EXPERTS, D, D_EXPERT), D),
        "moe_w_up": nrm(ks[22], (DEPTH, N_EXPERTS, D, D_EXPERT), D),
        "moe_w_down": nrm(ks[23], (DEPTH, N_EXPERTS, D_EXPERT, D), D_EXPERT),
        "final_norm": gain(ks[24], (D,)),
    }


def reference(x, c, positions, w_mod, b_mod, norm_mix, norm_ffn, ret_w_in, ret_w_out,
              w_mod_kv, b_mod_kv, norm_kv, mla_w_kv_a, mla_kv_norm, mla_w_kv_b,
              mla_w_q_a, mla_q_norm, mla_w_q_b, mla_w_o, router_w, router_b,
              moe_w_gate, moe_w_up, moe_w_down, final_norm):
    c_act = jax.nn.silu(c)
    h = x
    k_nope = k_rope = v_shared = None
    for layer in range(DEPTH):
        mod = c_act @ w_mod[layer] + b_mod[layer]
        sh1, sc1, g1, sh2, sc2, g2 = jnp.split(mod, 6, axis=-1)
        if layer < N_A:
            xn = modulate(rms_norm(h, norm_mix[layer]), sh1, sc1)
            mix = retention_mixer(xn, positions, ret_w_in[layer], ret_w_out[layer])
        else:
            if layer == N_A:
                kv_mod = c_act @ w_mod_kv + b_mod_kv
                sh_kv, sc_kv = jnp.split(kv_mod, 2, axis=-1)
                hn = modulate(rms_norm(h, norm_kv), sh_kv, sc_kv)
                k_nope, k_rope, v_shared = mla_shared_kv(hn, positions, mla_w_kv_a, mla_kv_norm, mla_w_kv_b)
            j = layer - N_A
            xn = modulate(rms_norm(h, norm_mix[layer]), sh1, sc1)
            mix = mla_attention(xn, positions, mla_w_q_a[j], mla_q_norm[j], mla_w_q_b[j], mla_w_o[j],
                                k_nope, k_rope, v_shared)
        h = h + g1[:, None, :] * mix
        xn = modulate(rms_norm(h, norm_ffn[layer]), sh2, sc2)
        h = h + g2[:, None, :] * grouped_moe(xn, router_w, router_b, moe_w_gate[layer],
                                             moe_w_up[layer], moe_w_down[layer])
    return rms_norm(h, final_norm)
```

```cpp
#include <hip/hip_runtime.h>
#include <cstdio>
#include <cstdint>

#ifndef MK_SINGLE
#define MK_SINGLE 1
#endif
#ifndef MK_CHECK
#define MK_CHECK 0
#endif

#define GAS __attribute__((address_space(1)))
#define LAS __attribute__((address_space(3)))
typedef unsigned short bf16_t;
typedef short bf16x8 __attribute__((ext_vector_type(8)));
typedef short s16x4 __attribute__((ext_vector_type(4)));
typedef float f32x4 __attribute__((ext_vector_type(4)));
typedef float f32x2 __attribute__((ext_vector_type(2)));
typedef float f32x16 __attribute__((ext_vector_type(16)));
typedef unsigned u32x4 __attribute__((ext_vector_type(4)));
typedef unsigned u32x2 __attribute__((ext_vector_type(2)));

constexpr int NB = 4, SEQ = 8192, DM = 1024, NTOK = NB * SEQ, THALF = NTOK / 2;
constexpr int NEXP = 16, DEXP = 512;
constexpr int RH = 4, RDK = 256, RDV = 512, RV = 2048;
constexpr int MH = 8, QLORA = 256, KVL = 128, ROPE = 64, QKD = 192;
constexpr float EPS = 1e-6f;
constexpr int NWAVES = 8, NTHREADS = 512, GRID = 256;
constexpr int MAXSLOTS = 69632;

constexpr size_t MiB = 1u << 20;
constexpr size_t WS_CTL = 0, CTL_BYTES = 1 * MiB;
constexpr size_t WS_MOD = 1 * MiB;
constexpr size_t WS_ROUTE = 2 * MiB;
constexpr size_t WS_SSQ = 3 * MiB;
constexpr size_t WS_STATS = 4 * MiB;
constexpr size_t WS_IDX = 8 * MiB;
constexpr size_t WS_WIN = 10 * MiB;
constexpr size_t WS_WOUT = 34 * MiB;
constexpr size_t WS_WQA = 42 * MiB;
constexpr size_t WS_WKVA = 43 * MiB;
constexpr size_t WS_WQB = 44 * MiB;
constexpr size_t WS_WO = 46 * MiB;
constexpr size_t WS_WGU = 50 * MiB;
constexpr size_t WS_WDN = 178 * MiB;
constexpr size_t WS_XN = 242 * MiB;
constexpr size_t WS_L = 306 * MiB;
constexpr size_t WS_END = 690 * MiB;
constexpr size_t WS_A2 = WS_L, WS_KR = WS_L + 64 * MiB, WS_KT = WS_L + 96 * MiB, WS_B2T = WS_L + 128 * MiB;
constexpr size_t WS_HDN = WS_L, WS_YB = WS_L + 68 * MiB;
constexpr size_t WS_HN = WS_L, WS_QA = WS_L + 64 * MiB, WS_AKV = WS_L + 80 * MiB, WS_Q = WS_L + 112 * MiB, WS_OL = WS_L + 208 * MiB, WS_KP = WS_L + 300 * MiB;
constexpr int CW_BAR = 4096;
constexpr int CW_CNT = 16384;
constexpr int CW_CHK = 32768;

constexpr int LDS_STAGE = 131072;
constexpr int LDS_MISC = LDS_STAGE;
constexpr int LDS_TAB = LDS_STAGE + 256;
constexpr int LDS_BYTES = 147456;

#define LDS_WAIT() asm volatile("s_waitcnt lgkmcnt(0)" ::: "memory")
#define VM_WAIT() asm volatile("s_waitcnt vmcnt(0)" ::: "memory")
__device__ __forceinline__ unsigned cvt_pk_bf16(float lo, float hi) { unsigned r; asm volatile("v_cvt_pk_bf16_f32 %0, %1, %2" : "=v"(r) : "v"(lo), "v"(hi)); return r; }
__device__ __forceinline__ float bf2f(unsigned short b) { return __uint_as_float((unsigned)b << 16); }
__device__ __forceinline__ float bflo(unsigned w) { return __uint_as_float(w << 16); }
__device__ __forceinline__ float bfhi(unsigned w) { return __uint_as_float(w & 0xffff0000u); }
template <int CTRL> __device__ __forceinline__ float dpp_f(float v) { return __int_as_float(__builtin_amdgcn_mov_dpp(__float_as_int(v), CTRL, 0xf, 0xf, true)); }
__device__ __forceinline__ float rows_sum(float v) {
    { auto t = __builtin_amdgcn_permlane16_swap(__float_as_uint(v), __float_as_uint(v), false, false); v = __uint_as_float(t[0]) + __uint_as_float(t[1]); }
    { auto t = __builtin_amdgcn_permlane32_swap(__float_as_uint(v), __float_as_uint(v), false, false); v = __uint_as_float(t[0]) + __uint_as_float(t[1]); }
    return v;
}
__device__ __forceinline__ float wave_sum(float v) {
    v += dpp_f<0xB1>(v);
    v += dpp_f<0x4E>(v);
    v += dpp_f<0x141>(v);
    v += dpp_f<0x140>(v);
    return rows_sum(v);
}
__device__ __forceinline__ void sincos_rad(float ang, float& s, float& c) {
    float r = __builtin_amdgcn_fractf(ang * 0.15915494309189535f);
    s = __builtin_amdgcn_sinf(r); c = __builtin_amdgcn_cosf(r);
}
__device__ __forceinline__ float silu_f(float x) { return x / (1.0f + __expf(-x)); }
__device__ __forceinline__ float log2_gamma(int h) { return h == 0 ? -0.04580368961312479f : (h == 1 ? -0.02272007650008353f : (h == 2 ? -0.011315313227834146f : -0.005646563141142063f)); }
constexpr float LOG2_THETA = 13.287712379549449f;

__device__ __forceinline__ int lane_id() { return (int)__builtin_amdgcn_mbcnt_hi(~0u, __builtin_amdgcn_mbcnt_lo(~0u, 0u)); }
#define XB_TMO      128
#define XB_XCNT(j)  (256  + 64 * (j))
#define XB_XSUB(j)  (1280 + 64 * (j))
#define XB_XGEN(j)  (2304 + 64 * (j))
#define XB_TOP      3328
#define XB_TOPGEN   3392
#define XCD_BAR_WORDS 3456
#define XB_SPIN_CAP (1u << 18)
__device__ __forceinline__ unsigned xb_ld(unsigned* p)              { return __hip_atomic_load(p, __ATOMIC_RELAXED, __HIP_MEMORY_SCOPE_AGENT); }
__device__ __forceinline__ unsigned xb_add(unsigned* p, unsigned v) { return __hip_atomic_fetch_add(p, v, __ATOMIC_RELAXED, __HIP_MEMORY_SCOPE_AGENT); }
__device__ __forceinline__ unsigned xb_xcc_id() { return (unsigned)__builtin_amdgcn_s_getreg((3 << 11) | 20) & 0xFu; }
#define XB_SPIN(cond, bar) do { unsigned _sp = 0; while (cond) { __builtin_amdgcn_s_sleep(1); \
    if ((++_sp & 255u) == 0u) { if (xb_ld(&(bar)[XB_TMO])) break; if (_sp > XB_SPIN_CAP) { atomicAdd(&(bar)[XB_TMO], 1u); break; } } } } while (0)
struct XcdBarrier { unsigned* bar; unsigned x; volatile LAS unsigned* st; };
__device__ __forceinline__ XcdBarrier xcd_barrier_post(unsigned* bar, volatile LAS unsigned* st) {
    XcdBarrier b; b.bar = bar; b.x = xb_xcc_id(); b.st = st;
    if (threadIdx.x == 0) (void)xb_add(&bar[XB_XCNT(b.x)], 1u);
    return b;
}
__device__ __forceinline__ void xcd_barrier_complete(unsigned* bar, unsigned x, unsigned& nloc, unsigned& nx) {
    const unsigned G = gridDim.x * gridDim.y * gridDim.z;
    unsigned sum, cnt, mine, sp = 0u;
    for (;;) {
        sum = 0u; cnt = 0u; mine = 0u;
#pragma unroll
        for (unsigned j = 0; j < 16; ++j) { const unsigned c = xb_ld(&bar[XB_XCNT(j)]); sum += c; cnt += (c > 0u) ? 1u : 0u; mine = (j == x) ? c : mine; }
        if (sum == G) break;
        __builtin_amdgcn_s_sleep(1);
        if ((++sp & 255u) == 0u) { if (xb_ld(&bar[XB_TMO])) break; if (sp > XB_SPIN_CAP) { atomicAdd(&bar[XB_TMO], 1u); break; } }
    }
    nloc = mine > 0u ? mine : 1u; nx = cnt > 0u ? cnt : 1u;
}
__device__ __forceinline__ void xcd_barrier(const XcdBarrier& b, const int wave) {
    asm volatile("s_waitcnt vmcnt(0)" ::: "memory");
    __syncthreads();
    if (wave == 0 && lane_id() == 0) {
        unsigned* bar = b.bar; unsigned bx = b.x; asm volatile("" : "+s"(bar), "+s"(bx));
        __builtin_amdgcn_s_waitcnt(0);
        unsigned nloc = b.st[0], nx = b.st[1];
        if (nloc == 0u) { xcd_barrier_complete(bar, bx, nloc, nx); b.st[0] = nloc; b.st[1] = nx; }
        const unsigned old = xb_add(&bar[XB_XSUB(bx)], 1u);
        const unsigned gen = old / nloc;
        if (old + 1u == (gen + 1u) * nloc) {
            __builtin_amdgcn_fence(__ATOMIC_RELEASE, "agent");
            asm volatile("s_waitcnt vmcnt(0)" ::: "memory");
            const unsigned og = xb_add(&bar[XB_TOP], 1u);
            const unsigned tg = og / nx;
            if (og + 1u == (tg + 1u) * nx) xb_add(&bar[XB_TOPGEN], 1u);
            else XB_SPIN(xb_ld(&bar[XB_TOPGEN]) == tg, bar);
            __builtin_amdgcn_fence(__ATOMIC_ACQUIRE, "agent");
            xb_add(&bar[XB_XGEN(bx)], 1u);
            asm volatile("s_waitcnt vmcnt(0)" ::: "memory");
        } else {
            XB_SPIN(xb_ld(&bar[XB_XGEN(bx)]) == gen, bar);
            __builtin_amdgcn_fence(__ATOMIC_ACQUIRE, "agent");
            asm volatile("s_waitcnt vmcnt(0)" ::: "memory");
        }
    }
    __syncthreads();
}

namespace pg8 {
constexpr int BM = 256, BK = 64, HALF = 128, HTB = HALF * BK * 2, STAGE_BYTES = 8 * HTB;
__host__ __device__ __forceinline__ int lds_byte(int r, int c) { const int st = (r >> 4) * 2 + (c >> 5), rr = r & 15, cc = c & 31, ob = rr * 64 + cc * 2; return st * 1024 + (ob ^ (((ob >> 9) & 1) << 5)); }
__host__ __device__ __forceinline__ void stage_rc(int b, int& R, int& C) { const int st = b / 1024, sb = b % 1024, swz = sb ^ (((sb >> 9) & 1) << 5); R = (st >> 1) * 16 + swz / 64; C = (st & 1) * 32 + (swz % 64) / 2; }
__host__ __device__ __forceinline__ int perm32(int rho) { const int n = rho >> 4, i = rho & 15; return 8 * (i >> 2) + 4 * n + (i & 3); }

struct Unit { const char* A; const char* B; int pm, pn, aux; };

struct TileOrder {
    int nM, nN, nwg, G, c;
    __device__ void init(int nM_, int nN_, int G_, int c_) { nM = nM_; nN = nN_; nwg = nM * nN; G = G_; c = c_; }
    __device__ bool tile(int i, int& pm, int& pn) const {
        const long L = (long)i * G + c; if (L >= nwg) return false;
        int wgid = (int)L; { const int q = nwg / 8, r = nwg % 8, xcd = wgid % 8, off = wgid / 8; wgid = (xcd < r ? xcd * (q + 1) : r * (q + 1) + (xcd - r) * q) + off; }
        const int nig = 8 * nN, gid = wgid / nig, fm = gid * 8, gsz = (nM - fm) < 8 ? (nM - fm) : 8;
        pm = fm + ((wgid % nig) % gsz); pn = (wgid % nig) / gsz; return true;
    }
};

template <class Epi, class Sched, bool GATHER>
__device__ __forceinline__ void gemm_phase(LAS unsigned char* lds, const int wid, const int K, const unsigned lda, const unsigned ldb, const Sched& S, const Epi& E) {
    int lane_ = (int)__builtin_amdgcn_mbcnt_hi(~0u, __builtin_amdgcn_mbcnt_lo(~0u, 0u)); asm volatile("" : "+v"(lane_));
    const int lane = lane_, tid = wid * 64 + lane, wr = wid >> 2, wc = wid & 3, fr = lane & 15, fq = lane >> 4;
    const int nt = K / BK;
    unsigned voffA[2], voffB[2]; int RA[2], CA[2];
#pragma unroll
    for (int i = 0; i < 2; ++i) { int R, C; stage_rc(tid * 16 + i * 8192, R, C); const int Rb = Epi::PERM ? ((R & ~31) + perm32(R & 31)) : R;
        RA[i] = R; CA[i] = C; voffA[i] = (unsigned)R * lda + (unsigned)C * 2u; voffB[i] = (unsigned)Rb * ldb + (unsigned)C * 2u; }
    const size_t kstep = (size_t)(BK * 2);
    const size_t hstepA = (size_t)HALF * lda, hstepB = (size_t)HALF * ldb;
    const unsigned ldsw = (unsigned)wid * 1024u;
    const int aoff = lds_byte(wr * 64 + fr, fq * 8), boff = lds_byte(wc * 32 + fr, fq * 8);
#define PG8_SA(b, h) (((b) * 2 + (h)) * HTB)
#define PG8_SB(b, h) ((4 + (b) * 2 + (h)) * HTB)
#define PG8_GLDS(gp, bufoff, i) __builtin_amdgcn_global_load_lds((const unsigned*)(gp), (LAS unsigned*)(lds + (bufoff) + ldsw + (i) * 8192), 16, 0, 0)
#define PG8_STAGE_B(bufoff, gbase) do { _Pragma("unroll") for (int _i = 0; _i < 2; ++_i) PG8_GLDS((const char*)(gbase) + voffB[_i], bufoff, _i); } while (0)
#define PG8_STAGE_A(bufoff, gbase, h, GO) do { _Pragma("unroll") for (int _i = 0; _i < 2; ++_i) { \
        if constexpr (GATHER) PG8_GLDS((const char*)(gbase) + GO[h][_i], bufoff, _i); else PG8_GLDS((const char*)(gbase) + (size_t)(h) * hstepA + voffA[_i], bufoff, _i); } } while (0)
#define PG8_LDA(dst, b, h) do { _Pragma("unroll") for (int m = 0; m < 4; ++m) _Pragma("unroll") for (int k = 0; k < 2; ++k) dst[m][k] = *(const LAS bf16x8*)(lds + PG8_SA(b, h) + aoff + m * 2048 + k * 1024); } while (0)
#define PG8_LDB(dst, b, h) do { _Pragma("unroll") for (int n = 0; n < 2; ++n) _Pragma("unroll") for (int k = 0; k < 2; ++k) dst[n][k] = *(const LAS bf16x8*)(lds + PG8_SB(b, h) + boff + n * 2048 + k * 1024); } while (0)
#define PG8_MMA(ai, bj, At, Bt) do { __builtin_amdgcn_s_setprio(1); _Pragma("unroll") for (int m = 0; m < 4; ++m) _Pragma("unroll") for (int n = 0; n < 2; ++n) _Pragma("unroll") for (int k = 0; k < 2; ++k) \
        acc[ai][bj][m][n] = __builtin_amdgcn_mfma_f32_16x16x32_bf16(Bt[n][k], At[m][k], acc[ai][bj][m][n], 0, 0, 0); __builtin_amdgcn_s_setprio(0); } while (0)
#define PG8_WAIT_V(n) asm volatile("s_waitcnt vmcnt(" #n ")" ::: "memory")
#define PG8_WAIT_L(n) asm volatile("s_waitcnt lgkmcnt(" #n ")" ::: "memory")
#define PG8_BAR __builtin_amdgcn_s_barrier()
#define PG8_SCHED __builtin_amdgcn_sched_barrier(0)
    Unit cur, nxt; int ui = 0;
    if (!S.next(0, cur)) return;
    unsigned goff[2][2] = {{0u, 0u}, {0u, 0u}}, ngoff[2][2] = {{0u, 0u}, {0u, 0u}};
    if constexpr (GATHER) {
#pragma unroll
        for (int h = 0; h < 2; ++h)
#pragma unroll
            for (int i = 0; i < 2; ++i) goff[h][i] = (unsigned)S.tok(cur, h * HALF + RA[i]) * lda + (unsigned)CA[i] * 2u;
    }
    f32x4 acc[2][2][4][2];
#pragma unroll
    for (int a = 0; a < 2; ++a)
#pragma unroll
        for (int b = 0; b < 2; ++b)
#pragma unroll
            for (int m = 0; m < 4; ++m)
#pragma unroll
                for (int n = 0; n < 2; ++n) acc[a][b][m][n] = (f32x4){0.f, 0.f, 0.f, 0.f};
    bf16x8 At[4][2], B0[2][2], B1[2][2];
    const char* cA = cur.A; const char* cB = cur.B;
    PG8_STAGE_B(PG8_SB(0, 0), cB); PG8_STAGE_B(PG8_SB(0, 1), cB + hstepB); PG8_STAGE_A(PG8_SA(0, 0), cA, 0, goff); PG8_STAGE_A(PG8_SA(0, 1), cA, 1, goff);
    if (wr == 1) PG8_BAR;
    PG8_WAIT_V(2); PG8_BAR;
    PG8_STAGE_B(PG8_SB(1, 0), cB + kstep); PG8_STAGE_A(PG8_SA(1, 0), cA + kstep, 0, goff); PG8_STAGE_B(PG8_SB(1, 1), cB + hstepB + kstep);
    PG8_WAIT_V(6); PG8_BAR;
    for (;;) {
        const bool has_next = S.next(ui + 1, nxt);
        const char* nA = has_next ? nxt.A : cA; const char* nB = has_next ? nxt.B : cB;
        if constexpr (GATHER) {
#pragma unroll
            for (int h = 0; h < 2; ++h)
#pragma unroll
                for (int i = 0; i < 2; ++i) ngoff[h][i] = has_next ? (unsigned)S.tok(nxt, h * HALF + RA[i]) * lda + (unsigned)CA[i] * 2u : goff[h][i];
        }
#pragma unroll 1
        for (int t = 0; t < nt; t += 2) {
            const bool last = (t == nt - 2);
            const char* a1 = cA + (size_t)(t + 1) * kstep;
            const char* a2 = last ? nA : cA + (size_t)(t + 2) * kstep; const char* b2 = last ? nB : cB + (size_t)(t + 2) * kstep;
            const char* a3 = a2 + kstep; const char* b3 = b2 + kstep;
            unsigned g2[2][2];
#pragma unroll
            for (int h = 0; h < 2; ++h)
#pragma unroll
                for (int i = 0; i < 2; ++i) g2[h][i] = last ? ngoff[h][i] : goff[h][i];
            PG8_LDB(B0, 0, 0); PG8_LDB(B1, 0, 1); PG8_SCHED; PG8_LDA(At, 0, 0); PG8_STAGE_A(PG8_SA(1, 1), a1, 1, goff);
            PG8_WAIT_V(8); PG8_WAIT_L(0); PG8_BAR; PG8_MMA(0, 0, At, B0); PG8_MMA(0, 1, At, B1); PG8_BAR; PG8_SCHED;
            PG8_LDA(At, 0, 1); PG8_STAGE_B(PG8_SB(0, 0), b2); PG8_STAGE_B(PG8_SB(0, 1), b2 + hstepB); PG8_STAGE_A(PG8_SA(0, 0), a2, 0, g2);
            PG8_WAIT_V(8); PG8_WAIT_L(0); PG8_BAR; PG8_MMA(1, 0, At, B0); PG8_MMA(1, 1, At, B1); PG8_BAR; PG8_SCHED;
            PG8_LDB(B0, 1, 0); PG8_LDB(B1, 1, 1); PG8_SCHED; PG8_LDA(At, 1, 0); PG8_STAGE_A(PG8_SA(0, 1), a2, 1, g2);
            PG8_WAIT_V(8); PG8_WAIT_L(0); PG8_BAR; PG8_MMA(0, 0, At, B0); PG8_MMA(0, 1, At, B1); PG8_BAR; PG8_SCHED;
            PG8_LDA(At, 1, 1); PG8_STAGE_B(PG8_SB(1, 0), b3); PG8_STAGE_B(PG8_SB(1, 1), b3 + hstepB); PG8_STAGE_A(PG8_SA(1, 0), a3, 0, g2);
            PG8_WAIT_V(8); PG8_WAIT_L(0); PG8_BAR; PG8_MMA(1, 0, At, B0); PG8_MMA(1, 1, At, B1); PG8_BAR; PG8_SCHED;
        }
        if (wr == 0) PG8_BAR;
        { int fr2 = fr, fq2 = fq; asm volatile("" : "+v"(fr2), "+v"(fq2)); E(acc, cur, wr, wc, fr2, fq2); }
        if (!has_next) break;
#pragma unroll
        for (int a = 0; a < 2; ++a)
#pragma unroll
            for (int b = 0; b < 2; ++b)
#pragma unroll
                for (int m = 0; m < 4; ++m)
#pragma unroll
                    for (int n = 0; n < 2; ++n) acc[a][b][m][n] = (f32x4){0.f, 0.f, 0.f, 0.f};
        cur = nxt; cA = nA; cB = nB; ++ui;
        if constexpr (GATHER) {
#pragma unroll
            for (int h = 0; h < 2; ++h)
#pragma unroll
                for (int i = 0; i < 2; ++i) goff[h][i] = ngoff[h][i];
        }
        if (wr == 1) PG8_BAR;
    }
    PG8_WAIT_V(0);
    PG8_BAR;
#undef PG8_SA
#undef PG8_SB
#undef PG8_GLDS
#undef PG8_STAGE_A
#undef PG8_STAGE_B
#undef PG8_LDA
#undef PG8_LDB
#undef PG8_MMA
#undef PG8_WAIT_V
#undef PG8_WAIT_L
#undef PG8_BAR
#undef PG8_SCHED
}
}
__device__ __forceinline__ const char* uni_ptr(const char* p) {
    unsigned long long v = (unsigned long long)p; unsigned lo = __builtin_amdgcn_readfirstlane((unsigned)v), hi = __builtin_amdgcn_readfirstlane((unsigned)(v >> 32));
    return (const char*)(((unsigned long long)hi << 32) | lo);
}
struct SchedStd {
    pg8::TileOrder T; const char* A; const char* B; size_t sA, sB;
    __device__ __forceinline__ bool next(int i, pg8::Unit& u) const { int pm, pn; if (!T.tile(i, pm, pn)) return false; u.pm = pm; u.pn = pn; u.aux = 0; u.A = A + (size_t)pm * sA; u.B = B + (size_t)pn * sB; return true; }
    __device__ __forceinline__ int tok(const pg8::Unit&, int) const { return 0; }
};
struct SchedBatch {
    const char* A; const char* B; size_t sA, sB, vA, vB; int nunits, nvt, G, c;
    __device__ __forceinline__ bool next(int i, pg8::Unit& u) const { const int L = i * G + c; if (L >= nunits * nvt) return false; const int uu = L / nvt, vt = L % nvt; u.pm = uu; u.pn = vt; u.aux = 0;
        u.A = A + (size_t)uu * sA + (size_t)vt * vA; u.B = B + (size_t)uu * sB + (size_t)vt * vB; return true; }
    __device__ __forceinline__ int tok(const pg8::Unit&, int) const { return 0; }
};
struct SchedMoE {
    const LAS int* tab; const char* A; const char* Bw; size_t sE, sPN, sRT; const int* idx; int G, c; bool gather;
    __device__ __forceinline__ bool next(int i, pg8::Unit& u) const {
        const int L = i * G + c, rt = L >> 2, pn = L & 3;
        const int ntile = __builtin_amdgcn_readfirstlane(tab[32]); if (rt >= ntile) return false;
        int e = 0;
#pragma unroll
        for (int k = 1; k < 16; ++k) e += (rt >= __builtin_amdgcn_readfirstlane(tab[16 + k])) ? 1 : 0;
        u.pm = rt; u.pn = pn; u.aux = e; u.A = gather ? A : A + (size_t)rt * sRT; u.B = Bw + (size_t)e * sE + (size_t)pn * sPN; return true;
    }
    __device__ __forceinline__ int tok(const pg8::Unit& u, int r) const {
        const int e = u.aux, p = (u.pm - __builtin_amdgcn_readfirstlane(tab[16 + e])) * 256 + r, n = __builtin_amdgcn_readfirstlane(tab[e]);
        return p < n ? idx[e * NTOK + p] : 0;
    }
};

typedef const f32x4 (&AccRef)[2][2][4][2];
__device__ __forceinline__ int launder(int x) { asm volatile("" : "+v"(x)); return x; }
__device__ __forceinline__ void st8(bf16_t* p, f32x4 v0, f32x4 v1) {
    u32x4 w; w.x = cvt_pk_bf16(v0[0], v0[1]); w.y = cvt_pk_bf16(v0[2], v0[3]); w.z = cvt_pk_bf16(v1[0], v1[1]); w.w = cvt_pk_bf16(v1[2], v1[3]); *(u32x4*)p = w;
}
struct EpiPlain {
    static constexpr bool PERM = true; bf16_t* out; int ld;
    __device__ __forceinline__ void operator()(AccRef acc, const pg8::Unit& u, int wr, int wc, int fr, int fq) const {
#pragma unroll
        for (int ai = 0; ai < 2; ++ai)
#pragma unroll
            for (int m = 0; m < 4; ++m) { const int r = ai * 128 + wr * 64 + m * 16 + fr; bf16_t* rp = out + (size_t)(u.pm * 256 + r) * ld + u.pn * 256 + wc * 32 + fq * 8;
#pragma unroll
                for (int bj = 0; bj < 2; ++bj) st8(rp + bj * 128, acc[ai][bj][m][0], acc[ai][bj][m][1]); }
    }
};
template <int MODE> struct EpiRopeQK {
    static constexpr bool PERM = true; bf16_t* out; const int* pos; int half;
    __device__ __forceinline__ void operator()(AccRef acc, const pg8::Unit& u, int wr, int wc, int fr, int fq) const {
        const int pm = u.pm, h = u.pn, uu = ((pm >> 5) * 4 + h) * 32 + (pm & 31); const float l2g = log2_gamma(h);
        constexpr int LD = MODE == 0 ? 512 : 256;
        float inv[8]; const int f0 = launder(wc * 32 + fq * 8);
#pragma unroll
        for (int k = 0; k < 8; ++k) inv[k] = __builtin_amdgcn_exp2f(-(float)(f0 + k) * (LOG2_THETA / 128.0f));
#pragma unroll
        for (int ai = 0; ai < 2; ++ai)
#pragma unroll
            for (int m = 0; m < 4; ++m) { const int r = ai * 128 + wr * 64 + m * 16 + fr; const float p = (float)pos[half * THALF + pm * 256 + r];
                const float dec = MODE == 0 ? __builtin_amdgcn_exp2f((float)r * l2g) : __builtin_amdgcn_exp2f(-(float)r * l2g) * 0.0625f;
                f32x4 o1[2], o2[2];
#pragma unroll
                for (int n = 0; n < 2; ++n)
#pragma unroll
                    for (int j = 0; j < 4; ++j) { float s, c; sincos_rad(p * inv[n * 4 + j], s, c); const float x1 = acc[ai][0][m][n][j], x2 = acc[ai][1][m][n][j];
                        o1[n][j] = (x1 * c - x2 * s) * dec; o2[n][j] = (x1 * s + x2 * c) * dec; }
                bf16_t* rp = out + (size_t)uu * (256 * LD) + (size_t)r * LD + wc * 32 + fq * 8;
                st8(rp, o1[0], o1[1]); st8(rp + 128, o2[0], o2[1]); __builtin_amdgcn_sched_barrier(0); }
    }
};
struct EpiRopeKT {
    static constexpr bool PERM = true; bf16_t* out; const int* pos; int half;
    __device__ __forceinline__ void operator()(AccRef acc, const pg8::Unit& u, int wr, int wc, int fr, int fq) const {
        const int h = u.pm, pn = u.pn, uu = ((pn >> 5) * 4 + h) * 32 + (pn & 31); const float l2g = log2_gamma(h);
        float pp[2][8], dec[2][8]; const int c00 = launder(wc * 32 + fq * 8), i00 = launder(wr * 64 + fr);
#pragma unroll
        for (int bj = 0; bj < 2; ++bj)
#pragma unroll
            for (int k = 0; k < 8; ++k) { const int c = bj * 128 + c00 + k; pp[bj][k] = (float)pos[half * THALF + pn * 256 + c]; dec[bj][k] = __builtin_amdgcn_exp2f(-(float)c * l2g) * 0.0625f; }
#pragma unroll
        for (int m = 0; m < 4; ++m) { const int i = i00 + m * 16; const float inv = __builtin_amdgcn_exp2f(-(float)i * (LOG2_THETA / 128.0f));
#pragma unroll
            for (int bj = 0; bj < 2; ++bj) { f32x4 o1[2], o2[2];
#pragma unroll
                for (int n = 0; n < 2; ++n)
#pragma unroll
                    for (int j = 0; j < 4; ++j) { float s, c; sincos_rad(pp[bj][n * 4 + j] * inv, s, c); const float x1 = acc[0][bj][m][n][j], x2 = acc[1][bj][m][n][j], d = dec[bj][n * 4 + j];
                        o1[n][j] = (x1 * c - x2 * s) * d; o2[n][j] = (x1 * s + x2 * c) * d; }
                bf16_t* rp = out + (size_t)uu * 65536 + (size_t)i * 256 + bj * 128 + c00;
                st8(rp, o1[0], o1[1]); st8(rp + 128 * 256, o2[0], o2[1]); __builtin_amdgcn_sched_barrier(0); } }
    }
};
struct EpiVT {
    static constexpr bool PERM = true; bf16_t* out;
    __device__ __forceinline__ void operator()(AccRef acc, const pg8::Unit& u, int wr, int wc, int fr, int fq) const {
        const int h = u.pm >> 1, vt = u.pm & 1, pn = u.pn, uu = ((pn >> 5) * 4 + h) * 32 + (pn & 31);
#pragma unroll
        for (int ai = 0; ai < 2; ++ai)
#pragma unroll
            for (int m = 0; m < 4; ++m) { const int r = ai * 128 + wr * 64 + m * 16 + fr; bf16_t* rp = out + (size_t)uu * 262144 + (size_t)(vt * 256 + r) * 512 + 256 + wc * 32 + fq * 8;
#pragma unroll
                for (int bj = 0; bj < 2; ++bj) st8(rp + bj * 128, acc[ai][bj][m][0], acc[ai][bj][m][1]); }
    }
};
struct EpiS {
    static constexpr bool PERM = true; bf16_t* out;
    __device__ __forceinline__ void operator()(AccRef acc, const pg8::Unit& u, int wr, int wc, int fr, int fq) const {
        const int uu = u.pm;
#pragma unroll
        for (int ai = 0; ai < 2; ++ai)
#pragma unroll
            for (int m = 0; m < 4; ++m) { const int r = ai * 128 + wr * 64 + m * 16 + fr; bf16_t* rp = out + (size_t)uu * 131072 + (size_t)r * 512 + 256 + wc * 32 + fq * 8;
#pragma unroll
                for (int bj = 0; bj < 2; ++bj) { const int c0 = bj * 128 + wc * 32 + fq * 8; f32x4 v0 = acc[ai][bj][m][0], v1 = acc[ai][bj][m][1];
#pragma unroll
                    for (int j = 0; j < 4; ++j) { if (c0 + j > r) v0[j] = 0.f; if (c0 + 4 + j > r) v1[j] = 0.f; }
                    st8(rp + bj * 128, v0, v1); } }
    }
};
struct EpiKV {
    static constexpr bool PERM = true; bf16_t* out;
    __device__ __forceinline__ void operator()(AccRef acc, const pg8::Unit& u, int wr, int wc, int fr, int fq) const {
        const int uu = u.pm, vt = u.pn, h = (uu >> 5) & 3; const float sc = __builtin_amdgcn_exp2f(255.0f * log2_gamma(h));
#pragma unroll
        for (int ai = 0; ai < 2; ++ai)
#pragma unroll
            for (int m = 0; m < 4; ++m) { const int r = ai * 128 + wr * 64 + m * 16 + fr; bf16_t* rp = out + (size_t)uu * 262144 + (size_t)(vt * 256 + r) * 512 + wc * 32 + fq * 8;
#pragma unroll
                for (int bj = 0; bj < 2; ++bj) st8(rp + bj * 128, acc[ai][bj][m][0] * sc, acc[ai][bj][m][1] * sc); }
    }
};
struct EpiFin {
    static constexpr bool PERM = true; bf16_t* out; float* stats;
    __device__ __forceinline__ void operator()(AccRef acc, const pg8::Unit& u, int wr, int wc, int fr, int fq) const {
        const int uu = u.pm, vt = u.pn, bl = uu >> 7, h = (uu >> 5) & 3, ch = uu & 31;
#pragma unroll
        for (int ai = 0; ai < 2; ++ai)
#pragma unroll
            for (int m = 0; m < 4; ++m) { const int r = ai * 128 + wr * 64 + m * 16 + fr; bf16_t* rp = out + (size_t)uu * 262144 + (size_t)(vt * 256 + r) * 512 + wc * 32 + fq * 8;
                float s = 0.f, q = 0.f;
#pragma unroll
                for (int bj = 0; bj < 2; ++bj) { const f32x4 v0 = acc[ai][bj][m][0], v1 = acc[ai][bj][m][1];
                    s += (v0[0] + v0[1]) + (v0[2] + v0[3]) + (v1[0] + v1[1]) + (v1[2] + v1[3]);
                    q += (v0[0] * v0[0] + v0[1] * v0[1]) + (v0[2] * v0[2] + v0[3] * v0[3]) + (v1[0] * v1[0] + v1[1] * v1[1]) + (v1[2] * v1[2] + v1[3] * v1[3]);
                    st8(rp + bj * 128, v0, v1); }
                s = rows_sum(s); q = rows_sum(q);
                const int tokl = bl * SEQ + ch * 256 + r;
                if (fq == 0) *(f32x2*)(stats + ((size_t)(tokl * 4 + h) * 8 + vt * 4 + wc) * 2) = (f32x2){s, q}; }
    }
};
struct EpiGate {
    static constexpr bool PERM = true; const bf16_t* o; const float* stats; bf16_t* y;
    __device__ __forceinline__ void operator()(AccRef acc, const pg8::Unit& u, int wr, int wc, int fr, int fq) const {
        const int pm = u.pm, h = u.pn >> 1, vt = u.pn & 1, uu = ((pm >> 5) * 4 + h) * 32 + (pm & 31);
#pragma unroll
        for (int ai = 0; ai < 2; ++ai)
#pragma unroll
            for (int m = 0; m < 4; ++m) { const int r = ai * 128 + wr * 64 + m * 16 + fr, tokl = pm * 256 + r;
                const f32x4* sp = (const f32x4*)(stats + (size_t)(tokl * 4 + h) * 16); const f32x4 a = sp[0], b = sp[1], c = sp[2], d = sp[3];
                const float mean = ((a[0] + a[2]) + (b[0] + b[2]) + (c[0] + c[2]) + (d[0] + d[2])) * (1.0f / 512.0f);
                const float ex2 = ((a[1] + a[3]) + (b[1] + b[3]) + (c[1] + c[3]) + (d[1] + d[3])) * (1.0f / 512.0f);
                const float rstd = __builtin_amdgcn_rsqf(fmaxf(ex2 - mean * mean, 0.f) + EPS);
                const bf16_t* op = o + (size_t)uu * 262144 + (size_t)(vt * 256 + r) * 512 + wc * 32 + fq * 8;
                bf16_t* yp = y + (size_t)tokl * 2048 + h * 512 + vt * 256 + wc * 32 + fq * 8;
#pragma unroll
                for (int bj = 0; bj < 2; ++bj) { const u32x4 ow = *(const u32x4*)(op + bj * 128); const f32x4 g0 = acc[ai][bj][m][0], g1 = acc[ai][bj][m][1];
                    f32x4 y0, y1;
                    y0[0] = silu_f(g0[0]) * (bflo(ow.x) - mean) * rstd; y0[1] = silu_f(g0[1]) * (bfhi(ow.x) - mean) * rstd; y0[2] = silu_f(g0[2]) * (bflo(ow.y) - mean) * rstd; y0[3] = silu_f(g0[3]) * (bfhi(ow.y) - mean) * rstd;
                    y1[0] = silu_f(g1[0]) * (bflo(ow.z) - mean) * rstd; y1[1] = silu_f(g1[1]) * (bfhi(ow.z) - mean) * rstd; y1[2] = silu_f(g1[2]) * (bflo(ow.w) - mean) * rstd; y1[3] = silu_f(g1[3]) * (bfhi(ow.w) - mean) * rstd;
                    st8(yp + bj * 128, y0, y1); } __builtin_amdgcn_sched_barrier(0); }
    }
};
struct EpiResid {
    static constexpr bool PERM = false; float* h; const float* gate; int tok0;
    __device__ __forceinline__ void operator()(AccRef acc, const pg8::Unit& u, int wr, int wc, int fr, int fq) const {
#pragma unroll
        for (int ai = 0; ai < 2; ++ai)
#pragma unroll
            for (int m = 0; m < 4; ++m) { const int row = tok0 + u.pm * 256 + ai * 128 + wr * 64 + m * 16 + fr, b = row >> 13;
#pragma unroll
                for (int bj = 0; bj < 2; ++bj)
#pragma unroll
                    for (int n = 0; n < 2; ++n) { const int c = u.pn * 256 + bj * 128 + wc * 32 + n * 16 + fq * 4; const f32x4 gv = *(const f32x4*)(gate + b * 6144 + c);
                        f32x4* hp = (f32x4*)(h + (size_t)row * DM + c); *hp = *hp + gv * acc[ai][bj][m][n]; } }
    }
};
struct EpiGU {
    static constexpr bool PERM = true; bf16_t* hdn;
    __device__ __forceinline__ void operator()(AccRef acc, const pg8::Unit& u, int wr, int wc, int fr, int fq) const {
#pragma unroll
        for (int ai = 0; ai < 2; ++ai)
#pragma unroll
            for (int m = 0; m < 4; ++m) { const int r = ai * 128 + wr * 64 + m * 16 + fr; f32x4 o0, o1;
#pragma unroll
                for (int j = 0; j < 4; ++j) { o0[j] = silu_f(acc[ai][0][m][0][j]) * acc[ai][1][m][0][j]; o1[j] = silu_f(acc[ai][0][m][1][j]) * acc[ai][1][m][1][j]; }
                st8(hdn + (size_t)(u.pm * 256 + r) * DEXP + u.pn * 128 + wc * 32 + fq * 8, o0, o1); }
    }
};
struct EpiQA {
    static constexpr bool PERM = true; bf16_t* out; float* ssq;
    __device__ __forceinline__ void operator()(AccRef acc, const pg8::Unit& u, int wr, int wc, int fr, int fq) const {
#pragma unroll
        for (int ai = 0; ai < 2; ++ai)
#pragma unroll
            for (int m = 0; m < 4; ++m) { const int row = u.pm * 256 + ai * 128 + wr * 64 + m * 16 + fr; bf16_t* rp = out + (size_t)row * 256 + wc * 32 + fq * 8; float q = 0.f;
#pragma unroll
                for (int bj = 0; bj < 2; ++bj) { const f32x4 v0 = acc[ai][bj][m][0], v1 = acc[ai][bj][m][1];
                    q += (v0[0] * v0[0] + v0[1] * v0[1]) + (v0[2] * v0[2] + v0[3] * v0[3]) + (v1[0] * v1[0] + v1[1] * v1[1]) + (v1[2] * v1[2] + v1[3] * v1[3]);
                    st8(rp + bj * 128, v0, v1); }
                q = rows_sum(q);
                if (fq == 0) ssq[(size_t)row * 4 + wc] = q; }
    }
};
struct EpiF32 {
    static constexpr bool PERM = false; float* out;
    __device__ __forceinline__ void operator()(AccRef acc, const pg8::Unit& u, int wr, int wc, int fr, int fq) const {
#pragma unroll
        for (int ai = 0; ai < 2; ++ai)
#pragma unroll
            for (int m = 0; m < 4; ++m) { const int row = u.pm * 256 + ai * 128 + wr * 64 + m * 16 + fr;
#pragma unroll
                for (int bj = 0; bj < 2; ++bj)
#pragma unroll
                    for (int n = 0; n < 2; ++n) *(f32x4*)(out + (size_t)row * 256 + bj * 128 + wc * 32 + n * 16 + fq * 4) = acc[ai][bj][m][n]; }
    }
};
struct EpiQB {
    static constexpr bool PERM = true; bf16_t* Q; const float* ssq; const int* pos;
    __device__ __forceinline__ void operator()(AccRef acc, const pg8::Unit& u, int wr, int wc, int fr, int fq) const {
        constexpr float QS = 0.10411754627697264f;
        const int pn = u.pn;
        float inv[8]; const int f0 = launder(fq * 8);
#pragma unroll
        for (int k = 0; k < 8; ++k) inv[k] = __builtin_amdgcn_exp2f(-(float)(f0 + k) * (LOG2_THETA / 32.0f));
#pragma unroll
        for (int ai = 0; ai < 2; ++ai)
#pragma unroll
            for (int m = 0; m < 4; ++m) { const int row = u.pm * 256 + ai * 128 + wr * 64 + m * 16 + fr; const f32x4 sq = *(const f32x4*)(ssq + (size_t)row * 4);
                const float rs = __builtin_amdgcn_rsqf(((sq[0] + sq[1]) + (sq[2] + sq[3])) * (1.0f / 256.0f) + EPS) * QS;
                if (pn < 4) {
#pragma unroll
                    for (int bj = 0; bj < 2; ++bj) st8(Q + (size_t)row * 1536 + (2 * pn + bj) * QKD + wc * 32 + fq * 8, acc[ai][bj][m][0] * rs, acc[ai][bj][m][1] * rs);
                } else {
                    const float p = (float)pos[row]; f32x4 o1[2], o2[2];
#pragma unroll
                    for (int n = 0; n < 2; ++n)
#pragma unroll
                        for (int j = 0; j < 4; ++j) { float s, c; sincos_rad(p * inv[n * 4 + j], s, c); const float x1 = acc[ai][0][m][n][j] * rs, x2 = acc[ai][1][m][n][j] * rs;
                            o1[n][j] = x1 * c - x2 * s; o2[n][j] = x1 * s + x2 * c; }
                    bf16_t* qp = Q + (size_t)row * 1536 + (4 * (pn - 4) + wc) * QKD + 128 + fq * 8;
                    st8(qp, o1[0], o1[1]); st8(qp + 32, o2[0], o2[1]); } __builtin_amdgcn_sched_barrier(0); }
    }
};
typedef const char __attribute__((address_space(4)))* kaptr_t;
struct Ctx { kaptr_t ka; LAS unsigned char* lds; int wave, vcu; };
__device__ __forceinline__ const void* ld_ka(kaptr_t ka, int off) { return *(const void* const __attribute__((address_space(4)))*)(ka + off); }
#define INF(k) ((const float*)ld_ka(ka, (k) * 8))
#define INI(k) ((const int*)ld_ka(ka, (k) * 8))
#define OUTP ((float*)ld_ka(ka, 200))
#define WSB ((unsigned char*)ld_ka(ka, 208))
#define CTLP ((unsigned*)(WSB + WS_CTL))
#define PHASE_ENTRY() kaptr_t ka = C.ka; asm volatile("" : "+s"(ka)); int lane_ = lane_id(); asm volatile("" : "+v"(lane_)); int wave_ = C.wave, vcu_ = C.vcu; asm volatile("" : "+s"(wave_), "+s"(vcu_)); \
    const int lane = lane_, wave = wave_, vcu = vcu_, tid = wave * 64 + lane; LAS unsigned char* const ldsb = C.lds; (void)tid; (void)lane; (void)vcu; (void)ldsb
#define WSP(T, off) ((T*)(WSB + (off)))

__device__ __forceinline__ void transpose_block(const float* W, int N, int k0, int n0, bf16_t* dst, int ldd, int drow, LAS float* scr, int lane) {
#pragma unroll 8
    for (int i = 0; i < 32; ++i) { const int kk = 2 * i + (lane >> 5); scr[kk * 33 + (lane & 31)] = W[(size_t)(k0 + kk) * N + n0 + (lane & 31)]; }
    LDS_WAIT(); asm volatile("" ::: "memory");
    const int c = lane & 7;
#pragma unroll
    for (int j = 0; j < 4; ++j) { const int n = (lane >> 3) + 8 * j; const LAS float* s = scr + (8 * c) * 33 + n;
        u32x4 o; o.x = cvt_pk_bf16(s[0 * 33], s[1 * 33]); o.y = cvt_pk_bf16(s[2 * 33], s[3 * 33]); o.z = cvt_pk_bf16(s[4 * 33], s[5 * 33]); o.w = cvt_pk_bf16(s[6 * 33], s[7 * 33]);
        *(u32x4*)(dst + (size_t)(drow + n) * ldd + k0 + 8 * c) = o; }
    LDS_WAIT(); asm volatile("" ::: "memory");
}
__device__ __forceinline__ void phase_prologue(Ctx& C) {
    PHASE_ENTRY();
    LAS float* cact = (LAS float*)ldsb;
    LAS float* red = (LAS float*)(ldsb + 16384);
    for (int i = tid; i < 4096; i += NTHREADS) cact[i] = silu_f(INF(1)[i]);
    __syncthreads();
    float* mod = WSP(float, WS_MOD);
    for (int g = vcu; g < 416; g += GRID) {
        const int col = g * 64 + lane; const float* W; int N, cc; const float* bias; float* dst; int dstride;
        if (col < 24576) { const int l = col / 6144; cc = col - l * 6144; W = INF(3) + (size_t)l * 1024 * 6144; N = 6144; bias = INF(4) + l * 6144; dst = mod + (size_t)l * 4 * 6144; dstride = 6144; }
        else { cc = col - 24576; W = INF(9); N = 2048; bias = INF(10); dst = mod + 4 * 4 * 6144; dstride = 2048; }
        float a0 = 0.f, a1 = 0.f, a2 = 0.f, a3 = 0.f;
        const float* wp = W + (size_t)(wave * 128) * N + cc;
#pragma unroll 16
        for (int k = 0; k < 128; ++k) { const float w = wp[(size_t)k * N]; const int kk = wave * 128 + k; a0 += cact[kk] * w; a1 += cact[1024 + kk] * w; a2 += cact[2048 + kk] * w; a3 += cact[3072 + kk] * w; }
        red[(wave * 4 + 0) * 64 + lane] = a0; red[(wave * 4 + 1) * 64 + lane] = a1; red[(wave * 4 + 2) * 64 + lane] = a2; red[(wave * 4 + 3) * 64 + lane] = a3;
        __syncthreads();
        if (tid < 256) { const int b = tid >> 6, ln = tid & 63; float s = 0.f;
#pragma unroll
            for (int w = 0; w < 8; ++w) s += red[(w * 4 + b) * 64 + ln];
            const int c2 = g * 64 + ln; const int cc2 = c2 < 24576 ? c2 % 6144 : c2 - 24576;
            dst[(size_t)b * dstride + cc2] = s + bias[cc2]; }
        __syncthreads();
    }
    LAS float* scr = (LAS float*)(ldsb + wave * 16384);
    const int gw = vcu * NWAVES + wave, NGW = GRID * NWAVES;
    constexpr int NIT = 8544 + 64 * 768;
    for (int it = gw; it < NIT; it += NGW) {
        if (it < 6144) { const int l = it / 3072, r = it % 3072, kb = r / 192, nb = r % 192;
            transpose_block(INF(7) + (size_t)l * 1024 * 6144, 6144, 64 * kb, 32 * nb, WSP(bf16_t, WS_WIN) + (size_t)l * 6144 * 1024, 1024, 32 * nb, scr, lane); }
        else if (it < 8192) { const int r0 = it - 6144, l = r0 / 1024, r = r0 % 1024, kb = r / 32, nb = r % 32;
            transpose_block(INF(8) + (size_t)l * 2048 * 1024, 1024, 64 * kb, 32 * nb, WSP(bf16_t, WS_WOUT) + (size_t)l * 1024 * 2048, 2048, 32 * nb, scr, lane); }
        else if (it < 8448) { const int r0 = it - 8192, j = r0 / 128, r = r0 % 128, kb = r / 8, nb = r % 8;
            transpose_block(INF(15) + (size_t)j * 1024 * 256, 256, 64 * kb, 32 * nb, WSP(bf16_t, WS_WQA) + (size_t)j * 256 * 1024, 1024, 32 * nb, scr, lane); }
        else if (it < 8544) { const int r = it - 8448, kb = r / 6, nb = r % 6;
            transpose_block(INF(12), 192, 64 * kb, 32 * nb, WSP(bf16_t, WS_WKVA), 1024, 32 * nb, scr, lane); }
        else { const int r0 = it - 8544, le = r0 / 768, r = r0 % 768;
            if (r < 512) { const int up = r >> 8, rr = r & 255, kb = rr / 16, nb = rr % 16, n0 = 32 * nb;
                transpose_block((up ? INF(22) : INF(21)) + (size_t)le * 1024 * 512, 512, 64 * kb, n0, WSP(bf16_t, WS_WGU) + (size_t)le * 1024 * 1024, 1024, (n0 >> 7) * 256 + (n0 & 127) + up * 128, scr, lane); }
            else { const int rr = r - 512, kb = rr / 32, nb = rr % 32;
                transpose_block(INF(23) + (size_t)le * 512 * 1024, 1024, 64 * kb, 32 * nb, WSP(bf16_t, WS_WDN) + (size_t)le * 1024 * 512, 512, 32 * nb, scr, lane); } }
    }
    const int gt = vcu * NTHREADS + tid, NGT = GRID * NTHREADS;
    for (int i = gt; i < 64 * 1024 / 8; i += NGT) *(u32x4*)(WSP(bf16_t, WS_WKVA) + 192 * 1024 + (size_t)i * 8) = (u32x4){0u, 0u, 0u, 0u};
    for (int i = gt; i < 2 * 1536 * 256; i += NGT) {
        const int k = i & 255, n = (i >> 8) % 1536, j = i / (1536 * 256);
        const float* wq = INF(17) + ((size_t)j * 256 + k) * 1536; float v;
        if (n < 1024) { const int head = n >> 7, cdim = n & 127; const float* a = wq + head * QKD; const float* b = INF(14) + (size_t)cdim * 2048 + head * 256; float s = 0.f;
#pragma unroll 8
            for (int d = 0; d < 128; d += 4) { const f32x4 av = *(const f32x4*)(a + d), bv = *(const f32x4*)(b + d); s += av[0] * bv[0] + av[1] * bv[1] + av[2] * bv[2] + av[3] * bv[3]; }
            v = s; }
        else { const int np = (n - 1024) & 255, pn = (n - 1024) >> 8, half = np >> 7, wcc = (np & 127) >> 5, ii = np & 31; v = wq[(4 * pn + wcc) * QKD + 128 + half * 32 + ii]; }
        v *= INF(16)[j * 256 + k];
        WSP(bf16_t, WS_WQB)[i] = (bf16_t)(cvt_pk_bf16(v, 0.f) & 0xffffu);
    }
    for (int i = gt; i < 2 * 1024 * 1024; i += NGT) {
        const int n = i & 1023, hc = (i >> 10) & 1023, j = i >> 20, hh = hc >> 7, cdim = hc & 127;
        const float* a = INF(14) + (size_t)cdim * 2048 + hh * 256 + 128; const float* b = INF(18) + ((size_t)j * 1024 + hh * 128) * 1024 + n; float s = 0.f;
#pragma unroll 8
        for (int v = 0; v < 128; ++v) s += a[v] * b[(size_t)v * 1024];
        WSP(bf16_t, WS_WO)[((size_t)j * 1024 + n) * 1024 + hc] = (bf16_t)(cvt_pk_bf16(s, 0.f) & 0xffffu);
    }
}

__device__ __forceinline__ void moe_tile_prefix(Ctx& C, int l) {
    PHASE_ENTRY();
    LAS int* tab = (LAS int*)(ldsb + LDS_TAB);
    if (tid == 0) { int acc = 0;
        for (int e = 0; e < 16; ++e) { const int n = (int)__hip_atomic_load(CTLP + CW_CNT + 64 * l + e, __ATOMIC_RELAXED, __HIP_MEMORY_SCOPE_AGENT); tab[e] = n; tab[16 + e] = acc; acc += (n + 255) >> 8; }
        tab[32] = acc; }
    __syncthreads();
}
__device__ __forceinline__ void store_bf16_row(bf16_t* row, int lane, const f32x4 (&v)[4]) {
#pragma unroll
    for (int j = 0; j < 4; ++j) { u32x2 w; w.x = cvt_pk_bf16(v[j][0], v[j][1]); w.y = cvt_pk_bf16(v[j][2], v[j][3]); *(u32x2*)(row + 4 * lane + 256 * j) = w; }
}
__device__ __forceinline__ void moe_combine_row(const LAS int* tab, const unsigned* route, const bf16_t* yb, int lane, int tok, const f32x4 (&G2)[4], f32x4 (&v)[4]) {
    const u32x4 rt = *(const u32x4*)(route + (size_t)tok * 4);
    const int e0 = rt.x >> 15, p0 = rt.x & 32767, e1 = rt.y >> 15, p1 = rt.y & 32767; const float w0 = __uint_as_float(rt.z), w1 = __uint_as_float(rt.w);
    const bf16_t* y0 = yb + (size_t)(tab[16 + e0] * 256 + p0) * DM; const bf16_t* y1 = yb + (size_t)(tab[16 + e1] * 256 + p1) * DM;
#pragma unroll
    for (int j = 0; j < 4; ++j) { const u32x2 a = *(const u32x2*)(y0 + 4 * lane + 256 * j), b = *(const u32x2*)(y1 + 4 * lane + 256 * j);
        v[j][0] += G2[j][0] * (w0 * bflo(a.x) + w1 * bflo(b.x)); v[j][1] += G2[j][1] * (w0 * bfhi(a.x) + w1 * bfhi(b.x));
        v[j][2] += G2[j][2] * (w0 * bflo(a.y) + w1 * bflo(b.y)); v[j][3] += G2[j][3] * (w0 * bfhi(a.y) + w1 * bfhi(b.y)); }
}
__device__ __forceinline__ float row_rstd(const f32x4 (&v)[4]) {
    float s = 0.f;
#pragma unroll
    for (int j = 0; j < 4; ++j) s += (v[j][0] * v[j][0] + v[j][1] * v[j][1]) + (v[j][2] * v[j][2] + v[j][3] * v[j][3]);
    return __builtin_amdgcn_rsqf(wave_sum(s) * (1.0f / DM) + EPS);
}
__device__ __forceinline__ void phase_norm_a(Ctx& C, int l) {
    PHASE_ENTRY(); const int b = vcu >> 6; const float* mod = WSP(float, WS_MOD);
    const float* xin = INF(0); float* hout = OUTP; bf16_t* xnp = WSP(bf16_t, WS_XN); bf16_t* hnp = WSP(bf16_t, WS_HN); const unsigned* route = WSP(unsigned, WS_ROUTE); const bf16_t* ybp = WSP(bf16_t, WS_YB);
    f32x4 Am[4], Bm[4], G2[4], Ak[4], Bk[4];
#pragma unroll
    for (int j = 0; j < 4; ++j) { const int c = 4 * lane + 256 * j;
        if (l < 4) { const float* ml = mod + (size_t)(l * 4 + b) * 6144; const f32x4 g = *(const f32x4*)(INF(5) + l * DM + c), sc = *(const f32x4*)(ml + 1024 + c); Am[j] = g * (1.0f + sc); Bm[j] = *(const f32x4*)(ml + c); }
        else { Am[j] = *(const f32x4*)(INF(24) + c); Bm[j] = (f32x4){0.f, 0.f, 0.f, 0.f}; }
        if (l > 0) G2[j] = *(const f32x4*)(mod + (size_t)((l - 1) * 4 + b) * 6144 + 5 * 1024 + c); else G2[j] = (f32x4){0.f, 0.f, 0.f, 0.f};
        if (l == 2) { const float* mk = mod + 4 * 4 * 6144 + b * 2048; const f32x4 g = *(const f32x4*)(INF(11) + c), sc = *(const f32x4*)(mk + 1024 + c); Ak[j] = g * (1.0f + sc); Bk[j] = *(const f32x4*)(mk + c); }
        else { Ak[j] = Am[j]; Bk[j] = Bm[j]; } }
    if (l > 0) moe_tile_prefix(C, l - 1);
    for (int rr = 0; rr < 16; ++rr) {
        const int tok = vcu * 128 + wave * 16 + rr; f32x4 v[4];
        const float* src = (l == 0 ? xin : hout) + (size_t)tok * DM;
#pragma unroll
        for (int j = 0; j < 4; ++j) v[j] = *(const f32x4*)(src + 4 * lane + 256 * j);
        if (l > 0) moe_combine_row((const LAS int*)(ldsb + LDS_TAB), route, ybp, lane, tok, G2, v);
        const float rstd = row_rstd(v);
        if (l < 4) {
#pragma unroll
            for (int j = 0; j < 4; ++j) *(f32x4*)(hout + (size_t)tok * DM + 4 * lane + 256 * j) = v[j];
            f32x4 o[4];
#pragma unroll
            for (int j = 0; j < 4; ++j) o[j] = v[j] * rstd * Am[j] + Bm[j];
            store_bf16_row(xnp + (size_t)tok * DM, lane, o);
            if (l == 2) {
#pragma unroll
                for (int j = 0; j < 4; ++j) o[j] = v[j] * rstd * Ak[j] + Bk[j];
                store_bf16_row(hnp + (size_t)tok * DM, lane, o); }
        } else {
#pragma unroll
            for (int j = 0; j < 4; ++j) *(f32x4*)(hout + (size_t)tok * DM + 4 * lane + 256 * j) = v[j] * rstd * Am[j];
        }
    }
}
__device__ __forceinline__ void phase_norm_b(Ctx& C, int l) {
    PHASE_ENTRY(); const int b = vcu >> 6; const float* ml = WSP(float, WS_MOD) + (size_t)(l * 4 + b) * 6144;
    const float* hin = OUTP; bf16_t* xnp = WSP(bf16_t, WS_XN);
    LAS float* wrT = (LAS float*)ldsb;
    LAS int* rec_e = (LAS int*)(ldsb + 65536);
    LAS float* rec_w = (LAS float*)(ldsb + 65536 + 1024);
    LAS int* rec_p = (LAS int*)(ldsb + 65536 + 2048);
    LAS int* lcnt = (LAS int*)(ldsb + 65536 + 3072);
    LAS int* gbase = (LAS int*)(ldsb + 65536 + 3072 + 64);
    for (int i = tid; i < 4096; i += NTHREADS) { const f32x4 w = *(const f32x4*)(INF(19) + (size_t)i * 4); const int col = i >> 2, e4 = (i & 3) * 4;
        wrT[(e4 + 0) * 1024 + col] = w[0]; wrT[(e4 + 1) * 1024 + col] = w[1]; wrT[(e4 + 2) * 1024 + col] = w[2]; wrT[(e4 + 3) * 1024 + col] = w[3]; }
    if (tid < 16) lcnt[tid] = 0;
    f32x4 Am[4], Bm[4];
#pragma unroll
    for (int j = 0; j < 4; ++j) { const int c = 4 * lane + 256 * j; const f32x4 g = *(const f32x4*)(INF(6) + l * DM + c), sc = *(const f32x4*)(ml + 4 * 1024 + c); Am[j] = g * (1.0f + sc); Bm[j] = *(const f32x4*)(ml + 3 * 1024 + c); }
    float rb[16];
#pragma unroll
    for (int e = 0; e < 16; ++e) rb[e] = INF(20)[e];
    __syncthreads();
    for (int rr = 0; rr < 16; ++rr) {
        const int rl = wave * 16 + rr, tok = vcu * 128 + rl; f32x4 v[4];
#pragma unroll
        for (int j = 0; j < 4; ++j) v[j] = *(const f32x4*)(hin + (size_t)tok * DM + 4 * lane + 256 * j);
        const float rstd = row_rstd(v);
#pragma unroll
        for (int j = 0; j < 4; ++j) v[j] = v[j] * rstd * Am[j] + Bm[j];
        store_bf16_row(xnp + (size_t)tok * DM, lane, v);
        float sc[16], bs[16];
#pragma unroll
        for (int e = 0; e < 16; ++e) { float p = 0.f;
#pragma unroll
            for (int j = 0; j < 4; ++j) { const f32x4 w = *(const LAS f32x4*)(wrT + e * 1024 + 4 * lane + 256 * j); p += (v[j][0] * w[0] + v[j][1] * w[1]) + (v[j][2] * w[2] + v[j][3] * w[3]); }
            p = wave_sum(p); sc[e] = 1.0f / (1.0f + __expf(-p)); bs[e] = sc[e] + rb[e]; }
        float gs[4];
#pragma unroll
        for (int g = 0; g < 4; ++g) { const float a = bs[4 * g], bq = bs[4 * g + 1], c = bs[4 * g + 2], d = bs[4 * g + 3];
            const float h1 = fmaxf(a, bq), l1 = fminf(a, bq), h2 = fmaxf(c, d), l2 = fminf(c, d); gs[g] = fmaxf(h1, h2) + fmaxf(fminf(h1, h2), fmaxf(l1, l2)); }
        int gi = 0; float best = gs[0];
#pragma unroll
        for (int g = 1; g < 4; ++g) if (gs[g] > best) { best = gs[g]; gi = g; }
        float iv[4], uv[4];
#pragma unroll
        for (int k = 0; k < 4; ++k) { iv[k] = gi == 0 ? bs[k] : (gi == 1 ? bs[4 + k] : (gi == 2 ? bs[8 + k] : bs[12 + k])); uv[k] = gi == 0 ? sc[k] : (gi == 1 ? sc[4 + k] : (gi == 2 ? sc[8 + k] : sc[12 + k])); }
        int i1 = 0; float b1 = iv[0];
#pragma unroll
        for (int k = 1; k < 4; ++k) if (iv[k] > b1) { b1 = iv[k]; i1 = k; }
        int i2 = -1; float b2 = 0.f;
#pragma unroll
        for (int k = 0; k < 4; ++k) if (k != i1 && (i2 < 0 || iv[k] > b2)) { b2 = iv[k]; i2 = k; }
        const float u1 = i1 == 0 ? uv[0] : (i1 == 1 ? uv[1] : (i1 == 2 ? uv[2] : uv[3])), u2 = i2 == 0 ? uv[0] : (i2 == 1 ? uv[1] : (i2 == 2 ? uv[2] : uv[3]));
        const float rs = 1.0f / (u1 + u2);
        if (lane == 0) { rec_e[rl * 2] = gi * 4 + i1; rec_e[rl * 2 + 1] = gi * 4 + i2; rec_w[rl * 2] = u1 * rs; rec_w[rl * 2 + 1] = u2 * rs; }
    }
    __syncthreads();
    if (tid < 128) { rec_p[tid * 2] = atomicAdd((int*)&lcnt[rec_e[tid * 2]], 1); rec_p[tid * 2 + 1] = atomicAdd((int*)&lcnt[rec_e[tid * 2 + 1]], 1); }
    __syncthreads();
    if (tid < 16) gbase[tid] = (int)__hip_atomic_fetch_add(CTLP + CW_CNT + 64 * l + tid, (unsigned)lcnt[tid], __ATOMIC_RELAXED, __HIP_MEMORY_SCOPE_AGENT);
    __syncthreads();
    if (tid < 128) { const int tok = vcu * 128 + tid, e0 = rec_e[tid * 2], e1 = rec_e[tid * 2 + 1], p0 = gbase[e0] + rec_p[tid * 2], p1 = gbase[e1] + rec_p[tid * 2 + 1];
        int* idx = WSP(int, WS_IDX); idx[e0 * NTOK + p0] = tok; idx[e1 * NTOK + p1] = tok;
        *(u32x4*)(WSP(unsigned, WS_ROUTE) + (size_t)tok * 4) = (u32x4){(unsigned)(e0 << 15 | p0), (unsigned)(e1 << 15 | p1), __float_as_uint(rec_w[tid * 2]), __float_as_uint(rec_w[tid * 2 + 1])}; }
    __syncthreads();
}
__device__ __forceinline__ void phase_prefix(Ctx& C) {
    PHASE_ENTRY(); const int g = vcu * NTHREADS + tid, dkv = g & 31, v = (g >> 5) & 511, bh = g >> 14, h = bh & 3;
    const float gam = __builtin_amdgcn_exp2f(log2_gamma(h)), gam256 = __builtin_amdgcn_exp2f(256.0f * log2_gamma(h));
    bf16_t* p = WSP(bf16_t, WS_B2T) + (size_t)bh * 32 * 262144 + (size_t)v * 512 + dkv * 8;
    float s[8];
#pragma unroll
    for (int k = 0; k < 8; ++k) s[k] = 0.f;
    for (int c0 = 0; c0 < 32; c0 += 4) {
        u32x4 kv[4];
#pragma unroll
        for (int i = 0; i < 4; ++i) kv[i] = *(const u32x4*)(p + (size_t)(c0 + i) * 262144);
#pragma unroll
        for (int i = 0; i < 4; ++i) {
            u32x4 o; o.x = cvt_pk_bf16(s[0] * gam, s[1] * gam); o.y = cvt_pk_bf16(s[2] * gam, s[3] * gam); o.z = cvt_pk_bf16(s[4] * gam, s[5] * gam); o.w = cvt_pk_bf16(s[6] * gam, s[7] * gam);
            *(u32x4*)(p + (size_t)(c0 + i) * 262144) = o;
            s[0] = s[0] * gam256 + bflo(kv[i].x); s[1] = s[1] * gam256 + bfhi(kv[i].x); s[2] = s[2] * gam256 + bflo(kv[i].y); s[3] = s[3] * gam256 + bfhi(kv[i].y);
            s[4] = s[4] * gam256 + bflo(kv[i].z); s[5] = s[5] * gam256 + bfhi(kv[i].z); s[6] = s[6] * gam256 + bflo(kv[i].w); s[7] = s[7] * gam256 + bfhi(kv[i].w); }
    }
}
__device__ __forceinline__ void phase_kvfin(Ctx& C) {
    PHASE_ENTRY(); const float* akv = WSP(float, WS_AKV); bf16_t* kpp = WSP(bf16_t, WS_KP); const int* posp = INI(2); const float g0 = INF(13)[2 * lane], g1 = INF(13)[2 * lane + 1];
    const float inv = __builtin_amdgcn_exp2f(-(float)(lane & 31) * (LOG2_THETA / 32.0f));
    for (int rr = 0; rr < 16; ++rr) {
        const int tok = vcu * 128 + wave * 16 + rr; const float* a = akv + (size_t)tok * 256; bf16_t* kp = kpp + (size_t)tok * QKD;
        const f32x2 cv = *(const f32x2*)(a + 2 * lane); const float rstd = __builtin_amdgcn_rsqf(wave_sum(cv[0] * cv[0] + cv[1] * cv[1]) * (1.0f / 128.0f) + EPS);
        *(unsigned*)(kp + 2 * lane) = cvt_pk_bf16(cv[0] * rstd * g0, cv[1] * rstd * g1);
        const float x1 = a[128 + (lane & 31)], x2 = a[160 + (lane & 31)]; float s, c; sincos_rad((float)posp[tok] * inv, s, c);
        const float o = lane < 32 ? x1 * c - x2 * s : x1 * s + x2 * c;
        kp[128 + lane] = (bf16_t)(cvt_pk_bf16(o, 0.f) & 0xffffu);
    }
}
namespace att {
constexpr int SHM_V = 16384, SHM_K = 24576, OFF_V = 0, OFF_K = 2 * SHM_V, OFF_WS = OFF_K + 2 * SHM_K, OFF_Q = OFF_WS + 2048;
constexpr float THR = 8.0f;
#define KSWZ(row, colB) ((row) * 384 + ((colB) ^ ((((row) >> 1) & 7) << 4)))
#define SBAR() __builtin_amdgcn_sched_barrier(0)
__device__ __forceinline__ int crow(int r, int hi) { return (r & 3) + 8 * (r >> 2) + 4 * hi; }
__device__ __forceinline__ void partialSM(f32x16& p0, f32x16& p1, float& m_reg, float& mn, float& alpha) {
    float pmax = p0[0];
#pragma unroll
    for (int r = 1; r < 16; ++r) pmax = fmaxf(pmax, p0[r]);
#pragma unroll
    for (int r = 0; r < 16; ++r) pmax = fmaxf(pmax, p1[r]);
    { auto rr = __builtin_amdgcn_permlane32_swap(__float_as_uint(pmax), __float_as_uint(pmax), false, false); pmax = fmaxf(__uint_as_float(rr[0]), __uint_as_float(rr[1])); }
    if (__builtin_expect(__all(pmax - m_reg <= THR), 1)) { mn = m_reg; alpha = 1.f; }
    else { mn = fmaxf(m_reg, pmax); alpha = __builtin_amdgcn_exp2f(m_reg - mn); m_reg = mn; }
#pragma unroll
    for (int r = 0; r < 16; ++r) p0[r] = p0[r] - mn;
#pragma unroll
    for (int r = 0; r < 16; ++r) p1[r] = p1[r] - mn;
#pragma unroll
    for (int r = 0; r < 16; ++r) p0[r] = __builtin_amdgcn_exp2f(p0[r]);
}
__device__ __forceinline__ void finishSM(f32x16& p0, f32x16& p1, float alpha, float& l_reg, bf16x8& pa0, bf16x8& pa1, bf16x8& pa2, bf16x8& pa3) {
#pragma unroll
    for (int r = 0; r < 16; ++r) p1[r] = __builtin_amdgcn_exp2f(p1[r]);
    float ps = 0;
#pragma unroll
    for (int r = 0; r < 16; ++r) ps += p0[r];
#pragma unroll
    for (int r = 0; r < 16; ++r) ps += p1[r];
    { auto rr = __builtin_amdgcn_permlane32_swap(__float_as_uint(ps), __float_as_uint(ps), false, false); ps = __uint_as_float(rr[0]) + __uint_as_float(rr[1]); }
    l_reg = l_reg * alpha + ps;
#define PK4(P, BASE, OUT) do { unsigned a0 = cvt_pk_bf16(P[BASE + 0], P[BASE + 1]), a1 = cvt_pk_bf16(P[BASE + 2], P[BASE + 3]);   \
    unsigned b0 = cvt_pk_bf16(P[BASE + 4], P[BASE + 5]), b1 = cvt_pk_bf16(P[BASE + 6], P[BASE + 7]);                              \
    auto r0 = __builtin_amdgcn_permlane32_swap(a0, b0, false, false); auto r1 = __builtin_amdgcn_permlane32_swap(a1, b1, false, false); \
    u32x4 w = {r0[0], r1[0], r0[1], r1[1]}; OUT = *reinterpret_cast<bf16x8*>(&w); } while (0)
    PK4(p0, 0, pa0); PK4(p0, 8, pa1); PK4(p1, 0, pa2); PK4(p1, 8, pa3);
#undef PK4
}
template <int BUF> __device__ __forceinline__ void qkt(f32x16& p0, f32x16& p1, const LAS char* const (&kb4)[4], const bf16x8* qr, const LAS char* ql) {
    p0 = f32x16{}; p1 = f32x16{};
#pragma unroll
    for (int d0 = 0; d0 < 12; ++d0) {
        const bf16x8 b0 = *reinterpret_cast<const LAS bf16x8*>(kb4[d0 & 3] + BUF * SHM_K + (d0 >> 2) * 128);
        const bf16x8 b1 = *reinterpret_cast<const LAS bf16x8*>(kb4[d0 & 3] + BUF * SHM_K + (d0 >> 2) * 128 + 32 * 384);
        const bf16x8 qf = d0 < 8 ? qr[d0 < 8 ? d0 : 0] : *reinterpret_cast<const LAS bf16x8*>(ql + (d0 - 8) * 1024);
        p0 = __builtin_amdgcn_mfma_f32_32x32x16_bf16(b0, qf, p0, 0, 0, 0);
        p1 = __builtin_amdgcn_mfma_f32_32x32x16_bf16(b1, qf, p1, 0, 0, 0); }
}
__device__ __forceinline__ int v_st(int k, int c) { const int kk = (k & ~0xC) | ((k & 4) << 1) | ((k & 8) >> 1); return ((kk >> 3) * 4 + (c >> 5)) * 512 + ((kk & 7) * 32 + (c & 31)) * 2; }
__device__ __forceinline__ int v_rd_base(int lane) { return ((lane & 3) << 3) | (((lane >> 2) & 3) << 6) | (((lane >> 4) & 1) << 5) | (((lane >> 5) & 1) << 8); }
constexpr int v_rd_off(int d0, int ks, int half) { return d0 * 512 + ks * 4096 + half * 2048; }
template <int OFF> __device__ __forceinline__ s16x4 tr_read(int vb) { s16x4 r; asm volatile("ds_read_b64_tr_b16 %0, %1 offset:%2" : "=&v"(r) : "v"(vb), "i"(OFF) : "memory"); return r; }
template <int D0> __device__ __forceinline__ void pv_one(f32x16& od, int vb, bf16x8 pa0, bf16x8 pa1, bf16x8 pa2, bf16x8 pa3) {
    const s16x4 l0 = tr_read<v_rd_off(D0, 0, 0)>(vb), h0 = tr_read<v_rd_off(D0, 0, 1)>(vb), l1 = tr_read<v_rd_off(D0, 1, 0)>(vb), h1 = tr_read<v_rd_off(D0, 1, 1)>(vb);
    const s16x4 l2 = tr_read<v_rd_off(D0, 2, 0)>(vb), h2 = tr_read<v_rd_off(D0, 2, 1)>(vb), l3 = tr_read<v_rd_off(D0, 3, 0)>(vb), h3 = tr_read<v_rd_off(D0, 3, 1)>(vb);
    asm volatile("s_waitcnt lgkmcnt(0)" ::: "memory"); SBAR();
#define PK(L, H) (bf16x8){L[0], L[1], L[2], L[3], H[0], H[1], H[2], H[3]}
    od = __builtin_amdgcn_mfma_f32_32x32x16_bf16(pa0, PK(l0, h0), od, 0, 0, 0);
    od = __builtin_amdgcn_mfma_f32_32x32x16_bf16(pa1, PK(l1, h1), od, 0, 0, 0);
    od = __builtin_amdgcn_mfma_f32_32x32x16_bf16(pa2, PK(l2, h2), od, 0, 0, 0);
    od = __builtin_amdgcn_mfma_f32_32x32x16_bf16(pa3, PK(l3, h3), od, 0, 0, 0);
#undef PK
}
__device__ __forceinline__ void pv_d0(f32x16* o, int vb, bf16x8 pa0, bf16x8 pa1, bf16x8 pa2, bf16x8 pa3) {
    pv_one<0>(o[0], vb, pa0, pa1, pa2, pa3); pv_one<1>(o[1], vb, pa0, pa1, pa2, pa3); pv_one<2>(o[2], vb, pa0, pa1, pa2, pa3); pv_one<3>(o[3], vb, pa0, pa1, pa2, pa3);
}
__device__ __forceinline__ void attn_unit(const bf16_t* __restrict__ Q, const bf16_t* __restrict__ Kp, bf16_t* __restrict__ O, int t0, int kbase, int nt_real, LAS char* lds, int wid) {
    int lane_ = (int)__builtin_amdgcn_mbcnt_hi(~0u, __builtin_amdgcn_mbcnt_lo(~0u, 0u)); asm volatile("" : "+v"(lane_));
    const int lane = lane_, tid = wid * 64 + lane, r32 = lane & 31, hi = lane >> 5;
    LAS char* V_lds = lds + OFF_V; LAS char* K_lds = lds + OFF_K;
    LAS float* ws = (LAS float*)(lds + OFF_WS) + wid * 64; LAS float* li_l = ws; LAS float* al_l = ws + 32;
    float m_reg = -1e30f, l_reg = 0; f32x16 o[4] = {}; bf16x8 qr[8];
    LAS char* qlds = lds + OFF_Q + wid * 4096 + lane * 16;
    const char* Qs = (const char*)Q + (size_t)t0 * 3072 + wid * (QKD * 2); const unsigned qlo = (unsigned)(r32 * 3072 + hi * 16);
#pragma unroll
    for (int d0 = 0; d0 < 8; ++d0) qr[d0] = *reinterpret_cast<const bf16x8*>(Qs + qlo + d0 * 32);
    __syncthreads();
#pragma unroll
    for (int d0 = 8; d0 < 12; ++d0) *reinterpret_cast<LAS bf16x8*>(qlds + (d0 - 8) * 1024) = *reinterpret_cast<const bf16x8*>(Qs + qlo + d0 * 32);
    const int vb0 = (int)(uintptr_t)V_lds + v_rd_base(lane);
    const LAS char* kb4[4];
#pragma unroll
    for (int q = 0; q < 4; ++q) kb4[q] = K_lds + r32 * 384 + ((q * 32 + hi * 16) ^ (((r32 >> 1) & 7) << 4));
    const int NT = (nt_real + 1) & ~1;
    const bool dummy = (NT != nt_real);
    bf16x8 sr_[1][3];
    const char* Kg = (const char*)(Kp + (size_t)kbase * QKD);
#define SLOAD(s, kt) do { _Pragma("unroll") for (int i = 0; i < 3; ++i) sr_[s][i] = *reinterpret_cast<const bf16x8*>(Kg + (size_t)(kt) * SHM_K + i * 8192 + (unsigned)(tid * 16)); } while (0)
#define SWRITE(b, s) do { int tl_ = (int)__builtin_amdgcn_mbcnt_hi(~0u, __builtin_amdgcn_mbcnt_lo(~0u, 0u)); asm volatile("" : "+v"(tl_)); tl_ += wid * 64; _Pragma("unroll") for (int i = 0; i < 3; ++i) { const int p_ = tl_ + 512 * i, row_ = p_ / 24, c16_ = p_ - row_ * 24; \
        *(LAS bf16x8*)(K_lds + (b) * SHM_K + KSWZ(row_, c16_ * 16)) = sr_[s][i]; if (c16_ < 16) *(LAS bf16x8*)(V_lds + (b) * SHM_V + v_st(row_, c16_ * 8)) = sr_[s][i]; } } while (0)
#define SWAIT() asm volatile("s_waitcnt vmcnt(0)" ::: "memory")
#define RESC(a) do { if (__any((a) < 1.f)) { if (hi == 0) al_l[r32] = (a); asm volatile("s_waitcnt lgkmcnt(0)" ::: "memory"); \
    _Pragma("unroll") for (int d = 0; d < 4; ++d) _Pragma("unroll") for (int r = 0; r < 16; ++r) o[d][r] *= al_l[crow(r, hi)]; } } while (0)
    f32x16 pA0, pA1, pB0, pB1; float mnA, mnB, alA, alB; bf16x8 pa0, pa1, pa2, pa3;
    SLOAD(0, 0); SWAIT(); SWRITE(0, 0); __syncthreads();
    qkt<0>(pA0, pA1, kb4, qr, qlds); partialSM(pA0, pA1, m_reg, mnA, alA);
    SLOAD(0, 1); SWAIT(); SWRITE(1, 0); __syncthreads();
    for (int j = 1; j + 1 < NT; j += 2) {
        SBAR(); qkt<1>(pB0, pB1, kb4, qr, qlds);
        finishSM(pA0, pA1, alA, l_reg, pa0, pa1, pa2, pa3); SBAR();
        SLOAD(0, j + 1); SBAR();
        pv_d0(o, vb0, pa0, pa1, pa2, pa3); partialSM(pB0, pB1, m_reg, mnB, alB);
        __syncthreads(); SWAIT(); SWRITE(0, 0);
        RESC(alB); __syncthreads();
        SBAR(); qkt<0>(pA0, pA1, kb4, qr, qlds);
        finishSM(pB0, pB1, alB, l_reg, pa0, pa1, pa2, pa3); SBAR();
        SLOAD(0, j + 2); SBAR();
        pv_d0(o, vb0 + SHM_V, pa0, pa1, pa2, pa3); partialSM(pA0, pA1, m_reg, mnA, alA);
        __syncthreads(); SWAIT(); SWRITE(1, 0);
        RESC(alA); __syncthreads();
    }
    SBAR(); qkt<1>(pB0, pB1, kb4, qr, qlds);
    if (dummy) {
#pragma unroll
        for (int r = 0; r < 16; ++r) { pB0[r] = -INFINITY; pB1[r] = -INFINITY; } }
    finishSM(pA0, pA1, alA, l_reg, pa0, pa1, pa2, pa3); SBAR();
    pv_d0(o, vb0, pa0, pa1, pa2, pa3); partialSM(pB0, pB1, m_reg, mnB, alB);
    __syncthreads(); RESC(alB);
    finishSM(pB0, pB1, alB, l_reg, pa0, pa1, pa2, pa3); SBAR();
    pv_d0(o, vb0 + SHM_V, pa0, pa1, pa2, pa3);
    {
        int lanee = (int)__builtin_amdgcn_mbcnt_hi(~0u, __builtin_amdgcn_mbcnt_lo(~0u, 0u)); asm volatile("" : "+v"(lanee));
        const int wide = wid, r32e = lanee & 31, hie = lanee >> 5;
        LAS float* lie = (LAS float*)(lds + OFF_WS) + wide * 64;
        if (hie == 0) lie[r32e] = l_reg; asm volatile("s_waitcnt lgkmcnt(0)" ::: "memory");
        char* Os = (char*)O + (size_t)t0 * 2048 + wide * 256; const unsigned olo = (unsigned)(r32e * 2);
#pragma unroll
        for (int r = 0; r < 16; ++r) { const int orow = crow(r, hie); const float rl = __builtin_amdgcn_rcpf(lie[orow]);
#pragma unroll
            for (int d0 = 0; d0 < 4; ++d0) *(bf16_t*)(Os + olo + (unsigned)(orow * 2048) + d0 * 64) = (bf16_t)(cvt_pk_bf16(o[d0][r] * rl, 0.f) & 0xffffu); }
    }
#undef SLOAD
#undef SWRITE
#undef SWAIT
#undef RESC
}
}
struct Args { const void* in[25]; float* out; unsigned char* ws; int lo, hi, l, hf; };
enum { PH_PRO = 0, PH_NA, PH_R2, PH_R3, PH_R4, PH_R5, PH_R6, PH_R7, PH_M2, PH_M3, PH_M4, PH_M5, PH_NB, PH_MOE1, PH_MOE2, PH_COUNT };

__device__ __forceinline__ void make_ctx(Ctx& C, unsigned char* lds_raw) {
    C.ka = (kaptr_t)__builtin_amdgcn_kernarg_segment_ptr(); C.lds = (LAS unsigned char*)lds_raw;
    C.wave = __builtin_amdgcn_readfirstlane((int)threadIdx.x >> 6);
    { const int bx = blockIdx.x; C.vcu = (bx & 7) * (GRID / 8) + (bx >> 3); }
}

template <int PH> __device__ __forceinline__ void run_phase(Ctx& C, const int l, const int hf) {
    PHASE_ENTRY(); const int wv = wave;
    LAS unsigned char* lds = ldsb; int bid_ = blockIdx.x; asm volatile("" : "+s"(bid_)); const int bid = bid_; const unsigned LD1K = 2048u;
    const float* gate1 = WSP(float, WS_MOD) + (size_t)l * 4 * 6144 + 2 * 1024;
    const bf16_t* win = WSP(bf16_t, WS_WIN) + (size_t)(l & 1) * 6144 * 1024;
    const bf16_t* xnh = WSP(bf16_t, WS_XN) + (size_t)hf * THALF * DM;
    const int j = l & 1;
    if constexpr (PH == PH_PRO) phase_prologue(C);
    if constexpr (PH == PH_NA) phase_norm_a(C, l);
    if constexpr (PH == PH_R2) {
        { SchedStd S; S.T.init(64, 4, GRID, bid); S.A = (const char*)xnh; S.B = (const char*)win; S.sA = 256 * 2048; S.sB = 256 * 2048;
          EpiRopeQK<0> E{WSP(bf16_t, WS_A2), INI(2), hf}; pg8::gemm_phase<EpiRopeQK<0>, SchedStd, false>(lds, wv, 1024, LD1K, LD1K, S, E); }
        { SchedStd S; S.T.init(64, 4, GRID, bid); S.A = (const char*)xnh; S.B = (const char*)(win + 1024 * 1024); S.sA = 256 * 2048; S.sB = 256 * 2048;
          EpiRopeQK<1> E{WSP(bf16_t, WS_KR), INI(2), hf}; pg8::gemm_phase<EpiRopeQK<1>, SchedStd, false>(lds, wv, 1024, LD1K, LD1K, S, E); }
        { SchedStd S; S.T.init(4, 64, GRID, bid); S.A = (const char*)(win + 1024 * 1024); S.B = (const char*)xnh; S.sA = 256 * 2048; S.sB = 256 * 2048;
          EpiRopeKT E{WSP(bf16_t, WS_KT), INI(2), hf}; pg8::gemm_phase<EpiRopeKT, SchedStd, false>(lds, wv, 1024, LD1K, LD1K, S, E); }
        { SchedStd S; S.T.init(8, 64, GRID, bid); S.A = (const char*)(win + 2048 * 1024); S.B = (const char*)xnh; S.sA = 256 * 2048; S.sB = 256 * 2048;
          EpiVT E{WSP(bf16_t, WS_B2T)}; pg8::gemm_phase<EpiVT, SchedStd, false>(lds, wv, 1024, LD1K, LD1K, S, E); }
    }
    if constexpr (PH == PH_R3) {
        { SchedBatch S{(const char*)WSP(bf16_t, WS_A2), (const char*)WSP(bf16_t, WS_KR), 256 * 1024, 256 * 512, 0, 0, 256, 1, GRID, vcu};
          EpiS E{WSP(bf16_t, WS_A2)}; pg8::gemm_phase<EpiS, SchedBatch, false>(lds, wv, 256, 1024u, 512u, S, E); }
        { SchedBatch S{(const char*)(WSP(bf16_t, WS_B2T) + 256), (const char*)WSP(bf16_t, WS_KT), 512 * 1024, 256 * 512, 256 * 1024, 0, 256, 2, GRID, vcu};
          EpiKV E{WSP(bf16_t, WS_B2T)}; pg8::gemm_phase<EpiKV, SchedBatch, false>(lds, wv, 256, 1024u, 512u, S, E); }
    }
    if constexpr (PH == PH_R4) phase_prefix(C);
    if constexpr (PH == PH_R5) {
        SchedBatch S{(const char*)WSP(bf16_t, WS_A2), (const char*)WSP(bf16_t, WS_B2T), 256 * 1024, 512 * 1024, 0, 256 * 1024, 256, 2, GRID, vcu};
        EpiFin E{WSP(bf16_t, WS_B2T), WSP(float, WS_STATS)}; pg8::gemm_phase<EpiFin, SchedBatch, false>(lds, wv, 512, 1024u, 1024u, S, E);
    }
    if constexpr (PH == PH_R6) {
        SchedStd S; S.T.init(64, 8, GRID, bid); S.A = (const char*)xnh; S.B = (const char*)(win + 4096 * 1024); S.sA = 256 * 2048; S.sB = 256 * 2048;
        EpiGate E{WSP(bf16_t, WS_B2T), WSP(float, WS_STATS), WSP(bf16_t, WS_A2)}; pg8::gemm_phase<EpiGate, SchedStd, false>(lds, wv, 1024, LD1K, LD1K, S, E);
    }
    if constexpr (PH == PH_R7) {
        SchedStd S; S.T.init(64, 4, GRID, bid); S.A = (const char*)WSP(bf16_t, WS_A2); S.B = (const char*)(WSP(bf16_t, WS_WOUT) + (size_t)l * 1024 * 2048); S.sA = 256 * 4096; S.sB = 256 * 4096;
        EpiResid E{OUTP, gate1, hf * THALF}; pg8::gemm_phase<EpiResid, SchedStd, false>(lds, wv, 2048, 4096u, 4096u, S, E);
    }
    if constexpr (PH == PH_M2) {
        { SchedStd S; S.T.init(128, 1, GRID, bid); S.A = (const char*)WSP(bf16_t, WS_XN); S.B = (const char*)(WSP(bf16_t, WS_WQA) + (size_t)j * 256 * 1024); S.sA = 256 * 2048; S.sB = 256 * 2048;
          EpiQA E{WSP(bf16_t, WS_QA), WSP(float, WS_SSQ)}; pg8::gemm_phase<EpiQA, SchedStd, false>(lds, wv, 1024, LD1K, LD1K, S, E); }
        if (l == 2) { SchedStd S; S.T.init(128, 1, GRID, (bid + 128) & 255); S.A = (const char*)WSP(bf16_t, WS_HN); S.B = (const char*)WSP(bf16_t, WS_WKVA); S.sA = 256 * 2048; S.sB = 256 * 2048;
          EpiF32 E{WSP(float, WS_AKV)}; pg8::gemm_phase<EpiF32, SchedStd, false>(lds, wv, 1024, LD1K, LD1K, S, E); }
    }
    if constexpr (PH == PH_M3) {
        if (l == 2) phase_kvfin(C);
        SchedStd S; S.T.init(128, 6, GRID, bid); S.A = (const char*)WSP(bf16_t, WS_QA); S.B = (const char*)(WSP(bf16_t, WS_WQB) + (size_t)j * 1536 * 256); S.sA = 256 * 512; S.sB = 256 * 512;
        EpiQB E{WSP(bf16_t, WS_Q), WSP(float, WS_SSQ), INI(2)}; pg8::gemm_phase<EpiQB, SchedStd, false>(lds, wv, 256, 512u, 512u, S, E);
    }
    if constexpr (PH == PH_M4) {
        const int b = vcu >> 6, i = vcu & 63;
#pragma unroll 1
        for (int uq = 0; uq < 4; ++uq) { const int cch = (uq < 2) ? (127 - i) : i, half = uq & 1;
            att::attn_unit(WSP(bf16_t, WS_Q), WSP(bf16_t, WS_KP), WSP(bf16_t, WS_OL), b * SEQ + cch * 64 + half * 32, b * SEQ, cch + 1, (LAS char*)lds, wave); }
        __syncthreads();
    }
    if constexpr (PH == PH_M5) {
        SchedStd S; S.T.init(128, 4, GRID, bid); S.A = (const char*)WSP(bf16_t, WS_OL); S.B = (const char*)(WSP(bf16_t, WS_WO) + (size_t)j * 1024 * 1024); S.sA = 256 * 2048; S.sB = 256 * 2048;
        EpiResid E{OUTP, gate1, 0}; pg8::gemm_phase<EpiResid, SchedStd, false>(lds, wv, 1024, LD1K, LD1K, S, E);
    }
    if constexpr (PH == PH_NB) phase_norm_b(C, l);
    if constexpr (PH == PH_MOE1) {
        moe_tile_prefix(C, l);
        SchedMoE S{(const LAS int*)(lds + LDS_TAB), (const char*)WSP(bf16_t, WS_XN), (const char*)(WSP(bf16_t, WS_WGU) + (size_t)l * 16 * 1024 * 1024), (size_t)1024 * 2048, (size_t)256 * 2048, 0, WSP(int, WS_IDX), GRID, vcu, true};
        EpiGU E{WSP(bf16_t, WS_HDN)}; pg8::gemm_phase<EpiGU, SchedMoE, true>(lds, wv, 1024, LD1K, LD1K, S, E);
    }
    if constexpr (PH == PH_MOE2) {
        moe_tile_prefix(C, l);
        SchedMoE S{(const LAS int*)(lds + LDS_TAB), (const char*)WSP(bf16_t, WS_HDN), (const char*)(WSP(bf16_t, WS_WDN) + (size_t)l * 16 * 1024 * 512), (size_t)1024 * 1024, (size_t)256 * 1024, (size_t)256 * 1024, WSP(int, WS_IDX), GRID, vcu, false};
        EpiPlain E{WSP(bf16_t, WS_YB), 1024}; pg8::gemm_phase<EpiPlain, SchedMoE, false>(lds, wv, 512, 1024u, 1024u, S, E);
    }
}

template <int PH> __global__ void __launch_bounds__(NTHREADS, 2) phase_kernel(Args args) {
    extern __shared__ __attribute__((aligned(16))) unsigned char lds_raw[];
    Ctx C; make_ctx(C, lds_raw); (void)args;
    run_phase<PH>(C, args.l, args.hf);
}
__global__ void __launch_bounds__(NTHREADS, 2) fwd_kernel(Args args) {
    extern __shared__ __attribute__((aligned(16))) unsigned char lds_raw[];
    Ctx C; make_ctx(C, lds_raw); (void)args;
    if (threadIdx.x < 64) ((LAS unsigned*)(C.lds + LDS_MISC))[threadIdx.x] = 0u;
    __syncthreads();
    XcdBarrier bar = xcd_barrier_post((unsigned*)((unsigned char*)args.ws + WS_CTL) + CW_BAR, (volatile LAS unsigned*)(C.lds + LDS_MISC));
#define SEAM() xcd_barrier(bar, C.wave)
    run_phase<PH_PRO>(C, 0, 0); SEAM();
    for (int l = 0; l < 4; ++l) {
        run_phase<PH_NA>(C, l, 0); SEAM();
        if (l < 2) {
            for (int hf = 0; hf < 2; ++hf) {
                run_phase<PH_R2>(C, l, hf); SEAM(); run_phase<PH_R3>(C, l, hf); SEAM(); run_phase<PH_R4>(C, l, hf); SEAM();
                run_phase<PH_R5>(C, l, hf); SEAM(); run_phase<PH_R6>(C, l, hf); SEAM(); run_phase<PH_R7>(C, l, hf); SEAM();
            }
        } else {
            run_phase<PH_M2>(C, l, 0); SEAM(); run_phase<PH_M3>(C, l, 0); SEAM(); run_phase<PH_M4>(C, l, 0); SEAM(); run_phase<PH_M5>(C, l, 0); SEAM();
        }
        run_phase<PH_NB>(C, l, 0); SEAM(); run_phase<PH_MOE1>(C, l, 0); SEAM(); run_phase<PH_MOE2>(C, l, 0); SEAM();
    }
    run_phase<PH_NA>(C, 4, 0);
#undef SEAM
}

template <int PH> static void launch_phase(Args& a, int l, int hf, hipStream_t stream) {
    static bool attr = false;
    if (!attr) { (void)hipFuncSetAttribute((const void*)phase_kernel<PH>, hipFuncAttributeMaxDynamicSharedMemorySize, LDS_BYTES); attr = true; }
    a.l = l; a.hf = hf;
    hipLaunchKernelGGL(phase_kernel<PH>, dim3(GRID), dim3(NTHREADS), LDS_BYTES, stream, a);
}
extern "C" void kernel_launch(void* const* d_in, const int* in_sizes, int n_in, void* d_out, int out_size, void* d_ws, size_t ws_size, hipStream_t stream) {
    static int ok = 0;
    if (ok == 0) {
        if (n_in != 25 || out_size != NTOK * DM || ws_size < WS_END) { fprintf(stderr, "kernel_launch: unexpected problem (n_in %d, out %d, ws %zu < %zu)\n", n_in, out_size, ws_size, (size_t)WS_END); ok = -1; return; }
        int dev = 0, cus = 0;
        if (hipGetDevice(&dev) != hipSuccess || hipDeviceGetAttribute(&cus, hipDeviceAttributeMultiprocessorCount, dev) != hipSuccess || cus < GRID) { fprintf(stderr, "kernel_launch: needs %d CUs, device has %d\n", GRID, cus); ok = -1; return; }
        ok = 1;
    }
    if (ok < 0) return;
    (void)hipMemsetAsync((char*)d_ws + WS_CTL, 0, CTL_BYTES, stream);
    Args a{};
    for (int i = 0; i < 25; ++i) a.in[i] = d_in[i];
    a.out = (float*)d_out; a.ws = (unsigned char*)d_ws; a.lo = 0; a.hi = 0;
#if MK_SINGLE
    static bool attr = false;
    if (!attr) { (void)hipFuncSetAttribute((const void*)fwd_kernel, hipFuncAttributeMaxDynamicSharedMemorySize, LDS_BYTES); attr = true; }
    hipLaunchKernelGGL(fwd_kernel, dim3(GRID), dim3(NTHREADS), LDS_BYTES, stream, a);
    return;
#endif
    launch_phase<PH_PRO>(a, 0, 0, stream);
    for (int l = 0; l < 4; ++l) {
        launch_phase<PH_NA>(a, l, 0, stream);
        if (l < 2) {
            for (int hf = 0; hf < 2; ++hf) {
                launch_phase<PH_R2>(a, l, hf, stream); launch_phase<PH_R3>(a, l, hf, stream); launch_phase<PH_R4>(a, l, hf, stream);
                launch_phase<PH_R5>(a, l, hf, stream); launch_phase<PH_R6>(a, l, hf, stream); launch_phase<PH_R7>(a, l, hf, stream);
            }
        } else {
            launch_phase<PH_M2>(a, l, 0, stream); launch_phase<PH_M3>(a, l, 0, stream); launch_phase<PH_M4>(a, l, 0, stream); launch_phase<PH_M5>(a, l, 0, stream);
        }
        launch_phase<PH_NB>(a, l, 0, stream); launch_phase<PH_MOE1>(a, l, 0, stream); launch_phase<PH_MOE2>(a, l, 0, stream);
    }
    launch_phase<PH_NA>(a, 4, 0, stream);
}
```

```cpp
#define PROBE_PH -1
#define PROBE_N 0
#include <hip/hip_runtime.h>
#include <cstdio>
#include <cstdint>

#ifndef MK_SINGLE
#define MK_SINGLE 1
#endif
#ifndef MK_CHECK
#define MK_CHECK 0
#endif

#define GAS __attribute__((address_space(1)))
#define LAS __attribute__((address_space(3)))
typedef unsigned short bf16_t;
typedef short bf16x8 __attribute__((ext_vector_type(8)));
typedef short s16x4 __attribute__((ext_vector_type(4)));
typedef float f32x4 __attribute__((ext_vector_type(4)));
typedef float f32x2 __attribute__((ext_vector_type(2)));
typedef float f32x16 __attribute__((ext_vector_type(16)));
typedef unsigned u32x4 __attribute__((ext_vector_type(4)));
typedef unsigned u32x2 __attribute__((ext_vector_type(2)));

constexpr int NB = 4, SEQ = 8192, DM = 1024, NTOK = NB * SEQ, THALF = NTOK / 2;
constexpr int NEXP = 16, DEXP = 512;
constexpr int RH = 4, RDK = 256, RDV = 512, RV = 2048;
constexpr int MH = 8, QLORA = 256, KVL = 128, ROPE = 64, QKD = 192;
constexpr float EPS = 1e-6f;
constexpr int NWAVES = 8, NTHREADS = 512, GRID = 256;
constexpr int MAXSLOTS = 69632;

constexpr size_t MiB = 1u << 20;
constexpr size_t WS_CTL = 0, CTL_BYTES = 1 * MiB;
constexpr size_t WS_MOD = 1 * MiB;
constexpr size_t WS_ROUTE = 2 * MiB;
constexpr size_t WS_SSQ = 3 * MiB;
constexpr size_t WS_STATS = 4 * MiB;
constexpr size_t WS_IDX = 8 * MiB;
constexpr size_t WS_WIN = 10 * MiB;
constexpr size_t WS_WOUT = 34 * MiB;
constexpr size_t WS_WQA = 42 * MiB;
constexpr size_t WS_WKVA = 43 * MiB;
constexpr size_t WS_WQB = 44 * MiB;
constexpr size_t WS_WO = 46 * MiB;
constexpr size_t WS_WGU = 50 * MiB;
constexpr size_t WS_WDN = 178 * MiB;
constexpr size_t WS_XN = 242 * MiB;
constexpr size_t WS_L = 306 * MiB;
constexpr size_t WS_END = 690 * MiB;
constexpr size_t WS_A2 = WS_L, WS_KR = WS_L + 64 * MiB, WS_KT = WS_L + 96 * MiB, WS_B2T = WS_L + 128 * MiB;
constexpr size_t WS_HDN = WS_L, WS_YB = WS_L + 68 * MiB;
constexpr size_t WS_HN = WS_L, WS_QA = WS_L + 64 * MiB, WS_AKV = WS_L + 80 * MiB, WS_Q = WS_L + 112 * MiB, WS_OL = WS_L + 208 * MiB, WS_KP = WS_L + 300 * MiB;
constexpr int CW_BAR = 4096;
constexpr int CW_CNT = 16384;
constexpr int CW_CHK = 32768;

constexpr int LDS_STAGE = 131072;
constexpr int LDS_MISC = LDS_STAGE;
constexpr int LDS_TAB = LDS_STAGE + 256;
constexpr int LDS_BYTES = 147456;

#define LDS_WAIT() asm volatile("s_waitcnt lgkmcnt(0)" ::: "memory")
#define VM_WAIT() asm volatile("s_waitcnt vmcnt(0)" ::: "memory")
__device__ __forceinline__ unsigned cvt_pk_bf16(float lo, float hi) { unsigned r; asm volatile("v_cvt_pk_bf16_f32 %0, %1, %2" : "=v"(r) : "v"(lo), "v"(hi)); return r; }
__device__ __forceinline__ float bf2f(unsigned short b) { return __uint_as_float((unsigned)b << 16); }
__device__ __forceinline__ float bflo(unsigned w) { return __uint_as_float(w << 16); }
__device__ __forceinline__ float bfhi(unsigned w) { return __uint_as_float(w & 0xffff0000u); }
template <int CTRL> __device__ __forceinline__ float dpp_f(float v) { return __int_as_float(__builtin_amdgcn_mov_dpp(__float_as_int(v), CTRL, 0xf, 0xf, true)); }
__device__ __forceinline__ float rows_sum(float v) {
    { auto t = __builtin_amdgcn_permlane16_swap(__float_as_uint(v), __float_as_uint(v), false, false); v = __uint_as_float(t[0]) + __uint_as_float(t[1]); }
    { auto t = __builtin_amdgcn_permlane32_swap(__float_as_uint(v), __float_as_uint(v), false, false); v = __uint_as_float(t[0]) + __uint_as_float(t[1]); }
    return v;
}
__device__ __forceinline__ float wave_sum(float v) {
    v += dpp_f<0xB1>(v);
    v += dpp_f<0x4E>(v);
    v += dpp_f<0x141>(v);
    v += dpp_f<0x140>(v);
    return rows_sum(v);
}
__device__ __forceinline__ void sincos_rad(float ang, float& s, float& c) {
    float r = __builtin_amdgcn_fractf(ang * 0.15915494309189535f);
    s = __builtin_amdgcn_sinf(r); c = __builtin_amdgcn_cosf(r);
}
__device__ __forceinline__ float silu_f(float x) { return x / (1.0f + __expf(-x)); }
__device__ __forceinline__ float log2_gamma(int h) { return h == 0 ? -0.04580368961312479f : (h == 1 ? -0.02272007650008353f : (h == 2 ? -0.011315313227834146f : -0.005646563141142063f)); }
constexpr float LOG2_THETA = 13.287712379549449f;

__device__ __forceinline__ int lane_id() { return (int)__builtin_amdgcn_mbcnt_hi(~0u, __builtin_amdgcn_mbcnt_lo(~0u, 0u)); }
#define XB_TMO      128
#define XB_XCNT(j)  (256  + 64 * (j))
#define XB_XSUB(j)  (1280 + 64 * (j))
#define XB_XGEN(j)  (2304 + 64 * (j))
#define XB_TOP      3328
#define XB_TOPGEN   3392
#define XCD_BAR_WORDS 3456
#define XB_SPIN_CAP (1u << 18)
__device__ __forceinline__ unsigned xb_ld(unsigned* p)              { return __hip_atomic_load(p, __ATOMIC_RELAXED, __HIP_MEMORY_SCOPE_AGENT); }
__device__ __forceinline__ unsigned xb_add(unsigned* p, unsigned v) { return __hip_atomic_fetch_add(p, v, __ATOMIC_RELAXED, __HIP_MEMORY_SCOPE_AGENT); }
__device__ __forceinline__ unsigned xb_xcc_id() { return (unsigned)__builtin_amdgcn_s_getreg((3 << 11) | 20) & 0xFu; }
#define XB_SPIN(cond, bar) do { unsigned _sp = 0; while (cond) { __builtin_amdgcn_s_sleep(1); \
    if ((++_sp & 255u) == 0u) { if (xb_ld(&(bar)[XB_TMO])) break; if (_sp > XB_SPIN_CAP) { atomicAdd(&(bar)[XB_TMO], 1u); break; } } } } while (0)
struct XcdBarrier { unsigned* bar; unsigned x; volatile LAS unsigned* st; };
__device__ __forceinline__ XcdBarrier xcd_barrier_post(unsigned* bar, volatile LAS unsigned* st) {
    XcdBarrier b; b.bar = bar; b.x = xb_xcc_id(); b.st = st;
    if (threadIdx.x == 0) (void)xb_add(&bar[XB_XCNT(b.x)], 1u);
    return b;
}
__device__ __forceinline__ void xcd_barrier_complete(unsigned* bar, unsigned x, unsigned& nloc, unsigned& nx) {
    const unsigned G = gridDim.x * gridDim.y * gridDim.z;
    unsigned sum, cnt, mine, sp = 0u;
    for (;;) {
        sum = 0u; cnt = 0u; mine = 0u;
#pragma unroll
        for (unsigned j = 0; j < 16; ++j) { const unsigned c = xb_ld(&bar[XB_XCNT(j)]); sum += c; cnt += (c > 0u) ? 1u : 0u; mine = (j == x) ? c : mine; }
        if (sum == G) break;
        __builtin_amdgcn_s_sleep(1);
        if ((++sp & 255u) == 0u) { if (xb_ld(&bar[XB_TMO])) break; if (sp > XB_SPIN_CAP) { atomicAdd(&bar[XB_TMO], 1u); break; } }
    }
    nloc = mine > 0u ? mine : 1u; nx = cnt > 0u ? cnt : 1u;
}
__device__ __forceinline__ void xcd_barrier(const XcdBarrier& b, const int wave) {
    asm volatile("s_waitcnt vmcnt(0)" ::: "memory");
    __syncthreads();
    if (wave == 0 && lane_id() == 0) {
        unsigned* bar = b.bar; unsigned bx = b.x; asm volatile("" : "+s"(bar), "+s"(bx));
        __builtin_amdgcn_s_waitcnt(0);
        unsigned nloc = b.st[0], nx = b.st[1];
        if (nloc == 0u) { xcd_barrier_complete(bar, bx, nloc, nx); b.st[0] = nloc; b.st[1] = nx; }
        const unsigned old = xb_add(&bar[XB_XSUB(bx)], 1u);
        const unsigned gen = old / nloc;
        if (old + 1u == (gen + 1u) * nloc) {
            __builtin_amdgcn_fence(__ATOMIC_RELEASE, "agent");
            asm volatile("s_waitcnt vmcnt(0)" ::: "memory");
            const unsigned og = xb_add(&bar[XB_TOP], 1u);
            const unsigned tg = og / nx;
            if (og + 1u == (tg + 1u) * nx) xb_add(&bar[XB_TOPGEN], 1u);
            else XB_SPIN(xb_ld(&bar[XB_TOPGEN]) == tg, bar);
            __builtin_amdgcn_fence(__ATOMIC_ACQUIRE, "agent");
            xb_add(&bar[XB_XGEN(bx)], 1u);
            asm volatile("s_waitcnt vmcnt(0)" ::: "memory");
        } else {
            XB_SPIN(xb_ld(&bar[XB_XGEN(bx)]) == gen, bar);
            __builtin_amdgcn_fence(__ATOMIC_ACQUIRE, "agent");
            asm volatile("s_waitcnt vmcnt(0)" ::: "memory");
        }
    }
    __syncthreads();
}

namespace pg8 {
constexpr int BM = 256, BK = 64, HALF = 128, HTB = HALF * BK * 2, STAGE_BYTES = 8 * HTB;
__host__ __device__ __forceinline__ int lds_byte(int r, int c) { const int st = (r >> 4) * 2 + (c >> 5), rr = r & 15, cc = c & 31, ob = rr * 64 + cc * 2; return st * 1024 + (ob ^ (((ob >> 9) & 1) << 5)); }
__host__ __device__ __forceinline__ void stage_rc(int b, int& R, int& C) { const int st = b / 1024, sb = b % 1024, swz = sb ^ (((sb >> 9) & 1) << 5); R = (st >> 1) * 16 + swz / 64; C = (st & 1) * 32 + (swz % 64) / 2; }
__host__ __device__ __forceinline__ int perm32(int rho) { const int n = rho >> 4, i = rho & 15; return 8 * (i >> 2) + 4 * n + (i & 3); }

struct Unit { const char* A; const char* B; int pm, pn, aux; };

struct TileOrder {
    int nM, nN, nwg, G, c;
    __device__ void init(int nM_, int nN_, int G_, int c_) { nM = nM_; nN = nN_; nwg = nM * nN; G = G_; c = c_; }
    __device__ bool tile(int i, int& pm, int& pn) const {
        const long L = (long)i * G + c; if (L >= nwg) return false;
        int wgid = (int)L; { const int q = nwg / 8, r = nwg % 8, xcd = wgid % 8, off = wgid / 8; wgid = (xcd < r ? xcd * (q + 1) : r * (q + 1) + (xcd - r) * q) + off; }
        const int nig = 8 * nN, gid = wgid / nig, fm = gid * 8, gsz = (nM - fm) < 8 ? (nM - fm) : 8;
        pm = fm + ((wgid % nig) % gsz); pn = (wgid % nig) / gsz; return true;
    }
};

template <class Epi, class Sched, bool GATHER>
__device__ __forceinline__ void gemm_phase(LAS unsigned char* lds, const int wid, const int K, const unsigned lda, const unsigned ldb, const Sched& S, const Epi& E) {
    int lane_ = (int)__builtin_amdgcn_mbcnt_hi(~0u, __builtin_amdgcn_mbcnt_lo(~0u, 0u)); asm volatile("" : "+v"(lane_));
    const int lane = lane_, tid = wid * 64 + lane, wr = wid >> 2, wc = wid & 3, fr = lane & 15, fq = lane >> 4;
    const int nt = K / BK;
    unsigned voffA[2], voffB[2]; int RA[2], CA[2];
#pragma unroll
    for (int i = 0; i < 2; ++i) { int R, C; stage_rc(tid * 16 + i * 8192, R, C); const int Rb = Epi::PERM ? ((R & ~31) + perm32(R & 31)) : R;
        RA[i] = R; CA[i] = C; voffA[i] = (unsigned)R * lda + (unsigned)C * 2u; voffB[i] = (unsigned)Rb * ldb + (unsigned)C * 2u; }
    const size_t kstep = (size_t)(BK * 2);
    const size_t hstepA = (size_t)HALF * lda, hstepB = (size_t)HALF * ldb;
    const unsigned ldsw = (unsigned)wid * 1024u;
    const int aoff = lds_byte(wr * 64 + fr, fq * 8), boff = lds_byte(wc * 32 + fr, fq * 8);
#define PG8_SA(b, h) (((b) * 2 + (h)) * HTB)
#define PG8_SB(b, h) ((4 + (b) * 2 + (h)) * HTB)
#define PG8_GLDS(gp, bufoff, i) __builtin_amdgcn_global_load_lds((const unsigned*)(gp), (LAS unsigned*)(lds + (bufoff) + ldsw + (i) * 8192), 16, 0, 0)
#define PG8_STAGE_B(bufoff, gbase) do { _Pragma("unroll") for (int _i = 0; _i < 2; ++_i) PG8_GLDS((const char*)(gbase) + voffB[_i], bufoff, _i); } while (0)
#define PG8_STAGE_A(bufoff, gbase, h, GO) do { _Pragma("unroll") for (int _i = 0; _i < 2; ++_i) { \
        if constexpr (GATHER) PG8_GLDS((const char*)(gbase) + GO[h][_i], bufoff, _i); else PG8_GLDS((const char*)(gbase) + (size_t)(h) * hstepA + voffA[_i], bufoff, _i); } } while (0)
#define PG8_LDA(dst, b, h) do { _Pragma("unroll") for (int m = 0; m < 4; ++m) _Pragma("unroll") for (int k = 0; k < 2; ++k) dst[m][k] = *(const LAS bf16x8*)(lds + PG8_SA(b, h) + aoff + m * 2048 + k * 1024); } while (0)
#define PG8_LDB(dst, b, h) do { _Pragma("unroll") for (int n = 0; n < 2; ++n) _Pragma("unroll") for (int k = 0; k < 2; ++k) dst[n][k] = *(const LAS bf16x8*)(lds + PG8_SB(b, h) + boff + n * 2048 + k * 1024); } while (0)
#define PG8_MMA(ai, bj, At, Bt) do { __builtin_amdgcn_s_setprio(1); _Pragma("unroll") for (int m = 0; m < 4; ++m) _Pragma("unroll") for (int n = 0; n < 2; ++n) _Pragma("unroll") for (int k = 0; k < 2; ++k) \
        acc[ai][bj][m][n] = __builtin_amdgcn_mfma_f32_16x16x32_bf16(Bt[n][k], At[m][k], acc[ai][bj][m][n], 0, 0, 0); __builtin_amdgcn_s_setprio(0); } while (0)
#define PG8_WAIT_V(n) asm volatile("s_waitcnt vmcnt(" #n ")" ::: "memory")
#define PG8_WAIT_L(n) asm volatile("s_waitcnt lgkmcnt(" #n ")" ::: "memory")
#define PG8_BAR __builtin_amdgcn_s_barrier()
#define PG8_SCHED __builtin_amdgcn_sched_barrier(0)
    Unit cur, nxt; int ui = 0;
    if (!S.next(0, cur)) return;
    unsigned goff[2][2] = {{0u, 0u}, {0u, 0u}}, ngoff[2][2] = {{0u, 0u}, {0u, 0u}};
    if constexpr (GATHER) {
#pragma unroll
        for (int h = 0; h < 2; ++h)
#pragma unroll
            for (int i = 0; i < 2; ++i) goff[h][i] = (unsigned)S.tok(cur, h * HALF + RA[i]) * lda + (unsigned)CA[i] * 2u;
    }
    f32x4 acc[2][2][4][2];
#pragma unroll
    for (int a = 0; a < 2; ++a)
#pragma unroll
        for (int b = 0; b < 2; ++b)
#pragma unroll
            for (int m = 0; m < 4; ++m)
#pragma unroll
                for (int n = 0; n < 2; ++n) acc[a][b][m][n] = (f32x4){0.f, 0.f, 0.f, 0.f};
    bf16x8 At[4][2], B0[2][2], B1[2][2];
    const char* cA = cur.A; const char* cB = cur.B;
    PG8_STAGE_B(PG8_SB(0, 0), cB); PG8_STAGE_B(PG8_SB(0, 1), cB + hstepB); PG8_STAGE_A(PG8_SA(0, 0), cA, 0, goff); PG8_STAGE_A(PG8_SA(0, 1), cA, 1, goff);
    if (wr == 1) PG8_BAR;
    PG8_WAIT_V(2); PG8_BAR;
    PG8_STAGE_B(PG8_SB(1, 0), cB + kstep); PG8_STAGE_A(PG8_SA(1, 0), cA + kstep, 0, goff); PG8_STAGE_B(PG8_SB(1, 1), cB + hstepB + kstep);
    PG8_WAIT_V(6); PG8_BAR;
    for (;;) {
        const bool has_next = S.next(ui + 1, nxt);
        const char* nA = has_next ? nxt.A : cA; const char* nB = has_next ? nxt.B : cB;
        if constexpr (GATHER) {
#pragma unroll
            for (int h = 0; h < 2; ++h)
#pragma unroll
                for (int i = 0; i < 2; ++i) ngoff[h][i] = has_next ? (unsigned)S.tok(nxt, h * HALF + RA[i]) * lda + (unsigned)CA[i] * 2u : goff[h][i];
        }
#pragma unroll 1
        for (int t = 0; t < nt; t += 2) {
            const bool last = (t == nt - 2);
            const char* a1 = cA + (size_t)(t + 1) * kstep;
            const char* a2 = last ? nA : cA + (size_t)(t + 2) * kstep; const char* b2 = last ? nB : cB + (size_t)(t + 2) * kstep;
            const char* a3 = a2 + kstep; const char* b3 = b2 + kstep;
            unsigned g2[2][2];
#pragma unroll
            for (int h = 0; h < 2; ++h)
#pragma unroll
                for (int i = 0; i < 2; ++i) g2[h][i] = last ? ngoff[h][i] : goff[h][i];
            PG8_LDB(B0, 0, 0); PG8_LDB(B1, 0, 1); PG8_SCHED; PG8_LDA(At, 0, 0); PG8_STAGE_A(PG8_SA(1, 1), a1, 1, goff);
            PG8_WAIT_V(8); PG8_WAIT_L(0); PG8_BAR; PG8_MMA(0, 0, At, B0); PG8_MMA(0, 1, At, B1); PG8_BAR; PG8_SCHED;
            PG8_LDA(At, 0, 1); PG8_STAGE_B(PG8_SB(0, 0), b2); PG8_STAGE_B(PG8_SB(0, 1), b2 + hstepB); PG8_STAGE_A(PG8_SA(0, 0), a2, 0, g2);
            PG8_WAIT_V(8); PG8_WAIT_L(0); PG8_BAR; PG8_MMA(1, 0, At, B0); PG8_MMA(1, 1, At, B1); PG8_BAR; PG8_SCHED;
            PG8_LDB(B0, 1, 0); PG8_LDB(B1, 1, 1); PG8_SCHED; PG8_LDA(At, 1, 0); PG8_STAGE_A(PG8_SA(0, 1), a2, 1, g2);
            PG8_WAIT_V(8); PG8_WAIT_L(0); PG8_BAR; PG8_MMA(0, 0, At, B0); PG8_MMA(0, 1, At, B1); PG8_BAR; PG8_SCHED;
            PG8_LDA(At, 1, 1); PG8_STAGE_B(PG8_SB(1, 0), b3); PG8_STAGE_B(PG8_SB(1, 1), b3 + hstepB); PG8_STAGE_A(PG8_SA(1, 0), a3, 0, g2);
            PG8_WAIT_V(8); PG8_WAIT_L(0); PG8_BAR; PG8_MMA(1, 0, At, B0); PG8_MMA(1, 1, At, B1); PG8_BAR; PG8_SCHED;
        }
        if (wr == 0) PG8_BAR;
        { int fr2 = fr, fq2 = fq; asm volatile("" : "+v"(fr2), "+v"(fq2)); E(acc, cur, wr, wc, fr2, fq2); }
        if (!has_next) break;
#pragma unroll
        for (int a = 0; a < 2; ++a)
#pragma unroll
            for (int b = 0; b < 2; ++b)
#pragma unroll
                for (int m = 0; m < 4; ++m)
#pragma unroll
                    for (int n = 0; n < 2; ++n) acc[a][b][m][n] = (f32x4){0.f, 0.f, 0.f, 0.f};
        cur = nxt; cA = nA; cB = nB; ++ui;
        if constexpr (GATHER) {
#pragma unroll
            for (int h = 0; h < 2; ++h)
#pragma unroll
                for (int i = 0; i < 2; ++i) goff[h][i] = ngoff[h][i];
        }
        if (wr == 1) PG8_BAR;
    }
    PG8_WAIT_V(0);
    PG8_BAR;
#undef PG8_SA
#undef PG8_SB
#undef PG8_GLDS
#undef PG8_STAGE_A
#undef PG8_STAGE_B
#undef PG8_LDA
#undef PG8_LDB
#undef PG8_MMA
#undef PG8_WAIT_V
#undef PG8_WAIT_L
#undef PG8_BAR
#undef PG8_SCHED
}
}
__device__ __forceinline__ const char* uni_ptr(const char* p) {
    unsigned long long v = (unsigned long long)p; unsigned lo = __builtin_amdgcn_readfirstlane((unsigned)v), hi = __builtin_amdgcn_readfirstlane((unsigned)(v >> 32));
    return (const char*)(((unsigned long long)hi << 32) | lo);
}
struct SchedStd {
    pg8::TileOrder T; const char* A; const char* B; size_t sA, sB;
    __device__ __forceinline__ bool next(int i, pg8::Unit& u) const { int pm, pn; if (!T.tile(i, pm, pn)) return false; u.pm = pm; u.pn = pn; u.aux = 0; u.A = A + (size_t)pm * sA; u.B = B + (size_t)pn * sB; return true; }
    __device__ __forceinline__ int tok(const pg8::Unit&, int) const { return 0; }
};
struct SchedBatch {
    const char* A; const char* B; size_t sA, sB, vA, vB; int nunits, nvt, G, c;
    __device__ __forceinline__ bool next(int i, pg8::Unit& u) const { const int L = i * G + c; if (L >= nunits * nvt) return false; const int uu = L / nvt, vt = L % nvt; u.pm = uu; u.pn = vt; u.aux = 0;
        u.A = A + (size_t)uu * sA + (size_t)vt * vA; u.B = B + (size_t)uu * sB + (size_t)vt * vB; return true; }
    __device__ __forceinline__ int tok(const pg8::Unit&, int) const { return 0; }
};
struct SchedMoE {
    const LAS int* tab; const char* A; const char* Bw; size_t sE, sPN, sRT; const int* idx; int G, c; bool gather;
    __device__ __forceinline__ bool next(int i, pg8::Unit& u) const {
        const int L = i * G + c, rt = L >> 2, pn = L & 3;
        const int ntile = __builtin_amdgcn_readfirstlane(tab[32]); if (rt >= ntile) return false;
        int e = 0;
#pragma unroll
        for (int k = 1; k < 16; ++k) e += (rt >= __builtin_amdgcn_readfirstlane(tab[16 + k])) ? 1 : 0;
        u.pm = rt; u.pn = pn; u.aux = e; u.A = gather ? A : A + (size_t)rt * sRT; u.B = Bw + (size_t)e * sE + (size_t)pn * sPN; return true;
    }
    __device__ __forceinline__ int tok(const pg8::Unit& u, int r) const {
        const int e = u.aux, p = (u.pm - __builtin_amdgcn_readfirstlane(tab[16 + e])) * 256 + r, n = __builtin_amdgcn_readfirstlane(tab[e]);
        return p < n ? idx[e * NTOK + p] : 0;
    }
};

typedef const f32x4 (&AccRef)[2][2][4][2];
__device__ __forceinline__ int launder(int x) { asm volatile("" : "+v"(x)); return x; }
__device__ __forceinline__ void st8(bf16_t* p, f32x4 v0, f32x4 v1) {
    u32x4 w; w.x = cvt_pk_bf16(v0[0], v0[1]); w.y = cvt_pk_bf16(v0[2], v0[3]); w.z = cvt_pk_bf16(v1[0], v1[1]); w.w = cvt_pk_bf16(v1[2], v1[3]); *(u32x4*)p = w;
}
struct EpiPlain {
    static constexpr bool PERM = true; bf16_t* out; int ld;
    __device__ __forceinline__ void operator()(AccRef acc, const pg8::Unit& u, int wr, int wc, int fr, int fq) const {
#pragma unroll
        for (int ai = 0; ai < 2; ++ai)
#pragma unroll
            for (int m = 0; m < 4; ++m) { const int r = ai * 128 + wr * 64 + m * 16 + fr; bf16_t* rp = out + (size_t)(u.pm * 256 + r) * ld + u.pn * 256 + wc * 32 + fq * 8;
#pragma unroll
                for (int bj = 0; bj < 2; ++bj) st8(rp + bj * 128, acc[ai][bj][m][0], acc[ai][bj][m][1]); }
    }
};
template <int MODE> struct EpiRopeQK {
    static constexpr bool PERM = true; bf16_t* out; const int* pos; int half;
    __device__ __forceinline__ void operator()(AccRef acc, const pg8::Unit& u, int wr, int wc, int fr, int fq) const {
        const int pm = u.pm, h = u.pn, uu = ((pm >> 5) * 4 + h) * 32 + (pm & 31); const float l2g = log2_gamma(h);
        constexpr int LD = MODE == 0 ? 512 : 256;
        float inv[8]; const int f0 = launder(wc * 32 + fq * 8);
#pragma unroll
        for (int k = 0; k < 8; ++k) inv[k] = __builtin_amdgcn_exp2f(-(float)(f0 + k) * (LOG2_THETA / 128.0f));
#pragma unroll
        for (int ai = 0; ai < 2; ++ai)
#pragma unroll
            for (int m = 0; m < 4; ++m) { const int r = ai * 128 + wr * 64 + m * 16 + fr; const float p = (float)pos[half * THALF + pm * 256 + r];
                const float dec = MODE == 0 ? __builtin_amdgcn_exp2f((float)r * l2g) : __builtin_amdgcn_exp2f(-(float)r * l2g) * 0.0625f;
                f32x4 o1[2], o2[2];
#pragma unroll
                for (int n = 0; n < 2; ++n)
#pragma unroll
                    for (int j = 0; j < 4; ++j) { float s, c; sincos_rad(p * inv[n * 4 + j], s, c); const float x1 = acc[ai][0][m][n][j], x2 = acc[ai][1][m][n][j];
                        o1[n][j] = (x1 * c - x2 * s) * dec; o2[n][j] = (x1 * s + x2 * c) * dec; }
                bf16_t* rp = out + (size_t)uu * (256 * LD) + (size_t)r * LD + wc * 32 + fq * 8;
                st8(rp, o1[0], o1[1]); st8(rp + 128, o2[0], o2[1]); __builtin_amdgcn_sched_barrier(0); }
    }
};
struct EpiRopeKT {
    static constexpr bool PERM = true; bf16_t* out; const int* pos; int half;
    __device__ __forceinline__ void operator()(AccRef acc, const pg8::Unit& u, int wr, int wc, int fr, int fq) const {
        const int h = u.pm, pn = u.pn, uu = ((pn >> 5) * 4 + h) * 32 + (pn & 31); const float l2g = log2_gamma(h);
        float pp[2][8], dec[2][8]; const int c00 = launder(wc * 32 + fq * 8), i00 = launder(wr * 64 + fr);
#pragma unroll
        for (int bj = 0; bj < 2; ++bj)
#pragma unroll
            for (int k = 0; k < 8; ++k) { const int c = bj * 128 + c00 + k; pp[bj][k] = (float)pos[half * THALF + pn * 256 + c]; dec[bj][k] = __builtin_amdgcn_exp2f(-(float)c * l2g) * 0.0625f; }
#pragma unroll
        for (int m = 0; m < 4; ++m) { const int i = i00 + m * 16; const float inv = __builtin_amdgcn_exp2f(-(float)i * (LOG2_THETA / 128.0f));
#pragma unroll
            for (int bj = 0; bj < 2; ++bj) { f32x4 o1[2], o2[2];
#pragma unroll
                for (int n = 0; n < 2; ++n)
#pragma unroll
                    for (int j = 0; j < 4; ++j) { float s, c; sincos_rad(pp[bj][n * 4 + j] * inv, s, c); const float x1 = acc[0][bj][m][n][j], x2 = acc[1][bj][m][n][j], d = dec[bj][n * 4 + j];
                        o1[n][j] = (x1 * c - x2 * s) * d; o2[n][j] = (x1 * s + x2 * c) * d; }
                bf16_t* rp = out + (size_t)uu * 65536 + (size_t)i * 256 + bj * 128 + c00;
                st8(rp, o1[0], o1[1]); st8(rp + 128 * 256, o2[0], o2[1]); __builtin_amdgcn_sched_barrier(0); } }
    }
};
struct EpiVT {
    static constexpr bool PERM = true; bf16_t* out;
    __device__ __forceinline__ void operator()(AccRef acc, const pg8::Unit& u, int wr, int wc, int fr, int fq) const {
        const int h = u.pm >> 1, vt = u.pm & 1, pn = u.pn, uu = ((pn >> 5) * 4 + h) * 32 + (pn & 31);
#pragma unroll
        for (int ai = 0; ai < 2; ++ai)
#pragma unroll
            for (int m = 0; m < 4; ++m) { const int r = ai * 128 + wr * 64 + m * 16 + fr; bf16_t* rp = out + (size_t)uu * 262144 + (size_t)(vt * 256 + r) * 512 + 256 + wc * 32 + fq * 8;
#pragma unroll
                for (int bj = 0; bj < 2; ++bj) st8(rp + bj * 128, acc[ai][bj][m][0], acc[ai][bj][m][1]); }
    }
};
struct EpiS {
    static constexpr bool PERM = true; bf16_t* out;
    __device__ __forceinline__ void operator()(AccRef acc, const pg8::Unit& u, int wr, int wc, int fr, int fq) const {
        const int uu = u.pm;
#pragma unroll
        for (int ai = 0; ai < 2; ++ai)
#pragma unroll
            for (int m = 0; m < 4; ++m) { const int r = ai * 128 + wr * 64 + m * 16 + fr; bf16_t* rp = out + (size_t)uu * 131072 + (size_t)r * 512 + 256 + wc * 32 + fq * 8;
#pragma unroll
                for (int bj = 0; bj < 2; ++bj) { const int c0 = bj * 128 + wc * 32 + fq * 8; f32x4 v0 = acc[ai][bj][m][0], v1 = acc[ai][bj][m][1];
#pragma unroll
                    for (int j = 0; j < 4; ++j) { if (c0 + j > r) v0[j] = 0.f; if (c0 + 4 + j > r) v1[j] = 0.f; }
                    st8(rp + bj * 128, v0, v1); } }
    }
};
struct EpiKV {
    static constexpr bool PERM = true; bf16_t* out;
    __device__ __forceinline__ void operator()(AccRef acc, const pg8::Unit& u, int wr, int wc, int fr, int fq) const {
        const int uu = u.pm, vt = u.pn, h = (uu >> 5) & 3; const float sc = __builtin_amdgcn_exp2f(255.0f * log2_gamma(h));
#pragma unroll
        for (int ai = 0; ai < 2; ++ai)
#pragma unroll
            for (int m = 0; m < 4; ++m) { const int r = ai * 128 + wr * 64 + m * 16 + fr; bf16_t* rp = out + (size_t)uu * 262144 + (size_t)(vt * 256 + r) * 512 + wc * 32 + fq * 8;
#pragma unroll
                for (int bj = 0; bj < 2; ++bj) st8(rp + bj * 128, acc[ai][bj][m][0] * sc, acc[ai][bj][m][1] * sc); }
    }
};
struct EpiFin {
    static constexpr bool PERM = true; bf16_t* out; float* stats;
    __device__ __forceinline__ void operator()(AccRef acc, const pg8::Unit& u, int wr, int wc, int fr, int fq) const {
        const int uu = u.pm, vt = u.pn, bl = uu >> 7, h = (uu >> 5) & 3, ch = uu & 31;
#pragma unroll
        for (int ai = 0; ai < 2; ++ai)
#pragma unroll
            for (int m = 0; m < 4; ++m) { const int r = ai * 128 + wr * 64 + m * 16 + fr; bf16_t* rp = out + (size_t)uu * 262144 + (size_t)(vt * 256 + r) * 512 + wc * 32 + fq * 8;
                float s = 0.f, q = 0.f;
#pragma unroll
                for (int bj = 0; bj < 2; ++bj) { const f32x4 v0 = acc[ai][bj][m][0], v1 = acc[ai][bj][m][1];
                    s += (v0[0] + v0[1]) + (v0[2] + v0[3]) + (v1[0] + v1[1]) + (v1[2] + v1[3]);
                    q += (v0[0] * v0[0] + v0[1] * v0[1]) + (v0[2] * v0[2] + v0[3] * v0[3]) + (v1[0] * v1[0] + v1[1] * v1[1]) + (v1[2] * v1[2] + v1[3] * v1[3]);
                    st8(rp + bj * 128, v0, v1); }
                s = rows_sum(s); q = rows_sum(q);
                const int tokl = bl * SEQ + ch * 256 + r;
                if (fq == 0) *(f32x2*)(stats + ((size_t)(tokl * 4 + h) * 8 + vt * 4 + wc) * 2) = (f32x2){s, q}; }
    }
};
struct EpiGate {
    static constexpr bool PERM = true; const bf16_t* o; const float* stats; bf16_t* y;
    __device__ __forceinline__ void operator()(AccRef acc, const pg8::Unit& u, int wr, int wc, int fr, int fq) const {
        const int pm = u.pm, h = u.pn >> 1, vt = u.pn & 1, uu = ((pm >> 5) * 4 + h) * 32 + (pm & 31);
#pragma unroll
        for (int ai = 0; ai < 2; ++ai)
#pragma unroll
            for (int m = 0; m < 4; ++m) { const int r = ai * 128 + wr * 64 + m * 16 + fr, tokl = pm * 256 + r;
                const f32x4* sp = (const f32x4*)(stats + (size_t)(tokl * 4 + h) * 16); const f32x4 a = sp[0], b = sp[1], c = sp[2], d = sp[3];
                const float mean = ((a[0] + a[2]) + (b[0] + b[2]) + (c[0] + c[2]) + (d[0] + d[2])) * (1.0f / 512.0f);
                const float ex2 = ((a[1] + a[3]) + (b[1] + b[3]) + (c[1] + c[3]) + (d[1] + d[3])) * (1.0f / 512.0f);
                const float rstd = __builtin_amdgcn_rsqf(fmaxf(ex2 - mean * mean, 0.f) + EPS);
                const bf16_t* op = o + (size_t)uu * 262144 + (size_t)(vt * 256 + r) * 512 + wc * 32 + fq * 8;
                bf16_t* yp = y + (size_t)tokl * 2048 + h * 512 + vt * 256 + wc * 32 + fq * 8;
#pragma unroll
                for (int bj = 0; bj < 2; ++bj) { const u32x4 ow = *(const u32x4*)(op + bj * 128); const f32x4 g0 = acc[ai][bj][m][0], g1 = acc[ai][bj][m][1];
                    f32x4 y0, y1;
                    y0[0] = silu_f(g0[0]) * (bflo(ow.x) - mean) * rstd; y0[1] = silu_f(g0[1]) * (bfhi(ow.x) - mean) * rstd; y0[2] = silu_f(g0[2]) * (bflo(ow.y) - mean) * rstd; y0[3] = silu_f(g0[3]) * (bfhi(ow.y) - mean) * rstd;
                    y1[0] = silu_f(g1[0]) * (bflo(ow.z) - mean) * rstd; y1[1] = silu_f(g1[1]) * (bfhi(ow.z) - mean) * rstd; y1[2] = silu_f(g1[2]) * (bflo(ow.w) - mean) * rstd; y1[3] = silu_f(g1[3]) * (bfhi(ow.w) - mean) * rstd;
                    st8(yp + bj * 128, y0, y1); } __builtin_amdgcn_sched_barrier(0); }
    }
};
struct EpiResid {
    static constexpr bool PERM = false; float* h; const float* gate; int tok0;
    __device__ __forceinline__ void operator()(AccRef acc, const pg8::Unit& u, int wr, int wc, int fr, int fq) const {
#pragma unroll
        for (int ai = 0; ai < 2; ++ai)
#pragma unroll
            for (int m = 0; m < 4; ++m) { const int row = tok0 + u.pm * 256 + ai * 128 + wr * 64 + m * 16 + fr, b = row >> 13;
#pragma unroll
                for (int bj = 0; bj < 2; ++bj)
#pragma unroll
                    for (int n = 0; n < 2; ++n) { const int c = u.pn * 256 + bj * 128 + wc * 32 + n * 16 + fq * 4; const f32x4 gv = *(const f32x4*)(gate + b * 6144 + c);
                        f32x4* hp = (f32x4*)(h + (size_t)row * DM + c); *hp = *hp + gv * acc[ai][bj][m][n]; } }
    }
};
struct EpiGU {
    static constexpr bool PERM = true; bf16_t* hdn;
    __device__ __forceinline__ void operator()(AccRef acc, const pg8::Unit& u, int wr, int wc, int fr, int fq) const {
#pragma unroll
        for (int ai = 0; ai < 2; ++ai)
#pragma unroll
            for (int m = 0; m < 4; ++m) { const int r = ai * 128 + wr * 64 + m * 16 + fr; f32x4 o0, o1;
#pragma unroll
                for (int j = 0; j < 4; ++j) { o0[j] = silu_f(acc[ai][0][m][0][j]) * acc[ai][1][m][0][j]; o1[j] = silu_f(acc[ai][0][m][1][j]) * acc[ai][1][m][1][j]; }
                st8(hdn + (size_t)(u.pm * 256 + r) * DEXP + u.pn * 128 + wc * 32 + fq * 8, o0, o1); }
    }
};
struct EpiQA {
    static constexpr bool PERM = true; bf16_t* out; float* ssq;
    __device__ __forceinline__ void operator()(AccRef acc, const pg8::Unit& u, int wr, int wc, int fr, int fq) const {
#pragma unroll
        for (int ai = 0; ai < 2; ++ai)
#pragma unroll
            for (int m = 0; m < 4; ++m) { const int row = u.pm * 256 + ai * 128 + wr * 64 + m * 16 + fr; bf16_t* rp = out + (size_t)row * 256 + wc * 32 + fq * 8; float q = 0.f;
#pragma unroll
                for (int bj = 0; bj < 2; ++bj) { const f32x4 v0 = acc[ai][bj][m][0], v1 = acc[ai][bj][m][1];
                    q += (v0[0] * v0[0] + v0[1] * v0[1]) + (v0[2] * v0[2] + v0[3] * v0[3]) + (v1[0] * v1[0] + v1[1] * v1[1]) + (v1[2] * v1[2] + v1[3] * v1[3]);
                    st8(rp + bj * 128, v0, v1); }
                q = rows_sum(q);
                if (fq == 0) ssq[(size_t)row * 4 + wc] = q; }
    }
};
struct EpiF32 {
    static constexpr bool PERM = false; float* out;
    __device__ __forceinline__ void operator()(AccRef acc, const pg8::Unit& u, int wr, int wc, int fr, int fq) const {
#pragma unroll
        for (int ai = 0; ai < 2; ++ai)
#pragma unroll
            for (int m = 0; m < 4; ++m) { const int row = u.pm * 256 + ai * 128 + wr * 64 + m * 16 + fr;
#pragma unroll
                for (int bj = 0; bj < 2; ++bj)
#pragma unroll
                    for (int n = 0; n < 2; ++n) *(f32x4*)(out + (size_t)row * 256 + bj * 128 + wc * 32 + n * 16 + fq * 4) = acc[ai][bj][m][n]; }
    }
};
struct EpiQB {
    static constexpr bool PERM = true; bf16_t* Q; const float* ssq; const int* pos;
    __device__ __forceinline__ void operator()(AccRef acc, const pg8::Unit& u, int wr, int wc, int fr, int fq) const {
        constexpr float QS = 0.10411754627697264f;
        const int pn = u.pn;
        float inv[8]; const int f0 = launder(fq * 8);
#pragma unroll
        for (int k = 0; k < 8; ++k) inv[k] = __builtin_amdgcn_exp2f(-(float)(f0 + k) * (LOG2_THETA / 32.0f));
#pragma unroll
        for (int ai = 0; ai < 2; ++ai)
#pragma unroll
            for (int m = 0; m < 4; ++m) { const int row = u.pm * 256 + ai * 128 + wr * 64 + m * 16 + fr; const f32x4 sq = *(const f32x4*)(ssq + (size_t)row * 4);
                const float rs = __builtin_amdgcn_rsqf(((sq[0] + sq[1]) + (sq[2] + sq[3])) * (1.0f / 256.0f) + EPS) * QS;
                if (pn < 4) {
#pragma unroll
                    for (int bj = 0; bj < 2; ++bj) st8(Q + (size_t)row * 1536 + (2 * pn + bj) * QKD + wc * 32 + fq * 8, acc[ai][bj][m][0] * rs, acc[ai][bj][m][1] * rs);
                } else {
                    const float p = (float)pos[row]; f32x4 o1[2], o2[2];
#pragma unroll
                    for (int n = 0; n < 2; ++n)
#pragma unroll
                        for (int j = 0; j < 4; ++j) { float s, c; sincos_rad(p * inv[n * 4 + j], s, c); const float x1 = acc[ai][0][m][n][j] * rs, x2 = acc[ai][1][m][n][j] * rs;
                            o1[n][j] = x1 * c - x2 * s; o2[n][j] = x1 * s + x2 * c; }
                    bf16_t* qp = Q + (size_t)row * 1536 + (4 * (pn - 4) + wc) * QKD + 128 + fq * 8;
                    st8(qp, o1[0], o1[1]); st8(qp + 32, o2[0], o2[1]); } __builtin_amdgcn_sched_barrier(0); }
    }
};
typedef const char __attribute__((address_space(4)))* kaptr_t;
struct Ctx { kaptr_t ka; LAS unsigned char* lds; int wave, vcu; };
__device__ __forceinline__ const void* ld_ka(kaptr_t ka, int off) { return *(const void* const __attribute__((address_space(4)))*)(ka + off); }
#define INF(k) ((const float*)ld_ka(ka, (k) * 8))
#define INI(k) ((const int*)ld_ka(ka, (k) * 8))
#define OUTP ((float*)ld_ka(ka, 200))
#define WSB ((unsigned char*)ld_ka(ka, 208))
#define CTLP ((unsigned*)(WSB + WS_CTL))
#define PHASE_ENTRY() kaptr_t ka = C.ka; asm volatile("" : "+s"(ka)); int lane_ = lane_id(); asm volatile("" : "+v"(lane_)); int wave_ = C.wave, vcu_ = C.vcu; asm volatile("" : "+s"(wave_), "+s"(vcu_)); \
    const int lane = lane_, wave = wave_, vcu = vcu_, tid = wave * 64 + lane; LAS unsigned char* const ldsb = C.lds; (void)tid; (void)lane; (void)vcu; (void)ldsb
#define WSP(T, off) ((T*)(WSB + (off)))

__device__ __forceinline__ void transpose_block(const float* W, int N, int k0, int n0, bf16_t* dst, int ldd, int drow, LAS float* scr, int lane) {
#pragma unroll 8
    for (int i = 0; i < 32; ++i) { const int kk = 2 * i + (lane >> 5); scr[kk * 33 + (lane & 31)] = W[(size_t)(k0 + kk) * N + n0 + (lane & 31)]; }
    LDS_WAIT(); asm volatile("" ::: "memory");
    const int c = lane & 7;
#pragma unroll
    for (int j = 0; j < 4; ++j) { const int n = (lane >> 3) + 8 * j; const LAS float* s = scr + (8 * c) * 33 + n;
        u32x4 o; o.x = cvt_pk_bf16(s[0 * 33], s[1 * 33]); o.y = cvt_pk_bf16(s[2 * 33], s[3 * 33]); o.z = cvt_pk_bf16(s[4 * 33], s[5 * 33]); o.w = cvt_pk_bf16(s[6 * 33], s[7 * 33]);
        *(u32x4*)(dst + (size_t)(drow + n) * ldd + k0 + 8 * c) = o; }
    LDS_WAIT(); asm volatile("" ::: "memory");
}
__device__ __forceinline__ void phase_prologue(Ctx& C) {
    PHASE_ENTRY();
    LAS float* cact = (LAS float*)ldsb;
    LAS float* red = (LAS float*)(ldsb + 16384);
    for (int i = tid; i < 4096; i += NTHREADS) cact[i] = silu_f(INF(1)[i]);
    __syncthreads();
    float* mod = WSP(float, WS_MOD);
    for (int g = vcu; g < 416; g += GRID) {
        const int col = g * 64 + lane; const float* W; int N, cc; const float* bias; float* dst; int dstride;
        if (col < 24576) { const int l = col / 6144; cc = col - l * 6144; W = INF(3) + (size_t)l * 1024 * 6144; N = 6144; bias = INF(4) + l * 6144; dst = mod + (size_t)l * 4 * 6144; dstride = 6144; }
        else { cc = col - 24576; W = INF(9); N = 2048; bias = INF(10); dst = mod + 4 * 4 * 6144; dstride = 2048; }
        float a0 = 0.f, a1 = 0.f, a2 = 0.f, a3 = 0.f;
        const float* wp = W + (size_t)(wave * 128) * N + cc;
#pragma unroll 16
        for (int k = 0; k < 128; ++k) { const float w = wp[(size_t)k * N]; const int kk = wave * 128 + k; a0 += cact[kk] * w; a1 += cact[1024 + kk] * w; a2 += cact[2048 + kk] * w; a3 += cact[3072 + kk] * w; }
        red[(wave * 4 + 0) * 64 + lane] = a0; red[(wave * 4 + 1) * 64 + lane] = a1; red[(wave * 4 + 2) * 64 + lane] = a2; red[(wave * 4 + 3) * 64 + lane] = a3;
        __syncthreads();
        if (tid < 256) { const int b = tid >> 6, ln = tid & 63; float s = 0.f;
#pragma unroll
            for (int w = 0; w < 8; ++w) s += red[(w * 4 + b) * 64 + ln];
            const int c2 = g * 64 + ln; const int cc2 = c2 < 24576 ? c2 % 6144 : c2 - 24576;
            dst[(size_t)b * dstride + cc2] = s + bias[cc2]; }
        __syncthreads();
    }
    LAS float* scr = (LAS float*)(ldsb + wave * 16384);
    const int gw = vcu * NWAVES + wave, NGW = GRID * NWAVES;
    constexpr int NIT = 8544 + 64 * 768;
    for (int it = gw; it < NIT; it += NGW) {
        if (it < 6144) { const int l = it / 3072, r = it % 3072, kb = r / 192, nb = r % 192;
            transpose_block(INF(7) + (size_t)l * 1024 * 6144, 6144, 64 * kb, 32 * nb, WSP(bf16_t, WS_WIN) + (size_t)l * 6144 * 1024, 1024, 32 * nb, scr, lane); }
        else if (it < 8192) { const int r0 = it - 6144, l = r0 / 1024, r = r0 % 1024, kb = r / 32, nb = r % 32;
            transpose_block(INF(8) + (size_t)l * 2048 * 1024, 1024, 64 * kb, 32 * nb, WSP(bf16_t, WS_WOUT) + (size_t)l * 1024 * 2048, 2048, 32 * nb, scr, lane); }
        else if (it < 8448) { const int r0 = it - 8192, j = r0 / 128, r = r0 % 128, kb = r / 8, nb = r % 8;
            transpose_block(INF(15) + (size_t)j * 1024 * 256, 256, 64 * kb, 32 * nb, WSP(bf16_t, WS_WQA) + (size_t)j * 256 * 1024, 1024, 32 * nb, scr, lane); }
        else if (it < 8544) { const int r = it - 8448, kb = r / 6, nb = r % 6;
            transpose_block(INF(12), 192, 64 * kb, 32 * nb, WSP(bf16_t, WS_WKVA), 1024, 32 * nb, scr, lane); }
        else { const int r0 = it - 8544, le = r0 / 768, r = r0 % 768;
            if (r < 512) { const int up = r >> 8, rr = r & 255, kb = rr / 16, nb = rr % 16, n0 = 32 * nb;
                transpose_block((up ? INF(22) : INF(21)) + (size_t)le * 1024 * 512, 512, 64 * kb, n0, WSP(bf16_t, WS_WGU) + (size_t)le * 1024 * 1024, 1024, (n0 >> 7) * 256 + (n0 & 127) + up * 128, scr, lane); }
            else { const int rr = r - 512, kb = rr / 32, nb = rr % 32;
                transpose_block(INF(23) + (size_t)le * 512 * 1024, 1024, 64 * kb, 32 * nb, WSP(bf16_t, WS_WDN) + (size_t)le * 1024 * 512, 512, 32 * nb, scr, lane); } }
    }
    const int gt = vcu * NTHREADS + tid, NGT = GRID * NTHREADS;
    for (int i = gt; i < 64 * 1024 / 8; i += NGT) *(u32x4*)(WSP(bf16_t, WS_WKVA) + 192 * 1024 + (size_t)i * 8) = (u32x4){0u, 0u, 0u, 0u};
    for (int i = gt; i < 2 * 1536 * 256; i += NGT) {
        const int k = i & 255, n = (i >> 8) % 1536, j = i / (1536 * 256);
        const float* wq = INF(17) + ((size_t)j * 256 + k) * 1536; float v;
        if (n < 1024) { const int head = n >> 7, cdim = n & 127; const float* a = wq + head * QKD; const float* b = INF(14) + (size_t)cdim * 2048 + head * 256; float s = 0.f;
#pragma unroll 8
            for (int d = 0; d < 128; d += 4) { const f32x4 av = *(const f32x4*)(a + d), bv = *(const f32x4*)(b + d); s += av[0] * bv[0] + av[1] * bv[1] + av[2] * bv[2] + av[3] * bv[3]; }
            v = s; }
        else { const int np = (n - 1024) & 255, pn = (n - 1024) >> 8, half = np >> 7, wcc = (np & 127) >> 5, ii = np & 31; v = wq[(4 * pn + wcc) * QKD + 128 + half * 32 + ii]; }
        v *= INF(16)[j * 256 + k];
        WSP(bf16_t, WS_WQB)[i] = (bf16_t)(cvt_pk_bf16(v, 0.f) & 0xffffu);
    }
    for (int it = vcu * NWAVES + wave; it < 2 * 8 * 16 * 4; it += GRID * NWAVES) {
        const int nq = it & 3, cb = (it >> 2) & 15, hh = (it >> 6) & 7, j = it >> 9, n0 = nq * 256 + 4 * lane, c0 = cb * 8;
        const float* a = INF(14) + (size_t)c0 * 2048 + hh * 256 + 128; const float* bq = INF(18) + ((size_t)j * 1024 + hh * 128) * 1024 + n0;
        f32x4 acc[8];
#pragma unroll
        for (int c = 0; c < 8; ++c) acc[c] = (f32x4){0.f, 0.f, 0.f, 0.f};
#pragma unroll 4
        for (int v = 0; v < 128; ++v) { const f32x4 bv = *(const f32x4*)(bq + (size_t)v * 1024);
#pragma unroll
            for (int c = 0; c < 8; ++c) acc[c] = acc[c] + bv * a[(size_t)c * 2048 + v]; }
        bf16_t* o = WSP(bf16_t, WS_WO) + ((size_t)j * 1024 + n0) * 1024 + hh * 128 + c0;
#pragma unroll
        for (int q = 0; q < 4; ++q) { u32x4 w; w.x = cvt_pk_bf16(acc[0][q], acc[1][q]); w.y = cvt_pk_bf16(acc[2][q], acc[3][q]); w.z = cvt_pk_bf16(acc[4][q], acc[5][q]); w.w = cvt_pk_bf16(acc[6][q], acc[7][q]);
            *(u32x4*)(o + (size_t)q * 1024) = w; }
    }
}

__device__ __forceinline__ void moe_tile_prefix(Ctx& C, int l) {
    PHASE_ENTRY();
    LAS int* tab = (LAS int*)(ldsb + LDS_TAB);
    if (tid == 0) { int acc = 0;
        for (int e = 0; e < 16; ++e) { const int n = (int)__hip_atomic_load(CTLP + CW_CNT + 64 * l + e, __ATOMIC_RELAXED, __HIP_MEMORY_SCOPE_AGENT); tab[e] = n; tab[16 + e] = acc; acc += (n + 255) >> 8; }
        tab[32] = acc; }
    __syncthreads();
}
__device__ __forceinline__ void store_bf16_row(bf16_t* row, int lane, const f32x4 (&v)[4]) {
#pragma unroll
    for (int j = 0; j < 4; ++j) { u32x2 w; w.x = cvt_pk_bf16(v[j][0], v[j][1]); w.y = cvt_pk_bf16(v[j][2], v[j][3]); *(u32x2*)(row + 4 * lane + 256 * j) = w; }
}
__device__ __forceinline__ void moe_combine_row(const LAS int* tab, const unsigned* route, const bf16_t* yb, int lane, int tok, const f32x4 (&G2)[4], f32x4 (&v)[4]) {
    const u32x4 rt = *(const u32x4*)(route + (size_t)tok * 4);
    const int e0 = rt.x >> 15, p0 = rt.x & 32767, e1 = rt.y >> 15, p1 = rt.y & 32767; const float w0 = __uint_as_float(rt.z), w1 = __uint_as_float(rt.w);
    const bf16_t* y0 = yb + (size_t)(tab[16 + e0] * 256 + p0) * DM; const bf16_t* y1 = yb + (size_t)(tab[16 + e1] * 256 + p1) * DM;
#pragma unroll
    for (int j = 0; j < 4; ++j) { const u32x2 a = *(const u32x2*)(y0 + 4 * lane + 256 * j), b = *(const u32x2*)(y1 + 4 * lane + 256 * j);
        v[j][0] += G2[j][0] * (w0 * bflo(a.x) + w1 * bflo(b.x)); v[j][1] += G2[j][1] * (w0 * bfhi(a.x) + w1 * bfhi(b.x));
        v[j][2] += G2[j][2] * (w0 * bflo(a.y) + w1 * bflo(b.y)); v[j][3] += G2[j][3] * (w0 * bfhi(a.y) + w1 * bfhi(b.y)); }
}
__device__ __forceinline__ float row_rstd(const f32x4 (&v)[4]) {
    float s = 0.f;
#pragma unroll
    for (int j = 0; j < 4; ++j) s += (v[j][0] * v[j][0] + v[j][1] * v[j][1]) + (v[j][2] * v[j][2] + v[j][3] * v[j][3]);
    return __builtin_amdgcn_rsqf(wave_sum(s) * (1.0f / DM) + EPS);
}
__device__ __forceinline__ void phase_norm_a(Ctx& C, int l, int rep = 0) {
    PHASE_ENTRY(); const int b = vcu >> 6; const float* mod = WSP(float, WS_MOD);
    const float* xin = INF(0); float* hout = OUTP; bf16_t* xnp = WSP(bf16_t, WS_XN); bf16_t* hnp = WSP(bf16_t, WS_HN); const unsigned* route = WSP(unsigned, WS_ROUTE); const bf16_t* ybp = WSP(bf16_t, WS_YB);
    f32x4 Am[4], Bm[4], G2[4], Ak[4], Bk[4];
#pragma unroll
    for (int j = 0; j < 4; ++j) { const int c = 4 * lane + 256 * j;
        if (l < 4) { const float* ml = mod + (size_t)(l * 4 + b) * 6144; const f32x4 g = *(const f32x4*)(INF(5) + l * DM + c), sc = *(const f32x4*)(ml + 1024 + c); Am[j] = g * (1.0f + sc); Bm[j] = *(const f32x4*)(ml + c); }
        else { Am[j] = *(const f32x4*)(INF(24) + c); Bm[j] = (f32x4){0.f, 0.f, 0.f, 0.f}; }
        if (l > 0 && !rep) G2[j] = *(const f32x4*)(mod + (size_t)((l - 1) * 4 + b) * 6144 + 5 * 1024 + c); else G2[j] = (f32x4){0.f, 0.f, 0.f, 0.f};
        if (l == 2) { const float* mk = mod + 4 * 4 * 6144 + b * 2048; const f32x4 g = *(const f32x4*)(INF(11) + c), sc = *(const f32x4*)(mk + 1024 + c); Ak[j] = g * (1.0f + sc); Bk[j] = *(const f32x4*)(mk + c); }
        else { Ak[j] = Am[j]; Bk[j] = Bm[j]; } }
    if (l > 0) moe_tile_prefix(C, l - 1);
    for (int rr = 0; rr < 16; ++rr) {
        const int tok = vcu * 128 + wave * 16 + rr; f32x4 v[4];
        const float* src = (l == 0 ? xin : hout) + (size_t)tok * DM;
#pragma unroll
        for (int j = 0; j < 4; ++j) v[j] = *(const f32x4*)(src + 4 * lane + 256 * j);
        if (l > 0) moe_combine_row((const LAS int*)(ldsb + LDS_TAB), route, ybp, lane, tok, G2, v);
        const float rstd = row_rstd(v);
        if (l < 4) {
#pragma unroll
            for (int j = 0; j < 4; ++j) *(f32x4*)(hout + (size_t)tok * DM + 4 * lane + 256 * j) = v[j];
            f32x4 o[4];
#pragma unroll
            for (int j = 0; j < 4; ++j) o[j] = v[j] * rstd * Am[j] + Bm[j];
            store_bf16_row(xnp + (size_t)tok * DM, lane, o);
            if (l == 2) {
#pragma unroll
                for (int j = 0; j < 4; ++j) o[j] = v[j] * rstd * Ak[j] + Bk[j];
                store_bf16_row(hnp + (size_t)tok * DM, lane, o); }
        } else {
#pragma unroll
            for (int j = 0; j < 4; ++j) *(f32x4*)(hout + (size_t)tok * DM + 4 * lane + 256 * j) = v[j] * rstd * Am[j];
        }
    }
}
constexpr int NBR = 4;
template <int CTRL> __device__ __forceinline__ float dpp_add(float v) { return v + dpp_f<CTRL>(v); }
__device__ __forceinline__ void phase_norm_b(Ctx& C, int l) {
    PHASE_ENTRY(); const int b = vcu >> 6; const float* ml = WSP(float, WS_MOD) + (size_t)(l * 4 + b) * 6144;
    const float* hin = OUTP; bf16_t* xnp = WSP(bf16_t, WS_XN);
    LAS float* wrT = (LAS float*)ldsb;
    LAS float* lgt = (LAS float*)(ldsb + 65536);
    LAS int* rec_e = (LAS int*)(ldsb + 65536 + 8192);
    LAS float* rec_w = (LAS float*)(ldsb + 65536 + 8192 + 1024);
    LAS int* rec_p = (LAS int*)(ldsb + 65536 + 8192 + 2048);
    LAS int* lcnt = (LAS int*)(ldsb + 65536 + 8192 + 3072);
    LAS int* gbase = (LAS int*)(ldsb + 65536 + 8192 + 3072 + 64);
    for (int i = tid; i < 4096; i += NTHREADS) { const f32x4 w = *(const f32x4*)(INF(19) + (size_t)i * 4); const int col = i >> 2, e4 = (i & 3) * 4;
        wrT[(e4 + 0) * 1024 + col] = w[0]; wrT[(e4 + 1) * 1024 + col] = w[1]; wrT[(e4 + 2) * 1024 + col] = w[2]; wrT[(e4 + 3) * 1024 + col] = w[3]; }
    if (tid < 16) lcnt[tid] = 0;
    f32x4 Am[4], Bm[4];
#pragma unroll
    for (int j = 0; j < 4; ++j) { const int c = 4 * lane + 256 * j; const f32x4 g = *(const f32x4*)(INF(6) + l * DM + c), sc = *(const f32x4*)(ml + 4 * 1024 + c); Am[j] = g * (1.0f + sc); Bm[j] = *(const f32x4*)(ml + 3 * 1024 + c); }
    const float* hrow = hin + (size_t)(vcu * 128 + wave * 16) * DM + 4 * lane;
    __syncthreads();
#pragma unroll 1
    for (int g = 0; g < 16 / NBR; ++g) {
        asm volatile("" ::: "memory");
        f32x4 v[NBR][4];
#pragma unroll
        for (int i = 0; i < NBR; ++i)
#pragma unroll
            for (int j = 0; j < 4; ++j) v[i][j] = *(const f32x4*)(hrow + (size_t)(g * NBR + i) * DM + 256 * j);
#pragma unroll
        for (int i = 0; i < NBR; ++i) { const float rstd = row_rstd(v[i]);
#pragma unroll
            for (int j = 0; j < 4; ++j) v[i][j] = v[i][j] * rstd * Am[j] + Bm[j];
            store_bf16_row(xnp + (size_t)(vcu * 128 + wave * 16 + g * NBR + i) * DM, lane, v[i]); }
        float p[NBR][16];
#pragma unroll
        for (int e = 0; e < 16; ++e) { f32x4 w[4];
#pragma unroll
            for (int j = 0; j < 4; ++j) w[j] = *(const LAS f32x4*)(wrT + e * 1024 + 4 * lane + 256 * j);
#pragma unroll
            for (int i = 0; i < NBR; ++i) { float a = 0.f;
#pragma unroll
                for (int j = 0; j < 4; ++j) a += (v[i][j][0] * w[j][0] + v[i][j][1] * w[j][1]) + (v[i][j][2] * w[j][2] + v[i][j][3] * w[j][3]);
                p[i][e] = a; asm volatile("" : "+v"(p[i][e])); }
            __builtin_amdgcn_sched_barrier(0); }
#pragma unroll
        for (int i = 0; i < NBR; ++i) {
            float q[8], r[4];
#pragma unroll
            for (int k = 0; k < 8; ++k) { auto t = __builtin_amdgcn_permlane32_swap(__float_as_uint(p[i][k]), __float_as_uint(p[i][k + 8]), false, false); q[k] = __uint_as_float(t[0]) + __uint_as_float(t[1]); }
#pragma unroll
            for (int k = 0; k < 4; ++k) { auto t = __builtin_amdgcn_permlane16_swap(__float_as_uint(q[k]), __float_as_uint(q[k + 4]), false, false); r[k] = __uint_as_float(t[0]) + __uint_as_float(t[1]); }
#pragma unroll
            for (int k = 0; k < 4; ++k) { r[k] = dpp_add<0xB1>(r[k]); r[k] = dpp_add<0x4E>(r[k]); r[k] = dpp_add<0x141>(r[k]); r[k] = dpp_add<0x140>(r[k]); }
            if ((lane & 15) == 0) { const int rho = lane >> 4; *(LAS f32x4*)(lgt + (wave * 16 + g * NBR + i) * 16 + 4 * (rho & 1) + 8 * (rho >> 1)) = (f32x4){r[0], r[1], r[2], r[3]}; }
        }
    }
    LDS_WAIT();
    if (lane < 16) {
        const int rl = wave * 16 + lane; float sc[16], bs[16];
#pragma unroll
        for (int e4 = 0; e4 < 4; ++e4) { const f32x4 lg = *(const LAS f32x4*)(lgt + rl * 16 + e4 * 4); const f32x4 rbv = *(const f32x4*)(INF(20) + e4 * 4);
#pragma unroll
            for (int k = 0; k < 4; ++k) { sc[e4 * 4 + k] = 1.0f / (1.0f + __expf(-lg[k])); bs[e4 * 4 + k] = sc[e4 * 4 + k] + rbv[k]; } }
        float gs[4];
#pragma unroll
        for (int g = 0; g < 4; ++g) { const float a = bs[4 * g], bq = bs[4 * g + 1], c = bs[4 * g + 2], d = bs[4 * g + 3];
            const float h1 = fmaxf(a, bq), l1 = fminf(a, bq), h2 = fmaxf(c, d), l2 = fminf(c, d); gs[g] = fmaxf(h1, h2) + fmaxf(fminf(h1, h2), fmaxf(l1, l2)); }
        int gi = 0; float best = gs[0];
#pragma unroll
        for (int g = 1; g < 4; ++g) if (gs[g] > best) { best = gs[g]; gi = g; }
        float iv[4], uv[4];
#pragma unroll
        for (int k = 0; k < 4; ++k) { iv[k] = gi == 0 ? bs[k] : (gi == 1 ? bs[4 + k] : (gi == 2 ? bs[8 + k] : bs[12 + k])); uv[k] = gi == 0 ? sc[k] : (gi == 1 ? sc[4 + k] : (gi == 2 ? sc[8 + k] : sc[12 + k])); }
        int i1 = 0; float b1 = iv[0];
#pragma unroll
        for (int k = 1; k < 4; ++k) if (iv[k] > b1) { b1 = iv[k]; i1 = k; }
        int i2 = -1; float b2 = 0.f;
#pragma unroll
        for (int k = 0; k < 4; ++k) if (k != i1 && (i2 < 0 || iv[k] > b2)) { b2 = iv[k]; i2 = k; }
        const float u1 = i1 == 0 ? uv[0] : (i1 == 1 ? uv[1] : (i1 == 2 ? uv[2] : uv[3])), u2 = i2 == 0 ? uv[0] : (i2 == 1 ? uv[1] : (i2 == 2 ? uv[2] : uv[3]));
        const float rs = 1.0f / (u1 + u2);
        rec_e[rl * 2] = gi * 4 + i1; rec_e[rl * 2 + 1] = gi * 4 + i2; rec_w[rl * 2] = u1 * rs; rec_w[rl * 2 + 1] = u2 * rs;
    }
    __syncthreads();
    if (tid < 128) { rec_p[tid * 2] = atomicAdd((int*)&lcnt[rec_e[tid * 2]], 1); rec_p[tid * 2 + 1] = atomicAdd((int*)&lcnt[rec_e[tid * 2 + 1]], 1); }
    __syncthreads();
    if (tid < 16) gbase[tid] = (int)__hip_atomic_fetch_add(CTLP + CW_CNT + 64 * l + tid, (unsigned)lcnt[tid], __ATOMIC_RELAXED, __HIP_MEMORY_SCOPE_AGENT);
    __syncthreads();
    if (tid < 128) { const int tok = vcu * 128 + tid, e0 = rec_e[tid * 2], e1 = rec_e[tid * 2 + 1], p0 = gbase[e0] + rec_p[tid * 2], p1 = gbase[e1] + rec_p[tid * 2 + 1];
        int* idx = WSP(int, WS_IDX); idx[e0 * NTOK + p0] = tok; idx[e1 * NTOK + p1] = tok;
        *(u32x4*)(WSP(unsigned, WS_ROUTE) + (size_t)tok * 4) = (u32x4){(unsigned)(e0 << 15 | p0), (unsigned)(e1 << 15 | p1), __float_as_uint(rec_w[tid * 2]), __float_as_uint(rec_w[tid * 2 + 1])}; }
    __syncthreads();
}
__device__ __forceinline__ void phase_prefix(Ctx& C) {
    PHASE_ENTRY(); const int g = vcu * NTHREADS + tid, dkv = g & 31, v = (g >> 5) & 511, bh = g >> 14, h = bh & 3;
    const float gam = __builtin_amdgcn_exp2f(log2_gamma(h)), gam256 = __builtin_amdgcn_exp2f(256.0f * log2_gamma(h));
    bf16_t* p = WSP(bf16_t, WS_B2T) + (size_t)bh * 32 * 262144 + (size_t)v * 512 + dkv * 8;
    float s[8];
#pragma unroll
    for (int k = 0; k < 8; ++k) s[k] = 0.f;
    for (int c0 = 0; c0 < 32; c0 += 4) {
        u32x4 kv[4];
#pragma unroll
        for (int i = 0; i < 4; ++i) kv[i] = *(const u32x4*)(p + (size_t)(c0 + i) * 262144);
#pragma unroll
        for (int i = 0; i < 4; ++i) {
            u32x4 o; o.x = cvt_pk_bf16(s[0] * gam, s[1] * gam); o.y = cvt_pk_bf16(s[2] * gam, s[3] * gam); o.z = cvt_pk_bf16(s[4] * gam, s[5] * gam); o.w = cvt_pk_bf16(s[6] * gam, s[7] * gam);
            *(u32x4*)(p + (size_t)(c0 + i) * 262144) = o;
            s[0] = s[0] * gam256 + bflo(kv[i].x); s[1] = s[1] * gam256 + bfhi(kv[i].x); s[2] = s[2] * gam256 + bflo(kv[i].y); s[3] = s[3] * gam256 + bfhi(kv[i].y);
            s[4] = s[4] * gam256 + bflo(kv[i].z); s[5] = s[5] * gam256 + bfhi(kv[i].z); s[6] = s[6] * gam256 + bflo(kv[i].w); s[7] = s[7] * gam256 + bfhi(kv[i].w); }
    }
}
__device__ __forceinline__ void phase_kvfin(Ctx& C) {
    PHASE_ENTRY(); const float* akv = WSP(float, WS_AKV); bf16_t* kpp = WSP(bf16_t, WS_KP); const int* posp = INI(2); const float g0 = INF(13)[2 * lane], g1 = INF(13)[2 * lane + 1];
    const float inv = __builtin_amdgcn_exp2f(-(float)(lane & 31) * (LOG2_THETA / 32.0f));
    for (int rr = 0; rr < 16; ++rr) {
        const int tok = vcu * 128 + wave * 16 + rr; const float* a = akv + (size_t)tok * 256; bf16_t* kp = kpp + (size_t)tok * QKD;
        const f32x2 cv = *(const f32x2*)(a + 2 * lane); const float rstd = __builtin_amdgcn_rsqf(wave_sum(cv[0] * cv[0] + cv[1] * cv[1]) * (1.0f / 128.0f) + EPS);
        *(unsigned*)(kp + 2 * lane) = cvt_pk_bf16(cv[0] * rstd * g0, cv[1] * rstd * g1);
        const float x1 = a[128 + (lane & 31)], x2 = a[160 + (lane & 31)]; float s, c; sincos_rad((float)posp[tok] * inv, s, c);
        const float o = lane < 32 ? x1 * c - x2 * s : x1 * s + x2 * c;
        kp[128 + lane] = (bf16_t)(cvt_pk_bf16(o, 0.f) & 0xffffu);
    }
}
namespace att {
constexpr int SHM_V = 16384, SHM_K = 24576, OFF_V = 0, OFF_K = 2 * SHM_V, OFF_WS = OFF_K + 2 * SHM_K, OFF_Q = OFF_WS + 2048;
constexpr float THR = 8.0f;
#define KSWZ(row, colB) ((row) * 384 + ((colB) ^ ((((row) >> 1) & 7) << 4)))
#define SBAR() __builtin_amdgcn_sched_barrier(0)
__device__ __forceinline__ int crow(int r, int hi) { return (r & 3) + 8 * (r >> 2) + 4 * hi; }
__device__ __forceinline__ void partialSM(f32x16& p0, f32x16& p1, float& m_reg, float& mn, float& alpha) {
    float pmax = p0[0];
#pragma unroll
    for (int r = 1; r < 16; ++r) pmax = fmaxf(pmax, p0[r]);
#pragma unroll
    for (int r = 0; r < 16; ++r) pmax = fmaxf(pmax, p1[r]);
    { auto rr = __builtin_amdgcn_permlane32_swap(__float_as_uint(pmax), __float_as_uint(pmax), false, false); pmax = fmaxf(__uint_as_float(rr[0]), __uint_as_float(rr[1])); }
    if (__builtin_expect(__all(pmax - m_reg <= THR), 1)) { mn = m_reg; alpha = 1.f; }
    else { mn = fmaxf(m_reg, pmax); alpha = __builtin_amdgcn_exp2f(m_reg - mn); m_reg = mn; }
#pragma unroll
    for (int r = 0; r < 16; ++r) p0[r] = p0[r] - mn;
#pragma unroll
    for (int r = 0; r < 16; ++r) p1[r] = p1[r] - mn;
#pragma unroll
    for (int r = 0; r < 16; ++r) p0[r] = __builtin_amdgcn_exp2f(p0[r]);
}
__device__ __forceinline__ void finishSM(f32x16& p0, f32x16& p1, float alpha, float& l_reg, bf16x8& pa0, bf16x8& pa1, bf16x8& pa2, bf16x8& pa3) {
#pragma unroll
    for (int r = 0; r < 16; ++r) p1[r] = __builtin_amdgcn_exp2f(p1[r]);
    float ps = 0;
#pragma unroll
    for (int r = 0; r < 16; ++r) ps += p0[r];
#pragma unroll
    for (int r = 0; r < 16; ++r) ps += p1[r];
    { auto rr = __builtin_amdgcn_permlane32_swap(__float_as_uint(ps), __float_as_uint(ps), false, false); ps = __uint_as_float(rr[0]) + __uint_as_float(rr[1]); }
    l_reg = l_reg * alpha + ps;
#define PK4(P, BASE, OUT) do { unsigned a0 = cvt_pk_bf16(P[BASE + 0], P[BASE + 1]), a1 = cvt_pk_bf16(P[BASE + 2], P[BASE + 3]);   \
    unsigned b0 = cvt_pk_bf16(P[BASE + 4], P[BASE + 5]), b1 = cvt_pk_bf16(P[BASE + 6], P[BASE + 7]);                              \
    auto r0 = __builtin_amdgcn_permlane32_swap(a0, b0, false, false); auto r1 = __builtin_amdgcn_permlane32_swap(a1, b1, false, false); \
    u32x4 w = {r0[0], r1[0], r0[1], r1[1]}; OUT = *reinterpret_cast<bf16x8*>(&w); } while (0)
    PK4(p0, 0, pa0); PK4(p0, 8, pa1); PK4(p1, 0, pa2); PK4(p1, 8, pa3);
#undef PK4
}
template <int BUF> __device__ __forceinline__ void qkt(f32x16& p0, f32x16& p1, const LAS char* const (&kb4)[4], const bf16x8* qr, const LAS char* ql) {
    p0 = f32x16{}; p1 = f32x16{};
#pragma unroll
    for (int d0 = 0; d0 < 12; ++d0) {
        const bf16x8 b0 = *reinterpret_cast<const LAS bf16x8*>(kb4[d0 & 3] + BUF * SHM_K + (d0 >> 2) * 128);
        const bf16x8 b1 = *reinterpret_cast<const LAS bf16x8*>(kb4[d0 & 3] + BUF * SHM_K + (d0 >> 2) * 128 + 32 * 384);
        const bf16x8 qf = d0 < 8 ? qr[d0 < 8 ? d0 : 0] : *reinterpret_cast<const LAS bf16x8*>(ql + (d0 - 8) * 1024);
        p0 = __builtin_amdgcn_mfma_f32_32x32x16_bf16(b0, qf, p0, 0, 0, 0);
        p1 = __builtin_amdgcn_mfma_f32_32x32x16_bf16(b1, qf, p1, 0, 0, 0); }
}
__device__ __forceinline__ int v_st(int k, int c) { const int kk = (k & ~0xC) | ((k & 4) << 1) | ((k & 8) >> 1); return ((kk >> 3) * 4 + (c >> 5)) * 512 + ((kk & 7) * 32 + (c & 31)) * 2; }
__device__ __forceinline__ int v_rd_base(int lane) { return ((lane & 3) << 3) | (((lane >> 2) & 3) << 6) | (((lane >> 4) & 1) << 5) | (((lane >> 5) & 1) << 8); }
constexpr int v_rd_off(int d0, int ks, int half) { return d0 * 512 + ks * 4096 + half * 2048; }
template <int OFF> __device__ __forceinline__ s16x4 tr_read(int vb) { s16x4 r; asm volatile("ds_read_b64_tr_b16 %0, %1 offset:%2" : "=&v"(r) : "v"(vb), "i"(OFF) : "memory"); return r; }
template <int D0> __device__ __forceinline__ void pv_one(f32x16& od, int vb, bf16x8 pa0, bf16x8 pa1, bf16x8 pa2, bf16x8 pa3) {
    const s16x4 l0 = tr_read<v_rd_off(D0, 0, 0)>(vb), h0 = tr_read<v_rd_off(D0, 0, 1)>(vb), l1 = tr_read<v_rd_off(D0, 1, 0)>(vb), h1 = tr_read<v_rd_off(D0, 1, 1)>(vb);
    const s16x4 l2 = tr_read<v_rd_off(D0, 2, 0)>(vb), h2 = tr_read<v_rd_off(D0, 2, 1)>(vb), l3 = tr_read<v_rd_off(D0, 3, 0)>(vb), h3 = tr_read<v_rd_off(D0, 3, 1)>(vb);
    asm volatile("s_waitcnt lgkmcnt(0)" ::: "memory"); SBAR();
#define PK(L, H) (bf16x8){L[0], L[1], L[2], L[3], H[0], H[1], H[2], H[3]}
    od = __builtin_amdgcn_mfma_f32_32x32x16_bf16(pa0, PK(l0, h0), od, 0, 0, 0);
    od = __builtin_amdgcn_mfma_f32_32x32x16_bf16(pa1, PK(l1, h1), od, 0, 0, 0);
    od = __builtin_amdgcn_mfma_f32_32x32x16_bf16(pa2, PK(l2, h2), od, 0, 0, 0);
    od = __builtin_amdgcn_mfma_f32_32x32x16_bf16(pa3, PK(l3, h3), od, 0, 0, 0);
#undef PK
}
__device__ __forceinline__ void pv_d0(f32x16* o, int vb, bf16x8 pa0, bf16x8 pa1, bf16x8 pa2, bf16x8 pa3) {
    pv_one<0>(o[0], vb, pa0, pa1, pa2, pa3); pv_one<1>(o[1], vb, pa0, pa1, pa2, pa3); pv_one<2>(o[2], vb, pa0, pa1, pa2, pa3); pv_one<3>(o[3], vb, pa0, pa1, pa2, pa3);
}
__device__ __forceinline__ void attn_unit(const bf16_t* __restrict__ Q, const bf16_t* __restrict__ Kp, bf16_t* __restrict__ O, int t0, int kbase, int nt_real, LAS char* lds, int wid) {
    int lane_ = (int)__builtin_amdgcn_mbcnt_hi(~0u, __builtin_amdgcn_mbcnt_lo(~0u, 0u)); asm volatile("" : "+v"(lane_));
    const int lane = lane_, tid = wid * 64 + lane, r32 = lane & 31, hi = lane >> 5;
    LAS char* V_lds = lds + OFF_V; LAS char* K_lds = lds + OFF_K;
    LAS float* ws = (LAS float*)(lds + OFF_WS) + wid * 64; LAS float* li_l = ws; LAS float* al_l = ws + 32;
    float m_reg = -1e30f, l_reg = 0; f32x16 o[4] = {}; bf16x8 qr[8];
    LAS char* qlds = lds + OFF_Q + wid * 4096 + lane * 16;
    const char* Qs = (const char*)Q + (size_t)t0 * 3072 + wid * (QKD * 2); const unsigned qlo = (unsigned)(r32 * 3072 + hi * 16);
#pragma unroll
    for (int d0 = 0; d0 < 8; ++d0) qr[d0] = *reinterpret_cast<const bf16x8*>(Qs + qlo + d0 * 32);
    __syncthreads();
#pragma unroll
    for (int d0 = 8; d0 < 12; ++d0) *reinterpret_cast<LAS bf16x8*>(qlds + (d0 - 8) * 1024) = *reinterpret_cast<const bf16x8*>(Qs + qlo + d0 * 32);
    const int vb0 = (int)(uintptr_t)V_lds + v_rd_base(lane);
    const LAS char* kb4[4];
#pragma unroll
    for (int q = 0; q < 4; ++q) kb4[q] = K_lds + r32 * 384 + ((q * 32 + hi * 16) ^ (((r32 >> 1) & 7) << 4));
    const int NT = (nt_real + 1) & ~1;
    const bool dummy = (NT != nt_real);
    bf16x8 sr_[1][3];
    const char* Kg = (const char*)(Kp + (size_t)kbase * QKD);
#define SLOAD(s, kt) do { _Pragma("unroll") for (int i = 0; i < 3; ++i) sr_[s][i] = *reinterpret_cast<const bf16x8*>(Kg + (size_t)(kt) * SHM_K + i * 8192 + (unsigned)(tid * 16)); } while (0)
#define SWRITE(b, s) do { int tl_ = (int)__builtin_amdgcn_mbcnt_hi(~0u, __builtin_amdgcn_mbcnt_lo(~0u, 0u)); asm volatile("" : "+v"(tl_)); tl_ += wid * 64; _Pragma("unroll") for (int i = 0; i < 3; ++i) { const int p_ = tl_ + 512 * i, row_ = p_ / 24, c16_ = p_ - row_ * 24; \
        *(LAS bf16x8*)(K_lds + (b) * SHM_K + KSWZ(row_, c16_ * 16)) = sr_[s][i]; if (c16_ < 16) *(LAS bf16x8*)(V_lds + (b) * SHM_V + v_st(row_, c16_ * 8)) = sr_[s][i]; } } while (0)
#define SWAIT() asm volatile("s_waitcnt vmcnt(0)" ::: "memory")
#define RESC(a) do { if (__any((a) < 1.f)) { if (hi == 0) al_l[r32] = (a); asm volatile("s_waitcnt lgkmcnt(0)" ::: "memory"); \
    _Pragma("unroll") for (int d = 0; d < 4; ++d) _Pragma("unroll") for (int r = 0; r < 16; ++r) o[d][r] *= al_l[crow(r, hi)]; } } while (0)
    f32x16 pA0, pA1, pB0, pB1; float mnA, mnB, alA, alB; bf16x8 pa0, pa1, pa2, pa3;
    SLOAD(0, 0); SWAIT(); SWRITE(0, 0); __syncthreads();
    qkt<0>(pA0, pA1, kb4, qr, qlds); partialSM(pA0, pA1, m_reg, mnA, alA);
    SLOAD(0, 1); SWAIT(); SWRITE(1, 0); __syncthreads();
    for (int j = 1; j + 1 < NT; j += 2) {
        SBAR(); qkt<1>(pB0, pB1, kb4, qr, qlds);
        finishSM(pA0, pA1, alA, l_reg, pa0, pa1, pa2, pa3); SBAR();
        SLOAD(0, j + 1); SBAR();
        pv_d0(o, vb0, pa0, pa1, pa2, pa3); partialSM(pB0, pB1, m_reg, mnB, alB);
        __syncthreads(); SWAIT(); SWRITE(0, 0);
        RESC(alB); __syncthreads();
        SBAR(); qkt<0>(pA0, pA1, kb4, qr, qlds);
        finishSM(pB0, pB1, alB, l_reg, pa0, pa1, pa2, pa3); SBAR();
        SLOAD(0, j + 2); SBAR();
        pv_d0(o, vb0 + SHM_V, pa0, pa1, pa2, pa3); partialSM(pA0, pA1, m_reg, mnA, alA);
        __syncthreads(); SWAIT(); SWRITE(1, 0);
        RESC(alA); __syncthreads();
    }
    SBAR(); qkt<1>(pB0, pB1, kb4, qr, qlds);
    if (dummy) {
#pragma unroll
        for (int r = 0; r < 16; ++r) { pB0[r] = -INFINITY; pB1[r] = -INFINITY; } }
    finishSM(pA0, pA1, alA, l_reg, pa0, pa1, pa2, pa3); SBAR();
    pv_d0(o, vb0, pa0, pa1, pa2, pa3); partialSM(pB0, pB1, m_reg, mnB, alB);
    __syncthreads(); RESC(alB);
    finishSM(pB0, pB1, alB, l_reg, pa0, pa1, pa2, pa3); SBAR();
    pv_d0(o, vb0 + SHM_V, pa0, pa1, pa2, pa3);
    {
        int lanee = (int)__builtin_amdgcn_mbcnt_hi(~0u, __builtin_amdgcn_mbcnt_lo(~0u, 0u)); asm volatile("" : "+v"(lanee));
        const int wide = wid, r32e = lanee & 31, hie = lanee >> 5;
        LAS float* lie = (LAS float*)(lds + OFF_WS) + wide * 64;
        if (hie == 0) lie[r32e] = l_reg; asm volatile("s_waitcnt lgkmcnt(0)" ::: "memory");
        char* Os = (char*)O + (size_t)t0 * 2048 + wide * 256; const unsigned olo = (unsigned)(r32e * 2);
#pragma unroll
        for (int r = 0; r < 16; ++r) { const int orow = crow(r, hie); const float rl = __builtin_amdgcn_rcpf(lie[orow]);
#pragma unroll
            for (int d0 = 0; d0 < 4; ++d0) *(bf16_t*)(Os + olo + (unsigned)(orow * 2048) + d0 * 64) = (bf16_t)(cvt_pk_bf16(o[d0][r] * rl, 0.f) & 0xffffu); }
    }
#undef SLOAD
#undef SWRITE
#undef SWAIT
#undef RESC
}
}
struct Args { const void* in[25]; float* out; unsigned char* ws; int lo, hi, l, hf; };
enum { PH_PRO = 0, PH_NA, PH_R2, PH_R3, PH_R4, PH_R5, PH_R6, PH_R7, PH_M2, PH_M3, PH_M4, PH_M5, PH_NB, PH_MOE1, PH_MOE2, PH_COUNT };

__device__ __forceinline__ void make_ctx(Ctx& C, unsigned char* lds_raw) {
    C.ka = (kaptr_t)__builtin_amdgcn_kernarg_segment_ptr(); C.lds = (LAS unsigned char*)lds_raw;
    C.wave = __builtin_amdgcn_readfirstlane((int)threadIdx.x >> 6);
    { const int bx = blockIdx.x; C.vcu = (bx & 7) * (GRID / 8) + (bx >> 3); }
}

template <int PH> __device__ __forceinline__ void run_phase(Ctx& C, const int l, const int hf, const int rep = 0) {
    PHASE_ENTRY(); const int wv = wave;
    LAS unsigned char* lds = ldsb; int bid_ = blockIdx.x; asm volatile("" : "+s"(bid_)); const int bid = bid_; const unsigned LD1K = 2048u;
    const float* gate1 = rep ? (const float*)(WSB + WS_CTL + 512 * 1024) : WSP(float, WS_MOD) + (size_t)l * 4 * 6144 + 2 * 1024;
    const bf16_t* win = WSP(bf16_t, WS_WIN) + (size_t)(l & 1) * 6144 * 1024;
    const bf16_t* xnh = WSP(bf16_t, WS_XN) + (size_t)hf * THALF * DM;
    const int j = l & 1;
    if constexpr (PH == PH_PRO) phase_prologue(C);
    if constexpr (PH == PH_NA) phase_norm_a(C, l, rep);
    if constexpr (PH == PH_R2) {
        { SchedStd S; S.T.init(64, 4, GRID, bid); S.A = (const char*)xnh; S.B = (const char*)win; S.sA = 256 * 2048; S.sB = 256 * 2048;
          EpiRopeQK<0> E{WSP(bf16_t, WS_A2), INI(2), hf}; pg8::gemm_phase<EpiRopeQK<0>, SchedStd, false>(lds, wv, 1024, LD1K, LD1K, S, E); }
        { SchedStd S; S.T.init(64, 4, GRID, bid); S.A = (const char*)xnh; S.B = (const char*)(win + 1024 * 1024); S.sA = 256 * 2048; S.sB = 256 * 2048;
          EpiRopeQK<1> E{WSP(bf16_t, WS_KR), INI(2), hf}; pg8::gemm_phase<EpiRopeQK<1>, SchedStd, false>(lds, wv, 1024, LD1K, LD1K, S, E); }
        { SchedStd S; S.T.init(4, 64, GRID, bid); S.A = (const char*)(win + 1024 * 1024); S.B = (const char*)xnh; S.sA = 256 * 2048; S.sB = 256 * 2048;
          EpiRopeKT E{WSP(bf16_t, WS_KT), INI(2), hf}; pg8::gemm_phase<EpiRopeKT, SchedStd, false>(lds, wv, 1024, LD1K, LD1K, S, E); }
        { SchedStd S; S.T.init(8, 64, GRID, bid); S.A = (const char*)(win + 2048 * 1024); S.B = (const char*)xnh; S.sA = 256 * 2048; S.sB = 256 * 2048;
          EpiVT E{WSP(bf16_t, WS_B2T)}; pg8::gemm_phase<EpiVT, SchedStd, false>(lds, wv, 1024, LD1K, LD1K, S, E); }
    }
    if constexpr (PH == PH_R3) {
        { SchedBatch S{(const char*)WSP(bf16_t, WS_A2), (const char*)WSP(bf16_t, WS_KR), 256 * 1024, 256 * 512, 0, 0, 256, 1, GRID, vcu};
          EpiS E{WSP(bf16_t, WS_A2)}; pg8::gemm_phase<EpiS, SchedBatch, false>(lds, wv, 256, 1024u, 512u, S, E); }
        { SchedBatch S{(const char*)(WSP(bf16_t, WS_B2T) + 256), (const char*)WSP(bf16_t, WS_KT), 512 * 1024, 256 * 512, 256 * 1024, 0, 256, 2, GRID, vcu};
          EpiKV E{WSP(bf16_t, WS_B2T)}; pg8::gemm_phase<EpiKV, SchedBatch, false>(lds, wv, 256, 1024u, 512u, S, E); }
    }
    if constexpr (PH == PH_R4) phase_prefix(C);
    if constexpr (PH == PH_R5) {
        SchedBatch S{(const char*)WSP(bf16_t, WS_A2), (const char*)WSP(bf16_t, WS_B2T), 256 * 1024, 512 * 1024, 0, 256 * 1024, 256, 2, GRID, vcu};
        EpiFin E{WSP(bf16_t, WS_B2T), WSP(float, WS_STATS)}; pg8::gemm_phase<EpiFin, SchedBatch, false>(lds, wv, 512, 1024u, 1024u, S, E);
    }
    if constexpr (PH == PH_R6) {
        SchedStd S; S.T.init(64, 8, GRID, bid); S.A = (const char*)xnh; S.B = (const char*)(win + 4096 * 1024); S.sA = 256 * 2048; S.sB = 256 * 2048;
        EpiGate E{WSP(bf16_t, WS_B2T), WSP(float, WS_STATS), WSP(bf16_t, WS_A2)}; pg8::gemm_phase<EpiGate, SchedStd, false>(lds, wv, 1024, LD1K, LD1K, S, E);
    }
    if constexpr (PH == PH_R7) {
        SchedStd S; S.T.init(64, 4, GRID, bid); S.A = (const char*)WSP(bf16_t, WS_A2); S.B = (const char*)(WSP(bf16_t, WS_WOUT) + (size_t)l * 1024 * 2048); S.sA = 256 * 4096; S.sB = 256 * 4096;
        EpiResid E{OUTP, gate1, hf * THALF}; pg8::gemm_phase<EpiResid, SchedStd, false>(lds, wv, 2048, 4096u, 4096u, S, E);
    }
    if constexpr (PH == PH_M2) {
        { SchedStd S; S.T.init(128, 1, GRID, bid); S.A = (const char*)WSP(bf16_t, WS_XN); S.B = (const char*)(WSP(bf16_t, WS_WQA) + (size_t)j * 256 * 1024); S.sA = 256 * 2048; S.sB = 256 * 2048;
          EpiQA E{WSP(bf16_t, WS_QA), WSP(float, WS_SSQ)}; pg8::gemm_phase<EpiQA, SchedStd, false>(lds, wv, 1024, LD1K, LD1K, S, E); }
        if (l == 2) { SchedStd S; S.T.init(128, 1, GRID, (bid + 128) & 255); S.A = (const char*)WSP(bf16_t, WS_HN); S.B = (const char*)WSP(bf16_t, WS_WKVA); S.sA = 256 * 2048; S.sB = 256 * 2048;
          EpiF32 E{WSP(float, WS_AKV)}; pg8::gemm_phase<EpiF32, SchedStd, false>(lds, wv, 1024, LD1K, LD1K, S, E); }
    }
    if constexpr (PH == PH_M3) {
        if (l == 2) phase_kvfin(C);
        SchedStd S; S.T.init(128, 6, GRID, bid); S.A = (const char*)WSP(bf16_t, WS_QA); S.B = (const char*)(WSP(bf16_t, WS_WQB) + (size_t)j * 1536 * 256); S.sA = 256 * 512; S.sB = 256 * 512;
        EpiQB E{WSP(bf16_t, WS_Q), WSP(float, WS_SSQ), INI(2)}; pg8::gemm_phase<EpiQB, SchedStd, false>(lds, wv, 256, 512u, 512u, S, E);
    }
    if constexpr (PH == PH_M4) {
        const int b = vcu >> 6, i = vcu & 63;
#pragma unroll 1
        for (int uq = 0; uq < 4; ++uq) { const int cch = (uq < 2) ? (127 - i) : i, half = uq & 1;
            att::attn_unit(WSP(bf16_t, WS_Q), WSP(bf16_t, WS_KP), WSP(bf16_t, WS_OL), b * SEQ + cch * 64 + half * 32, b * SEQ, cch + 1, (LAS char*)lds, wave); }
        __syncthreads();
    }
    if constexpr (PH == PH_M5) {
        SchedStd S; S.T.init(128, 4, GRID, bid); S.A = (const char*)WSP(bf16_t, WS_OL); S.B = (const char*)(WSP(bf16_t, WS_WO) + (size_t)j * 1024 * 1024); S.sA = 256 * 2048; S.sB = 256 * 2048;
        EpiResid E{OUTP, gate1, 0}; pg8::gemm_phase<EpiResid, SchedStd, false>(lds, wv, 1024, LD1K, LD1K, S, E);
    }
    if constexpr (PH == PH_NB) phase_norm_b(C, l);
    if constexpr (PH == PH_MOE1) {
        moe_tile_prefix(C, l);
        SchedMoE S{(const LAS int*)(lds + LDS_TAB), (const char*)WSP(bf16_t, WS_XN), (const char*)(WSP(bf16_t, WS_WGU) + (size_t)l * 16 * 1024 * 1024), (size_t)1024 * 2048, (size_t)256 * 2048, 0, WSP(int, WS_IDX), GRID, vcu, true};
        EpiGU E{WSP(bf16_t, WS_HDN)}; pg8::gemm_phase<EpiGU, SchedMoE, true>(lds, wv, 1024, LD1K, LD1K, S, E);
    }
    if constexpr (PH == PH_MOE2) {
        moe_tile_prefix(C, l);
        SchedMoE S{(const LAS int*)(lds + LDS_TAB), (const char*)WSP(bf16_t, WS_HDN), (const char*)(WSP(bf16_t, WS_WDN) + (size_t)l * 16 * 1024 * 512), (size_t)1024 * 1024, (size_t)256 * 1024, (size_t)256 * 1024, WSP(int, WS_IDX), GRID, vcu, false};
        EpiPlain E{WSP(bf16_t, WS_YB), 1024}; pg8::gemm_phase<EpiPlain, SchedMoE, false>(lds, wv, 512, 1024u, 1024u, S, E);
    }
}

template <int PH> __global__ void __launch_bounds__(NTHREADS, 2) phase_kernel(Args args) {
    extern __shared__ __attribute__((aligned(16))) unsigned char lds_raw[];
    Ctx C; make_ctx(C, lds_raw); (void)args;
    run_phase<PH>(C, args.l, args.hf);
}
__global__ void __launch_bounds__(NTHREADS, 2) fwd_kernel(Args args) {
    extern __shared__ __attribute__((aligned(16))) unsigned char lds_raw[];
    Ctx C; make_ctx(C, lds_raw); (void)args;
    if (threadIdx.x < 64) ((LAS unsigned*)(C.lds + LDS_MISC))[threadIdx.x] = 0u;
    __syncthreads();
    XcdBarrier bar = xcd_barrier_post((unsigned*)((unsigned char*)args.ws + WS_CTL) + CW_BAR, (volatile LAS unsigned*)(C.lds + LDS_MISC));
#define SEAM() xcd_barrier(bar, C.wave)
#ifndef PROBE_PH
#define PROBE_PH -1
#define PROBE_N 0
#endif
#define RUNP(PH, l, hf) do { run_phase<PH>(C, l, hf); SEAM(); if constexpr (PH == PROBE_PH) { _Pragma("unroll 1") for (int rp_ = 0; rp_ < PROBE_N; ++rp_) { run_phase<PH>(C, l, hf, 1); SEAM(); } } } while (0)
    RUNP(PH_PRO, 0, 0);
    for (int l = 0; l < 4; ++l) {
        RUNP(PH_NA, l, 0);
        if (l < 2) {
            for (int hf = 0; hf < 2; ++hf) { RUNP(PH_R2, l, hf); RUNP(PH_R3, l, hf); RUNP(PH_R4, l, hf); RUNP(PH_R5, l, hf); RUNP(PH_R6, l, hf); RUNP(PH_R7, l, hf); }
        } else { RUNP(PH_M2, l, 0); RUNP(PH_M3, l, 0); RUNP(PH_M4, l, 0); RUNP(PH_M5, l, 0); }
        RUNP(PH_NB, l, 0); RUNP(PH_MOE1, l, 0); RUNP(PH_MOE2, l, 0);
    }
    run_phase<PH_NA>(C, 4, 0);
#undef RUNP
#undef SEAM
}

template <int PH> static void launch_phase(Args& a, int l, int hf, hipStream_t stream) {
    static bool attr = false;
    if (!attr) { (void)hipFuncSetAttribute((const void*)phase_kernel<PH>, hipFuncAttributeMaxDynamicSharedMemorySize, LDS_BYTES); attr = true; }
    a.l = l; a.hf = hf;
    hipLaunchKernelGGL(phase_kernel<PH>, dim3(GRID), dim3(NTHREADS), LDS_BYTES, stream, a);
}
extern "C" void kernel_launch(void* const* d_in, const int* in_sizes, int n_in, void* d_out, int out_size, void* d_ws, size_t ws_size, hipStream_t stream) {
    static int ok = 0;
    if (ok == 0) {
        if (n_in != 25 || out_size != NTOK * DM || ws_size < WS_END) { fprintf(stderr, "kernel_launch: unexpected problem (n_in %d, out %d, ws %zu < %zu)\n", n_in, out_size, ws_size, (size_t)WS_END); ok = -1; return; }
        int dev = 0, cus = 0;
        if (hipGetDevice(&dev) != hipSuccess || hipDeviceGetAttribute(&cus, hipDeviceAttributeMultiprocessorCount, dev) != hipSuccess || cus < GRID) { fprintf(stderr, "kernel_launch: needs %d CUs, device has %d\n", GRID, cus); ok = -1; return; }
        ok = 1;
    }
    if (ok < 0) return;
    (void)hipMemsetAsync((char*)d_ws + WS_CTL, 0, CTL_BYTES, stream);
    Args a{};
    for (int i = 0; i < 25; ++i) a.in[i] = d_in[i];
    a.out = (float*)d_out; a.ws = (unsigned char*)d_ws; a.lo = 0; a.hi = 0;
#if MK_SINGLE
    static bool attr = false;
    if (!attr) { (void)hipFuncSetAttribute((const void*)fwd_kernel, hipFuncAttributeMaxDynamicSharedMemorySize, LDS_BYTES); attr = true; }
    hipLaunchKernelGGL(fwd_kernel, dim3(GRID), dim3(NTHREADS), LDS_BYTES, stream, a);
    return;
#endif
    launch_phase<PH_PRO>(a, 0, 0, stream);
    for (int l = 0; l < 4; ++l) {
        launch_phase<PH_NA>(a, l, 0, stream);
        if (l < 2) {
            for (int hf = 0; hf < 2; ++hf) {
                launch_phase<PH_R2>(a, l, hf, stream); launch_phase<PH_R3>(a, l, hf, stream); launch_phase<PH_R4>(a, l, hf, stream);
                launch_phase<PH_R5>(a, l, hf, stream); launch_phase<PH_R6>(a, l, hf, stream); launch_phase<PH_R7>(a, l, hf, stream);
            }
        } else {
            launch_phase<PH_M2>(a, l, 0, stream); launch_phase<PH_M3>(a, l, 0, stream); launch_phase<PH_M4>(a, l, 0, stream); launch_phase<PH_M5>(a, l, 0, stream);
        }
        launch_phase<PH_NB>(a, l, 0, stream); launch_phase<PH_MOE1>(a, l, 0, stream); launch_phase<PH_MOE2>(a, l, 0, stream);
    }
    launch_phase<PH_NA>(a, 4, 0, stream);
}
```

```cpp
#define PROBE_PH -1
#define PROBE_N 0
#include <hip/hip_runtime.h>
#include <cstdio>
#include <cstdint>

#ifndef MK_SINGLE
#define MK_SINGLE 1
#endif
#ifndef MK_CHECK
#define MK_CHECK 0
#endif

#define GAS __attribute__((address_space(1)))
#define LAS __attribute__((address_space(3)))
typedef unsigned short bf16_t;
typedef short bf16x8 __attribute__((ext_vector_type(8)));
typedef short s16x4 __attribute__((ext_vector_type(4)));
typedef float f32x4 __attribute__((ext_vector_type(4)));
typedef float f32x2 __attribute__((ext_vector_type(2)));
typedef float f32x16 __attribute__((ext_vector_type(16)));
typedef unsigned u32x4 __attribute__((ext_vector_type(4)));
typedef unsigned u32x2 __attribute__((ext_vector_type(2)));

constexpr int NB = 4, SEQ = 8192, DM = 1024, NTOK = NB * SEQ, THALF = NTOK / 2;
constexpr int NEXP = 16, DEXP = 512;
constexpr int RH = 4, RDK = 256, RDV = 512, RV = 2048;
constexpr int MH = 8, QLORA = 256, KVL = 128, ROPE = 64, QKD = 192;
constexpr float EPS = 1e-6f;
constexpr int NWAVES = 8, NTHREADS = 512, GRID = 256;
constexpr int MAXSLOTS = 69632;

constexpr size_t MiB = 1u << 20;
constexpr size_t WS_CTL = 0, CTL_BYTES = 1 * MiB;
constexpr size_t WS_MOD = 1 * MiB;
constexpr size_t WS_ROUTE = 2 * MiB;
constexpr size_t WS_SSQ = 3 * MiB;
constexpr size_t WS_STATS = 4 * MiB;
constexpr size_t WS_IDX = 8 * MiB;
constexpr size_t WS_WIN = 10 * MiB;
constexpr size_t WS_WOUT = 34 * MiB;
constexpr size_t WS_WQA = 42 * MiB;
constexpr size_t WS_WKVA = 43 * MiB;
constexpr size_t WS_WQB = 44 * MiB;
constexpr size_t WS_WO = 46 * MiB;
constexpr size_t WS_WGU = 50 * MiB;
constexpr size_t WS_WDN = 178 * MiB;
constexpr size_t WS_XN = 242 * MiB;
constexpr size_t WS_L = 306 * MiB;
constexpr size_t WS_END = 690 * MiB;
constexpr size_t WS_A2 = WS_L, WS_KR = WS_L + 64 * MiB, WS_KT = WS_L + 96 * MiB, WS_B2T = WS_L + 128 * MiB;
constexpr size_t WS_HDN = WS_L, WS_YB = WS_L + 68 * MiB;
constexpr size_t WS_HN = WS_L, WS_QA = WS_L + 64 * MiB, WS_AKV = WS_L + 80 * MiB, WS_Q = WS_L + 112 * MiB, WS_OL = WS_L + 208 * MiB, WS_KP = WS_L + 300 * MiB;
constexpr int CW_BAR = 4096;
constexpr int CW_CNT = 16384;
constexpr int CW_CHK = 32768;

constexpr int LDS_STAGE = 131072;
constexpr int LDS_MISC = LDS_STAGE;
constexpr int LDS_TAB = LDS_STAGE + 256;
constexpr int LDS_BYTES = 147456;

#define LDS_WAIT() asm volatile("s_waitcnt lgkmcnt(0)" ::: "memory")
#define VM_WAIT() asm volatile("s_waitcnt vmcnt(0)" ::: "memory")
__device__ __forceinline__ unsigned cvt_pk_bf16(float lo, float hi) { unsigned r; asm volatile("v_cvt_pk_bf16_f32 %0, %1, %2" : "=v"(r) : "v"(lo), "v"(hi)); return r; }
__device__ __forceinline__ unsigned pk4_fp8(float a, float b, float c2, float d) { int w = __builtin_amdgcn_cvt_pk_fp8_f32(a, b, 0, false); return (unsigned)__builtin_amdgcn_cvt_pk_fp8_f32(c2, d, w, true); }
__device__ __forceinline__ float bf2f(unsigned short b) { return __uint_as_float((unsigned)b << 16); }
__device__ __forceinline__ float bflo(unsigned w) { return __uint_as_float(w << 16); }
__device__ __forceinline__ float bfhi(unsigned w) { return __uint_as_float(w & 0xffff0000u); }
template <int CTRL> __device__ __forceinline__ float dpp_f(float v) { return __int_as_float(__builtin_amdgcn_mov_dpp(__float_as_int(v), CTRL, 0xf, 0xf, true)); }
__device__ __forceinline__ float rows_sum(float v) {
    { auto t = __builtin_amdgcn_permlane16_swap(__float_as_uint(v), __float_as_uint(v), false, false); v = __uint_as_float(t[0]) + __uint_as_float(t[1]); }
    { auto t = __builtin_amdgcn_permlane32_swap(__float_as_uint(v), __float_as_uint(v), false, false); v = __uint_as_float(t[0]) + __uint_as_float(t[1]); }
    return v;
}
__device__ __forceinline__ float wave_sum(float v) {
    v += dpp_f<0xB1>(v);
    v += dpp_f<0x4E>(v);
    v += dpp_f<0x141>(v);
    v += dpp_f<0x140>(v);
    return rows_sum(v);
}
__device__ __forceinline__ void sincos_rad(float ang, float& s, float& c) {
    float r = __builtin_amdgcn_fractf(ang * 0.15915494309189535f);
    s = __builtin_amdgcn_sinf(r); c = __builtin_amdgcn_cosf(r);
}
__device__ __forceinline__ float silu_f(float x) { return x / (1.0f + __expf(-x)); }
__device__ __forceinline__ float log2_gamma(int h) { return h == 0 ? -0.04580368961312479f : (h == 1 ? -0.02272007650008353f : (h == 2 ? -0.011315313227834146f : -0.005646563141142063f)); }
constexpr float LOG2_THETA = 13.287712379549449f;

__device__ __forceinline__ int lane_id() { return (int)__builtin_amdgcn_mbcnt_hi(~0u, __builtin_amdgcn_mbcnt_lo(~0u, 0u)); }
#define XB_TMO      128
#define XB_XCNT(j)  (256  + 64 * (j))
#define XB_XSUB(j)  (1280 + 64 * (j))
#define XB_XGEN(j)  (2304 + 64 * (j))
#define XB_TOP      3328
#define XB_TOPGEN   3392
#define XCD_BAR_WORDS 3456
#define XB_SPIN_CAP (1u << 18)
__device__ __forceinline__ unsigned xb_ld(unsigned* p)              { return __hip_atomic_load(p, __ATOMIC_RELAXED, __HIP_MEMORY_SCOPE_AGENT); }
__device__ __forceinline__ unsigned xb_add(unsigned* p, unsigned v) { return __hip_atomic_fetch_add(p, v, __ATOMIC_RELAXED, __HIP_MEMORY_SCOPE_AGENT); }
__device__ __forceinline__ unsigned xb_xcc_id() { return (unsigned)__builtin_amdgcn_s_getreg((3 << 11) | 20) & 0xFu; }
#define XB_SPIN(cond, bar) do { unsigned _sp = 0; while (cond) { __builtin_amdgcn_s_sleep(1); \
    if ((++_sp & 255u) == 0u) { if (xb_ld(&(bar)[XB_TMO])) break; if (_sp > XB_SPIN_CAP) { atomicAdd(&(bar)[XB_TMO], 1u); break; } } } } while (0)
struct XcdBarrier { unsigned* bar; unsigned x; volatile LAS unsigned* st; };
__device__ __forceinline__ XcdBarrier xcd_barrier_post(unsigned* bar, volatile LAS unsigned* st) {
    XcdBarrier b; b.bar = bar; b.x = xb_xcc_id(); b.st = st;
    if (threadIdx.x == 0) (void)xb_add(&bar[XB_XCNT(b.x)], 1u);
    return b;
}
__device__ __forceinline__ void xcd_barrier_complete(unsigned* bar, unsigned x, unsigned& nloc, unsigned& nx) {
    const unsigned G = gridDim.x * gridDim.y * gridDim.z;
    unsigned sum, cnt, mine, sp = 0u;
    for (;;) {
        sum = 0u; cnt = 0u; mine = 0u;
#pragma unroll
        for (unsigned j = 0; j < 16; ++j) { const unsigned c = xb_ld(&bar[XB_XCNT(j)]); sum += c; cnt += (c > 0u) ? 1u : 0u; mine = (j == x) ? c : mine; }
        if (sum == G) break;
        __builtin_amdgcn_s_sleep(1);
        if ((++sp & 255u) == 0u) { if (xb_ld(&bar[XB_TMO])) break; if (sp > XB_SPIN_CAP) { atomicAdd(&bar[XB_TMO], 1u); break; } }
    }
    nloc = mine > 0u ? mine : 1u; nx = cnt > 0u ? cnt : 1u;
}
__device__ __forceinline__ void xcd_barrier(const XcdBarrier& b, const int wave) {
    asm volatile("s_waitcnt vmcnt(0)" ::: "memory");
    __syncthreads();
    if (wave == 0 && lane_id() == 0) {
        unsigned* bar = b.bar; unsigned bx = b.x; asm volatile("" : "+s"(bar), "+s"(bx));
        __builtin_amdgcn_s_waitcnt(0);
        unsigned nloc = b.st[0], nx = b.st[1];
        if (nloc == 0u) { xcd_barrier_complete(bar, bx, nloc, nx); b.st[0] = nloc; b.st[1] = nx; }
        const unsigned old = xb_add(&bar[XB_XSUB(bx)], 1u);
        const unsigned gen = old / nloc;
        if (old + 1u == (gen + 1u) * nloc) {
            __builtin_amdgcn_fence(__ATOMIC_RELEASE, "agent");
            asm volatile("s_waitcnt vmcnt(0)" ::: "memory");
            const unsigned og = xb_add(&bar[XB_TOP], 1u);
            const unsigned tg = og / nx;
            if (og + 1u == (tg + 1u) * nx) xb_add(&bar[XB_TOPGEN], 1u);
            else XB_SPIN(xb_ld(&bar[XB_TOPGEN]) == tg, bar);
            __builtin_amdgcn_fence(__ATOMIC_ACQUIRE, "agent");
            xb_add(&bar[XB_XGEN(bx)], 1u);
            asm volatile("s_waitcnt vmcnt(0)" ::: "memory");
        } else {
            XB_SPIN(xb_ld(&bar[XB_XGEN(bx)]) == gen, bar);
            __builtin_amdgcn_fence(__ATOMIC_ACQUIRE, "agent");
            asm volatile("s_waitcnt vmcnt(0)" ::: "memory");
        }
    }
    __syncthreads();
}

namespace pg8 {
constexpr int BM = 256, BK = 64, HALF = 128, HTB = HALF * BK * 2, STAGE_BYTES = 8 * HTB;
__host__ __device__ __forceinline__ int lds_byte(int r, int c) { const int st = (r >> 4) * 2 + (c >> 5), rr = r & 15, cc = c & 31, ob = rr * 64 + cc * 2; return st * 1024 + (ob ^ (((ob >> 9) & 1) << 5)); }
__host__ __device__ __forceinline__ void stage_rc(int b, int& R, int& C) { const int st = b / 1024, sb = b % 1024, swz = sb ^ (((sb >> 9) & 1) << 5); R = (st >> 1) * 16 + swz / 64; C = (st & 1) * 32 + (swz % 64) / 2; }
__host__ __device__ __forceinline__ int perm32(int rho) { const int n = rho >> 4, i = rho & 15; return 8 * (i >> 2) + 4 * n + (i & 3); }

struct Unit { const char* A; const char* B; int pm, pn, aux; };

struct TileOrder {
    int nM, nN, nwg, G, c;
    __device__ void init(int nM_, int nN_, int G_, int c_) { nM = nM_; nN = nN_; nwg = nM * nN; G = G_; c = c_; }
    __device__ bool tile(int i, int& pm, int& pn) const {
        const long L = (long)i * G + c; if (L >= nwg) return false;
        int wgid = (int)L; { const int q = nwg / 8, r = nwg % 8, xcd = wgid % 8, off = wgid / 8; wgid = (xcd < r ? xcd * (q + 1) : r * (q + 1) + (xcd - r) * q) + off; }
        const int nig = 8 * nN, gid = wgid / nig, fm = gid * 8, gsz = (nM - fm) < 8 ? (nM - fm) : 8;
        pm = fm + ((wgid % nig) % gsz); pn = (wgid % nig) / gsz; return true;
    }
};

typedef int i32x8 __attribute__((ext_vector_type(8)));
typedef int i32x4 __attribute__((ext_vector_type(4)));
__device__ __forceinline__ i32x8 cat8(bf16x8 lo, bf16x8 hi) { const i32x4 a = __builtin_bit_cast(i32x4, lo), b = __builtin_bit_cast(i32x4, hi); return __builtin_shufflevector(a, b, 0, 1, 2, 3, 4, 5, 6, 7); }
template <class Epi, class Sched, bool GATHER, bool FP8 = false, int SCW = 0x7f7f7f7f, int SCX = 0x7f7f7f7f>
__device__ __forceinline__ void gemm_phase(LAS unsigned char* lds, const int wid, const int K, const unsigned lda, const unsigned ldb, const Sched& S, const Epi& E) {
    int lane_ = (int)__builtin_amdgcn_mbcnt_hi(~0u, __builtin_amdgcn_mbcnt_lo(~0u, 0u)); asm volatile("" : "+v"(lane_));
    const int lane = lane_, tid = wid * 64 + lane, wr = wid >> 2, wc = wid & 3, fr = lane & 15, fq = lane >> 4;
    const int nt = K / BK;
    unsigned voffA[2], voffB[2]; int RA[2], CA[2];
#pragma unroll
    for (int i = 0; i < 2; ++i) { int R, C; stage_rc(tid * 16 + i * 8192, R, C); const int Rb = Epi::PERM ? ((R & ~31) + perm32(R & 31)) : R;
        RA[i] = R; CA[i] = C; voffA[i] = (unsigned)R * lda + (unsigned)C * 2u; voffB[i] = (unsigned)Rb * ldb + (unsigned)C * 2u; }
    const size_t kstep = (size_t)(BK * 2);
    const size_t hstepA = (size_t)HALF * lda, hstepB = (size_t)HALF * ldb;
    const unsigned ldsw = (unsigned)wid * 1024u;
    const int aoff = lds_byte(wr * 64 + fr, fq * 8), boff = lds_byte(wc * 32 + fr, fq * 8);
#define PG8_SA(b, h) (((b) * 2 + (h)) * HTB)
#define PG8_SB(b, h) ((4 + (b) * 2 + (h)) * HTB)
#define PG8_GLDS(gp, bufoff, i) __builtin_amdgcn_global_load_lds((const unsigned*)(gp), (LAS unsigned*)(lds + (bufoff) + ldsw + (i) * 8192), 16, 0, 0)
#define PG8_STAGE_B(bufoff, gbase) do { _Pragma("unroll") for (int _i = 0; _i < 2; ++_i) PG8_GLDS((const char*)(gbase) + voffB[_i], bufoff, _i); } while (0)
#define PG8_STAGE_A(bufoff, gbase, h, GO) do { _Pragma("unroll") for (int _i = 0; _i < 2; ++_i) { \
        if constexpr (GATHER) PG8_GLDS((const char*)(gbase) + GO[h][_i], bufoff, _i); else PG8_GLDS((const char*)(gbase) + (size_t)(h) * hstepA + voffA[_i], bufoff, _i); } } while (0)
#define PG8_LDA(dst, b, h) do { _Pragma("unroll") for (int m = 0; m < 4; ++m) _Pragma("unroll") for (int k = 0; k < 2; ++k) dst[m][k] = *(const LAS bf16x8*)(lds + PG8_SA(b, h) + aoff + m * 2048 + k * 1024); } while (0)
#define PG8_LDB(dst, b, h) do { _Pragma("unroll") for (int n = 0; n < 2; ++n) _Pragma("unroll") for (int k = 0; k < 2; ++k) dst[n][k] = *(const LAS bf16x8*)(lds + PG8_SB(b, h) + boff + n * 2048 + k * 1024); } while (0)
#define PG8_MFMA8(ACC, W8, X8) asm volatile("v_mfma_scale_f32_16x16x128_f8f6f4 %0, %1, %2, %0, %3, %4 op_sel_hi:[0,0,0]" : "+v"(ACC) : "v"(W8), "v"(X8), "v"(scw_), "v"(scx_))
#define PG8_MMA(ai, bj, At, Bt) do { __builtin_amdgcn_s_setprio(1); if constexpr (FP8) { i32x8 a8_[4], b8_[2]; _Pragma("unroll") for (int m = 0; m < 4; ++m) a8_[m] = cat8(At[m][0], At[m][1]); \
        _Pragma("unroll") for (int n = 0; n < 2; ++n) b8_[n] = cat8(Bt[n][0], Bt[n][1]); asm volatile("s_nop 3" ::: "memory"); \
        _Pragma("unroll") for (int m = 0; m < 4; ++m) _Pragma("unroll") for (int n = 0; n < 2; ++n) PG8_MFMA8(acc[ai][bj][m][n], b8_[n], a8_[m]); } else { \
        _Pragma("unroll") for (int m = 0; m < 4; ++m) _Pragma("unroll") for (int n = 0; n < 2; ++n) _Pragma("unroll") for (int k = 0; k < 2; ++k) \
        acc[ai][bj][m][n] = __builtin_amdgcn_mfma_f32_16x16x32_bf16(Bt[n][k], At[m][k], acc[ai][bj][m][n], 0, 0, 0); } __builtin_amdgcn_s_setprio(0); } while (0)
#define PG8_WAIT_V(n) asm volatile("s_waitcnt vmcnt(" #n ")" ::: "memory")
#define PG8_WAIT_L(n) asm volatile("s_waitcnt lgkmcnt(" #n ")" ::: "memory")
#define PG8_BAR __builtin_amdgcn_s_barrier()
#define PG8_SCHED __builtin_amdgcn_sched_barrier(0)
    Unit cur, nxt; int ui = 0;
    if (!S.next(0, cur)) return;
    int scw_ = SCW, scx_ = SCX; asm volatile("" : "+v"(scw_), "+v"(scx_)); (void)scw_; (void)scx_;
    unsigned goff[2][2] = {{0u, 0u}, {0u, 0u}}, ngoff[2][2] = {{0u, 0u}, {0u, 0u}};
    if constexpr (GATHER) {
#pragma unroll
        for (int h = 0; h < 2; ++h)
#pragma unroll
            for (int i = 0; i < 2; ++i) goff[h][i] = (unsigned)S.tok(cur, h * HALF + RA[i]) * lda + (unsigned)CA[i] * 2u;
    }
    f32x4 acc[2][2][4][2];
#pragma unroll
    for (int a = 0; a < 2; ++a)
#pragma unroll
        for (int b = 0; b < 2; ++b)
#pragma unroll
            for (int m = 0; m < 4; ++m)
#pragma unroll
                for (int n = 0; n < 2; ++n) acc[a][b][m][n] = (f32x4){0.f, 0.f, 0.f, 0.f};
    bf16x8 At[4][2], B0[2][2], B1[2][2];
    const char* cA = cur.A; const char* cB = cur.B;
    PG8_STAGE_B(PG8_SB(0, 0), cB); PG8_STAGE_B(PG8_SB(0, 1), cB + hstepB); PG8_STAGE_A(PG8_SA(0, 0), cA, 0, goff); PG8_STAGE_A(PG8_SA(0, 1), cA, 1, goff);
    if (wr == 1) PG8_BAR;
    PG8_WAIT_V(2); PG8_BAR;
    PG8_STAGE_B(PG8_SB(1, 0), cB + kstep); PG8_STAGE_A(PG8_SA(1, 0), cA + kstep, 0, goff); PG8_STAGE_B(PG8_SB(1, 1), cB + hstepB + kstep);
    PG8_WAIT_V(6); PG8_BAR;
    for (;;) {
        const bool has_next = S.next(ui + 1, nxt);
        const char* nA = has_next ? nxt.A : cA; const char* nB = has_next ? nxt.B : cB;
        if constexpr (GATHER) {
#pragma unroll
            for (int h = 0; h < 2; ++h)
#pragma unroll
                for (int i = 0; i < 2; ++i) ngoff[h][i] = has_next ? (unsigned)S.tok(nxt, h * HALF + RA[i]) * lda + (unsigned)CA[i] * 2u : goff[h][i];
        }
#pragma unroll 1
        for (int t = 0; t < nt; t += 2) {
            const bool last = (t == nt - 2);
            const char* a1 = cA + (size_t)(t + 1) * kstep;
            const char* a2 = last ? nA : cA + (size_t)(t + 2) * kstep; const char* b2 = last ? nB : cB + (size_t)(t + 2) * kstep;
            const char* a3 = a2 + kstep; const char* b3 = b2 + kstep;
            unsigned g2[2][2];
#pragma unroll
            for (int h = 0; h < 2; ++h)
#pragma unroll
                for (int i = 0; i < 2; ++i) g2[h][i] = last ? ngoff[h][i] : goff[h][i];
            PG8_LDB(B0, 0, 0); PG8_LDB(B1, 0, 1); PG8_SCHED; PG8_LDA(At, 0, 0); PG8_STAGE_A(PG8_SA(1, 1), a1, 1, goff);
            PG8_WAIT_V(8); PG8_WAIT_L(0); PG8_BAR; PG8_MMA(0, 0, At, B0); PG8_MMA(0, 1, At, B1); PG8_BAR; PG8_SCHED;
            PG8_LDA(At, 0, 1); PG8_STAGE_B(PG8_SB(0, 0), b2); PG8_STAGE_B(PG8_SB(0, 1), b2 + hstepB); PG8_STAGE_A(PG8_SA(0, 0), a2, 0, g2);
            PG8_WAIT_V(8); PG8_WAIT_L(0); PG8_BAR; PG8_MMA(1, 0, At, B0); PG8_MMA(1, 1, At, B1); PG8_BAR; PG8_SCHED;
            PG8_LDB(B0, 1, 0); PG8_LDB(B1, 1, 1); PG8_SCHED; PG8_LDA(At, 1, 0); PG8_STAGE_A(PG8_SA(0, 1), a2, 1, g2);
            PG8_WAIT_V(8); PG8_WAIT_L(0); PG8_BAR; PG8_MMA(0, 0, At, B0); PG8_MMA(0, 1, At, B1); PG8_BAR; PG8_SCHED;
            PG8_LDA(At, 1, 1); PG8_STAGE_B(PG8_SB(1, 0), b3); PG8_STAGE_B(PG8_SB(1, 1), b3 + hstepB); PG8_STAGE_A(PG8_SA(1, 0), a3, 0, g2);
            PG8_WAIT_V(8); PG8_WAIT_L(0); PG8_BAR; PG8_MMA(1, 0, At, B0); PG8_MMA(1, 1, At, B1); PG8_BAR; PG8_SCHED;
        }
        if (wr == 0) PG8_BAR;
        if constexpr (FP8) asm volatile("s_nop 7\n\ts_nop 7" ::: "memory");
        { int fr2 = fr, fq2 = fq; asm volatile("" : "+v"(fr2), "+v"(fq2)); E(acc, cur, wr, wc, fr2, fq2); }
        if (!has_next) break;
#pragma unroll
        for (int a = 0; a < 2; ++a)
#pragma unroll
            for (int b = 0; b < 2; ++b)
#pragma unroll
                for (int m = 0; m < 4; ++m)
#pragma unroll
                    for (int n = 0; n < 2; ++n) acc[a][b][m][n] = (f32x4){0.f, 0.f, 0.f, 0.f};
        cur = nxt; cA = nA; cB = nB; ++ui;
        if constexpr (GATHER) {
#pragma unroll
            for (int h = 0; h < 2; ++h)
#pragma unroll
                for (int i = 0; i < 2; ++i) goff[h][i] = ngoff[h][i];
        }
        if (wr == 1) PG8_BAR;
    }
    PG8_WAIT_V(0);
    PG8_BAR;
#undef PG8_SA
#undef PG8_SB
#undef PG8_GLDS
#undef PG8_STAGE_A
#undef PG8_STAGE_B
#undef PG8_LDA
#undef PG8_LDB
#undef PG8_MMA
#undef PG8_MFMA8
#undef PG8_WAIT_V
#undef PG8_WAIT_L
#undef PG8_BAR
#undef PG8_SCHED
}
}
__device__ __forceinline__ const char* uni_ptr(const char* p) {
    unsigned long long v = (unsigned long long)p; unsigned lo = __builtin_amdgcn_readfirstlane((unsigned)v), hi = __builtin_amdgcn_readfirstlane((unsigned)(v >> 32));
    return (const char*)(((unsigned long long)hi << 32) | lo);
}
struct SchedStd {
    pg8::TileOrder T; const char* A; const char* B; size_t sA, sB;
    __device__ __forceinline__ bool next(int i, pg8::Unit& u) const { int pm, pn; if (!T.tile(i, pm, pn)) return false; u.pm = pm; u.pn = pn; u.aux = 0; u.A = A + (size_t)pm * sA; u.B = B + (size_t)pn * sB; return true; }
    __device__ __forceinline__ int tok(const pg8::Unit&, int) const { return 0; }
};
struct SchedBatch {
    const char* A; const char* B; size_t sA, sB, vA, vB; int nunits, nvt, G, c;
    __device__ __forceinline__ bool next(int i, pg8::Unit& u) const { const int L = i * G + c; if (L >= nunits * nvt) return false; const int uu = L / nvt, vt = L % nvt; u.pm = uu; u.pn = vt; u.aux = 0;
        u.A = A + (size_t)uu * sA + (size_t)vt * vA; u.B = B + (size_t)uu * sB + (size_t)vt * vB; return true; }
    __device__ __forceinline__ int tok(const pg8::Unit&, int) const { return 0; }
};
struct SchedMoE {
    const LAS int* tab; const char* A; const char* Bw; size_t sE, sPN, sRT; const int* idx; int G, c; bool gather;
    __device__ __forceinline__ bool next(int i, pg8::Unit& u) const {
        const int L = i * G + c, rt = L >> 2, pn = L & 3;
        const int ntile = __builtin_amdgcn_readfirstlane(tab[32]); if (rt >= ntile) return false;
        int e = 0;
#pragma unroll
        for (int k = 1; k < 16; ++k) e += (rt >= __builtin_amdgcn_readfirstlane(tab[16 + k])) ? 1 : 0;
        e = __builtin_amdgcn_readfirstlane(e);
        u.pm = rt; u.pn = pn; u.aux = e; u.A = gather ? A : A + (size_t)rt * sRT; u.B = Bw + (size_t)e * sE + (size_t)pn * sPN; return true;
    }
    __device__ __forceinline__ int tok(const pg8::Unit& u, int r) const {
        const int e = u.aux, p = (u.pm - __builtin_amdgcn_readfirstlane(tab[16 + e])) * 256 + r, n = __builtin_amdgcn_readfirstlane(tab[e]);
        return p < n ? idx[e * NTOK + p] : 0;
    }
};

typedef const f32x4 (&AccRef)[2][2][4][2];
__device__ __forceinline__ int launder(int x) { asm volatile("" : "+v"(x)); return x; }
__device__ __forceinline__ void st8(bf16_t* p, f32x4 v0, f32x4 v1) {
    u32x4 w; w.x = cvt_pk_bf16(v0[0], v0[1]); w.y = cvt_pk_bf16(v0[2], v0[3]); w.z = cvt_pk_bf16(v1[0], v1[1]); w.w = cvt_pk_bf16(v1[2], v1[3]); *(u32x4*)p = w;
}
struct EpiPlain {
    static constexpr bool PERM = true; bf16_t* out; int ld;
    __device__ __forceinline__ void operator()(AccRef acc, const pg8::Unit& u, int wr, int wc, int fr, int fq) const {
#pragma unroll
        for (int ai = 0; ai < 2; ++ai)
#pragma unroll
            for (int m = 0; m < 4; ++m) { const int r = ai * 128 + wr * 64 + m * 16 + fr; bf16_t* rp = out + (size_t)(u.pm * 256 + r) * ld + u.pn * 256 + wc * 32 + fq * 8;
#pragma unroll
                for (int bj = 0; bj < 2; ++bj) st8(rp + bj * 128, acc[ai][bj][m][0], acc[ai][bj][m][1]); }
    }
};
template <int MODE> struct EpiRopeQK {
    static constexpr bool PERM = true; bf16_t* out; const int* pos; int half;
    __device__ __forceinline__ void operator()(AccRef acc, const pg8::Unit& u, int wr, int wc, int fr, int fq) const {
        const int pm = u.pm, h = u.pn, uu = ((pm >> 5) * 4 + h) * 32 + (pm & 31); const float l2g = log2_gamma(h);
        constexpr int LD = MODE == 0 ? 512 : 256;
        float inv[8]; const int f0 = launder(wc * 32 + fq * 8);
#pragma unroll
        for (int k = 0; k < 8; ++k) inv[k] = __builtin_amdgcn_exp2f(-(float)(f0 + k) * (LOG2_THETA / 128.0f));
#pragma unroll
        for (int ai = 0; ai < 2; ++ai)
#pragma unroll
            for (int m = 0; m < 4; ++m) { const int r = ai * 128 + wr * 64 + m * 16 + fr; const float p = (float)pos[half * THALF + pm * 256 + r];
                const float dec = MODE == 0 ? __builtin_amdgcn_exp2f((float)r * l2g) : __builtin_amdgcn_exp2f(-(float)r * l2g) * 0.0625f;
                f32x4 o1[2], o2[2];
#pragma unroll
                for (int n = 0; n < 2; ++n)
#pragma unroll
                    for (int j = 0; j < 4; ++j) { float s, c; sincos_rad(p * inv[n * 4 + j], s, c); const float x1 = acc[ai][0][m][n][j], x2 = acc[ai][1][m][n][j];
                        o1[n][j] = (x1 * c - x2 * s) * dec; o2[n][j] = (x1 * s + x2 * c) * dec; }
                bf16_t* rp = out + (size_t)uu * (256 * LD) + (size_t)r * LD + wc * 32 + fq * 8;
                st8(rp, o1[0], o1[1]); st8(rp + 128, o2[0], o2[1]); __builtin_amdgcn_sched_barrier(0); }
    }
};
struct EpiRopeKT {
    static constexpr bool PERM = true; bf16_t* out; const int* pos; int half;
    __device__ __forceinline__ void operator()(AccRef acc, const pg8::Unit& u, int wr, int wc, int fr, int fq) const {
        const int h = u.pm, pn = u.pn, uu = ((pn >> 5) * 4 + h) * 32 + (pn & 31); const float l2g = log2_gamma(h);
        float pp[2][8], dec[2][8]; const int c00 = launder(wc * 32 + fq * 8), i00 = launder(wr * 64 + fr);
#pragma unroll
        for (int bj = 0; bj < 2; ++bj)
#pragma unroll
            for (int k = 0; k < 8; ++k) { const int c = bj * 128 + c00 + k; pp[bj][k] = (float)pos[half * THALF + pn * 256 + c]; dec[bj][k] = __builtin_amdgcn_exp2f(-(float)c * l2g) * 0.0625f; }
#pragma unroll
        for (int m = 0; m < 4; ++m) { const int i = i00 + m * 16; const float inv = __builtin_amdgcn_exp2f(-(float)i * (LOG2_THETA / 128.0f));
#pragma unroll
            for (int bj = 0; bj < 2; ++bj) { f32x4 o1[2], o2[2];
#pragma unroll
                for (int n = 0; n < 2; ++n)
#pragma unroll
                    for (int j = 0; j < 4; ++j) { float s, c; sincos_rad(pp[bj][n * 4 + j] * inv, s, c); const float x1 = acc[0][bj][m][n][j], x2 = acc[1][bj][m][n][j], d = dec[bj][n * 4 + j];
                        o1[n][j] = (x1 * c - x2 * s) * d; o2[n][j] = (x1 * s + x2 * c) * d; }
                bf16_t* rp = out + (size_t)uu * 65536 + (size_t)i * 256 + bj * 128 + c00;
                st8(rp, o1[0], o1[1]); st8(rp + 128 * 256, o2[0], o2[1]); __builtin_amdgcn_sched_barrier(0); } }
    }
};
struct EpiVT {
    static constexpr bool PERM = true; bf16_t* out;
    __device__ __forceinline__ void operator()(AccRef acc, const pg8::Unit& u, int wr, int wc, int fr, int fq) const {
        const int h = u.pm >> 1, vt = u.pm & 1, pn = u.pn, uu = ((pn >> 5) * 4 + h) * 32 + (pn & 31);
#pragma unroll
        for (int ai = 0; ai < 2; ++ai)
#pragma unroll
            for (int m = 0; m < 4; ++m) { const int r = ai * 128 + wr * 64 + m * 16 + fr; bf16_t* rp = out + (size_t)uu * 262144 + (size_t)(vt * 256 + r) * 512 + 256 + wc * 32 + fq * 8;
#pragma unroll
                for (int bj = 0; bj < 2; ++bj) st8(rp + bj * 128, acc[ai][bj][m][0], acc[ai][bj][m][1]); }
    }
};
struct EpiS {
    static constexpr bool PERM = true; bf16_t* out;
    __device__ __forceinline__ void operator()(AccRef acc, const pg8::Unit& u, int wr, int wc, int fr, int fq) const {
        const int uu = u.pm;
#pragma unroll
        for (int ai = 0; ai < 2; ++ai)
#pragma unroll
            for (int m = 0; m < 4; ++m) { const int r = ai * 128 + wr * 64 + m * 16 + fr; bf16_t* rp = out + (size_t)uu * 131072 + (size_t)r * 512 + 256 + wc * 32 + fq * 8;
#pragma unroll
                for (int bj = 0; bj < 2; ++bj) { const int c0 = bj * 128 + wc * 32 + fq * 8; f32x4 v0 = acc[ai][bj][m][0], v1 = acc[ai][bj][m][1];
#pragma unroll
                    for (int j = 0; j < 4; ++j) { if (c0 + j > r) v0[j] = 0.f; if (c0 + 4 + j > r) v1[j] = 0.f; }
                    st8(rp + bj * 128, v0, v1); } }
    }
};
struct EpiKV {
    static constexpr bool PERM = true; bf16_t* out;
    __device__ __forceinline__ void operator()(AccRef acc, const pg8::Unit& u, int wr, int wc, int fr, int fq) const {
        const int uu = u.pm, vt = u.pn, h = (uu >> 5) & 3; const float sc = __builtin_amdgcn_exp2f(255.0f * log2_gamma(h));
#pragma unroll
        for (int ai = 0; ai < 2; ++ai)
#pragma unroll
            for (int m = 0; m < 4; ++m) { const int r = ai * 128 + wr * 64 + m * 16 + fr; bf16_t* rp = out + (size_t)uu * 262144 + (size_t)(vt * 256 + r) * 512 + wc * 32 + fq * 8;
#pragma unroll
                for (int bj = 0; bj < 2; ++bj) st8(rp + bj * 128, acc[ai][bj][m][0] * sc, acc[ai][bj][m][1] * sc); }
    }
};
struct EpiFin {
    static constexpr bool PERM = true; bf16_t* out; float* stats;
    __device__ __forceinline__ void operator()(AccRef acc, const pg8::Unit& u, int wr, int wc, int fr, int fq) const {
        const int uu = u.pm, vt = u.pn, bl = uu >> 7, h = (uu >> 5) & 3, ch = uu & 31;
#pragma unroll
        for (int ai = 0; ai < 2; ++ai)
#pragma unroll
            for (int m = 0; m < 4; ++m) { const int r = ai * 128 + wr * 64 + m * 16 + fr; bf16_t* rp = out + (size_t)uu * 262144 + (size_t)(vt * 256 + r) * 512 + wc * 32 + fq * 8;
                float s = 0.f, q = 0.f;
#pragma unroll
                for (int bj = 0; bj < 2; ++bj) { const f32x4 v0 = acc[ai][bj][m][0], v1 = acc[ai][bj][m][1];
                    s += (v0[0] + v0[1]) + (v0[2] + v0[3]) + (v1[0] + v1[1]) + (v1[2] + v1[3]);
                    q += (v0[0] * v0[0] + v0[1] * v0[1]) + (v0[2] * v0[2] + v0[3] * v0[3]) + (v1[0] * v1[0] + v1[1] * v1[1]) + (v1[2] * v1[2] + v1[3] * v1[3]);
                    st8(rp + bj * 128, v0, v1); }
                s = rows_sum(s); q = rows_sum(q);
                const int tokl = bl * SEQ + ch * 256 + r;
                if (fq == 0) *(f32x2*)(stats + ((size_t)(tokl * 4 + h) * 8 + vt * 4 + wc) * 2) = (f32x2){s, q}; }
    }
};
struct EpiGate {
    static constexpr bool PERM = true; const bf16_t* o; const float* stats; bf16_t* y;
    __device__ __forceinline__ void operator()(AccRef acc, const pg8::Unit& u, int wr, int wc, int fr, int fq) const {
        const int pm = u.pm, h = u.pn >> 1, vt = u.pn & 1, uu = ((pm >> 5) * 4 + h) * 32 + (pm & 31);
#pragma unroll
        for (int ai = 0; ai < 2; ++ai)
#pragma unroll
            for (int m = 0; m < 4; ++m) { const int r = ai * 128 + wr * 64 + m * 16 + fr, tokl = pm * 256 + r;
                const f32x4* sp = (const f32x4*)(stats + (size_t)(tokl * 4 + h) * 16); const f32x4 a = sp[0], b = sp[1], c = sp[2], d = sp[3];
                const float mean = ((a[0] + a[2]) + (b[0] + b[2]) + (c[0] + c[2]) + (d[0] + d[2])) * (1.0f / 512.0f);
                const float ex2 = ((a[1] + a[3]) + (b[1] + b[3]) + (c[1] + c[3]) + (d[1] + d[3])) * (1.0f / 512.0f);
                const float rstd = __builtin_amdgcn_rsqf(fmaxf(ex2 - mean * mean, 0.f) + EPS);
                const bf16_t* op = o + (size_t)uu * 262144 + (size_t)(vt * 256 + r) * 512 + wc * 32 + fq * 8;
                bf16_t* yp = y + (size_t)tokl * 2048 + h * 512 + vt * 256 + wc * 32 + fq * 8;
#pragma unroll
                for (int bj = 0; bj < 2; ++bj) { const u32x4 ow = *(const u32x4*)(op + bj * 128); const f32x4 g0 = acc[ai][bj][m][0], g1 = acc[ai][bj][m][1];
                    f32x4 y0, y1;
                    y0[0] = silu_f(g0[0]) * (bflo(ow.x) - mean) * rstd; y0[1] = silu_f(g0[1]) * (bfhi(ow.x) - mean) * rstd; y0[2] = silu_f(g0[2]) * (bflo(ow.y) - mean) * rstd; y0[3] = silu_f(g0[3]) * (bfhi(ow.y) - mean) * rstd;
                    y1[0] = silu_f(g1[0]) * (bflo(ow.z) - mean) * rstd; y1[1] = silu_f(g1[1]) * (bfhi(ow.z) - mean) * rstd; y1[2] = silu_f(g1[2]) * (bflo(ow.w) - mean) * rstd; y1[3] = silu_f(g1[3]) * (bfhi(ow.w) - mean) * rstd;
                    st8(yp + bj * 128, y0, y1); } __builtin_amdgcn_sched_barrier(0); }
    }
};
struct EpiResid {
    static constexpr bool PERM = false; float* h; const float* gate; int tok0;
    __device__ __forceinline__ void operator()(AccRef acc, const pg8::Unit& u, int wr, int wc, int fr, int fq) const {
#pragma unroll
        for (int ai = 0; ai < 2; ++ai)
#pragma unroll
            for (int m = 0; m < 4; ++m) { const int row = tok0 + u.pm * 256 + ai * 128 + wr * 64 + m * 16 + fr, b = row >> 13;
#pragma unroll
                for (int bj = 0; bj < 2; ++bj)
#pragma unroll
                    for (int n = 0; n < 2; ++n) { const int c = u.pn * 256 + bj * 128 + wc * 32 + n * 16 + fq * 4; const f32x4 gv = *(const f32x4*)(gate + b * 6144 + c);
                        f32x4* hp = (f32x4*)(h + (size_t)row * DM + c); *hp = *hp + gv * acc[ai][bj][m][n]; } }
    }
};
struct EpiGU {
    static constexpr bool PERM = true; bf16_t* hdn;
    __device__ __forceinline__ void operator()(AccRef acc, const pg8::Unit& u, int wr, int wc, int fr, int fq) const {
#pragma unroll
        for (int ai = 0; ai < 2; ++ai)
#pragma unroll
            for (int m = 0; m < 4; ++m) { const int r = ai * 128 + wr * 64 + m * 16 + fr; f32x4 o0, o1;
#pragma unroll
                for (int j = 0; j < 4; ++j) { o0[j] = silu_f(acc[ai][0][m][0][j]) * acc[ai][1][m][0][j]; o1[j] = silu_f(acc[ai][0][m][1][j]) * acc[ai][1][m][1][j]; }
                st8(hdn + (size_t)(u.pm * 256 + r) * DEXP + u.pn * 128 + wc * 32 + fq * 8, o0, o1); }
    }
};
struct EpiGU8 {
    static constexpr bool PERM = true; unsigned char* hdn;
    __device__ __forceinline__ void operator()(AccRef acc, const pg8::Unit& u, int wr, int wc, int fr, int fq) const {
#pragma unroll
        for (int ai = 0; ai < 2; ++ai)
#pragma unroll
            for (int m = 0; m < 4; ++m) { const int r = ai * 128 + wr * 64 + m * 16 + fr; f32x4 o0, o1;
#pragma unroll
                for (int j = 0; j < 4; ++j) { o0[j] = 4.0f * silu_f(acc[ai][0][m][0][j]) * acc[ai][1][m][0][j]; o1[j] = 4.0f * silu_f(acc[ai][0][m][1][j]) * acc[ai][1][m][1][j]; }
                u32x2 w; w.x = pk4_fp8(o0[0], o0[1], o0[2], o0[3]); w.y = pk4_fp8(o1[0], o1[1], o1[2], o1[3]);
                *(u32x2*)(hdn + (size_t)(u.pm * 256 + r) * DEXP + u.pn * 128 + wc * 32 + fq * 8) = w; }
    }
};
struct EpiQA {
    static constexpr bool PERM = true; bf16_t* out; float* ssq;
    __device__ __forceinline__ void operator()(AccRef acc, const pg8::Unit& u, int wr, int wc, int fr, int fq) const {
#pragma unroll
        for (int ai = 0; ai < 2; ++ai)
#pragma unroll
            for (int m = 0; m < 4; ++m) { const int row = u.pm * 256 + ai * 128 + wr * 64 + m * 16 + fr; bf16_t* rp = out + (size_t)row * 256 + wc * 32 + fq * 8; float q = 0.f;
#pragma unroll
                for (int bj = 0; bj < 2; ++bj) { const f32x4 v0 = acc[ai][bj][m][0], v1 = acc[ai][bj][m][1];
                    q += (v0[0] * v0[0] + v0[1] * v0[1]) + (v0[2] * v0[2] + v0[3] * v0[3]) + (v1[0] * v1[0] + v1[1] * v1[1]) + (v1[2] * v1[2] + v1[3] * v1[3]);
                    st8(rp + bj * 128, v0, v1); }
                q = rows_sum(q);
                if (fq == 0) ssq[(size_t)row * 4 + wc] = q; }
    }
};
struct EpiF32 {
    static constexpr bool PERM = false; float* out;
    __device__ __forceinline__ void operator()(AccRef acc, const pg8::Unit& u, int wr, int wc, int fr, int fq) const {
#pragma unroll
        for (int ai = 0; ai < 2; ++ai)
#pragma unroll
            for (int m = 0; m < 4; ++m) { const int row = u.pm * 256 + ai * 128 + wr * 64 + m * 16 + fr;
#pragma unroll
                for (int bj = 0; bj < 2; ++bj)
#pragma unroll
                    for (int n = 0; n < 2; ++n) *(f32x4*)(out + (size_t)row * 256 + bj * 128 + wc * 32 + n * 16 + fq * 4) = acc[ai][bj][m][n]; }
    }
};
struct EpiQB {
    static constexpr bool PERM = true; bf16_t* Q; const float* ssq; const int* pos;
    __device__ __forceinline__ void operator()(AccRef acc, const pg8::Unit& u, int wr, int wc, int fr, int fq) const {
        constexpr float QS = 0.10411754627697264f;
        const int pn = u.pn;
        float inv[8]; const int f0 = launder(fq * 8);
#pragma unroll
        for (int k = 0; k < 8; ++k) inv[k] = __builtin_amdgcn_exp2f(-(float)(f0 + k) * (LOG2_THETA / 32.0f));
#pragma unroll
        for (int ai = 0; ai < 2; ++ai)
#pragma unroll
            for (int m = 0; m < 4; ++m) { const int row = u.pm * 256 + ai * 128 + wr * 64 + m * 16 + fr; const f32x4 sq = *(const f32x4*)(ssq + (size_t)row * 4);
                const float rs = __builtin_amdgcn_rsqf(((sq[0] + sq[1]) + (sq[2] + sq[3])) * (1.0f / 256.0f) + EPS) * QS;
                if (pn < 4) {
#pragma unroll
                    for (int bj = 0; bj < 2; ++bj) st8(Q + (size_t)row * 1536 + (2 * pn + bj) * QKD + wc * 32 + fq * 8, acc[ai][bj][m][0] * rs, acc[ai][bj][m][1] * rs);
                } else {
                    const float p = (float)pos[row]; f32x4 o1[2], o2[2];
#pragma unroll
                    for (int n = 0; n < 2; ++n)
#pragma unroll
                        for (int j = 0; j < 4; ++j) { float s, c; sincos_rad(p * inv[n * 4 + j], s, c); const float x1 = acc[ai][0][m][n][j] * rs, x2 = acc[ai][1][m][n][j] * rs;
                            o1[n][j] = x1 * c - x2 * s; o2[n][j] = x1 * s + x2 * c; }
                    bf16_t* qp = Q + (size_t)row * 1536 + (4 * (pn - 4) + wc) * QKD + 128 + fq * 8;
                    st8(qp, o1[0], o1[1]); st8(qp + 32, o2[0], o2[1]); } __builtin_amdgcn_sched_barrier(0); }
    }
};
typedef const char __attribute__((address_space(4)))* kaptr_t;
struct Ctx { kaptr_t ka; LAS unsigned char* lds; int wave, vcu; };
__device__ __forceinline__ const void* ld_ka(kaptr_t ka, int off) { return *(const void* const __attribute__((address_space(4)))*)(ka + off); }
#define INF(k) ((const float*)ld_ka(ka, (k) * 8))
#define INI(k) ((const int*)ld_ka(ka, (k) * 8))
#define OUTP ((float*)ld_ka(ka, 200))
#define WSB ((unsigned char*)ld_ka(ka, 208))
#define CTLP ((unsigned*)(WSB + WS_CTL))
#define PHASE_ENTRY() kaptr_t ka = C.ka; asm volatile("" : "+s"(ka)); int lane_ = lane_id(); asm volatile("" : "+v"(lane_)); int wave_ = C.wave, vcu_ = C.vcu; asm volatile("" : "+s"(wave_), "+s"(vcu_)); \
    const int lane = lane_, wave = wave_, vcu = vcu_, tid = wave * 64 + lane; LAS unsigned char* const ldsb = C.lds; (void)tid; (void)lane; (void)vcu; (void)ldsb
#define WSP(T, off) ((T*)(WSB + (off)))

__device__ __forceinline__ void transpose_block(const float* W, int N, int k0, int n0, bf16_t* dst, int ldd, int drow, LAS float* scr, int lane) {
#pragma unroll 8
    for (int i = 0; i < 32; ++i) { const int kk = 2 * i + (lane >> 5); scr[kk * 33 + (lane & 31)] = W[(size_t)(k0 + kk) * N + n0 + (lane & 31)]; }
    LDS_WAIT(); asm volatile("" ::: "memory");
    const int c = lane & 7;
#pragma unroll
    for (int j = 0; j < 4; ++j) { const int n = (lane >> 3) + 8 * j; const LAS float* s = scr + (8 * c) * 33 + n;
        u32x4 o; o.x = cvt_pk_bf16(s[0 * 33], s[1 * 33]); o.y = cvt_pk_bf16(s[2 * 33], s[3 * 33]); o.z = cvt_pk_bf16(s[4 * 33], s[5 * 33]); o.w = cvt_pk_bf16(s[6 * 33], s[7 * 33]);
        *(u32x4*)(dst + (size_t)(drow + n) * ldd + k0 + 8 * c) = o; }
    LDS_WAIT(); asm volatile("" ::: "memory");
}
__device__ __forceinline__ void transpose_block_f8(const float* W, int N, int k0, int n0, unsigned char* dst, int ldd, int drow, float sc, LAS float* scr, int lane) {
#pragma unroll 8
    for (int i = 0; i < 32; ++i) { const int kk = 2 * i + (lane >> 5); scr[kk * 33 + (lane & 31)] = W[(size_t)(k0 + kk) * N + n0 + (lane & 31)]; }
    LDS_WAIT(); asm volatile("" ::: "memory");
    const int c = lane & 7;
#pragma unroll
    for (int j = 0; j < 4; ++j) { const int n = (lane >> 3) + 8 * j; const LAS float* s = scr + (8 * c) * 33 + n;
        u32x2 o; o.x = pk4_fp8(sc * s[0 * 33], sc * s[1 * 33], sc * s[2 * 33], sc * s[3 * 33]); o.y = pk4_fp8(sc * s[4 * 33], sc * s[5 * 33], sc * s[6 * 33], sc * s[7 * 33]);
        *(u32x2*)(dst + (size_t)(drow + n) * ldd + k0 + 8 * c) = o; }
    LDS_WAIT(); asm volatile("" ::: "memory");
}
__device__ __forceinline__ void phase_prologue(Ctx& C) {
    PHASE_ENTRY();
    LAS float* cact = (LAS float*)ldsb;
    LAS float* red = (LAS float*)(ldsb + 16384);
    for (int i = tid; i < 4096; i += NTHREADS) cact[i] = silu_f(INF(1)[i]);
    __syncthreads();
    float* mod = WSP(float, WS_MOD);
    for (int g = vcu; g < 416; g += GRID) {
        const int col = g * 64 + lane; const float* W; int N, cc; const float* bias; float* dst; int dstride;
        if (col < 24576) { const int l = col / 6144; cc = col - l * 6144; W = INF(3) + (size_t)l * 1024 * 6144; N = 6144; bias = INF(4) + l * 6144; dst = mod + (size_t)l * 4 * 6144; dstride = 6144; }
        else { cc = col - 24576; W = INF(9); N = 2048; bias = INF(10); dst = mod + 4 * 4 * 6144; dstride = 2048; }
        float a0 = 0.f, a1 = 0.f, a2 = 0.f, a3 = 0.f;
        const float* wp = W + (size_t)(wave * 128) * N + cc;
#pragma unroll 16
        for (int k = 0; k < 128; ++k) { const float w = wp[(size_t)k * N]; const int kk = wave * 128 + k; a0 += cact[kk] * w; a1 += cact[1024 + kk] * w; a2 += cact[2048 + kk] * w; a3 += cact[3072 + kk] * w; }
        red[(wave * 4 + 0) * 64 + lane] = a0; red[(wave * 4 + 1) * 64 + lane] = a1; red[(wave * 4 + 2) * 64 + lane] = a2; red[(wave * 4 + 3) * 64 + lane] = a3;
        __syncthreads();
        if (tid < 256) { const int b = tid >> 6, ln = tid & 63; float s = 0.f;
#pragma unroll
            for (int w = 0; w < 8; ++w) s += red[(w * 4 + b) * 64 + ln];
            const int c2 = g * 64 + ln; const int cc2 = c2 < 24576 ? c2 % 6144 : c2 - 24576;
            dst[(size_t)b * dstride + cc2] = s + bias[cc2]; }
        __syncthreads();
    }
    LAS float* scr = (LAS float*)(ldsb + wave * 16384);
    const int gw = vcu * NWAVES + wave, NGW = GRID * NWAVES;
    constexpr int NIT = 8544 + 64 * 768;
    for (int it = gw; it < NIT; it += NGW) {
        if (it < 6144) { const int l = it / 3072, r = it % 3072, kb = r / 192, nb = r % 192;
            transpose_block(INF(7) + (size_t)l * 1024 * 6144, 6144, 64 * kb, 32 * nb, WSP(bf16_t, WS_WIN) + (size_t)l * 6144 * 1024, 1024, 32 * nb, scr, lane); }
        else if (it < 8192) { const int r0 = it - 6144, l = r0 / 1024, r = r0 % 1024, kb = r / 32, nb = r % 32;
            transpose_block(INF(8) + (size_t)l * 2048 * 1024, 1024, 64 * kb, 32 * nb, WSP(bf16_t, WS_WOUT) + (size_t)l * 1024 * 2048, 2048, 32 * nb, scr, lane); }
        else if (it < 8448) { const int r0 = it - 8192, j = r0 / 128, r = r0 % 128, kb = r / 8, nb = r % 8;
            transpose_block(INF(15) + (size_t)j * 1024 * 256, 256, 64 * kb, 32 * nb, WSP(bf16_t, WS_WQA) + (size_t)j * 256 * 1024, 1024, 32 * nb, scr, lane); }
        else if (it < 8544) { const int r = it - 8448, kb = r / 6, nb = r % 6;
            transpose_block(INF(12), 192, 64 * kb, 32 * nb, WSP(bf16_t, WS_WKVA), 1024, 32 * nb, scr, lane); }
        else { const int r0 = it - 8544, le = r0 / 768, r = r0 % 768;
            if (r < 512) { const int up = r >> 8, rr = r & 255, kb = rr / 16, nb = rr % 16, n0 = 32 * nb;
                transpose_block_f8((up ? INF(22) : INF(21)) + (size_t)le * 1024 * 512, 512, 64 * kb, n0, WSP(unsigned char, WS_WGU) + (size_t)le * 1024 * 1024, 1024, (n0 >> 7) * 256 + (n0 & 127) + up * 128, 64.0f, scr, lane); }
            else { const int rr = r - 512, kb = rr / 32, nb = rr % 32;
                transpose_block_f8(INF(23) + (size_t)le * 512 * 1024, 1024, 64 * kb, 32 * nb, WSP(unsigned char, WS_WDN) + (size_t)le * 1024 * 512, 512, 32 * nb, 64.0f, scr, lane); } }
    }
    const int gt = vcu * NTHREADS + tid, NGT = GRID * NTHREADS;
    for (int i = gt; i < 64 * 1024 / 8; i += NGT) *(u32x4*)(WSP(bf16_t, WS_WKVA) + 192 * 1024 + (size_t)i * 8) = (u32x4){0u, 0u, 0u, 0u};
    for (int i = gt; i < 2 * 1536 * 256; i += NGT) {
        const int k = i & 255, n = (i >> 8) % 1536, j = i / (1536 * 256);
        const float* wq = INF(17) + ((size_t)j * 256 + k) * 1536; float v;
        if (n < 1024) { const int head = n >> 7, cdim = n & 127; const float* a = wq + head * QKD; const float* b = INF(14) + (size_t)cdim * 2048 + head * 256; float s = 0.f;
#pragma unroll 8
            for (int d = 0; d < 128; d += 4) { const f32x4 av = *(const f32x4*)(a + d), bv = *(const f32x4*)(b + d); s += av[0] * bv[0] + av[1] * bv[1] + av[2] * bv[2] + av[3] * bv[3]; }
            v = s; }
        else { const int np = (n - 1024) & 255, pn = (n - 1024) >> 8, half = np >> 7, wcc = (np & 127) >> 5, ii = np & 31; v = wq[(4 * pn + wcc) * QKD + 128 + half * 32 + ii]; }
        v *= INF(16)[j * 256 + k];
        WSP(bf16_t, WS_WQB)[i] = (bf16_t)(cvt_pk_bf16(v, 0.f) & 0xffffu);
    }
    for (int it = vcu * NWAVES + wave; it < 2 * 8 * 16 * 4; it += GRID * NWAVES) {
        const int nq = it & 3, cb = (it >> 2) & 15, hh = (it >> 6) & 7, j = it >> 9, n0 = nq * 256 + 4 * lane, c0 = cb * 8;
        const float* a = INF(14) + (size_t)c0 * 2048 + hh * 256 + 128; const float* bq = INF(18) + ((size_t)j * 1024 + hh * 128) * 1024 + n0;
        f32x4 acc[8];
#pragma unroll
        for (int c = 0; c < 8; ++c) acc[c] = (f32x4){0.f, 0.f, 0.f, 0.f};
#pragma unroll 4
        for (int v = 0; v < 128; ++v) { const f32x4 bv = *(const f32x4*)(bq + (size_t)v * 1024);
#pragma unroll
            for (int c = 0; c < 8; ++c) acc[c] = acc[c] + bv * a[(size_t)c * 2048 + v]; }
        bf16_t* o = WSP(bf16_t, WS_WO) + ((size_t)j * 1024 + n0) * 1024 + hh * 128 + c0;
#pragma unroll
        for (int q = 0; q < 4; ++q) { u32x4 w; w.x = cvt_pk_bf16(acc[0][q], acc[1][q]); w.y = cvt_pk_bf16(acc[2][q], acc[3][q]); w.z = cvt_pk_bf16(acc[4][q], acc[5][q]); w.w = cvt_pk_bf16(acc[6][q], acc[7][q]);
            *(u32x4*)(o + (size_t)q * 1024) = w; }
    }
}

__device__ __forceinline__ void moe_tile_prefix(Ctx& C, int l) {
    PHASE_ENTRY();
    LAS int* tab = (LAS int*)(ldsb + LDS_TAB);
    if (tid == 0) { int acc = 0;
        for (int e = 0; e < 16; ++e) { const int n = (int)__hip_atomic_load(CTLP + CW_CNT + 64 * l + e, __ATOMIC_RELAXED, __HIP_MEMORY_SCOPE_AGENT); tab[e] = n; tab[16 + e] = acc; acc += (n + 255) >> 8; }
        tab[32] = acc; }
    __syncthreads();
}
__device__ __forceinline__ void store_bf16_row(bf16_t* row, int lane, const f32x4 (&v)[4]) {
#pragma unroll
    for (int j = 0; j < 4; ++j) { u32x2 w; w.x = cvt_pk_bf16(v[j][0], v[j][1]); w.y = cvt_pk_bf16(v[j][2], v[j][3]); *(u32x2*)(row + 4 * lane + 256 * j) = w; }
}
__device__ __forceinline__ void moe_combine_row(const LAS int* tab, const unsigned* route, const bf16_t* yb, int lane, int tok, const f32x4 (&G2)[4], f32x4 (&v)[4]) {
    const u32x4 rt = *(const u32x4*)(route + (size_t)tok * 4);
    const int e0 = rt.x >> 15, p0 = rt.x & 32767, e1 = rt.y >> 15, p1 = rt.y & 32767; const float w0 = __uint_as_float(rt.z), w1 = __uint_as_float(rt.w);
    const bf16_t* y0 = yb + (size_t)(tab[16 + e0] * 256 + p0) * DM; const bf16_t* y1 = yb + (size_t)(tab[16 + e1] * 256 + p1) * DM;
#pragma unroll
    for (int j = 0; j < 4; ++j) { const u32x2 a = *(const u32x2*)(y0 + 4 * lane + 256 * j), b = *(const u32x2*)(y1 + 4 * lane + 256 * j);
        v[j][0] += G2[j][0] * (w0 * bflo(a.x) + w1 * bflo(b.x)); v[j][1] += G2[j][1] * (w0 * bfhi(a.x) + w1 * bfhi(b.x));
        v[j][2] += G2[j][2] * (w0 * bflo(a.y) + w1 * bflo(b.y)); v[j][3] += G2[j][3] * (w0 * bfhi(a.y) + w1 * bfhi(b.y)); }
}
__device__ __forceinline__ float row_rstd(const f32x4 (&v)[4]) {
    float s = 0.f;
#pragma unroll
    for (int j = 0; j < 4; ++j) s += (v[j][0] * v[j][0] + v[j][1] * v[j][1]) + (v[j][2] * v[j][2] + v[j][3] * v[j][3]);
    return __builtin_amdgcn_rsqf(wave_sum(s) * (1.0f / DM) + EPS);
}
__device__ __forceinline__ void phase_norm_a(Ctx& C, int l, int rep = 0) {
    PHASE_ENTRY(); const int b = vcu >> 6; const float* mod = WSP(float, WS_MOD);
    const float* xin = INF(0); float* hout = OUTP; bf16_t* xnp = WSP(bf16_t, WS_XN); bf16_t* hnp = WSP(bf16_t, WS_HN); const unsigned* route = WSP(unsigned, WS_ROUTE); const bf16_t* ybp = WSP(bf16_t, WS_YB);
    f32x4 Am[4], Bm[4], G2[4], Ak[4], Bk[4];
#pragma unroll
    for (int j = 0; j < 4; ++j) { const int c = 4 * lane + 256 * j;
        if (l < 4) { const float* ml = mod + (size_t)(l * 4 + b) * 6144; const f32x4 g = *(const f32x4*)(INF(5) + l * DM + c), sc = *(const f32x4*)(ml + 1024 + c); Am[j] = g * (1.0f + sc); Bm[j] = *(const f32x4*)(ml + c); }
        else { Am[j] = *(const f32x4*)(INF(24) + c); Bm[j] = (f32x4){0.f, 0.f, 0.f, 0.f}; }
        if (l > 0 && !rep) G2[j] = *(const f32x4*)(mod + (size_t)((l - 1) * 4 + b) * 6144 + 5 * 1024 + c); else G2[j] = (f32x4){0.f, 0.f, 0.f, 0.f};
        if (l == 2) { const float* mk = mod + 4 * 4 * 6144 + b * 2048; const f32x4 g = *(const f32x4*)(INF(11) + c), sc = *(const f32x4*)(mk + 1024 + c); Ak[j] = g * (1.0f + sc); Bk[j] = *(const f32x4*)(mk + c); }
        else { Ak[j] = Am[j]; Bk[j] = Bm[j]; } }
    if (l > 0) moe_tile_prefix(C, l - 1);
    for (int rr = 0; rr < 16; ++rr) {
        const int tok = vcu * 128 + wave * 16 + rr; f32x4 v[4];
        const float* src = (l == 0 ? xin : hout) + (size_t)tok * DM;
#pragma unroll
        for (int j = 0; j < 4; ++j) v[j] = *(const f32x4*)(src + 4 * lane + 256 * j);
        if (l > 0) moe_combine_row((const LAS int*)(ldsb + LDS_TAB), route, ybp, lane, tok, G2, v);
        const float rstd = row_rstd(v);
        if (l < 4) {
#pragma unroll
            for (int j = 0; j < 4; ++j) *(f32x4*)(hout + (size_t)tok * DM + 4 * lane + 256 * j) = v[j];
            f32x4 o[4];
#pragma unroll
            for (int j = 0; j < 4; ++j) o[j] = v[j] * rstd * Am[j] + Bm[j];
            store_bf16_row(xnp + (size_t)tok * DM, lane, o);
            if (l == 2) {
#pragma unroll
                for (int j = 0; j < 4; ++j) o[j] = v[j] * rstd * Ak[j] + Bk[j];
                store_bf16_row(hnp + (size_t)tok * DM, lane, o); }
        } else {
#pragma unroll
            for (int j = 0; j < 4; ++j) *(f32x4*)(hout + (size_t)tok * DM + 4 * lane + 256 * j) = v[j] * rstd * Am[j];
        }
    }
}
constexpr int NBR = 4;
template <int CTRL> __device__ __forceinline__ float dpp_add(float v) { return v + dpp_f<CTRL>(v); }
__device__ __forceinline__ void phase_norm_b(Ctx& C, int l) {
    PHASE_ENTRY(); const int b = vcu >> 6; const float* ml = WSP(float, WS_MOD) + (size_t)(l * 4 + b) * 6144;
    const float* hin = OUTP; bf16_t* xnp = WSP(bf16_t, WS_XN);
    LAS float* wrT = (LAS float*)ldsb;
    LAS float* lgt = (LAS float*)(ldsb + 65536);
    LAS int* rec_e = (LAS int*)(ldsb + 65536 + 8192);
    LAS float* rec_w = (LAS float*)(ldsb + 65536 + 8192 + 1024);
    LAS int* rec_p = (LAS int*)(ldsb + 65536 + 8192 + 2048);
    LAS int* lcnt = (LAS int*)(ldsb + 65536 + 8192 + 3072);
    LAS int* gbase = (LAS int*)(ldsb + 65536 + 8192 + 3072 + 64);
    for (int i = tid; i < 4096; i += NTHREADS) { const f32x4 w = *(const f32x4*)(INF(19) + (size_t)i * 4); const int col = i >> 2, e4 = (i & 3) * 4;
        wrT[(e4 + 0) * 1024 + col] = w[0]; wrT[(e4 + 1) * 1024 + col] = w[1]; wrT[(e4 + 2) * 1024 + col] = w[2]; wrT[(e4 + 3) * 1024 + col] = w[3]; }
    if (tid < 16) lcnt[tid] = 0;
    f32x4 Am[4], Bm[4];
#pragma unroll
    for (int j = 0; j < 4; ++j) { const int c = 4 * lane + 256 * j; const f32x4 g = *(const f32x4*)(INF(6) + l * DM + c), sc = *(const f32x4*)(ml + 4 * 1024 + c); Am[j] = g * (1.0f + sc); Bm[j] = *(const f32x4*)(ml + 3 * 1024 + c); }
    const float* hrow = hin + (size_t)(vcu * 128 + wave * 16) * DM + 4 * lane;
    __syncthreads();
#pragma unroll 1
    for (int g = 0; g < 16 / NBR; ++g) {
        asm volatile("" ::: "memory");
        f32x4 v[NBR][4];
#pragma unroll
        for (int i = 0; i < NBR; ++i)
#pragma unroll
            for (int j = 0; j < 4; ++j) v[i][j] = *(const f32x4*)(hrow + (size_t)(g * NBR + i) * DM + 256 * j);
#pragma unroll
        for (int i = 0; i < NBR; ++i) { const float rstd = row_rstd(v[i]);
#pragma unroll
            for (int j = 0; j < 4; ++j) v[i][j] = v[i][j] * rstd * Am[j] + Bm[j];
            { unsigned char* xr = (unsigned char*)xnp + (size_t)(vcu * 128 + wave * 16 + g * NBR + i) * DM;
#pragma unroll
              for (int j = 0; j < 4; ++j) *(unsigned*)(xr + 4 * lane + 256 * j) = pk4_fp8(4.0f * v[i][j][0], 4.0f * v[i][j][1], 4.0f * v[i][j][2], 4.0f * v[i][j][3]); } }
        float p[NBR][16];
#pragma unroll
        for (int e = 0; e < 16; ++e) { f32x4 w[4];
#pragma unroll
            for (int j = 0; j < 4; ++j) w[j] = *(const LAS f32x4*)(wrT + e * 1024 + 4 * lane + 256 * j);
#pragma unroll
            for (int i = 0; i < NBR; ++i) { float a = 0.f;
#pragma unroll
                for (int j = 0; j < 4; ++j) a += (v[i][j][0] * w[j][0] + v[i][j][1] * w[j][1]) + (v[i][j][2] * w[j][2] + v[i][j][3] * w[j][3]);
                p[i][e] = a; asm volatile("" : "+v"(p[i][e])); }
            __builtin_amdgcn_sched_barrier(0); }
#pragma unroll
        for (int i = 0; i < NBR; ++i) {
            float q[8], r[4];
#pragma unroll
            for (int k = 0; k < 8; ++k) { auto t = __builtin_amdgcn_permlane32_swap(__float_as_uint(p[i][k]), __float_as_uint(p[i][k + 8]), false, false); q[k] = __uint_as_float(t[0]) + __uint_as_float(t[1]); }
#pragma unroll
            for (int k = 0; k < 4; ++k) { auto t = __builtin_amdgcn_permlane16_swap(__float_as_uint(q[k]), __float_as_uint(q[k + 4]), false, false); r[k] = __uint_as_float(t[0]) + __uint_as_float(t[1]); }
#pragma unroll
            for (int k = 0; k < 4; ++k) { r[k] = dpp_add<0xB1>(r[k]); r[k] = dpp_add<0x4E>(r[k]); r[k] = dpp_add<0x141>(r[k]); r[k] = dpp_add<0x140>(r[k]); }
            if ((lane & 15) == 0) { const int rho = lane >> 4; *(LAS f32x4*)(lgt + (wave * 16 + g * NBR + i) * 16 + 4 * (rho & 1) + 8 * (rho >> 1)) = (f32x4){r[0], r[1], r[2], r[3]}; }
        }
    }
    LDS_WAIT();
    if (lane < 16) {
        const int rl = wave * 16 + lane; float sc[16], bs[16];
#pragma unroll
        for (int e4 = 0; e4 < 4; ++e4) { const f32x4 lg = *(const LAS f32x4*)(lgt + rl * 16 + e4 * 4); const f32x4 rbv = *(const f32x4*)(INF(20) + e4 * 4);
#pragma unroll
            for (int k = 0; k < 4; ++k) { sc[e4 * 4 + k] = 1.0f / (1.0f + __expf(-lg[k])); bs[e4 * 4 + k] = sc[e4 * 4 + k] + rbv[k]; } }
        float gs[4];
#pragma unroll
        for (int g = 0; g < 4; ++g) { const float a = bs[4 * g], bq = bs[4 * g + 1], c = bs[4 * g + 2], d = bs[4 * g + 3];
            const float h1 = fmaxf(a, bq), l1 = fminf(a, bq), h2 = fmaxf(c, d), l2 = fminf(c, d); gs[g] = fmaxf(h1, h2) + fmaxf(fminf(h1, h2), fmaxf(l1, l2)); }
        int gi = 0; float best = gs[0];
#pragma unroll
        for (int g = 1; g < 4; ++g) if (gs[g] > best) { best = gs[g]; gi = g; }
        float iv[4], uv[4];
#pragma unroll
        for (int k = 0; k < 4; ++k) { iv[k] = gi == 0 ? bs[k] : (gi == 1 ? bs[4 + k] : (gi == 2 ? bs[8 + k] : bs[12 + k])); uv[k] = gi == 0 ? sc[k] : (gi == 1 ? sc[4 + k] : (gi == 2 ? sc[8 + k] : sc[12 + k])); }
        int i1 = 0; float b1 = iv[0];
#pragma unroll
        for (int k = 1; k < 4; ++k) if (iv[k] > b1) { b1 = iv[k]; i1 = k; }
        int i2 = -1; float b2 = 0.f;
#pragma unroll
        for (int k = 0; k < 4; ++k) if (k != i1 && (i2 < 0 || iv[k] > b2)) { b2 = iv[k]; i2 = k; }
        const float u1 = i1 == 0 ? uv[0] : (i1 == 1 ? uv[1] : (i1 == 2 ? uv[2] : uv[3])), u2 = i2 == 0 ? uv[0] : (i2 == 1 ? uv[1] : (i2 == 2 ? uv[2] : uv[3]));
        const float rs = 1.0f / (u1 + u2);
        rec_e[rl * 2] = gi * 4 + i1; rec_e[rl * 2 + 1] = gi * 4 + i2; rec_w[rl * 2] = u1 * rs; rec_w[rl * 2 + 1] = u2 * rs;
    }
    __syncthreads();
    if (tid < 128) { rec_p[tid * 2] = atomicAdd((int*)&lcnt[rec_e[tid * 2]], 1); rec_p[tid * 2 + 1] = atomicAdd((int*)&lcnt[rec_e[tid * 2 + 1]], 1); }
    __syncthreads();
    if (tid < 16) gbase[tid] = (int)__hip_atomic_fetch_add(CTLP + CW_CNT + 64 * l + tid, (unsigned)lcnt[tid], __ATOMIC_RELAXED, __HIP_MEMORY_SCOPE_AGENT);
    __syncthreads();
    if (tid < 128) { const int tok = vcu * 128 + tid, e0 = rec_e[tid * 2], e1 = rec_e[tid * 2 + 1], p0 = gbase[e0] + rec_p[tid * 2], p1 = gbase[e1] + rec_p[tid * 2 + 1];
        int* idx = WSP(int, WS_IDX); idx[e0 * NTOK + p0] = tok; idx[e1 * NTOK + p1] = tok;
        *(u32x4*)(WSP(unsigned, WS_ROUTE) + (size_t)tok * 4) = (u32x4){(unsigned)(e0 << 15 | p0), (unsigned)(e1 << 15 | p1), __float_as_uint(rec_w[tid * 2]), __float_as_uint(rec_w[tid * 2 + 1])}; }
    __syncthreads();
}
__device__ __forceinline__ void phase_prefix(Ctx& C) {
    PHASE_ENTRY(); const int g = vcu * NTHREADS + tid, dkv = g & 31, v = (g >> 5) & 511, bh = g >> 14, h = bh & 3;
    const float gam = __builtin_amdgcn_exp2f(log2_gamma(h)), gam256 = __builtin_amdgcn_exp2f(256.0f * log2_gamma(h));
    bf16_t* p = WSP(bf16_t, WS_B2T) + (size_t)bh * 32 * 262144 + (size_t)v * 512 + dkv * 8;
    float s[8];
#pragma unroll
    for (int k = 0; k < 8; ++k) s[k] = 0.f;
    for (int c0 = 0; c0 < 32; c0 += 4) {
        u32x4 kv[4];
#pragma unroll
        for (int i = 0; i < 4; ++i) kv[i] = *(const u32x4*)(p + (size_t)(c0 + i) * 262144);
#pragma unroll
        for (int i = 0; i < 4; ++i) {
            u32x4 o; o.x = cvt_pk_bf16(s[0] * gam, s[1] * gam); o.y = cvt_pk_bf16(s[2] * gam, s[3] * gam); o.z = cvt_pk_bf16(s[4] * gam, s[5] * gam); o.w = cvt_pk_bf16(s[6] * gam, s[7] * gam);
            *(u32x4*)(p + (size_t)(c0 + i) * 262144) = o;
            s[0] = s[0] * gam256 + bflo(kv[i].x); s[1] = s[1] * gam256 + bfhi(kv[i].x); s[2] = s[2] * gam256 + bflo(kv[i].y); s[3] = s[3] * gam256 + bfhi(kv[i].y);
            s[4] = s[4] * gam256 + bflo(kv[i].z); s[5] = s[5] * gam256 + bfhi(kv[i].z); s[6] = s[6] * gam256 + bflo(kv[i].w); s[7] = s[7] * gam256 + bfhi(kv[i].w); }
    }
}
__device__ __forceinline__ void phase_kvfin(Ctx& C) {
    PHASE_ENTRY(); const float* akv = WSP(float, WS_AKV); bf16_t* kpp = WSP(bf16_t, WS_KP); const int* posp = INI(2); const float g0 = INF(13)[2 * lane], g1 = INF(13)[2 * lane + 1];
    const float inv = __builtin_amdgcn_exp2f(-(float)(lane & 31) * (LOG2_THETA / 32.0f));
    for (int rr = 0; rr < 16; ++rr) {
        const int tok = vcu * 128 + wave * 16 + rr; const float* a = akv + (size_t)tok * 256; bf16_t* kp = kpp + (size_t)tok * QKD;
        const f32x2 cv = *(const f32x2*)(a + 2 * lane); const float rstd = __builtin_amdgcn_rsqf(wave_sum(cv[0] * cv[0] + cv[1] * cv[1]) * (1.0f / 128.0f) + EPS);
        *(unsigned*)(kp + 2 * lane) = cvt_pk_bf16(cv[0] * rstd * g0, cv[1] * rstd * g1);
        const float x1 = a[128 + (lane & 31)], x2 = a[160 + (lane & 31)]; float s, c; sincos_rad((float)posp[tok] * inv, s, c);
        const float o = lane < 32 ? x1 * c - x2 * s : x1 * s + x2 * c;
        kp[128 + lane] = (bf16_t)(cvt_pk_bf16(o, 0.f) & 0xffffu);
    }
}
namespace att {
constexpr int SHM_V = 16384, SHM_K = 24576, OFF_V = 0, OFF_K = 2 * SHM_V, OFF_WS = OFF_K + 2 * SHM_K, OFF_Q = OFF_WS + 2048;
constexpr float THR = 8.0f;
#define KSWZ(row, colB) ((row) * 384 + ((colB) ^ ((((row) >> 1) & 7) << 4)))
#define SBAR() __builtin_amdgcn_sched_barrier(0)
__device__ __forceinline__ int crow(int r, int hi) { return (r & 3) + 8 * (r >> 2) + 4 * hi; }
__device__ __forceinline__ void partialSM(f32x16& p0, f32x16& p1, float& m_reg, float& mn, float& alpha) {
    float pmax = p0[0];
#pragma unroll
    for (int r = 1; r < 16; ++r) pmax = fmaxf(pmax, p0[r]);
#pragma unroll
    for (int r = 0; r < 16; ++r) pmax = fmaxf(pmax, p1[r]);
    { auto rr = __builtin_amdgcn_permlane32_swap(__float_as_uint(pmax), __float_as_uint(pmax), false, false); pmax = fmaxf(__uint_as_float(rr[0]), __uint_as_float(rr[1])); }
    if (__builtin_expect(__all(pmax - m_reg <= THR), 1)) { mn = m_reg; alpha = 1.f; }
    else { mn = fmaxf(m_reg, pmax); alpha = __builtin_amdgcn_exp2f(m_reg - mn); m_reg = mn; }
#pragma unroll
    for (int r = 0; r < 16; ++r) p0[r] = p0[r] - mn;
#pragma unroll
    for (int r = 0; r < 16; ++r) p1[r] = p1[r] - mn;
#pragma unroll
    for (int r = 0; r < 16; ++r) p0[r] = __builtin_amdgcn_exp2f(p0[r]);
}
__device__ __forceinline__ void finishSM(f32x16& p0, f32x16& p1, float alpha, float& l_reg, bf16x8& pa0, bf16x8& pa1, bf16x8& pa2, bf16x8& pa3) {
#pragma unroll
    for (int r = 0; r < 16; ++r) p1[r] = __builtin_amdgcn_exp2f(p1[r]);
    float ps = 0;
#pragma unroll
    for (int r = 0; r < 16; ++r) ps += p0[r];
#pragma unroll
    for (int r = 0; r < 16; ++r) ps += p1[r];
    { auto rr = __builtin_amdgcn_permlane32_swap(__float_as_uint(ps), __float_as_uint(ps), false, false); ps = __uint_as_float(rr[0]) + __uint_as_float(rr[1]); }
    l_reg = l_reg * alpha + ps;
#define PK4(P, BASE, OUT) do { unsigned a0 = cvt_pk_bf16(P[BASE + 0], P[BASE + 1]), a1 = cvt_pk_bf16(P[BASE + 2], P[BASE + 3]);   \
    unsigned b0 = cvt_pk_bf16(P[BASE + 4], P[BASE + 5]), b1 = cvt_pk_bf16(P[BASE + 6], P[BASE + 7]);                              \
    auto r0 = __builtin_amdgcn_permlane32_swap(a0, b0, false, false); auto r1 = __builtin_amdgcn_permlane32_swap(a1, b1, false, false); \
    u32x4 w = {r0[0], r1[0], r0[1], r1[1]}; OUT = *reinterpret_cast<bf16x8*>(&w); } while (0)
    PK4(p0, 0, pa0); PK4(p0, 8, pa1); PK4(p1, 0, pa2); PK4(p1, 8, pa3);
#undef PK4
}
template <int BUF> __device__ __forceinline__ void qkt(f32x16& p0, f32x16& p1, const LAS char* const (&kb4)[4], const bf16x8* qr, const LAS char* ql) {
    p0 = f32x16{}; p1 = f32x16{};
#pragma unroll
    for (int d0 = 0; d0 < 12; ++d0) {
        const bf16x8 b0 = *reinterpret_cast<const LAS bf16x8*>(kb4[d0 & 3] + BUF * SHM_K + (d0 >> 2) * 128);
        const bf16x8 b1 = *reinterpret_cast<const LAS bf16x8*>(kb4[d0 & 3] + BUF * SHM_K + (d0 >> 2) * 128 + 32 * 384);
        const bf16x8 qf = d0 < 8 ? qr[d0 < 8 ? d0 : 0] : *reinterpret_cast<const LAS bf16x8*>(ql + (d0 - 8) * 1024);
        p0 = __builtin_amdgcn_mfma_f32_32x32x16_bf16(b0, qf, p0, 0, 0, 0);
        p1 = __builtin_amdgcn_mfma_f32_32x32x16_bf16(b1, qf, p1, 0, 0, 0); }
}
__device__ __forceinline__ int v_st(int k, int c) { const int kk = (k & ~0xC) | ((k & 4) << 1) | ((k & 8) >> 1); return ((kk >> 3) * 4 + (c >> 5)) * 512 + ((kk & 7) * 32 + (c & 31)) * 2; }
__device__ __forceinline__ int v_rd_base(int lane) { return ((lane & 3) << 3) | (((lane >> 2) & 3) << 6) | (((lane >> 4) & 1) << 5) | (((lane >> 5) & 1) << 8); }
constexpr int v_rd_off(int d0, int ks, int half) { return d0 * 512 + ks * 4096 + half * 2048; }
template <int OFF> __device__ __forceinline__ s16x4 tr_read(int vb) { s16x4 r; asm volatile("ds_read_b64_tr_b16 %0, %1 offset:%2" : "=&v"(r) : "v"(vb), "i"(OFF) : "memory"); return r; }
template <int D0> __device__ __forceinline__ void pv_one(f32x16& od, int vb, bf16x8 pa0, bf16x8 pa1, bf16x8 pa2, bf16x8 pa3) {
    const s16x4 l0 = tr_read<v_rd_off(D0, 0, 0)>(vb), h0 = tr_read<v_rd_off(D0, 0, 1)>(vb), l1 = tr_read<v_rd_off(D0, 1, 0)>(vb), h1 = tr_read<v_rd_off(D0, 1, 1)>(vb);
    const s16x4 l2 = tr_read<v_rd_off(D0, 2, 0)>(vb), h2 = tr_read<v_rd_off(D0, 2, 1)>(vb), l3 = tr_read<v_rd_off(D0, 3, 0)>(vb), h3 = tr_read<v_rd_off(D0, 3, 1)>(vb);
    asm volatile("s_waitcnt lgkmcnt(0)" ::: "memory"); SBAR();
#define PK(L, H) (bf16x8){L[0], L[1], L[2], L[3], H[0], H[1], H[2], H[3]}
    od = __builtin_amdgcn_mfma_f32_32x32x16_bf16(pa0, PK(l0, h0), od, 0, 0, 0);
    od = __builtin_amdgcn_mfma_f32_32x32x16_bf16(pa1, PK(l1, h1), od, 0, 0, 0);
    od = __builtin_amdgcn_mfma_f32_32x32x16_bf16(pa2, PK(l2, h2), od, 0, 0, 0);
    od = __builtin_amdgcn_mfma_f32_32x32x16_bf16(pa3, PK(l3, h3), od, 0, 0, 0);
#undef PK
}
__device__ __forceinline__ void pv_d0(f32x16* o, int vb, bf16x8 pa0, bf16x8 pa1, bf16x8 pa2, bf16x8 pa3) {
    pv_one<0>(o[0], vb, pa0, pa1, pa2, pa3); pv_one<1>(o[1], vb, pa0, pa1, pa2, pa3); pv_one<2>(o[2], vb, pa0, pa1, pa2, pa3); pv_one<3>(o[3], vb, pa0, pa1, pa2, pa3);
}
__device__ __forceinline__ void attn_unit(const bf16_t* __restrict__ Q, const bf16_t* __restrict__ Kp, bf16_t* __restrict__ O, int t0, int kbase, int nt_real, LAS char* lds, int wid) {
    int lane_ = (int)__builtin_amdgcn_mbcnt_hi(~0u, __builtin_amdgcn_mbcnt_lo(~0u, 0u)); asm volatile("" : "+v"(lane_));
    const int lane = lane_, tid = wid * 64 + lane, r32 = lane & 31, hi = lane >> 5;
    LAS char* V_lds = lds + OFF_V; LAS char* K_lds = lds + OFF_K;
    LAS float* ws = (LAS float*)(lds + OFF_WS) + wid * 64; LAS float* li_l = ws; LAS float* al_l = ws + 32;
    float m_reg = -1e30f, l_reg = 0; f32x16 o[4] = {}; bf16x8 qr[8];
    LAS char* qlds = lds + OFF_Q + wid * 4096 + lane * 16;
    const char* Qs = (const char*)Q + (size_t)t0 * 3072 + wid * (QKD * 2); const unsigned qlo = (unsigned)(r32 * 3072 + hi * 16);
#pragma unroll
    for (int d0 = 0; d0 < 8; ++d0) qr[d0] = *reinterpret_cast<const bf16x8*>(Qs + qlo + d0 * 32);
    __syncthreads();
#pragma unroll
    for (int d0 = 8; d0 < 12; ++d0) *reinterpret_cast<LAS bf16x8*>(qlds + (d0 - 8) * 1024) = *reinterpret_cast<const bf16x8*>(Qs + qlo + d0 * 32);
    const int vb0 = (int)(uintptr_t)V_lds + v_rd_base(lane);
    const LAS char* kb4[4];
#pragma unroll
    for (int q = 0; q < 4; ++q) kb4[q] = K_lds + r32 * 384 + ((q * 32 + hi * 16) ^ (((r32 >> 1) & 7) << 4));
    const int NT = (nt_real + 1) & ~1;
    const bool dummy = (NT != nt_real);
    bf16x8 sr_[1][3];
    const char* Kg = (const char*)(Kp + (size_t)kbase * QKD);
#define SLOAD(s, kt) do { _Pragma("unroll") for (int i = 0; i < 3; ++i) sr_[s][i] = *reinterpret_cast<const bf16x8*>(Kg + (size_t)(kt) * SHM_K + i * 8192 + (unsigned)(tid * 16)); } while (0)
#define SWRITE(b, s) do { int tl_ = (int)__builtin_amdgcn_mbcnt_hi(~0u, __builtin_amdgcn_mbcnt_lo(~0u, 0u)); asm volatile("" : "+v"(tl_)); tl_ += wid * 64; _Pragma("unroll") for (int i = 0; i < 3; ++i) { const int p_ = tl_ + 512 * i, row_ = p_ / 24, c16_ = p_ - row_ * 24; \
        *(LAS bf16x8*)(K_lds + (b) * SHM_K + KSWZ(row_, c16_ * 16)) = sr_[s][i]; if (c16_ < 16) *(LAS bf16x8*)(V_lds + (b) * SHM_V + v_st(row_, c16_ * 8)) = sr_[s][i]; } } while (0)
#define SWAIT() asm volatile("s_waitcnt vmcnt(0)" ::: "memory")
#define RESC(a) do { if (__any((a) < 1.f)) { if (hi == 0) al_l[r32] = (a); asm volatile("s_waitcnt lgkmcnt(0)" ::: "memory"); \
    _Pragma("unroll") for (int d = 0; d < 4; ++d) _Pragma("unroll") for (int r = 0; r < 16; ++r) o[d][r] *= al_l[crow(r, hi)]; } } while (0)
    f32x16 pA0, pA1, pB0, pB1; float mnA, mnB, alA, alB; bf16x8 pa0, pa1, pa2, pa3;
    SLOAD(0, 0); SWAIT(); SWRITE(0, 0); __syncthreads();
    qkt<0>(pA0, pA1, kb4, qr, qlds); partialSM(pA0, pA1, m_reg, mnA, alA);
    SLOAD(0, 1); SWAIT(); SWRITE(1, 0); __syncthreads();
    for (int j = 1; j + 1 < NT; j += 2) {
        SBAR(); qkt<1>(pB0, pB1, kb4, qr, qlds);
        finishSM(pA0, pA1, alA, l_reg, pa0, pa1, pa2, pa3); SBAR();
        SLOAD(0, j + 1); SBAR();
        pv_d0(o, vb0, pa0, pa1, pa2, pa3); partialSM(pB0, pB1, m_reg, mnB, alB);
        __syncthreads(); SWAIT(); SWRITE(0, 0);
        RESC(alB); __syncthreads();
        SBAR(); qkt<0>(pA0, pA1, kb4, qr, qlds);
        finishSM(pB0, pB1, alB, l_reg, pa0, pa1, pa2, pa3); SBAR();
        SLOAD(0, j + 2); SBAR();
        pv_d0(o, vb0 + SHM_V, pa0, pa1, pa2, pa3); partialSM(pA0, pA1, m_reg, mnA, alA);
        __syncthreads(); SWAIT(); SWRITE(1, 0);
        RESC(alA); __syncthreads();
    }
    SBAR(); qkt<1>(pB0, pB1, kb4, qr, qlds);
    if (dummy) {
#pragma unroll
        for (int r = 0; r < 16; ++r) { pB0[r] = -INFINITY; pB1[r] = -INFINITY; } }
    finishSM(pA0, pA1, alA, l_reg, pa0, pa1, pa2, pa3); SBAR();
    pv_d0(o, vb0, pa0, pa1, pa2, pa3); partialSM(pB0, pB1, m_reg, mnB, alB);
    __syncthreads(); RESC(alB);
    finishSM(pB0, pB1, alB, l_reg, pa0, pa1, pa2, pa3); SBAR();
    pv_d0(o, vb0 + SHM_V, pa0, pa1, pa2, pa3);
    {
        int lanee = (int)__builtin_amdgcn_mbcnt_hi(~0u, __builtin_amdgcn_mbcnt_lo(~0u, 0u)); asm volatile("" : "+v"(lanee));
        const int wide = wid, r32e = lanee & 31, hie = lanee >> 5;
        LAS float* lie = (LAS float*)(lds + OFF_WS) + wide * 64;
        if (hie == 0) lie[r32e] = l_reg; asm volatile("s_waitcnt lgkmcnt(0)" ::: "memory");
        char* Os = (char*)O + (size_t)t0 * 2048 + wide * 256; const unsigned olo = (unsigned)(r32e * 2);
#pragma unroll
        for (int r = 0; r < 16; ++r) { const int orow = crow(r, hie); const float rl = __builtin_amdgcn_rcpf(lie[orow]);
#pragma unroll
            for (int d0 = 0; d0 < 4; ++d0) *(bf16_t*)(Os + olo + (unsigned)(orow * 2048) + d0 * 64) = (bf16_t)(cvt_pk_bf16(o[d0][r] * rl, 0.f) & 0xffffu); }
    }
#undef SLOAD
#undef SWRITE
#undef SWAIT
#undef RESC
}
}
struct Args { const void* in[25]; float* out; unsigned char* ws; int lo, hi, l, hf; };
enum { PH_PRO = 0, PH_NA, PH_R2, PH_R3, PH_R4, PH_R5, PH_R6, PH_R7, PH_M2, PH_M3, PH_M4, PH_M5, PH_NB, PH_MOE1, PH_MOE2, PH_COUNT };

__device__ __forceinline__ void make_ctx(Ctx& C, unsigned char* lds_raw) {
    C.ka = (kaptr_t)__builtin_amdgcn_kernarg_segment_ptr(); C.lds = (LAS unsigned char*)lds_raw;
    C.wave = __builtin_amdgcn_readfirstlane((int)threadIdx.x >> 6);
    { const int bx = blockIdx.x; C.vcu = (bx & 7) * (GRID / 8) + (bx >> 3); }
}

template <int PH> __device__ __forceinline__ void run_phase(Ctx& C, const int l, const int hf, const int rep = 0) {
    PHASE_ENTRY(); const int wv = wave;
    LAS unsigned char* lds = ldsb; int bid_ = blockIdx.x; asm volatile("" : "+s"(bid_)); const int bid = bid_; const unsigned LD1K = 2048u;
    const float* gate1 = rep ? (const float*)(WSB + WS_CTL + 512 * 1024) : WSP(float, WS_MOD) + (size_t)l * 4 * 6144 + 2 * 1024;
    const bf16_t* win = WSP(bf16_t, WS_WIN) + (size_t)(l & 1) * 6144 * 1024;
    const bf16_t* xnh = WSP(bf16_t, WS_XN) + (size_t)hf * THALF * DM;
    const int j = l & 1;
    if constexpr (PH == PH_PRO) phase_prologue(C);
    if constexpr (PH == PH_NA) phase_norm_a(C, l, rep);
    if constexpr (PH == PH_R2) {
        { SchedStd S; S.T.init(64, 4, GRID, bid); S.A = (const char*)xnh; S.B = (const char*)win; S.sA = 256 * 2048; S.sB = 256 * 2048;
          EpiRopeQK<0> E{WSP(bf16_t, WS_A2), INI(2), hf}; pg8::gemm_phase<EpiRopeQK<0>, SchedStd, false>(lds, wv, 1024, LD1K, LD1K, S, E); }
        { SchedStd S; S.T.init(64, 4, GRID, bid); S.A = (const char*)xnh; S.B = (const char*)(win + 1024 * 1024); S.sA = 256 * 2048; S.sB = 256 * 2048;
          EpiRopeQK<1> E{WSP(bf16_t, WS_KR), INI(2), hf}; pg8::gemm_phase<EpiRopeQK<1>, SchedStd, false>(lds, wv, 1024, LD1K, LD1K, S, E); }
        { SchedStd S; S.T.init(4, 64, GRID, bid); S.A = (const char*)(win + 1024 * 1024); S.B = (const char*)xnh; S.sA = 256 * 2048; S.sB = 256 * 2048;
          EpiRopeKT E{WSP(bf16_t, WS_KT), INI(2), hf}; pg8::gemm_phase<EpiRopeKT, SchedStd, false>(lds, wv, 1024, LD1K, LD1K, S, E); }
        { SchedStd S; S.T.init(8, 64, GRID, bid); S.A = (const char*)(win + 2048 * 1024); S.B = (const char*)xnh; S.sA = 256 * 2048; S.sB = 256 * 2048;
          EpiVT E{WSP(bf16_t, WS_B2T)}; pg8::gemm_phase<EpiVT, SchedStd, false>(lds, wv, 1024, LD1K, LD1K, S, E); }
    }
    if constexpr (PH == PH_R3) {
        { SchedBatch S{(const char*)WSP(bf16_t, WS_A2), (const char*)WSP(bf16_t, WS_KR), 256 * 1024, 256 * 512, 0, 0, 256, 1, GRID, vcu};
          EpiS E{WSP(bf16_t, WS_A2)}; pg8::gemm_phase<EpiS, SchedBatch, false>(lds, wv, 256, 1024u, 512u, S, E); }
        { SchedBatch S{(const char*)(WSP(bf16_t, WS_B2T) + 256), (const char*)WSP(bf16_t, WS_KT), 512 * 1024, 256 * 512, 256 * 1024, 0, 256, 2, GRID, vcu};
          EpiKV E{WSP(bf16_t, WS_B2T)}; pg8::gemm_phase<EpiKV, SchedBatch, false>(lds, wv, 256, 1024u, 512u, S, E); }
    }
    if constexpr (PH == PH_R4) phase_prefix(C);
    if constexpr (PH == PH_R5) {
        SchedBatch S{(const char*)WSP(bf16_t, WS_A2), (const char*)WSP(bf16_t, WS_B2T), 256 * 1024, 512 * 1024, 0, 256 * 1024, 256, 2, GRID, vcu};
        EpiFin E{WSP(bf16_t, WS_B2T), WSP(float, WS_STATS)}; pg8::gemm_phase<EpiFin, SchedBatch, false>(lds, wv, 512, 1024u, 1024u, S, E);
    }
    if constexpr (PH == PH_R6) {
        SchedStd S; S.T.init(64, 8, GRID, bid); S.A = (const char*)xnh; S.B = (const char*)(win + 4096 * 1024); S.sA = 256 * 2048; S.sB = 256 * 2048;
        EpiGate E{WSP(bf16_t, WS_B2T), WSP(float, WS_STATS), WSP(bf16_t, WS_A2)}; pg8::gemm_phase<EpiGate, SchedStd, false>(lds, wv, 1024, LD1K, LD1K, S, E);
    }
    if constexpr (PH == PH_R7) {
        SchedStd S; S.T.init(64, 4, GRID, bid); S.A = (const char*)WSP(bf16_t, WS_A2); S.B = (const char*)(WSP(bf16_t, WS_WOUT) + (size_t)l * 1024 * 2048); S.sA = 256 * 4096; S.sB = 256 * 4096;
        EpiResid E{OUTP, gate1, hf * THALF}; pg8::gemm_phase<EpiResid, SchedStd, false>(lds, wv, 2048, 4096u, 4096u, S, E);
    }
    if constexpr (PH == PH_M2) {
        { SchedStd S; S.T.init(128, 1, GRID, bid); S.A = (const char*)WSP(bf16_t, WS_XN); S.B = (const char*)(WSP(bf16_t, WS_WQA) + (size_t)j * 256 * 1024); S.sA = 256 * 2048; S.sB = 256 * 2048;
          EpiQA E{WSP(bf16_t, WS_QA), WSP(float, WS_SSQ)}; pg8::gemm_phase<EpiQA, SchedStd, false>(lds, wv, 1024, LD1K, LD1K, S, E); }
        if (l == 2) { SchedStd S; S.T.init(128, 1, GRID, (bid + 128) & 255); S.A = (const char*)WSP(bf16_t, WS_HN); S.B = (const char*)WSP(bf16_t, WS_WKVA); S.sA = 256 * 2048; S.sB = 256 * 2048;
          EpiF32 E{WSP(float, WS_AKV)}; pg8::gemm_phase<EpiF32, SchedStd, false>(lds, wv, 1024, LD1K, LD1K, S, E); }
    }
    if constexpr (PH == PH_M3) {
        if (l == 2) phase_kvfin(C);
        SchedStd S; S.T.init(128, 6, GRID, bid); S.A = (const char*)WSP(bf16_t, WS_QA); S.B = (const char*)(WSP(bf16_t, WS_WQB) + (size_t)j * 1536 * 256); S.sA = 256 * 512; S.sB = 256 * 512;
        EpiQB E{WSP(bf16_t, WS_Q), WSP(float, WS_SSQ), INI(2)}; pg8::gemm_phase<EpiQB, SchedStd, false>(lds, wv, 256, 512u, 512u, S, E);
    }
    if constexpr (PH == PH_M4) {
        const int b = vcu >> 6, i = vcu & 63;
#pragma unroll 1
        for (int uq = 0; uq < 4; ++uq) { const int cch = (uq < 2) ? (127 - i) : i, half = uq & 1;
            att::attn_unit(WSP(bf16_t, WS_Q), WSP(bf16_t, WS_KP), WSP(bf16_t, WS_OL), b * SEQ + cch * 64 + half * 32, b * SEQ, cch + 1, (LAS char*)lds, wave); }
        __syncthreads();
    }
    if constexpr (PH == PH_M5) {
        SchedStd S; S.T.init(128, 4, GRID, bid); S.A = (const char*)WSP(bf16_t, WS_OL); S.B = (const char*)(WSP(bf16_t, WS_WO) + (size_t)j * 1024 * 1024); S.sA = 256 * 2048; S.sB = 256 * 2048;
        EpiResid E{OUTP, gate1, 0}; pg8::gemm_phase<EpiResid, SchedStd, false>(lds, wv, 1024, LD1K, LD1K, S, E);
    }
    if constexpr (PH == PH_NB) phase_norm_b(C, l);
    if constexpr (PH == PH_MOE1) {
        moe_tile_prefix(C, l);
        SchedMoE S{(const LAS int*)(lds + LDS_TAB), (const char*)WSP(unsigned char, WS_XN), (const char*)(WSP(unsigned char, WS_WGU) + (size_t)l * 16 * 1024 * 1024), (size_t)1024 * 1024, (size_t)256 * 1024, 0, WSP(int, WS_IDX), GRID, vcu, true};
        EpiGU8 E{WSP(unsigned char, WS_HDN)}; pg8::gemm_phase<EpiGU8, SchedMoE, true, true, 0x79797979, 0x7d7d7d7d>(lds, wv, 512, 1024u, 1024u, S, E);
    }
    if constexpr (PH == PH_MOE2) {
        moe_tile_prefix(C, l);
        SchedMoE S{(const LAS int*)(lds + LDS_TAB), (const char*)WSP(unsigned char, WS_HDN), (const char*)(WSP(unsigned char, WS_WDN) + (size_t)l * 16 * 1024 * 512), (size_t)1024 * 512, (size_t)256 * 512, (size_t)256 * 512, WSP(int, WS_IDX), GRID, vcu, false};
        EpiPlain E{WSP(bf16_t, WS_YB), 1024}; pg8::gemm_phase<EpiPlain, SchedMoE, false, true, 0x79797979, 0x7d7d7d7d>(lds, wv, 256, 512u, 512u, S, E);
    }
}

template <int PH> __global__ void __launch_bounds__(NTHREADS, 2) phase_kernel(Args args) {
    extern __shared__ __attribute__((aligned(16))) unsigned char lds_raw[];
    Ctx C; make_ctx(C, lds_raw); (void)args;
    run_phase<PH>(C, args.l, args.hf);
}
__global__ void __launch_bounds__(NTHREADS, 2) fwd_kernel(Args args) {
    extern __shared__ __attribute__((aligned(16))) unsigned char lds_raw[];
    Ctx C; make_ctx(C, lds_raw); (void)args;
    if (threadIdx.x < 64) ((LAS unsigned*)(C.lds + LDS_MISC))[threadIdx.x] = 0u;
    __syncthreads();
    XcdBarrier bar = xcd_barrier_post((unsigned*)((unsigned char*)args.ws + WS_CTL) + CW_BAR, (volatile LAS unsigned*)(C.lds + LDS_MISC));
#define SEAM() xcd_barrier(bar, C.wave)
#ifndef PROBE_PH
#define PROBE_PH -1
#define PROBE_N 0
#endif
#define RUNP(PH, l, hf) do { run_phase<PH>(C, l, hf); SEAM(); if constexpr (PH == PROBE_PH) { _Pragma("unroll 1") for (int rp_ = 0; rp_ < PROBE_N; ++rp_) { run_phase<PH>(C, l, hf, 1); SEAM(); } } } while (0)
    RUNP(PH_PRO, 0, 0);
    for (int l = 0; l < 4; ++l) {
        RUNP(PH_NA, l, 0);
        if (l < 2) {
            for (int hf = 0; hf < 2; ++hf) { RUNP(PH_R2, l, hf); RUNP(PH_R3, l, hf); RUNP(PH_R4, l, hf); RUNP(PH_R5, l, hf); RUNP(PH_R6, l, hf); RUNP(PH_R7, l, hf); }
        } else { RUNP(PH_M2, l, 0); RUNP(PH_M3, l, 0); RUNP(PH_M4, l, 0); RUNP(PH_M5, l, 0); }
        RUNP(PH_NB, l, 0); RUNP(PH_MOE1, l, 0); RUNP(PH_MOE2, l, 0);
    }
    run_phase<PH_NA>(C, 4, 0);
#undef RUNP
#undef SEAM
}

template <int PH> static void launch_phase(Args& a, int l, int hf, hipStream_t stream) {
    static bool attr = false;
    if (!attr) { (void)hipFuncSetAttribute((const void*)phase_kernel<PH>, hipFuncAttributeMaxDynamicSharedMemorySize, LDS_BYTES); attr = true; }
    a.l = l; a.hf = hf;
    hipLaunchKernelGGL(phase_kernel<PH>, dim3(GRID), dim3(NTHREADS), LDS_BYTES, stream, a);
}
extern "C" void kernel_launch(void* const* d_in, const int* in_sizes, int n_in, void* d_out, int out_size, void* d_ws, size_t ws_size, hipStream_t stream) {
    static int ok = 0;
    if (ok == 0) {
        if (n_in != 25 || out_size != NTOK * DM || ws_size < WS_END) { fprintf(stderr, "kernel_launch: unexpected problem (n_in %d, out %d, ws %zu < %zu)\n", n_in, out_size, ws_size, (size_t)WS_END); ok = -1; return; }
        int dev = 0, cus = 0;
        if (hipGetDevice(&dev) != hipSuccess || hipDeviceGetAttribute(&cus, hipDeviceAttributeMultiprocessorCount, dev) != hipSuccess || cus < GRID) { fprintf(stderr, "kernel_launch: needs %d CUs, device has %d\n", GRID, cus); ok = -1; return; }
        ok = 1;
    }
    if (ok < 0) return;
    (void)hipMemsetAsync((char*)d_ws + WS_CTL, 0, CTL_BYTES, stream);
    Args a{};
    for (int i = 0; i < 25; ++i) a.in[i] = d_in[i];
    a.out = (float*)d_out; a.ws = (unsigned char*)d_ws; a.lo = 0; a.hi = 0;
#if MK_SINGLE
    static bool attr = false;
    if (!attr) { (void)hipFuncSetAttribute((const void*)fwd_kernel, hipFuncAttributeMaxDynamicSharedMemorySize, LDS_BYTES); attr = true; }
    hipLaunchKernelGGL(fwd_kernel, dim3(GRID), dim3(NTHREADS), LDS_BYTES, stream, a);
    return;
#endif
    launch_phase<PH_PRO>(a, 0, 0, stream);
    for (int l = 0; l < 4; ++l) {
        launch_phase<PH_NA>(a, l, 0, stream);
        if (l < 2) {
            for (int hf = 0; hf < 2; ++hf) {
                launch_phase<PH_R2>(a, l, hf, stream); launch_phase<PH_R3>(a, l, hf, stream); launch_phase<PH_R4>(a, l, hf, stream);
                launch_phase<PH_R5>(a, l, hf, stream); launch_phase<PH_R6>(a, l, hf, stream); launch_phase<PH_R7>(a, l, hf, stream);
            }
        } else {
            launch_phase<PH_M2>(a, l, 0, stream); launch_phase<PH_M3>(a, l, 0, stream); launch_phase<PH_M4>(a, l, 0, stream); launch_phase<PH_M5>(a, l, 0, stream);
        }
        launch_phase<PH_NB>(a, l, 0, stream); launch_phase<PH_MOE1>(a, l, 0, stream); launch_phase<PH_MOE2>(a, l, 0, stream);
    }
    launch_phase<PH_NA>(a, 4, 0, stream);
}
```

```cpp
#include <hip/hip_runtime.h>
#include <cstdio>
#include <cstdint>

#ifndef MK_SINGLE
#define MK_SINGLE 1
#endif
#ifndef FP8_R2
#define FP8_R2 0
#define FP8_R6 1
#define FP8_R7 1
#define FP8_M2 0
#define FP8_M5 1
#endif
#ifndef MK_CHECK
#define MK_CHECK 0
#endif

#define GAS __attribute__((address_space(1)))
#define LAS __attribute__((address_space(3)))
typedef unsigned short bf16_t;
typedef short bf16x8 __attribute__((ext_vector_type(8)));
typedef short s16x4 __attribute__((ext_vector_type(4)));
typedef float f32x4 __attribute__((ext_vector_type(4)));
typedef float f32x2 __attribute__((ext_vector_type(2)));
typedef float f32x16 __attribute__((ext_vector_type(16)));
typedef unsigned u32x4 __attribute__((ext_vector_type(4)));
typedef unsigned u32x2 __attribute__((ext_vector_type(2)));

constexpr int NB = 4, SEQ = 8192, DM = 1024, NTOK = NB * SEQ, THALF = NTOK / 2;
constexpr int NEXP = 16, DEXP = 512;
constexpr int RH = 4, RDK = 256, RDV = 512, RV = 2048;
constexpr int MH = 8, QLORA = 256, KVL = 128, ROPE = 64, QKD = 192;
constexpr float EPS = 1e-6f;
constexpr int NWAVES = 8, NTHREADS = 512, GRID = 256;
constexpr int MAXSLOTS = 69632;

constexpr size_t MiB = 1u << 20;
constexpr size_t WS_CTL = 0, CTL_BYTES = 1 * MiB;
constexpr size_t WS_MOD = 1 * MiB;
constexpr size_t WS_ROUTE = 2 * MiB;
constexpr size_t WS_SSQ = 3 * MiB;
constexpr size_t WS_STATS = 4 * MiB;
constexpr size_t WS_IDX = 8 * MiB;
constexpr size_t WS_WIN = 10 * MiB;
constexpr size_t WS_WOUT = 34 * MiB;
constexpr size_t WS_WQA = 42 * MiB;
constexpr size_t WS_WKVA = 43 * MiB;
constexpr size_t WS_WQB = 44 * MiB;
constexpr size_t WS_WO = 46 * MiB;
constexpr size_t WS_WGU = 50 * MiB;
constexpr size_t WS_WDN = 178 * MiB;
constexpr size_t WS_XN = 242 * MiB;
constexpr size_t WS_L = 306 * MiB;
constexpr size_t WS_END = 690 * MiB;
constexpr size_t WS_A2 = WS_L, WS_KR = WS_L + 64 * MiB, WS_KT = WS_L + 96 * MiB, WS_B2T = WS_L + 128 * MiB;
constexpr size_t WS_HDN = WS_L, WS_YB = WS_L + 68 * MiB;
constexpr size_t WS_HN = WS_L, WS_QA = WS_L + 64 * MiB, WS_AKV = WS_L + 80 * MiB, WS_Q = WS_L + 112 * MiB, WS_OL = WS_L + 208 * MiB, WS_KP = WS_L + 300 * MiB;
constexpr size_t WS_XN8 = 114 * MiB;
constexpr size_t WS_WIN8 = 146 * MiB;
constexpr size_t WS_WOUT8 = 158 * MiB;
constexpr size_t WS_WQA8 = 162 * MiB;
constexpr size_t WS_WO8 = 163 * MiB;
constexpr size_t WS_ACT8 = 210 * MiB;
constexpr int CW_BAR = 4096;
constexpr int CW_CNT = 16384;
constexpr int CW_CHK = 32768;

constexpr int LDS_STAGE = 131072;
constexpr int LDS_MISC = LDS_STAGE;
constexpr int LDS_TAB = LDS_STAGE + 256;
constexpr int LDS_BYTES = 147456;

#define LDS_WAIT() asm volatile("s_waitcnt lgkmcnt(0)" ::: "memory")
#define VM_WAIT() asm volatile("s_waitcnt vmcnt(0)" ::: "memory")
__device__ __forceinline__ unsigned cvt_pk_bf16(float lo, float hi) { unsigned r; asm volatile("v_cvt_pk_bf16_f32 %0, %1, %2" : "=v"(r) : "v"(lo), "v"(hi)); return r; }
__device__ __forceinline__ unsigned pk4_fp8(float a, float b, float c2, float d) { int w = __builtin_amdgcn_cvt_pk_fp8_f32(a, b, 0, false); return (unsigned)__builtin_amdgcn_cvt_pk_fp8_f32(c2, d, w, true); }
__device__ __forceinline__ float bf2f(unsigned short b) { return __uint_as_float((unsigned)b << 16); }
__device__ __forceinline__ float bflo(unsigned w) { return __uint_as_float(w << 16); }
__device__ __forceinline__ float bfhi(unsigned w) { return __uint_as_float(w & 0xffff0000u); }
template <int CTRL> __device__ __forceinline__ float dpp_f(float v) { return __int_as_float(__builtin_amdgcn_mov_dpp(__float_as_int(v), CTRL, 0xf, 0xf, true)); }
__device__ __forceinline__ float rows_sum(float v) {
    { auto t = __builtin_amdgcn_permlane16_swap(__float_as_uint(v), __float_as_uint(v), false, false); v = __uint_as_float(t[0]) + __uint_as_float(t[1]); }
    { auto t = __builtin_amdgcn_permlane32_swap(__float_as_uint(v), __float_as_uint(v), false, false); v = __uint_as_float(t[0]) + __uint_as_float(t[1]); }
    return v;
}
__device__ __forceinline__ float wave_sum(float v) {
    v += dpp_f<0xB1>(v);
    v += dpp_f<0x4E>(v);
    v += dpp_f<0x141>(v);
    v += dpp_f<0x140>(v);
    return rows_sum(v);
}
__device__ __forceinline__ void sincos_rad(float ang, float& s, float& c) {
    float r = __builtin_amdgcn_fractf(ang * 0.15915494309189535f);
    s = __builtin_amdgcn_sinf(r); c = __builtin_amdgcn_cosf(r);
}
__device__ __forceinline__ float silu_f(float x) { return x / (1.0f + __expf(-x)); }
__device__ __forceinline__ float log2_gamma(int h) { return h == 0 ? -0.04580368961312479f : (h == 1 ? -0.02272007650008353f : (h == 2 ? -0.011315313227834146f : -0.005646563141142063f)); }
constexpr float LOG2_THETA = 13.287712379549449f;

__device__ __forceinline__ int lane_id() { return (int)__builtin_amdgcn_mbcnt_hi(~0u, __builtin_amdgcn_mbcnt_lo(~0u, 0u)); }
#define XB_TMO      128
#define XB_XCNT(j)  (256  + 64 * (j))
#define XB_XSUB(j)  (1280 + 64 * (j))
#define XB_XGEN(j)  (2304 + 64 * (j))
#define XB_TOP      3328
#define XB_TOPGEN   3392
#define XCD_BAR_WORDS 3456
#define XB_SPIN_CAP (1u << 18)
__device__ __forceinline__ unsigned xb_ld(unsigned* p)              { return __hip_atomic_load(p, __ATOMIC_RELAXED, __HIP_MEMORY_SCOPE_AGENT); }
__device__ __forceinline__ unsigned xb_add(unsigned* p, unsigned v) { return __hip_atomic_fetch_add(p, v, __ATOMIC_RELAXED, __HIP_MEMORY_SCOPE_AGENT); }
__device__ __forceinline__ unsigned xb_xcc_id() { return (unsigned)__builtin_amdgcn_s_getreg((3 << 11) | 20) & 0xFu; }
#define XB_SPIN(cond, bar) do { unsigned _sp = 0; while (cond) { __builtin_amdgcn_s_sleep(1); \
    if ((++_sp & 255u) == 0u) { if (xb_ld(&(bar)[XB_TMO])) break; if (_sp > XB_SPIN_CAP) { atomicAdd(&(bar)[XB_TMO], 1u); break; } } } } while (0)
struct XcdBarrier { unsigned* bar; unsigned x; volatile LAS unsigned* st; };
__device__ __forceinline__ XcdBarrier xcd_barrier_post(unsigned* bar, volatile LAS unsigned* st) {
    XcdBarrier b; b.bar = bar; b.x = xb_xcc_id(); b.st = st;
    if (threadIdx.x == 0) (void)xb_add(&bar[XB_XCNT(b.x)], 1u);
    return b;
}
__device__ __forceinline__ void xcd_barrier_complete(unsigned* bar, unsigned x, unsigned& nloc, unsigned& nx) {
    const unsigned G = gridDim.x * gridDim.y * gridDim.z;
    unsigned sum, cnt, mine, sp = 0u;
    for (;;) {
        sum = 0u; cnt = 0u; mine = 0u;
#pragma unroll
        for (unsigned j = 0; j < 16; ++j) { const unsigned c = xb_ld(&bar[XB_XCNT(j)]); sum += c; cnt += (c > 0u) ? 1u : 0u; mine = (j == x) ? c : mine; }
        if (sum == G) break;
        __builtin_amdgcn_s_sleep(1);
        if ((++sp & 255u) == 0u) { if (xb_ld(&bar[XB_TMO])) break; if (sp > XB_SPIN_CAP) { atomicAdd(&bar[XB_TMO], 1u); break; } }
    }
    nloc = mine > 0u ? mine : 1u; nx = cnt > 0u ? cnt : 1u;
}
__device__ __forceinline__ void xcd_barrier(const XcdBarrier& b, const int wave) {
    asm volatile("s_waitcnt vmcnt(0)" ::: "memory");
    __syncthreads();
    if (wave == 0 && lane_id() == 0) {
        unsigned* bar = b.bar; unsigned bx = b.x; asm volatile("" : "+s"(bar), "+s"(bx));
        __builtin_amdgcn_s_waitcnt(0);
        unsigned nloc = b.st[0], nx = b.st[1];
        if (nloc == 0u) { xcd_barrier_complete(bar, bx, nloc, nx); b.st[0] = nloc; b.st[1] = nx; }
        const unsigned old = xb_add(&bar[XB_XSUB(bx)], 1u);
        const unsigned gen = old / nloc;
        if (old + 1u == (gen + 1u) * nloc) {
            __builtin_amdgcn_fence(__ATOMIC_RELEASE, "agent");
            asm volatile("s_waitcnt vmcnt(0)" ::: "memory");
            const unsigned og = xb_add(&bar[XB_TOP], 1u);
            const unsigned tg = og / nx;
            if (og + 1u == (tg + 1u) * nx) xb_add(&bar[XB_TOPGEN], 1u);
            else XB_SPIN(xb_ld(&bar[XB_TOPGEN]) == tg, bar);
            __builtin_amdgcn_fence(__ATOMIC_ACQUIRE, "agent");
            xb_add(&bar[XB_XGEN(bx)], 1u);
            asm volatile("s_waitcnt vmcnt(0)" ::: "memory");
        } else {
            XB_SPIN(xb_ld(&bar[XB_XGEN(bx)]) == gen, bar);
            __builtin_amdgcn_fence(__ATOMIC_ACQUIRE, "agent");
            asm volatile("s_waitcnt vmcnt(0)" ::: "memory");
        }
    }
    __syncthreads();
}

namespace pg8 {
constexpr int BM = 256, BK = 64, HALF = 128, HTB = HALF * BK * 2, STAGE_BYTES = 8 * HTB;
__host__ __device__ __forceinline__ int lds_byte(int r, int c) { const int st = (r >> 4) * 2 + (c >> 5), rr = r & 15, cc = c & 31, ob = rr * 64 + cc * 2; return st * 1024 + (ob ^ (((ob >> 9) & 1) << 5)); }
__host__ __device__ __forceinline__ void stage_rc(int b, int& R, int& C) { const int st = b / 1024, sb = b % 1024, swz = sb ^ (((sb >> 9) & 1) << 5); R = (st >> 1) * 16 + swz / 64; C = (st & 1) * 32 + (swz % 64) / 2; }
__host__ __device__ __forceinline__ int perm32(int rho) { const int n = rho >> 4, i = rho & 15; return 8 * (i >> 2) + 4 * n + (i & 3); }

struct Unit { const char* A; const char* B; int pm, pn, aux; };

struct TileOrder {
    int nM, nN, nwg, G, c;
    __device__ void init(int nM_, int nN_, int G_, int c_) { nM = nM_; nN = nN_; nwg = nM * nN; G = G_; c = c_; }
    __device__ bool tile(int i, int& pm, int& pn) const {
        const long L = (long)i * G + c; if (L >= nwg) return false;
        int wgid = (int)L; { const int q = nwg / 8, r = nwg % 8, xcd = wgid % 8, off = wgid / 8; wgid = (xcd < r ? xcd * (q + 1) : r * (q + 1) + (xcd - r) * q) + off; }
        const int nig = 8 * nN, gid = wgid / nig, fm = gid * 8, gsz = (nM - fm) < 8 ? (nM - fm) : 8;
        pm = fm + ((wgid % nig) % gsz); pn = (wgid % nig) / gsz; return true;
    }
};

typedef int i32x8 __attribute__((ext_vector_type(8)));
typedef int i32x4 __attribute__((ext_vector_type(4)));
__device__ __forceinline__ i32x8 cat8(bf16x8 lo, bf16x8 hi) { const i32x4 a = __builtin_bit_cast(i32x4, lo), b = __builtin_bit_cast(i32x4, hi); return __builtin_shufflevector(a, b, 0, 1, 2, 3, 4, 5, 6, 7); }
template <class Epi, class Sched, bool GATHER, bool FP8 = false, int SCW = 0x7f7f7f7f, int SCX = 0x7f7f7f7f>
__device__ __forceinline__ void gemm_phase(LAS unsigned char* lds, const int wid, const int K, const unsigned lda, const unsigned ldb, const Sched& S, const Epi& E) {
    int lane_ = (int)__builtin_amdgcn_mbcnt_hi(~0u, __builtin_amdgcn_mbcnt_lo(~0u, 0u)); asm volatile("" : "+v"(lane_));
    const int lane = lane_, tid = wid * 64 + lane, wr = wid >> 2, wc = wid & 3, fr = lane & 15, fq = lane >> 4;
    const int nt = K / BK;
    unsigned voffA[2], voffB[2]; int RA[2], CA[2];
#pragma unroll
    for (int i = 0; i < 2; ++i) { int R, C; stage_rc(tid * 16 + i * 8192, R, C); const int Rb = Epi::PERM ? ((R & ~31) + perm32(R & 31)) : R;
        RA[i] = R; CA[i] = C; voffA[i] = (unsigned)R * lda + (unsigned)C * 2u; voffB[i] = (unsigned)Rb * ldb + (unsigned)C * 2u; }
    const size_t kstep = (size_t)(BK * 2);
    const size_t hstepA = (size_t)HALF * lda, hstepB = (size_t)HALF * ldb;
    const unsigned ldsw = (unsigned)wid * 1024u;
    const int aoff = lds_byte(wr * 64 + fr, fq * 8), boff = lds_byte(wc * 32 + fr, fq * 8);
#define PG8_SA(b, h) (((b) * 2 + (h)) * HTB)
#define PG8_SB(b, h) ((4 + (b) * 2 + (h)) * HTB)
#define PG8_GLDS(gp, bufoff, i) __builtin_amdgcn_global_load_lds((const unsigned*)(gp), (LAS unsigned*)(lds + (bufoff) + ldsw + (i) * 8192), 16, 0, 0)
#define PG8_STAGE_B(bufoff, gbase) do { _Pragma("unroll") for (int _i = 0; _i < 2; ++_i) PG8_GLDS((const char*)(gbase) + voffB[_i], bufoff, _i); } while (0)
#define PG8_STAGE_A(bufoff, gbase, h, GO) do { _Pragma("unroll") for (int _i = 0; _i < 2; ++_i) { \
        if constexpr (GATHER) PG8_GLDS((const char*)(gbase) + GO[h][_i], bufoff, _i); else PG8_GLDS((const char*)(gbase) + (size_t)(h) * hstepA + voffA[_i], bufoff, _i); } } while (0)
#define PG8_LDA(dst, b, h) do { _Pragma("unroll") for (int m = 0; m < 4; ++m) _Pragma("unroll") for (int k = 0; k < 2; ++k) dst[m][k] = *(const LAS bf16x8*)(lds + PG8_SA(b, h) + aoff + m * 2048 + k * 1024); } while (0)
#define PG8_LDB(dst, b, h) do { _Pragma("unroll") for (int n = 0; n < 2; ++n) _Pragma("unroll") for (int k = 0; k < 2; ++k) dst[n][k] = *(const LAS bf16x8*)(lds + PG8_SB(b, h) + boff + n * 2048 + k * 1024); } while (0)
#define PG8_MFMA8(ACC, W8, X8) asm volatile("v_mfma_scale_f32_16x16x128_f8f6f4 %0, %1, %2, %0, %3, %4 op_sel_hi:[0,0,0]" : "+v"(ACC) : "v"(W8), "v"(X8), "v"(scw_), "v"(scx_))
#define PG8_MMA(ai, bj, At, Bt) do { __builtin_amdgcn_s_setprio(1); if constexpr (FP8) { i32x8 a8_[4], b8_[2]; _Pragma("unroll") for (int m = 0; m < 4; ++m) a8_[m] = cat8(At[m][0], At[m][1]); \
        _Pragma("unroll") for (int n = 0; n < 2; ++n) b8_[n] = cat8(Bt[n][0], Bt[n][1]); asm volatile("s_nop 3" ::: "memory"); \
        _Pragma("unroll") for (int m = 0; m < 4; ++m) _Pragma("unroll") for (int n = 0; n < 2; ++n) PG8_MFMA8(acc[ai][bj][m][n], b8_[n], a8_[m]); } else { \
        _Pragma("unroll") for (int m = 0; m < 4; ++m) _Pragma("unroll") for (int n = 0; n < 2; ++n) _Pragma("unroll") for (int k = 0; k < 2; ++k) \
        acc[ai][bj][m][n] = __builtin_amdgcn_mfma_f32_16x16x32_bf16(Bt[n][k], At[m][k], acc[ai][bj][m][n], 0, 0, 0); } __builtin_amdgcn_s_setprio(0); } while (0)
#define PG8_WAIT_V(n) asm volatile("s_waitcnt vmcnt(" #n ")" ::: "memory")
#define PG8_WAIT_L(n) asm volatile("s_waitcnt lgkmcnt(" #n ")" ::: "memory")
#define PG8_BAR __builtin_amdgcn_s_barrier()
#define PG8_SCHED __builtin_amdgcn_sched_barrier(0)
    Unit cur, nxt; int ui = 0;
    if (!S.next(0, cur)) return;
    int scw_ = SCW, scx_ = SCX; asm volatile("" : "+v"(scw_), "+v"(scx_)); (void)scw_; (void)scx_;
    unsigned goff[2][2] = {{0u, 0u}, {0u, 0u}}, ngoff[2][2] = {{0u, 0u}, {0u, 0u}};
    if constexpr (GATHER) {
#pragma unroll
        for (int h = 0; h < 2; ++h)
#pragma unroll
            for (int i = 0; i < 2; ++i) goff[h][i] = (unsigned)S.tok(cur, h * HALF + RA[i]) * lda + (unsigned)CA[i] * 2u;
    }
    f32x4 acc[2][2][4][2];
#pragma unroll
    for (int a = 0; a < 2; ++a)
#pragma unroll
        for (int b = 0; b < 2; ++b)
#pragma unroll
            for (int m = 0; m < 4; ++m)
#pragma unroll
                for (int n = 0; n < 2; ++n) acc[a][b][m][n] = (f32x4){0.f, 0.f, 0.f, 0.f};
    bf16x8 At[4][2], B0[2][2], B1[2][2];
    const char* cA = cur.A; const char* cB = cur.B;
    PG8_STAGE_B(PG8_SB(0, 0), cB); PG8_STAGE_B(PG8_SB(0, 1), cB + hstepB); PG8_STAGE_A(PG8_SA(0, 0), cA, 0, goff); PG8_STAGE_A(PG8_SA(0, 1), cA, 1, goff);
    if (wr == 1) PG8_BAR;
    PG8_WAIT_V(2); PG8_BAR;
    PG8_STAGE_B(PG8_SB(1, 0), cB + kstep); PG8_STAGE_A(PG8_SA(1, 0), cA + kstep, 0, goff); PG8_STAGE_B(PG8_SB(1, 1), cB + hstepB + kstep);
    PG8_WAIT_V(6); PG8_BAR;
    for (;;) {
        const bool has_next = S.next(ui + 1, nxt);
        const char* nA = has_next ? nxt.A : cA; const char* nB = has_next ? nxt.B : cB;
        if constexpr (GATHER) {
#pragma unroll
            for (int h = 0; h < 2; ++h)
#pragma unroll
                for (int i = 0; i < 2; ++i) ngoff[h][i] = has_next ? (unsigned)S.tok(nxt, h * HALF + RA[i]) * lda + (unsigned)CA[i] * 2u : goff[h][i];
        }
#pragma unroll 1
        for (int t = 0; t < nt; t += 2) {
            const bool last = (t == nt - 2);
            const char* a1 = cA + (size_t)(t + 1) * kstep;
            const char* a2 = last ? nA : cA + (size_t)(t + 2) * kstep; const char* b2 = last ? nB : cB + (size_t)(t + 2) * kstep;
            const char* a3 = a2 + kstep; const char* b3 = b2 + kstep;
            unsigned g2[2][2];
#pragma unroll
            for (int h = 0; h < 2; ++h)
#pragma unroll
                for (int i = 0; i < 2; ++i) g2[h][i] = last ? ngoff[h][i] : goff[h][i];
            PG8_LDB(B0, 0, 0); PG8_LDB(B1, 0, 1); PG8_SCHED; PG8_LDA(At, 0, 0); PG8_STAGE_A(PG8_SA(1, 1), a1, 1, goff);
            PG8_WAIT_V(8); PG8_WAIT_L(0); PG8_BAR; PG8_MMA(0, 0, At, B0); PG8_MMA(0, 1, At, B1); PG8_BAR; PG8_SCHED;
            PG8_LDA(At, 0, 1); PG8_STAGE_B(PG8_SB(0, 0), b2); PG8_STAGE_B(PG8_SB(0, 1), b2 + hstepB); PG8_STAGE_A(PG8_SA(0, 0), a2, 0, g2);
            PG8_WAIT_V(8); PG8_WAIT_L(0); PG8_BAR; PG8_MMA(1, 0, At, B0); PG8_MMA(1, 1, At, B1); PG8_BAR; PG8_SCHED;
            PG8_LDB(B0, 1, 0); PG8_LDB(B1, 1, 1); PG8_SCHED; PG8_LDA(At, 1, 0); PG8_STAGE_A(PG8_SA(0, 1), a2, 1, g2);
            PG8_WAIT_V(8); PG8_WAIT_L(0); PG8_BAR; PG8_MMA(0, 0, At, B0); PG8_MMA(0, 1, At, B1); PG8_BAR; PG8_SCHED;
            PG8_LDA(At, 1, 1); PG8_STAGE_B(PG8_SB(1, 0), b3); PG8_STAGE_B(PG8_SB(1, 1), b3 + hstepB); PG8_STAGE_A(PG8_SA(1, 0), a3, 0, g2);
            PG8_WAIT_V(8); PG8_WAIT_L(0); PG8_BAR; PG8_MMA(1, 0, At, B0); PG8_MMA(1, 1, At, B1); PG8_BAR; PG8_SCHED;
        }
        if (wr == 0) PG8_BAR;
        if constexpr (FP8) asm volatile("s_nop 7\n\ts_nop 7" ::: "memory");
        { int fr2 = fr, fq2 = fq; asm volatile("" : "+v"(fr2), "+v"(fq2)); E(acc, cur, wr, wc, fr2, fq2); }
        if (!has_next) break;
#pragma unroll
        for (int a = 0; a < 2; ++a)
#pragma unroll
            for (int b = 0; b < 2; ++b)
#pragma unroll
                for (int m = 0; m < 4; ++m)
#pragma unroll
                    for (int n = 0; n < 2; ++n) acc[a][b][m][n] = (f32x4){0.f, 0.f, 0.f, 0.f};
        cur = nxt; cA = nA; cB = nB; ++ui;
        if constexpr (GATHER) {
#pragma unroll
            for (int h = 0; h < 2; ++h)
#pragma unroll
                for (int i = 0; i < 2; ++i) goff[h][i] = ngoff[h][i];
        }
        if (wr == 1) PG8_BAR;
    }
    PG8_WAIT_V(0);
    PG8_BAR;
#undef PG8_SA
#undef PG8_SB
#undef PG8_GLDS
#undef PG8_STAGE_A
#undef PG8_STAGE_B
#undef PG8_LDA
#undef PG8_LDB
#undef PG8_MMA
#undef PG8_MFMA8
#undef PG8_WAIT_V
#undef PG8_WAIT_L
#undef PG8_BAR
#undef PG8_SCHED
}
}
__device__ __forceinline__ const char* uni_ptr(const char* p) {
    unsigned long long v = (unsigned long long)p; unsigned lo = __builtin_amdgcn_readfirstlane((unsigned)v), hi = __builtin_amdgcn_readfirstlane((unsigned)(v >> 32));
    return (const char*)(((unsigned long long)hi << 32) | lo);
}
struct SchedStd {
    pg8::TileOrder T; const char* A; const char* B; size_t sA, sB;
    __device__ __forceinline__ bool next(int i, pg8::Unit& u) const { int pm, pn; if (!T.tile(i, pm, pn)) return false; u.pm = pm; u.pn = pn; u.aux = 0; u.A = A + (size_t)pm * sA; u.B = B + (size_t)pn * sB; return true; }
    __device__ __forceinline__ int tok(const pg8::Unit&, int) const { return 0; }
};
struct SchedBatch {
    const char* A; const char* B; size_t sA, sB, vA, vB; int nunits, nvt, G, c;
    __device__ __forceinline__ bool next(int i, pg8::Unit& u) const { const int L = i * G + c; if (L >= nunits * nvt) return false; const int uu = L / nvt, vt = L % nvt; u.pm = uu; u.pn = vt; u.aux = 0;
        u.A = A + (size_t)uu * sA + (size_t)vt * vA; u.B = B + (size_t)uu * sB + (size_t)vt * vB; return true; }
    __device__ __forceinline__ int tok(const pg8::Unit&, int) const { return 0; }
};
struct SchedMoE {
    const LAS int* tab; const char* A; const char* Bw; size_t sE, sPN, sRT; const int* idx; int G, c; bool gather;
    __device__ __forceinline__ bool next(int i, pg8::Unit& u) const {
        const int L = i * G + c, rt = L >> 2, pn = L & 3;
        const int ntile = __builtin_amdgcn_readfirstlane(tab[32]); if (rt >= ntile) return false;
        int e = 0;
#pragma unroll
        for (int k = 1; k < 16; ++k) e += (rt >= __builtin_amdgcn_readfirstlane(tab[16 + k])) ? 1 : 0;
        e = __builtin_amdgcn_readfirstlane(e);
        u.pm = rt; u.pn = pn; u.aux = e; u.A = gather ? A : A + (size_t)rt * sRT; u.B = Bw + (size_t)e * sE + (size_t)pn * sPN; return true;
    }
    __device__ __forceinline__ int tok(const pg8::Unit& u, int r) const {
        const int e = u.aux, p = (u.pm - __builtin_amdgcn_readfirstlane(tab[16 + e])) * 256 + r, n = __builtin_amdgcn_readfirstlane(tab[e]);
        return p < n ? idx[e * NTOK + p] : 0;
    }
};

typedef const f32x4 (&AccRef)[2][2][4][2];
__device__ __forceinline__ int launder(int x) { asm volatile("" : "+v"(x)); return x; }
__device__ __forceinline__ void st8(bf16_t* p, f32x4 v0, f32x4 v1) {
    u32x4 w; w.x = cvt_pk_bf16(v0[0], v0[1]); w.y = cvt_pk_bf16(v0[2], v0[3]); w.z = cvt_pk_bf16(v1[0], v1[1]); w.w = cvt_pk_bf16(v1[2], v1[3]); *(u32x4*)p = w;
}
struct EpiPlain {
    static constexpr bool PERM = true; bf16_t* out; int ld;
    __device__ __forceinline__ void operator()(AccRef acc, const pg8::Unit& u, int wr, int wc, int fr, int fq) const {
#pragma unroll
        for (int ai = 0; ai < 2; ++ai)
#pragma unroll
            for (int m = 0; m < 4; ++m) { const int r = ai * 128 + wr * 64 + m * 16 + fr; bf16_t* rp = out + (size_t)(u.pm * 256 + r) * ld + u.pn * 256 + wc * 32 + fq * 8;
#pragma unroll
                for (int bj = 0; bj < 2; ++bj) st8(rp + bj * 128, acc[ai][bj][m][0], acc[ai][bj][m][1]); }
    }
};
template <int MODE> struct EpiRopeQK {
    static constexpr bool PERM = true; bf16_t* out; const int* pos; int half;
    __device__ __forceinline__ void operator()(AccRef acc, const pg8::Unit& u, int wr, int wc, int fr, int fq) const {
        const int pm = u.pm, h = u.pn, uu = ((pm >> 5) * 4 + h) * 32 + (pm & 31); const float l2g = log2_gamma(h);
        constexpr int LD = MODE == 0 ? 512 : 256;
        float inv[8]; const int f0 = launder(wc * 32 + fq * 8);
#pragma unroll
        for (int k = 0; k < 8; ++k) inv[k] = __builtin_amdgcn_exp2f(-(float)(f0 + k) * (LOG2_THETA / 128.0f));
#pragma unroll
        for (int ai = 0; ai < 2; ++ai)
#pragma unroll
            for (int m = 0; m < 4; ++m) { const int r = ai * 128 + wr * 64 + m * 16 + fr; const float p = (float)pos[half * THALF + pm * 256 + r];
                const float dec = MODE == 0 ? __builtin_amdgcn_exp2f((float)r * l2g) : __builtin_amdgcn_exp2f(-(float)r * l2g) * 0.0625f;
                f32x4 o1[2], o2[2];
#pragma unroll
                for (int n = 0; n < 2; ++n)
#pragma unroll
                    for (int j = 0; j < 4; ++j) { float s, c; sincos_rad(p * inv[n * 4 + j], s, c); const float x1 = acc[ai][0][m][n][j], x2 = acc[ai][1][m][n][j];
                        o1[n][j] = (x1 * c - x2 * s) * dec; o2[n][j] = (x1 * s + x2 * c) * dec; }
                bf16_t* rp = out + (size_t)uu * (256 * LD) + (size_t)r * LD + wc * 32 + fq * 8;
                st8(rp, o1[0], o1[1]); st8(rp + 128, o2[0], o2[1]); __builtin_amdgcn_sched_barrier(0); }
    }
};
struct EpiRopeKT {
    static constexpr bool PERM = true; bf16_t* out; const int* pos; int half;
    __device__ __forceinline__ void operator()(AccRef acc, const pg8::Unit& u, int wr, int wc, int fr, int fq) const {
        const int h = u.pm, pn = u.pn, uu = ((pn >> 5) * 4 + h) * 32 + (pn & 31); const float l2g = log2_gamma(h);
        float pp[2][8], dec[2][8]; const int c00 = launder(wc * 32 + fq * 8), i00 = launder(wr * 64 + fr);
#pragma unroll
        for (int bj = 0; bj < 2; ++bj)
#pragma unroll
            for (int k = 0; k < 8; ++k) { const int c = bj * 128 + c00 + k; pp[bj][k] = (float)pos[half * THALF + pn * 256 + c]; dec[bj][k] = __builtin_amdgcn_exp2f(-(float)c * l2g) * 0.0625f; }
#pragma unroll
        for (int m = 0; m < 4; ++m) { const int i = i00 + m * 16; const float inv = __builtin_amdgcn_exp2f(-(float)i * (LOG2_THETA / 128.0f));
#pragma unroll
            for (int bj = 0; bj < 2; ++bj) { f32x4 o1[2], o2[2];
#pragma unroll
                for (int n = 0; n < 2; ++n)
#pragma unroll
                    for (int j = 0; j < 4; ++j) { float s, c; sincos_rad(pp[bj][n * 4 + j] * inv, s, c); const float x1 = acc[0][bj][m][n][j], x2 = acc[1][bj][m][n][j], d = dec[bj][n * 4 + j];
                        o1[n][j] = (x1 * c - x2 * s) * d; o2[n][j] = (x1 * s + x2 * c) * d; }
                bf16_t* rp = out + (size_t)uu * 65536 + (size_t)i * 256 + bj * 128 + c00;
                st8(rp, o1[0], o1[1]); st8(rp + 128 * 256, o2[0], o2[1]); __builtin_amdgcn_sched_barrier(0); } }
    }
};
struct EpiVT {
    static constexpr bool PERM = true; bf16_t* out;
    __device__ __forceinline__ void operator()(AccRef acc, const pg8::Unit& u, int wr, int wc, int fr, int fq) const {
        const int h = u.pm >> 1, vt = u.pm & 1, pn = u.pn, uu = ((pn >> 5) * 4 + h) * 32 + (pn & 31);
#pragma unroll
        for (int ai = 0; ai < 2; ++ai)
#pragma unroll
            for (int m = 0; m < 4; ++m) { const int r = ai * 128 + wr * 64 + m * 16 + fr; bf16_t* rp = out + (size_t)uu * 262144 + (size_t)(vt * 256 + r) * 512 + 256 + wc * 32 + fq * 8;
#pragma unroll
                for (int bj = 0; bj < 2; ++bj) st8(rp + bj * 128, acc[ai][bj][m][0], acc[ai][bj][m][1]); }
    }
};
struct EpiS {
    static constexpr bool PERM = true; bf16_t* out;
    __device__ __forceinline__ void operator()(AccRef acc, const pg8::Unit& u, int wr, int wc, int fr, int fq) const {
        const int uu = u.pm;
#pragma unroll
        for (int ai = 0; ai < 2; ++ai)
#pragma unroll
            for (int m = 0; m < 4; ++m) { const int r = ai * 128 + wr * 64 + m * 16 + fr; bf16_t* rp = out + (size_t)uu * 131072 + (size_t)r * 512 + 256 + wc * 32 + fq * 8;
#pragma unroll
                for (int bj = 0; bj < 2; ++bj) { const int c0 = bj * 128 + wc * 32 + fq * 8; f32x4 v0 = acc[ai][bj][m][0], v1 = acc[ai][bj][m][1];
#pragma unroll
                    for (int j = 0; j < 4; ++j) { if (c0 + j > r) v0[j] = 0.f; if (c0 + 4 + j > r) v1[j] = 0.f; }
                    st8(rp + bj * 128, v0, v1); } }
    }
};
struct EpiKV {
    static constexpr bool PERM = true; bf16_t* out;
    __device__ __forceinline__ void operator()(AccRef acc, const pg8::Unit& u, int wr, int wc, int fr, int fq) const {
        const int uu = u.pm, vt = u.pn, h = (uu >> 5) & 3; const float sc = __builtin_amdgcn_exp2f(255.0f * log2_gamma(h));
#pragma unroll
        for (int ai = 0; ai < 2; ++ai)
#pragma unroll
            for (int m = 0; m < 4; ++m) { const int r = ai * 128 + wr * 64 + m * 16 + fr; bf16_t* rp = out + (size_t)uu * 262144 + (size_t)(vt * 256 + r) * 512 + wc * 32 + fq * 8;
#pragma unroll
                for (int bj = 0; bj < 2; ++bj) st8(rp + bj * 128, acc[ai][bj][m][0] * sc, acc[ai][bj][m][1] * sc); }
    }
};
struct EpiFin {
    static constexpr bool PERM = true; bf16_t* out; float* stats;
    __device__ __forceinline__ void operator()(AccRef acc, const pg8::Unit& u, int wr, int wc, int fr, int fq) const {
        const int uu = u.pm, vt = u.pn, bl = uu >> 7, h = (uu >> 5) & 3, ch = uu & 31;
#pragma unroll
        for (int ai = 0; ai < 2; ++ai)
#pragma unroll
            for (int m = 0; m < 4; ++m) { const int r = ai * 128 + wr * 64 + m * 16 + fr; bf16_t* rp = out + (size_t)uu * 262144 + (size_t)(vt * 256 + r) * 512 + wc * 32 + fq * 8;
                float s = 0.f, q = 0.f;
#pragma unroll
                for (int bj = 0; bj < 2; ++bj) { const f32x4 v0 = acc[ai][bj][m][0], v1 = acc[ai][bj][m][1];
                    s += (v0[0] + v0[1]) + (v0[2] + v0[3]) + (v1[0] + v1[1]) + (v1[2] + v1[3]);
                    q += (v0[0] * v0[0] + v0[1] * v0[1]) + (v0[2] * v0[2] + v0[3] * v0[3]) + (v1[0] * v1[0] + v1[1] * v1[1]) + (v1[2] * v1[2] + v1[3] * v1[3]);
                    st8(rp + bj * 128, v0, v1); }
                s = rows_sum(s); q = rows_sum(q);
                const int tokl = bl * SEQ + ch * 256 + r;
                if (fq == 0) *(f32x2*)(stats + ((size_t)(tokl * 4 + h) * 8 + vt * 4 + wc) * 2) = (f32x2){s, q}; }
    }
};
template <bool F8> struct EpiGate {
    static constexpr bool PERM = true; const bf16_t* o; const float* stats; bf16_t* y; unsigned char* y8;
    __device__ __forceinline__ void operator()(AccRef acc, const pg8::Unit& u, int wr, int wc, int fr, int fq) const {
        const int pm = u.pm, h = u.pn >> 1, vt = u.pn & 1, uu = ((pm >> 5) * 4 + h) * 32 + (pm & 31);
#pragma unroll
        for (int ai = 0; ai < 2; ++ai)
#pragma unroll
            for (int m = 0; m < 4; ++m) { const int r = ai * 128 + wr * 64 + m * 16 + fr, tokl = pm * 256 + r;
                const f32x4* sp = (const f32x4*)(stats + (size_t)(tokl * 4 + h) * 16); const f32x4 a = sp[0], b = sp[1], c = sp[2], d = sp[3];
                const float mean = ((a[0] + a[2]) + (b[0] + b[2]) + (c[0] + c[2]) + (d[0] + d[2])) * (1.0f / 512.0f);
                const float ex2 = ((a[1] + a[3]) + (b[1] + b[3]) + (c[1] + c[3]) + (d[1] + d[3])) * (1.0f / 512.0f);
                const float rstd = __builtin_amdgcn_rsqf(fmaxf(ex2 - mean * mean, 0.f) + EPS);
                const bf16_t* op = o + (size_t)uu * 262144 + (size_t)(vt * 256 + r) * 512 + wc * 32 + fq * 8;
                bf16_t* yp = y + (size_t)tokl * 2048 + h * 512 + vt * 256 + wc * 32 + fq * 8;
#pragma unroll
                for (int bj = 0; bj < 2; ++bj) { const u32x4 ow = *(const u32x4*)(op + bj * 128); const f32x4 g0 = acc[ai][bj][m][0], g1 = acc[ai][bj][m][1];
                    f32x4 y0, y1;
                    y0[0] = silu_f(g0[0]) * (bflo(ow.x) - mean) * rstd; y0[1] = silu_f(g0[1]) * (bfhi(ow.x) - mean) * rstd; y0[2] = silu_f(g0[2]) * (bflo(ow.y) - mean) * rstd; y0[3] = silu_f(g0[3]) * (bfhi(ow.y) - mean) * rstd;
                    y1[0] = silu_f(g1[0]) * (bflo(ow.z) - mean) * rstd; y1[1] = silu_f(g1[1]) * (bfhi(ow.z) - mean) * rstd; y1[2] = silu_f(g1[2]) * (bflo(ow.w) - mean) * rstd; y1[3] = silu_f(g1[3]) * (bfhi(ow.w) - mean) * rstd;
                    if constexpr (F8) { u32x2 w; w.x = pk4_fp8(4.0f * y0[0], 4.0f * y0[1], 4.0f * y0[2], 4.0f * y0[3]); w.y = pk4_fp8(4.0f * y1[0], 4.0f * y1[1], 4.0f * y1[2], 4.0f * y1[3]);
                        *(u32x2*)(y8 + (size_t)tokl * 2048 + h * 512 + vt * 256 + wc * 32 + fq * 8 + bj * 128) = w; }
                    else st8(yp + bj * 128, y0, y1); } __builtin_amdgcn_sched_barrier(0); }
    }
};
struct EpiResid {
    static constexpr bool PERM = false; float* h; const float* gate; int tok0;
    __device__ __forceinline__ void operator()(AccRef acc, const pg8::Unit& u, int wr, int wc, int fr, int fq) const {
#pragma unroll
        for (int ai = 0; ai < 2; ++ai)
#pragma unroll
            for (int m = 0; m < 4; ++m) { const int row = tok0 + u.pm * 256 + ai * 128 + wr * 64 + m * 16 + fr, b = row >> 13;
#pragma unroll
                for (int bj = 0; bj < 2; ++bj)
#pragma unroll
                    for (int n = 0; n < 2; ++n) { const int c = u.pn * 256 + bj * 128 + wc * 32 + n * 16 + fq * 4; const f32x4 gv = *(const f32x4*)(gate + b * 6144 + c);
                        f32x4* hp = (f32x4*)(h + (size_t)row * DM + c); *hp = *hp + gv * acc[ai][bj][m][n]; } }
    }
};
struct EpiGU {
    static constexpr bool PERM = true; bf16_t* hdn;
    __device__ __forceinline__ void operator()(AccRef acc, const pg8::Unit& u, int wr, int wc, int fr, int fq) const {
#pragma unroll
        for (int ai = 0; ai < 2; ++ai)
#pragma unroll
            for (int m = 0; m < 4; ++m) { const int r = ai * 128 + wr * 64 + m * 16 + fr; f32x4 o0, o1;
#pragma unroll
                for (int j = 0; j < 4; ++j) { o0[j] = silu_f(acc[ai][0][m][0][j]) * acc[ai][1][m][0][j]; o1[j] = silu_f(acc[ai][0][m][1][j]) * acc[ai][1][m][1][j]; }
                st8(hdn + (size_t)(u.pm * 256 + r) * DEXP + u.pn * 128 + wc * 32 + fq * 8, o0, o1); }
    }
};
struct EpiGU8 {
    static constexpr bool PERM = true; unsigned char* hdn;
    __device__ __forceinline__ void operator()(AccRef acc, const pg8::Unit& u, int wr, int wc, int fr, int fq) const {
#pragma unroll
        for (int ai = 0; ai < 2; ++ai)
#pragma unroll
            for (int m = 0; m < 4; ++m) { const int r = ai * 128 + wr * 64 + m * 16 + fr; f32x4 o0, o1;
#pragma unroll
                for (int j = 0; j < 4; ++j) { o0[j] = 4.0f * silu_f(acc[ai][0][m][0][j]) * acc[ai][1][m][0][j]; o1[j] = 4.0f * silu_f(acc[ai][0][m][1][j]) * acc[ai][1][m][1][j]; }
                u32x2 w; w.x = pk4_fp8(o0[0], o0[1], o0[2], o0[3]); w.y = pk4_fp8(o1[0], o1[1], o1[2], o1[3]);
                *(u32x2*)(hdn + (size_t)(u.pm * 256 + r) * DEXP + u.pn * 128 + wc * 32 + fq * 8) = w; }
    }
};
struct EpiQA {
    static constexpr bool PERM = true; bf16_t* out; float* ssq;
    __device__ __forceinline__ void operator()(AccRef acc, const pg8::Unit& u, int wr, int wc, int fr, int fq) const {
#pragma unroll
        for (int ai = 0; ai < 2; ++ai)
#pragma unroll
            for (int m = 0; m < 4; ++m) { const int row = u.pm * 256 + ai * 128 + wr * 64 + m * 16 + fr; bf16_t* rp = out + (size_t)row * 256 + wc * 32 + fq * 8; float q = 0.f;
#pragma unroll
                for (int bj = 0; bj < 2; ++bj) { const f32x4 v0 = acc[ai][bj][m][0], v1 = acc[ai][bj][m][1];
                    q += (v0[0] * v0[0] + v0[1] * v0[1]) + (v0[2] * v0[2] + v0[3] * v0[3]) + (v1[0] * v1[0] + v1[1] * v1[1]) + (v1[2] * v1[2] + v1[3] * v1[3]);
                    st8(rp + bj * 128, v0, v1); }
                q = rows_sum(q);
                if (fq == 0) ssq[(size_t)row * 4 + wc] = q; }
    }
};
struct EpiF32 {
    static constexpr bool PERM = false; float* out;
    __device__ __forceinline__ void operator()(AccRef acc, const pg8::Unit& u, int wr, int wc, int fr, int fq) const {
#pragma unroll
        for (int ai = 0; ai < 2; ++ai)
#pragma unroll
            for (int m = 0; m < 4; ++m) { const int row = u.pm * 256 + ai * 128 + wr * 64 + m * 16 + fr;
#pragma unroll
                for (int bj = 0; bj < 2; ++bj)
#pragma unroll
                    for (int n = 0; n < 2; ++n) *(f32x4*)(out + (size_t)row * 256 + bj * 128 + wc * 32 + n * 16 + fq * 4) = acc[ai][bj][m][n]; }
    }
};
struct EpiQB {
    static constexpr bool PERM = true; bf16_t* Q; const float* ssq; const int* pos;
    __device__ __forceinline__ void operator()(AccRef acc, const pg8::Unit& u, int wr, int wc, int fr, int fq) const {
        constexpr float QS = 0.10411754627697264f;
        const int pn = u.pn;
        float inv[8]; const int f0 = launder(fq * 8);
#pragma unroll
        for (int k = 0; k < 8; ++k) inv[k] = __builtin_amdgcn_exp2f(-(float)(f0 + k) * (LOG2_THETA / 32.0f));
#pragma unroll
        for (int ai = 0; ai < 2; ++ai)
#pragma unroll
            for (int m = 0; m < 4; ++m) { const int row = u.pm * 256 + ai * 128 + wr * 64 + m * 16 + fr; const f32x4 sq = *(const f32x4*)(ssq + (size_t)row * 4);
                const float rs = __builtin_amdgcn_rsqf(((sq[0] + sq[1]) + (sq[2] + sq[3])) * (1.0f / 256.0f) + EPS) * QS;
                if (pn < 4) {
#pragma unroll
                    for (int bj = 0; bj < 2; ++bj) st8(Q + (size_t)row * 1536 + (2 * pn + bj) * QKD + wc * 32 + fq * 8, acc[ai][bj][m][0] * rs, acc[ai][bj][m][1] * rs);
                } else {
                    const float p = (float)pos[row]; f32x4 o1[2], o2[2];
#pragma unroll
                    for (int n = 0; n < 2; ++n)
#pragma unroll
                        for (int j = 0; j < 4; ++j) { float s, c; sincos_rad(p * inv[n * 4 + j], s, c); const float x1 = acc[ai][0][m][n][j] * rs, x2 = acc[ai][1][m][n][j] * rs;
                            o1[n][j] = x1 * c - x2 * s; o2[n][j] = x1 * s + x2 * c; }
                    bf16_t* qp = Q + (size_t)row * 1536 + (4 * (pn - 4) + wc) * QKD + 128 + fq * 8;
                    st8(qp, o1[0], o1[1]); st8(qp + 32, o2[0], o2[1]); } __builtin_amdgcn_sched_barrier(0); }
    }
};
typedef const char __attribute__((address_space(4)))* kaptr_t;
struct Ctx { kaptr_t ka; LAS unsigned char* lds; int wave, vcu; };
__device__ __forceinline__ const void* ld_ka(kaptr_t ka, int off) { return *(const void* const __attribute__((address_space(4)))*)(ka + off); }
#define INF(k) ((const float*)ld_ka(ka, (k) * 8))
#define INI(k) ((const int*)ld_ka(ka, (k) * 8))
#define OUTP ((float*)ld_ka(ka, 200))
#define WSB ((unsigned char*)ld_ka(ka, 208))
#define CTLP ((unsigned*)(WSB + WS_CTL))
#define PHASE_ENTRY() kaptr_t ka = C.ka; asm volatile("" : "+s"(ka)); int lane_ = lane_id(); asm volatile("" : "+v"(lane_)); int wave_ = C.wave, vcu_ = C.vcu; asm volatile("" : "+s"(wave_), "+s"(vcu_)); \
    const int lane = lane_, wave = wave_, vcu = vcu_, tid = wave * 64 + lane; LAS unsigned char* const ldsb = C.lds; (void)tid; (void)lane; (void)vcu; (void)ldsb
#define WSP(T, off) ((T*)(WSB + (off)))

__device__ __forceinline__ void transpose_block(const float* W, int N, int k0, int n0, bf16_t* dst, int ldd, int drow, LAS float* scr, int lane) {
#pragma unroll 8
    for (int i = 0; i < 32; ++i) { const int kk = 2 * i + (lane >> 5); scr[kk * 33 + (lane & 31)] = W[(size_t)(k0 + kk) * N + n0 + (lane & 31)]; }
    LDS_WAIT(); asm volatile("" ::: "memory");
    const int c = lane & 7;
#pragma unroll
    for (int j = 0; j < 4; ++j) { const int n = (lane >> 3) + 8 * j; const LAS float* s = scr + (8 * c) * 33 + n;
        u32x4 o; o.x = cvt_pk_bf16(s[0 * 33], s[1 * 33]); o.y = cvt_pk_bf16(s[2 * 33], s[3 * 33]); o.z = cvt_pk_bf16(s[4 * 33], s[5 * 33]); o.w = cvt_pk_bf16(s[6 * 33], s[7 * 33]);
        *(u32x4*)(dst + (size_t)(drow + n) * ldd + k0 + 8 * c) = o; }
    LDS_WAIT(); asm volatile("" ::: "memory");
}
__device__ __forceinline__ void transpose_block_f8(const float* W, int N, int k0, int n0, unsigned char* dst, int ldd, int drow, float sc, LAS float* scr, int lane) {
#pragma unroll 8
    for (int i = 0; i < 32; ++i) { const int kk = 2 * i + (lane >> 5); scr[kk * 33 + (lane & 31)] = W[(size_t)(k0 + kk) * N + n0 + (lane & 31)]; }
    LDS_WAIT(); asm volatile("" ::: "memory");
    const int c = lane & 7;
#pragma unroll
    for (int j = 0; j < 4; ++j) { const int n = (lane >> 3) + 8 * j; const LAS float* s = scr + (8 * c) * 33 + n;
        u32x2 o; o.x = pk4_fp8(sc * s[0 * 33], sc * s[1 * 33], sc * s[2 * 33], sc * s[3 * 33]); o.y = pk4_fp8(sc * s[4 * 33], sc * s[5 * 33], sc * s[6 * 33], sc * s[7 * 33]);
        *(u32x2*)(dst + (size_t)(drow + n) * ldd + k0 + 8 * c) = o; }
    LDS_WAIT(); asm volatile("" ::: "memory");
}
__device__ __forceinline__ void phase_prologue(Ctx& C) {
    PHASE_ENTRY();
    LAS float* cact = (LAS float*)ldsb;
    LAS float* red = (LAS float*)(ldsb + 16384);
    for (int i = tid; i < 4096; i += NTHREADS) cact[i] = silu_f(INF(1)[i]);
    __syncthreads();
    float* mod = WSP(float, WS_MOD);
    for (int g = vcu; g < 416; g += GRID) {
        const int col = g * 64 + lane; const float* W; int N, cc; const float* bias; float* dst; int dstride;
        if (col < 24576) { const int l = col / 6144; cc = col - l * 6144; W = INF(3) + (size_t)l * 1024 * 6144; N = 6144; bias = INF(4) + l * 6144; dst = mod + (size_t)l * 4 * 6144; dstride = 6144; }
        else { cc = col - 24576; W = INF(9); N = 2048; bias = INF(10); dst = mod + 4 * 4 * 6144; dstride = 2048; }
        float a0 = 0.f, a1 = 0.f, a2 = 0.f, a3 = 0.f;
        const float* wp = W + (size_t)(wave * 128) * N + cc;
#pragma unroll 16
        for (int k = 0; k < 128; ++k) { const float w = wp[(size_t)k * N]; const int kk = wave * 128 + k; a0 += cact[kk] * w; a1 += cact[1024 + kk] * w; a2 += cact[2048 + kk] * w; a3 += cact[3072 + kk] * w; }
        red[(wave * 4 + 0) * 64 + lane] = a0; red[(wave * 4 + 1) * 64 + lane] = a1; red[(wave * 4 + 2) * 64 + lane] = a2; red[(wave * 4 + 3) * 64 + lane] = a3;
        __syncthreads();
        if (tid < 256) { const int b = tid >> 6, ln = tid & 63; float s = 0.f;
#pragma unroll
            for (int w = 0; w < 8; ++w) s += red[(w * 4 + b) * 64 + ln];
            const int c2 = g * 64 + ln; const int cc2 = c2 < 24576 ? c2 % 6144 : c2 - 24576;
            dst[(size_t)b * dstride + cc2] = s + bias[cc2]; }
        __syncthreads();
    }
    LAS float* scr = (LAS float*)(ldsb + wave * 16384);
    const int gw = vcu * NWAVES + wave, NGW = GRID * NWAVES;
    constexpr int NIT = 8544 + 64 * 768;
    for (int it = gw; it < NIT; it += NGW) {
        if (it < 6144) { const int l = it / 3072, r = it % 3072, kb = r / 192, nb = r % 192;
            transpose_block(INF(7) + (size_t)l * 1024 * 6144, 6144, 64 * kb, 32 * nb, WSP(bf16_t, WS_WIN) + (size_t)l * 6144 * 1024, 1024, 32 * nb, scr, lane);
            transpose_block_f8(INF(7) + (size_t)l * 1024 * 6144, 6144, 64 * kb, 32 * nb, WSP(unsigned char, WS_WIN8) + (size_t)l * 6144 * 1024, 1024, 32 * nb, 64.0f, scr, lane); }
        else if (it < 8192) { const int r0 = it - 6144, l = r0 / 1024, r = r0 % 1024, kb = r / 32, nb = r % 32;
            transpose_block_f8(INF(8) + (size_t)l * 2048 * 1024, 1024, 64 * kb, 32 * nb, WSP(unsigned char, WS_WOUT8) + (size_t)l * 1024 * 2048, 2048, 32 * nb, 64.0f, scr, lane);
            transpose_block(INF(8) + (size_t)l * 2048 * 1024, 1024, 64 * kb, 32 * nb, WSP(bf16_t, WS_WOUT) + (size_t)l * 1024 * 2048, 2048, 32 * nb, scr, lane); }
        else if (it < 8448) { const int r0 = it - 8192, j = r0 / 128, r = r0 % 128, kb = r / 8, nb = r % 8;
            transpose_block_f8(INF(15) + (size_t)j * 1024 * 256, 256, 64 * kb, 32 * nb, WSP(unsigned char, WS_WQA8) + (size_t)j * 256 * 1024, 1024, 32 * nb, 64.0f, scr, lane);
            transpose_block(INF(15) + (size_t)j * 1024 * 256, 256, 64 * kb, 32 * nb, WSP(bf16_t, WS_WQA) + (size_t)j * 256 * 1024, 1024, 32 * nb, scr, lane); }
        else if (it < 8544) { const int r = it - 8448, kb = r / 6, nb = r % 6;
            transpose_block(INF(12), 192, 64 * kb, 32 * nb, WSP(bf16_t, WS_WKVA), 1024, 32 * nb, scr, lane); }
        else { const int r0 = it - 8544, le = r0 / 768, r = r0 % 768;
            if (r < 512) { const int up = r >> 8, rr = r & 255, kb = rr / 16, nb = rr % 16, n0 = 32 * nb;
                transpose_block_f8((up ? INF(22) : INF(21)) + (size_t)le * 1024 * 512, 512, 64 * kb, n0, WSP(unsigned char, WS_WGU) + (size_t)le * 1024 * 1024, 1024, (n0 >> 7) * 256 + (n0 & 127) + up * 128, 64.0f, scr, lane); }
            else { const int rr = r - 512, kb = rr / 32, nb = rr % 32;
                transpose_block_f8(INF(23) + (size_t)le * 512 * 1024, 1024, 64 * kb, 32 * nb, WSP(unsigned char, WS_WDN) + (size_t)le * 1024 * 512, 512, 32 * nb, 64.0f, scr, lane); } }
    }
    const int gt = vcu * NTHREADS + tid, NGT = GRID * NTHREADS;
    for (int i = gt; i < 64 * 1024 / 8; i += NGT) *(u32x4*)(WSP(bf16_t, WS_WKVA) + 192 * 1024 + (size_t)i * 8) = (u32x4){0u, 0u, 0u, 0u};
    for (int i = gt; i < 2 * 1536 * 256; i += NGT) {
        const int k = i & 255, n = (i >> 8) % 1536, j = i / (1536 * 256);
        const float* wq = INF(17) + ((size_t)j * 256 + k) * 1536; float v;
        if (n < 1024) { const int head = n >> 7, cdim = n & 127; const float* a = wq + head * QKD; const float* b = INF(14) + (size_t)cdim * 2048 + head * 256; float s = 0.f;
#pragma unroll 8
            for (int d = 0; d < 128; d += 4) { const f32x4 av = *(const f32x4*)(a + d), bv = *(const f32x4*)(b + d); s += av[0] * bv[0] + av[1] * bv[1] + av[2] * bv[2] + av[3] * bv[3]; }
            v = s; }
        else { const int np = (n - 1024) & 255, pn = (n - 1024) >> 8, half = np >> 7, wcc = (np & 127) >> 5, ii = np & 31; v = wq[(4 * pn + wcc) * QKD + 128 + half * 32 + ii]; }
        v *= INF(16)[j * 256 + k];
        WSP(bf16_t, WS_WQB)[i] = (bf16_t)(cvt_pk_bf16(v, 0.f) & 0xffffu);
    }
    for (int it = vcu * NWAVES + wave; it < 2 * 8 * 16 * 4; it += GRID * NWAVES) {
        const int nq = it & 3, cb = (it >> 2) & 15, hh = (it >> 6) & 7, j = it >> 9, n0 = nq * 256 + 4 * lane, c0 = cb * 8;
        const float* a = INF(14) + (size_t)c0 * 2048 + hh * 256 + 128; const float* bq = INF(18) + ((size_t)j * 1024 + hh * 128) * 1024 + n0;
        f32x4 acc[8];
#pragma unroll
        for (int c = 0; c < 8; ++c) acc[c] = (f32x4){0.f, 0.f, 0.f, 0.f};
#pragma unroll 4
        for (int v = 0; v < 128; ++v) { const f32x4 bv = *(const f32x4*)(bq + (size_t)v * 1024);
#pragma unroll
            for (int c = 0; c < 8; ++c) acc[c] = acc[c] + bv * a[(size_t)c * 2048 + v]; }
        bf16_t* o = WSP(bf16_t, WS_WO) + ((size_t)j * 1024 + n0) * 1024 + hh * 128 + c0;
#pragma unroll
        for (int q = 0; q < 4; ++q) { u32x4 w; w.x = cvt_pk_bf16(acc[0][q], acc[1][q]); w.y = cvt_pk_bf16(acc[2][q], acc[3][q]); w.z = cvt_pk_bf16(acc[4][q], acc[5][q]); w.w = cvt_pk_bf16(acc[6][q], acc[7][q]);
            *(u32x4*)(o + (size_t)q * 1024) = w;
            u32x2 w8; w8.x = pk4_fp8(64.f * acc[0][q], 64.f * acc[1][q], 64.f * acc[2][q], 64.f * acc[3][q]); w8.y = pk4_fp8(64.f * acc[4][q], 64.f * acc[5][q], 64.f * acc[6][q], 64.f * acc[7][q]);
            *(u32x2*)(WSP(unsigned char, WS_WO8) + ((size_t)j * 1024 + n0 + q) * 1024 + hh * 128 + c0) = w8; }
    }
}

__device__ __forceinline__ void moe_tile_prefix(Ctx& C, int l) {
    PHASE_ENTRY();
    LAS int* tab = (LAS int*)(ldsb + LDS_TAB);
    if (tid == 0) { int acc = 0;
        for (int e = 0; e < 16; ++e) { const int n = (int)__hip_atomic_load(CTLP + CW_CNT + 64 * l + e, __ATOMIC_RELAXED, __HIP_MEMORY_SCOPE_AGENT); tab[e] = n; tab[16 + e] = acc; acc += (n + 255) >> 8; }
        tab[32] = acc; }
    __syncthreads();
}
__device__ __forceinline__ void store_fp8_row(unsigned char* row, int lane, const f32x4 (&v)[4], float sc) {
#pragma unroll
    for (int j = 0; j < 4; ++j) *(unsigned*)(row + 4 * lane + 256 * j) = pk4_fp8(sc * v[j][0], sc * v[j][1], sc * v[j][2], sc * v[j][3]);
}
__device__ __forceinline__ void store_bf16_row(bf16_t* row, int lane, const f32x4 (&v)[4]) {
#pragma unroll
    for (int j = 0; j < 4; ++j) { u32x2 w; w.x = cvt_pk_bf16(v[j][0], v[j][1]); w.y = cvt_pk_bf16(v[j][2], v[j][3]); *(u32x2*)(row + 4 * lane + 256 * j) = w; }
}
__device__ __forceinline__ void moe_combine_row(const LAS int* tab, const unsigned* route, const bf16_t* yb, int lane, int tok, const f32x4 (&G2)[4], f32x4 (&v)[4]) {
    const u32x4 rt = *(const u32x4*)(route + (size_t)tok * 4);
    const int e0 = rt.x >> 15, p0 = rt.x & 32767, e1 = rt.y >> 15, p1 = rt.y & 32767; const float w0 = __uint_as_float(rt.z), w1 = __uint_as_float(rt.w);
    const bf16_t* y0 = yb + (size_t)(tab[16 + e0] * 256 + p0) * DM; const bf16_t* y1 = yb + (size_t)(tab[16 + e1] * 256 + p1) * DM;
#pragma unroll
    for (int j = 0; j < 4; ++j) { const u32x2 a = *(const u32x2*)(y0 + 4 * lane + 256 * j), b = *(const u32x2*)(y1 + 4 * lane + 256 * j);
        v[j][0] += G2[j][0] * (w0 * bflo(a.x) + w1 * bflo(b.x)); v[j][1] += G2[j][1] * (w0 * bfhi(a.x) + w1 * bfhi(b.x));
        v[j][2] += G2[j][2] * (w0 * bflo(a.y) + w1 * bflo(b.y)); v[j][3] += G2[j][3] * (w0 * bfhi(a.y) + w1 * bfhi(b.y)); }
}
__device__ __forceinline__ float row_rstd(const f32x4 (&v)[4]) {
    float s = 0.f;
#pragma unroll
    for (int j = 0; j < 4; ++j) s += (v[j][0] * v[j][0] + v[j][1] * v[j][1]) + (v[j][2] * v[j][2] + v[j][3] * v[j][3]);
    return __builtin_amdgcn_rsqf(wave_sum(s) * (1.0f / DM) + EPS);
}
__device__ __forceinline__ void phase_norm_a(Ctx& C, int l, int rep = 0) {
    PHASE_ENTRY(); const int b = vcu >> 6; const float* mod = WSP(float, WS_MOD);
    const float* xin = INF(0); float* hout = OUTP; bf16_t* xnp = WSP(bf16_t, WS_XN); unsigned char* xn8p = WSP(unsigned char, WS_XN8); bf16_t* hnp = WSP(bf16_t, WS_HN); const unsigned* route = WSP(unsigned, WS_ROUTE); const bf16_t* ybp = WSP(bf16_t, WS_YB);
    f32x4 Am[4], Bm[4], G2[4], Ak[4], Bk[4];
#pragma unroll
    for (int j = 0; j < 4; ++j) { const int c = 4 * lane + 256 * j;
        if (l < 4) { const float* ml = mod + (size_t)(l * 4 + b) * 6144; const f32x4 g = *(const f32x4*)(INF(5) + l * DM + c), sc = *(const f32x4*)(ml + 1024 + c); Am[j] = g * (1.0f + sc); Bm[j] = *(const f32x4*)(ml + c); }
        else { Am[j] = *(const f32x4*)(INF(24) + c); Bm[j] = (f32x4){0.f, 0.f, 0.f, 0.f}; }
        if (l > 0 && !rep) G2[j] = *(const f32x4*)(mod + (size_t)((l - 1) * 4 + b) * 6144 + 5 * 1024 + c); else G2[j] = (f32x4){0.f, 0.f, 0.f, 0.f};
        if (l == 2) { const float* mk = mod + 4 * 4 * 6144 + b * 2048; const f32x4 g = *(const f32x4*)(INF(11) + c), sc = *(const f32x4*)(mk + 1024 + c); Ak[j] = g * (1.0f + sc); Bk[j] = *(const f32x4*)(mk + c); }
        else { Ak[j] = Am[j]; Bk[j] = Bm[j]; } }
    if (l > 0) moe_tile_prefix(C, l - 1);
    for (int rr = 0; rr < 16; ++rr) {
        const int tok = vcu * 128 + wave * 16 + rr; f32x4 v[4];
        const float* src = (l == 0 ? xin : hout) + (size_t)tok * DM;
#pragma unroll
        for (int j = 0; j < 4; ++j) v[j] = *(const f32x4*)(src + 4 * lane + 256 * j);
        if (l > 0) moe_combine_row((const LAS int*)(ldsb + LDS_TAB), route, ybp, lane, tok, G2, v);
        const float rstd = row_rstd(v);
        if (l < 4) {
#pragma unroll
            for (int j = 0; j < 4; ++j) *(f32x4*)(hout + (size_t)tok * DM + 4 * lane + 256 * j) = v[j];
            f32x4 o[4];
#pragma unroll
            for (int j = 0; j < 4; ++j) o[j] = v[j] * rstd * Am[j] + Bm[j];
            store_bf16_row(xnp + (size_t)tok * DM, lane, o); store_fp8_row(xn8p + (size_t)tok * DM, lane, o, 4.0f);
            if (l == 2) {
#pragma unroll
                for (int j = 0; j < 4; ++j) o[j] = v[j] * rstd * Ak[j] + Bk[j];
                store_bf16_row(hnp + (size_t)tok * DM, lane, o); }
        } else {
#pragma unroll
            for (int j = 0; j < 4; ++j) *(f32x4*)(hout + (size_t)tok * DM + 4 * lane + 256 * j) = v[j] * rstd * Am[j];
        }
    }
}
constexpr int NBR = 4;
template <int CTRL> __device__ __forceinline__ float dpp_add(float v) { return v + dpp_f<CTRL>(v); }
__device__ __forceinline__ void phase_norm_b(Ctx& C, int l) {
    PHASE_ENTRY(); const int b = vcu >> 6; const float* ml = WSP(float, WS_MOD) + (size_t)(l * 4 + b) * 6144;
    const float* hin = OUTP; bf16_t* xnp = WSP(bf16_t, WS_XN);
    LAS float* wrT = (LAS float*)ldsb;
    LAS float* lgt = (LAS float*)(ldsb + 65536);
    LAS int* rec_e = (LAS int*)(ldsb + 65536 + 8192);
    LAS float* rec_w = (LAS float*)(ldsb + 65536 + 8192 + 1024);
    LAS int* rec_p = (LAS int*)(ldsb + 65536 + 8192 + 2048);
    LAS int* lcnt = (LAS int*)(ldsb + 65536 + 8192 + 3072);
    LAS int* gbase = (LAS int*)(ldsb + 65536 + 8192 + 3072 + 64);
    for (int i = tid; i < 4096; i += NTHREADS) { const f32x4 w = *(const f32x4*)(INF(19) + (size_t)i * 4); const int col = i >> 2, e4 = (i & 3) * 4;
        wrT[(e4 + 0) * 1024 + col] = w[0]; wrT[(e4 + 1) * 1024 + col] = w[1]; wrT[(e4 + 2) * 1024 + col] = w[2]; wrT[(e4 + 3) * 1024 + col] = w[3]; }
    if (tid < 16) lcnt[tid] = 0;
    f32x4 Am[4], Bm[4];
#pragma unroll
    for (int j = 0; j < 4; ++j) { const int c = 4 * lane + 256 * j; const f32x4 g = *(const f32x4*)(INF(6) + l * DM + c), sc = *(const f32x4*)(ml + 4 * 1024 + c); Am[j] = g * (1.0f + sc); Bm[j] = *(const f32x4*)(ml + 3 * 1024 + c); }
    const float* hrow = hin + (size_t)(vcu * 128 + wave * 16) * DM + 4 * lane;
    __syncthreads();
#pragma unroll 1
    for (int g = 0; g < 16 / NBR; ++g) {
        asm volatile("" ::: "memory");
        f32x4 v[NBR][4];
#pragma unroll
        for (int i = 0; i < NBR; ++i)
#pragma unroll
            for (int j = 0; j < 4; ++j) v[i][j] = *(const f32x4*)(hrow + (size_t)(g * NBR + i) * DM + 256 * j);
#pragma unroll
        for (int i = 0; i < NBR; ++i) { const float rstd = row_rstd(v[i]);
#pragma unroll
            for (int j = 0; j < 4; ++j) v[i][j] = v[i][j] * rstd * Am[j] + Bm[j];
            { unsigned char* xr = (unsigned char*)xnp + (size_t)(vcu * 128 + wave * 16 + g * NBR + i) * DM;
#pragma unroll
              for (int j = 0; j < 4; ++j) *(unsigned*)(xr + 4 * lane + 256 * j) = pk4_fp8(4.0f * v[i][j][0], 4.0f * v[i][j][1], 4.0f * v[i][j][2], 4.0f * v[i][j][3]); } }
        float p[NBR][16];
#pragma unroll
        for (int e = 0; e < 16; ++e) { f32x4 w[4];
#pragma unroll
            for (int j = 0; j < 4; ++j) w[j] = *(const LAS f32x4*)(wrT + e * 1024 + 4 * lane + 256 * j);
#pragma unroll
            for (int i = 0; i < NBR; ++i) { float a = 0.f;
#pragma unroll
                for (int j = 0; j < 4; ++j) a += (v[i][j][0] * w[j][0] + v[i][j][1] * w[j][1]) + (v[i][j][2] * w[j][2] + v[i][j][3] * w[j][3]);
                p[i][e] = a; asm volatile("" : "+v"(p[i][e])); }
            __builtin_amdgcn_sched_barrier(0); }
#pragma unroll
        for (int i = 0; i < NBR; ++i) {
            float q[8], r[4];
#pragma unroll
            for (int k = 0; k < 8; ++k) { auto t = __builtin_amdgcn_permlane32_swap(__float_as_uint(p[i][k]), __float_as_uint(p[i][k + 8]), false, false); q[k] = __uint_as_float(t[0]) + __uint_as_float(t[1]); }
#pragma unroll
            for (int k = 0; k < 4; ++k) { auto t = __builtin_amdgcn_permlane16_swap(__float_as_uint(q[k]), __float_as_uint(q[k + 4]), false, false); r[k] = __uint_as_float(t[0]) + __uint_as_float(t[1]); }
#pragma unroll
            for (int k = 0; k < 4; ++k) { r[k] = dpp_add<0xB1>(r[k]); r[k] = dpp_add<0x4E>(r[k]); r[k] = dpp_add<0x141>(r[k]); r[k] = dpp_add<0x140>(r[k]); }
            if ((lane & 15) == 0) { const int rho = lane >> 4; *(LAS f32x4*)(lgt + (wave * 16 + g * NBR + i) * 16 + 4 * (rho & 1) + 8 * (rho >> 1)) = (f32x4){r[0], r[1], r[2], r[3]}; }
        }
    }
    LDS_WAIT();
    if (lane < 16) {
        const int rl = wave * 16 + lane; float sc[16], bs[16];
#pragma unroll
        for (int e4 = 0; e4 < 4; ++e4) { const f32x4 lg = *(const LAS f32x4*)(lgt + rl * 16 + e4 * 4); const f32x4 rbv = *(const f32x4*)(INF(20) + e4 * 4);
#pragma unroll
            for (int k = 0; k < 4; ++k) { sc[e4 * 4 + k] = 1.0f / (1.0f + __expf(-lg[k])); bs[e4 * 4 + k] = sc[e4 * 4 + k] + rbv[k]; } }
        float gs[4];
#pragma unroll
        for (int g = 0; g < 4; ++g) { const float a = bs[4 * g], bq = bs[4 * g + 1], c = bs[4 * g + 2], d = bs[4 * g + 3];
            const float h1 = fmaxf(a, bq), l1 = fminf(a, bq), h2 = fmaxf(c, d), l2 = fminf(c, d); gs[g] = fmaxf(h1, h2) + fmaxf(fminf(h1, h2), fmaxf(l1, l2)); }
        int gi = 0; float best = gs[0];
#pragma unroll
        for (int g = 1; g < 4; ++g) if (gs[g] > best) { best = gs[g]; gi = g; }
        float iv[4], uv[4];
#pragma unroll
        for (int k = 0; k < 4; ++k) { iv[k] = gi == 0 ? bs[k] : (gi == 1 ? bs[4 + k] : (gi == 2 ? bs[8 + k] : bs[12 + k])); uv[k] = gi == 0 ? sc[k] : (gi == 1 ? sc[4 + k] : (gi == 2 ? sc[8 + k] : sc[12 + k])); }
        int i1 = 0; float b1 = iv[0];
#pragma unroll
        for (int k = 1; k < 4; ++k) if (iv[k] > b1) { b1 = iv[k]; i1 = k; }
        int i2 = -1; float b2 = 0.f;
#pragma unroll
        for (int k = 0; k < 4; ++k) if (k != i1 && (i2 < 0 || iv[k] > b2)) { b2 = iv[k]; i2 = k; }
        const float u1 = i1 == 0 ? uv[0] : (i1 == 1 ? uv[1] : (i1 == 2 ? uv[2] : uv[3])), u2 = i2 == 0 ? uv[0] : (i2 == 1 ? uv[1] : (i2 == 2 ? uv[2] : uv[3]));
        const float rs = 1.0f / (u1 + u2);
        rec_e[rl * 2] = gi * 4 + i1; rec_e[rl * 2 + 1] = gi * 4 + i2; rec_w[rl * 2] = u1 * rs; rec_w[rl * 2 + 1] = u2 * rs;
    }
    __syncthreads();
    if (tid < 128) { rec_p[tid * 2] = atomicAdd((int*)&lcnt[rec_e[tid * 2]], 1); rec_p[tid * 2 + 1] = atomicAdd((int*)&lcnt[rec_e[tid * 2 + 1]], 1); }
    __syncthreads();
    if (tid < 16) gbase[tid] = (int)__hip_atomic_fetch_add(CTLP + CW_CNT + 64 * l + tid, (unsigned)lcnt[tid], __ATOMIC_RELAXED, __HIP_MEMORY_SCOPE_AGENT);
    __syncthreads();
    if (tid < 128) { const int tok = vcu * 128 + tid, e0 = rec_e[tid * 2], e1 = rec_e[tid * 2 + 1], p0 = gbase[e0] + rec_p[tid * 2], p1 = gbase[e1] + rec_p[tid * 2 + 1];
        int* idx = WSP(int, WS_IDX); idx[e0 * NTOK + p0] = tok; idx[e1 * NTOK + p1] = tok;
        *(u32x4*)(WSP(unsigned, WS_ROUTE) + (size_t)tok * 4) = (u32x4){(unsigned)(e0 << 15 | p0), (unsigned)(e1 << 15 | p1), __float_as_uint(rec_w[tid * 2]), __float_as_uint(rec_w[tid * 2 + 1])}; }
    __syncthreads();
}
__device__ __forceinline__ void phase_prefix(Ctx& C) {
    PHASE_ENTRY(); const int g = vcu * NTHREADS + tid, dkv = g & 31, v = (g >> 5) & 511, bh = g >> 14, h = bh & 3;
    const float gam = __builtin_amdgcn_exp2f(log2_gamma(h)), gam256 = __builtin_amdgcn_exp2f(256.0f * log2_gamma(h));
    bf16_t* p = WSP(bf16_t, WS_B2T) + (size_t)bh * 32 * 262144 + (size_t)v * 512 + dkv * 8;
    float s[8];
#pragma unroll
    for (int k = 0; k < 8; ++k) s[k] = 0.f;
    for (int c0 = 0; c0 < 32; c0 += 4) {
        u32x4 kv[4];
#pragma unroll
        for (int i = 0; i < 4; ++i) kv[i] = *(const u32x4*)(p + (size_t)(c0 + i) * 262144);
#pragma unroll
        for (int i = 0; i < 4; ++i) {
            u32x4 o; o.x = cvt_pk_bf16(s[0] * gam, s[1] * gam); o.y = cvt_pk_bf16(s[2] * gam, s[3] * gam); o.z = cvt_pk_bf16(s[4] * gam, s[5] * gam); o.w = cvt_pk_bf16(s[6] * gam, s[7] * gam);
            *(u32x4*)(p + (size_t)(c0 + i) * 262144) = o;
            s[0] = s[0] * gam256 + bflo(kv[i].x); s[1] = s[1] * gam256 + bfhi(kv[i].x); s[2] = s[2] * gam256 + bflo(kv[i].y); s[3] = s[3] * gam256 + bfhi(kv[i].y);
            s[4] = s[4] * gam256 + bflo(kv[i].z); s[5] = s[5] * gam256 + bfhi(kv[i].z); s[6] = s[6] * gam256 + bflo(kv[i].w); s[7] = s[7] * gam256 + bfhi(kv[i].w); }
    }
}
__device__ __forceinline__ void phase_kvfin(Ctx& C) {
    PHASE_ENTRY(); const float* akv = WSP(float, WS_AKV); bf16_t* kpp = WSP(bf16_t, WS_KP); const int* posp = INI(2); const float g0 = INF(13)[2 * lane], g1 = INF(13)[2 * lane + 1];
    const float inv = __builtin_amdgcn_exp2f(-(float)(lane & 31) * (LOG2_THETA / 32.0f));
    for (int rr = 0; rr < 16; ++rr) {
        const int tok = vcu * 128 + wave * 16 + rr; const float* a = akv + (size_t)tok * 256; bf16_t* kp = kpp + (size_t)tok * QKD;
        const f32x2 cv = *(const f32x2*)(a + 2 * lane); const float rstd = __builtin_amdgcn_rsqf(wave_sum(cv[0] * cv[0] + cv[1] * cv[1]) * (1.0f / 128.0f) + EPS);
        *(unsigned*)(kp + 2 * lane) = cvt_pk_bf16(cv[0] * rstd * g0, cv[1] * rstd * g1);
        const float x1 = a[128 + (lane & 31)], x2 = a[160 + (lane & 31)]; float s, c; sincos_rad((float)posp[tok] * inv, s, c);
        const float o = lane < 32 ? x1 * c - x2 * s : x1 * s + x2 * c;
        kp[128 + lane] = (bf16_t)(cvt_pk_bf16(o, 0.f) & 0xffffu);
    }
}
namespace att {
constexpr int SHM_V = 16384, SHM_K = 24576, OFF_V = 0, OFF_K = 2 * SHM_V, OFF_WS = OFF_K + 2 * SHM_K, OFF_Q = OFF_WS + 2048;
constexpr float THR = 8.0f;
#define KSWZ(row, colB) ((row) * 384 + ((colB) ^ ((((row) >> 1) & 7) << 4)))
#define SBAR() __builtin_amdgcn_sched_barrier(0)
__device__ __forceinline__ int crow(int r, int hi) { return (r & 3) + 8 * (r >> 2) + 4 * hi; }
__device__ __forceinline__ void partialSM(f32x16& p0, f32x16& p1, float& m_reg, float& mn, float& alpha) {
    float pmax = p0[0];
#pragma unroll
    for (int r = 1; r < 16; ++r) pmax = fmaxf(pmax, p0[r]);
#pragma unroll
    for (int r = 0; r < 16; ++r) pmax = fmaxf(pmax, p1[r]);
    { auto rr = __builtin_amdgcn_permlane32_swap(__float_as_uint(pmax), __float_as_uint(pmax), false, false); pmax = fmaxf(__uint_as_float(rr[0]), __uint_as_float(rr[1])); }
    if (__builtin_expect(__all(pmax - m_reg <= THR), 1)) { mn = m_reg; alpha = 1.f; }
    else { mn = fmaxf(m_reg, pmax); alpha = __builtin_amdgcn_exp2f(m_reg - mn); m_reg = mn; }
#pragma unroll
    for (int r = 0; r < 16; ++r) p0[r] = p0[r] - mn;
#pragma unroll
    for (int r = 0; r < 16; ++r) p1[r] = p1[r] - mn;
#pragma unroll
    for (int r = 0; r < 16; ++r) p0[r] = __builtin_amdgcn_exp2f(p0[r]);
}
__device__ __forceinline__ void finishSM(f32x16& p0, f32x16& p1, float alpha, float& l_reg, bf16x8& pa0, bf16x8& pa1, bf16x8& pa2, bf16x8& pa3) {
#pragma unroll
    for (int r = 0; r < 16; ++r) p1[r] = __builtin_amdgcn_exp2f(p1[r]);
    float ps = 0;
#pragma unroll
    for (int r = 0; r < 16; ++r) ps += p0[r];
#pragma unroll
    for (int r = 0; r < 16; ++r) ps += p1[r];
    { auto rr = __builtin_amdgcn_permlane32_swap(__float_as_uint(ps), __float_as_uint(ps), false, false); ps = __uint_as_float(rr[0]) + __uint_as_float(rr[1]); }
    l_reg = l_reg * alpha + ps;
#define PK4(P, BASE, OUT) do { unsigned a0 = cvt_pk_bf16(P[BASE + 0], P[BASE + 1]), a1 = cvt_pk_bf16(P[BASE + 2], P[BASE + 3]);   \
    unsigned b0 = cvt_pk_bf16(P[BASE + 4], P[BASE + 5]), b1 = cvt_pk_bf16(P[BASE + 6], P[BASE + 7]);                              \
    auto r0 = __builtin_amdgcn_permlane32_swap(a0, b0, false, false); auto r1 = __builtin_amdgcn_permlane32_swap(a1, b1, false, false); \
    u32x4 w = {r0[0], r1[0], r0[1], r1[1]}; OUT = *reinterpret_cast<bf16x8*>(&w); } while (0)
    PK4(p0, 0, pa0); PK4(p0, 8, pa1); PK4(p1, 0, pa2); PK4(p1, 8, pa3);
#undef PK4
}
template <int BUF> __device__ __forceinline__ void qkt(f32x16& p0, f32x16& p1, const LAS char* const (&kb4)[4], const bf16x8* qr, const LAS char* ql) {
    p0 = f32x16{}; p1 = f32x16{};
#pragma unroll
    for (int d0 = 0; d0 < 12; ++d0) {
        const bf16x8 b0 = *reinterpret_cast<const LAS bf16x8*>(kb4[d0 & 3] + BUF * SHM_K + (d0 >> 2) * 128);
        const bf16x8 b1 = *reinterpret_cast<const LAS bf16x8*>(kb4[d0 & 3] + BUF * SHM_K + (d0 >> 2) * 128 + 32 * 384);
        const bf16x8 qf = d0 < 8 ? qr[d0 < 8 ? d0 : 0] : *reinterpret_cast<const LAS bf16x8*>(ql + (d0 - 8) * 1024);
        p0 = __builtin_amdgcn_mfma_f32_32x32x16_bf16(b0, qf, p0, 0, 0, 0);
        p1 = __builtin_amdgcn_mfma_f32_32x32x16_bf16(b1, qf, p1, 0, 0, 0); }
}
__device__ __forceinline__ int v_st(int k, int c) { const int kk = (k & ~0xC) | ((k & 4) << 1) | ((k & 8) >> 1); return ((kk >> 3) * 4 + (c >> 5)) * 512 + ((kk & 7) * 32 + (c & 31)) * 2; }
__device__ __forceinline__ int v_rd_base(int lane) { return ((lane & 3) << 3) | (((lane >> 2) & 3) << 6) | (((lane >> 4) & 1) << 5) | (((lane >> 5) & 1) << 8); }
constexpr int v_rd_off(int d0, int ks, int half) { return d0 * 512 + ks * 4096 + half * 2048; }
template <int OFF> __device__ __forceinline__ s16x4 tr_read(int vb) { s16x4 r; asm volatile("ds_read_b64_tr_b16 %0, %1 offset:%2" : "=&v"(r) : "v"(vb), "i"(OFF) : "memory"); return r; }
template <int D0> __device__ __forceinline__ void pv_one(f32x16& od, int vb, bf16x8 pa0, bf16x8 pa1, bf16x8 pa2, bf16x8 pa3) {
    const s16x4 l0 = tr_read<v_rd_off(D0, 0, 0)>(vb), h0 = tr_read<v_rd_off(D0, 0, 1)>(vb), l1 = tr_read<v_rd_off(D0, 1, 0)>(vb), h1 = tr_read<v_rd_off(D0, 1, 1)>(vb);
    const s16x4 l2 = tr_read<v_rd_off(D0, 2, 0)>(vb), h2 = tr_read<v_rd_off(D0, 2, 1)>(vb), l3 = tr_read<v_rd_off(D0, 3, 0)>(vb), h3 = tr_read<v_rd_off(D0, 3, 1)>(vb);
    asm volatile("s_waitcnt lgkmcnt(0)" ::: "memory"); SBAR();
#define PK(L, H) (bf16x8){L[0], L[1], L[2], L[3], H[0], H[1], H[2], H[3]}
    od = __builtin_amdgcn_mfma_f32_32x32x16_bf16(pa0, PK(l0, h0), od, 0, 0, 0);
    od = __builtin_amdgcn_mfma_f32_32x32x16_bf16(pa1, PK(l1, h1), od, 0, 0, 0);
    od = __builtin_amdgcn_mfma_f32_32x32x16_bf16(pa2, PK(l2, h2), od, 0, 0, 0);
    od = __builtin_amdgcn_mfma_f32_32x32x16_bf16(pa3, PK(l3, h3), od, 0, 0, 0);
#undef PK
}
__device__ __forceinline__ void pv_d0(f32x16* o, int vb, bf16x8 pa0, bf16x8 pa1, bf16x8 pa2, bf16x8 pa3) {
    pv_one<0>(o[0], vb, pa0, pa1, pa2, pa3); pv_one<1>(o[1], vb, pa0, pa1, pa2, pa3); pv_one<2>(o[2], vb, pa0, pa1, pa2, pa3); pv_one<3>(o[3], vb, pa0, pa1, pa2, pa3);
}
template <bool O8> __device__ __forceinline__ void attn_unit(const bf16_t* __restrict__ Q, const bf16_t* __restrict__ Kp, bf16_t* __restrict__ O, int t0, int kbase, int nt_real, LAS char* lds, int wid) {
    int lane_ = (int)__builtin_amdgcn_mbcnt_hi(~0u, __builtin_amdgcn_mbcnt_lo(~0u, 0u)); asm volatile("" : "+v"(lane_));
    const int lane = lane_, tid = wid * 64 + lane, r32 = lane & 31, hi = lane >> 5;
    LAS char* V_lds = lds + OFF_V; LAS char* K_lds = lds + OFF_K;
    LAS float* ws = (LAS float*)(lds + OFF_WS) + wid * 64; LAS float* li_l = ws; LAS float* al_l = ws + 32;
    float m_reg = -1e30f, l_reg = 0; f32x16 o[4] = {}; bf16x8 qr[8];
    LAS char* qlds = lds + OFF_Q + wid * 4096 + lane * 16;
    const char* Qs = (const char*)Q + (size_t)t0 * 3072 + wid * (QKD * 2); const unsigned qlo = (unsigned)(r32 * 3072 + hi * 16);
#pragma unroll
    for (int d0 = 0; d0 < 8; ++d0) qr[d0] = *reinterpret_cast<const bf16x8*>(Qs + qlo + d0 * 32);
    __syncthreads();
#pragma unroll
    for (int d0 = 8; d0 < 12; ++d0) *reinterpret_cast<LAS bf16x8*>(qlds + (d0 - 8) * 1024) = *reinterpret_cast<const bf16x8*>(Qs + qlo + d0 * 32);
    const int vb0 = (int)(uintptr_t)V_lds + v_rd_base(lane);
    const LAS char* kb4[4];
#pragma unroll
    for (int q = 0; q < 4; ++q) kb4[q] = K_lds + r32 * 384 + ((q * 32 + hi * 16) ^ (((r32 >> 1) & 7) << 4));
    const int NT = (nt_real + 1) & ~1;
    const bool dummy = (NT != nt_real);
    bf16x8 sr_[1][3];
    const char* Kg = (const char*)(Kp + (size_t)kbase * QKD);
#define SLOAD(s, kt) do { _Pragma("unroll") for (int i = 0; i < 3; ++i) sr_[s][i] = *reinterpret_cast<const bf16x8*>(Kg + (size_t)(kt) * SHM_K + i * 8192 + (unsigned)(tid * 16)); } while (0)
#define SWRITE(b, s) do { int tl_ = (int)__builtin_amdgcn_mbcnt_hi(~0u, __builtin_amdgcn_mbcnt_lo(~0u, 0u)); asm volatile("" : "+v"(tl_)); tl_ += wid * 64; _Pragma("unroll") for (int i = 0; i < 3; ++i) { const int p_ = tl_ + 512 * i, row_ = p_ / 24, c16_ = p_ - row_ * 24; \
        *(LAS bf16x8*)(K_lds + (b) * SHM_K + KSWZ(row_, c16_ * 16)) = sr_[s][i]; if (c16_ < 16) *(LAS bf16x8*)(V_lds + (b) * SHM_V + v_st(row_, c16_ * 8)) = sr_[s][i]; } } while (0)
#define SWAIT() asm volatile("s_waitcnt vmcnt(0)" ::: "memory")
#define RESC(a) do { if (__any((a) < 1.f)) { if (hi == 0) al_l[r32] = (a); asm volatile("s_waitcnt lgkmcnt(0)" ::: "memory"); \
    _Pragma("unroll") for (int d = 0; d < 4; ++d) _Pragma("unroll") for (int r = 0; r < 16; ++r) o[d][r] *= al_l[crow(r, hi)]; } } while (0)
    f32x16 pA0, pA1, pB0, pB1; float mnA, mnB, alA, alB; bf16x8 pa0, pa1, pa2, pa3;
    SLOAD(0, 0); SWAIT(); SWRITE(0, 0); __syncthreads();
    qkt<0>(pA0, pA1, kb4, qr, qlds); partialSM(pA0, pA1, m_reg, mnA, alA);
    SLOAD(0, 1); SWAIT(); SWRITE(1, 0); __syncthreads();
    for (int j = 1; j + 1 < NT; j += 2) {
        SBAR(); qkt<1>(pB0, pB1, kb4, qr, qlds);
        finishSM(pA0, pA1, alA, l_reg, pa0, pa1, pa2, pa3); SBAR();
        SLOAD(0, j + 1); SBAR();
        pv_d0(o, vb0, pa0, pa1, pa2, pa3); partialSM(pB0, pB1, m_reg, mnB, alB);
        __syncthreads(); SWAIT(); SWRITE(0, 0);
        RESC(alB); __syncthreads();
        SBAR(); qkt<0>(pA0, pA1, kb4, qr, qlds);
        finishSM(pB0, pB1, alB, l_reg, pa0, pa1, pa2, pa3); SBAR();
        SLOAD(0, j + 2); SBAR();
        pv_d0(o, vb0 + SHM_V, pa0, pa1, pa2, pa3); partialSM(pA0, pA1, m_reg, mnA, alA);
        __syncthreads(); SWAIT(); SWRITE(1, 0);
        RESC(alA); __syncthreads();
    }
    SBAR(); qkt<1>(pB0, pB1, kb4, qr, qlds);
    if (dummy) {
#pragma unroll
        for (int r = 0; r < 16; ++r) { pB0[r] = -INFINITY; pB1[r] = -INFINITY; } }
    finishSM(pA0, pA1, alA, l_reg, pa0, pa1, pa2, pa3); SBAR();
    pv_d0(o, vb0, pa0, pa1, pa2, pa3); partialSM(pB0, pB1, m_reg, mnB, alB);
    __syncthreads(); RESC(alB);
    finishSM(pB0, pB1, alB, l_reg, pa0, pa1, pa2, pa3); SBAR();
    pv_d0(o, vb0 + SHM_V, pa0, pa1, pa2, pa3);
    {
        int lanee = (int)__builtin_amdgcn_mbcnt_hi(~0u, __builtin_amdgcn_mbcnt_lo(~0u, 0u)); asm volatile("" : "+v"(lanee));
        const int wide = wid, r32e = lanee & 31, hie = lanee >> 5;
        LAS float* lie = (LAS float*)(lds + OFF_WS) + wide * 64;
        if (hie == 0) lie[r32e] = l_reg; asm volatile("s_waitcnt lgkmcnt(0)" ::: "memory");
        char* Os = (char*)O + (size_t)t0 * (O8 ? 1024 : 2048) + wide * (O8 ? 128 : 256); const unsigned olo = (unsigned)(r32e * (O8 ? 1 : 2));
#pragma unroll
        for (int r = 0; r < 16; ++r) { const int orow = crow(r, hie); const float rl = __builtin_amdgcn_rcpf(lie[orow]);
#pragma unroll
            for (int d0 = 0; d0 < 4; ++d0) { if constexpr (O8) *(unsigned char*)(Os + olo + (unsigned)(orow * 1024) + d0 * 32) = (unsigned char)(pk4_fp8(16.0f * o[d0][r] * rl, 0.f, 0.f, 0.f) & 0xffu);
                else *(bf16_t*)(Os + olo + (unsigned)(orow * 2048) + d0 * 64) = (bf16_t)(cvt_pk_bf16(o[d0][r] * rl, 0.f) & 0xffffu); } }
    }
#undef SLOAD
#undef SWRITE
#undef SWAIT
#undef RESC
}
}
struct Args { const void* in[25]; float* out; unsigned char* ws; int lo, hi, l, hf; };
enum { PH_PRO = 0, PH_NA, PH_R2, PH_R3, PH_R4, PH_R5, PH_R6, PH_R7, PH_M2, PH_M3, PH_M4, PH_M5, PH_NB, PH_MOE1, PH_MOE2, PH_COUNT };

__device__ __forceinline__ void make_ctx(Ctx& C, unsigned char* lds_raw) {
    C.ka = (kaptr_t)__builtin_amdgcn_kernarg_segment_ptr(); C.lds = (LAS unsigned char*)lds_raw;
    C.wave = __builtin_amdgcn_readfirstlane((int)threadIdx.x >> 6);
    { const int bx = blockIdx.x; C.vcu = (bx & 7) * (GRID / 8) + (bx >> 3); }
}

template <int PH> __device__ __forceinline__ void run_phase(Ctx& C, const int l, const int hf, const int rep = 0) {
    PHASE_ENTRY(); const int wv = wave;
    LAS unsigned char* lds = ldsb; int bid_ = blockIdx.x; asm volatile("" : "+s"(bid_)); const int bid = bid_; const unsigned LD1K = 2048u;
    const float* gate1 = rep ? (const float*)(WSB + WS_CTL + 512 * 1024) : WSP(float, WS_MOD) + (size_t)l * 4 * 6144 + 2 * 1024;
    const bf16_t* win = WSP(bf16_t, WS_WIN) + (size_t)(l & 1) * 6144 * 1024;
    const bf16_t* xnh = WSP(bf16_t, WS_XN) + (size_t)hf * THALF * DM;
    const int j = l & 1;
    if constexpr (PH == PH_PRO) phase_prologue(C);
    if constexpr (PH == PH_NA) phase_norm_a(C, l, rep);
    if constexpr (PH == PH_R2) {
        constexpr bool F8 = FP8_R2 != 0; constexpr unsigned LD = F8 ? 1024u : 2048u; constexpr int KP = F8 ? 512 : 1024; constexpr int SW = F8 ? 0x79797979 : 0x7f7f7f7f, SX = F8 ? 0x7d7d7d7d : 0x7f7f7f7f;
        const char* X = F8 ? (const char*)(WSP(unsigned char, WS_XN8) + (size_t)hf * THALF * DM) : (const char*)xnh;
        const char* W = F8 ? (const char*)(WSP(unsigned char, WS_WIN8) + (size_t)(l & 1) * 6144 * 1024) : (const char*)win;
        { SchedStd S; S.T.init(64, 4, GRID, bid); S.A = X; S.B = W; S.sA = 256 * LD; S.sB = 256 * LD;
          EpiRopeQK<0> E{WSP(bf16_t, WS_A2), INI(2), hf}; pg8::gemm_phase<EpiRopeQK<0>, SchedStd, false, F8, SW, SX>(lds, wv, KP, LD, LD, S, E); }
        { SchedStd S; S.T.init(64, 4, GRID, bid); S.A = X; S.B = W + (size_t)1024 * LD; S.sA = 256 * LD; S.sB = 256 * LD;
          EpiRopeQK<1> E{WSP(bf16_t, WS_KR), INI(2), hf}; pg8::gemm_phase<EpiRopeQK<1>, SchedStd, false, F8, SW, SX>(lds, wv, KP, LD, LD, S, E); }
        { SchedStd S; S.T.init(4, 64, GRID, bid); S.A = W + (size_t)1024 * LD; S.B = X; S.sA = 256 * LD; S.sB = 256 * LD;
          EpiRopeKT E{WSP(bf16_t, WS_KT), INI(2), hf}; pg8::gemm_phase<EpiRopeKT, SchedStd, false, F8, SW, SX>(lds, wv, KP, LD, LD, S, E); }
        { SchedStd S; S.T.init(8, 64, GRID, bid); S.A = W + (size_t)2048 * LD; S.B = X; S.sA = 256 * LD; S.sB = 256 * LD;
          EpiVT E{WSP(bf16_t, WS_B2T)}; pg8::gemm_phase<EpiVT, SchedStd, false, F8, SW, SX>(lds, wv, KP, LD, LD, S, E); }
    }
    if constexpr (PH == PH_R3) {
        { SchedBatch S{(const char*)WSP(bf16_t, WS_A2), (const char*)WSP(bf16_t, WS_KR), 256 * 1024, 256 * 512, 0, 0, 256, 1, GRID, vcu};
          EpiS E{WSP(bf16_t, WS_A2)}; pg8::gemm_phase<EpiS, SchedBatch, false>(lds, wv, 256, 1024u, 512u, S, E); }
        { SchedBatch S{(const char*)(WSP(bf16_t, WS_B2T) + 256), (const char*)WSP(bf16_t, WS_KT), 512 * 1024, 256 * 512, 256 * 1024, 0, 256, 2, GRID, vcu};
          EpiKV E{WSP(bf16_t, WS_B2T)}; pg8::gemm_phase<EpiKV, SchedBatch, false>(lds, wv, 256, 1024u, 512u, S, E); }
    }
    if constexpr (PH == PH_R4) phase_prefix(C);
    if constexpr (PH == PH_R5) {
        SchedBatch S{(const char*)WSP(bf16_t, WS_A2), (const char*)WSP(bf16_t, WS_B2T), 256 * 1024, 512 * 1024, 0, 256 * 1024, 256, 2, GRID, vcu};
        EpiFin E{WSP(bf16_t, WS_B2T), WSP(float, WS_STATS)}; pg8::gemm_phase<EpiFin, SchedBatch, false>(lds, wv, 512, 1024u, 1024u, S, E);
    }
    if constexpr (PH == PH_R6) {
        constexpr bool F8 = FP8_R6 != 0; constexpr unsigned LD = F8 ? 1024u : 2048u; constexpr int KP = F8 ? 512 : 1024; constexpr int SW = F8 ? 0x79797979 : 0x7f7f7f7f, SX = F8 ? 0x7d7d7d7d : 0x7f7f7f7f;
        const char* X = F8 ? (const char*)(WSP(unsigned char, WS_XN8) + (size_t)hf * THALF * DM) : (const char*)xnh;
        const char* W = F8 ? (const char*)(WSP(unsigned char, WS_WIN8) + (size_t)(l & 1) * 6144 * 1024) : (const char*)win;
        SchedStd S; S.T.init(64, 8, GRID, bid); S.A = X; S.B = W + (size_t)4096 * LD; S.sA = 256 * LD; S.sB = 256 * LD;
        EpiGate<FP8_R7 != 0> E{WSP(bf16_t, WS_B2T), WSP(float, WS_STATS), WSP(bf16_t, WS_A2), WSP(unsigned char, WS_ACT8)}; pg8::gemm_phase<EpiGate<FP8_R7 != 0>, SchedStd, false, F8, SW, SX>(lds, wv, KP, LD, LD, S, E);
    }
    if constexpr (PH == PH_R7) {
        constexpr bool F8 = FP8_R7 != 0; constexpr unsigned LD = F8 ? 2048u : 4096u; constexpr int KP = F8 ? 1024 : 2048; constexpr int SW = F8 ? 0x79797979 : 0x7f7f7f7f, SX = F8 ? 0x7d7d7d7d : 0x7f7f7f7f;
        SchedStd S; S.T.init(64, 4, GRID, bid); S.A = F8 ? (const char*)WSP(unsigned char, WS_ACT8) : (const char*)WSP(bf16_t, WS_A2);
        S.B = F8 ? (const char*)(WSP(unsigned char, WS_WOUT8) + (size_t)l * 1024 * 2048) : (const char*)(WSP(bf16_t, WS_WOUT) + (size_t)l * 1024 * 2048); S.sA = 256 * LD; S.sB = 256 * LD;
        EpiResid E{OUTP, gate1, hf * THALF}; pg8::gemm_phase<EpiResid, SchedStd, false, F8, SW, SX>(lds, wv, KP, LD, LD, S, E);
    }
    if constexpr (PH == PH_M2) {
        { constexpr bool F8 = FP8_M2 != 0; constexpr unsigned LD = F8 ? 1024u : 2048u; constexpr int KP = F8 ? 512 : 1024; constexpr int SW = F8 ? 0x79797979 : 0x7f7f7f7f, SX = F8 ? 0x7d7d7d7d : 0x7f7f7f7f;
          SchedStd S; S.T.init(128, 1, GRID, bid); S.A = F8 ? (const char*)WSP(unsigned char, WS_XN8) : (const char*)WSP(bf16_t, WS_XN);
          S.B = F8 ? (const char*)(WSP(unsigned char, WS_WQA8) + (size_t)j * 256 * 1024) : (const char*)(WSP(bf16_t, WS_WQA) + (size_t)j * 256 * 1024); S.sA = 256 * LD; S.sB = 256 * LD;
          EpiQA E{WSP(bf16_t, WS_QA), WSP(float, WS_SSQ)}; pg8::gemm_phase<EpiQA, SchedStd, false, F8, SW, SX>(lds, wv, KP, LD, LD, S, E); }
        if (l == 2) { SchedStd S; S.T.init(128, 1, GRID, (bid + 128) & 255); S.A = (const char*)WSP(bf16_t, WS_HN); S.B = (const char*)WSP(bf16_t, WS_WKVA); S.sA = 256 * 2048; S.sB = 256 * 2048;
          EpiF32 E{WSP(float, WS_AKV)}; pg8::gemm_phase<EpiF32, SchedStd, false>(lds, wv, 1024, LD1K, LD1K, S, E); }
    }
    if constexpr (PH == PH_M3) {
        if (l == 2) phase_kvfin(C);
        SchedStd S; S.T.init(128, 6, GRID, bid); S.A = (const char*)WSP(bf16_t, WS_QA); S.B = (const char*)(WSP(bf16_t, WS_WQB) + (size_t)j * 1536 * 256); S.sA = 256 * 512; S.sB = 256 * 512;
        EpiQB E{WSP(bf16_t, WS_Q), WSP(float, WS_SSQ), INI(2)}; pg8::gemm_phase<EpiQB, SchedStd, false>(lds, wv, 256, 512u, 512u, S, E);
    }
    if constexpr (PH == PH_M4) {
        const int b = vcu >> 6, i = vcu & 63;
#pragma unroll 1
        for (int uq = 0; uq < 4; ++uq) { const int cch = (uq < 2) ? (127 - i) : i, half = uq & 1;
            att::attn_unit<FP8_M5 != 0>(WSP(bf16_t, WS_Q), WSP(bf16_t, WS_KP), FP8_M5 ? (bf16_t*)WSP(unsigned char, WS_ACT8) : WSP(bf16_t, WS_OL), b * SEQ + cch * 64 + half * 32, b * SEQ, cch + 1, (LAS char*)lds, wave); }
        __syncthreads();
    }
    if constexpr (PH == PH_M5) {
        constexpr bool F8 = FP8_M5 != 0; constexpr unsigned LD = F8 ? 1024u : 2048u; constexpr int KP = F8 ? 512 : 1024; constexpr int SW = F8 ? 0x79797979 : 0x7f7f7f7f, SX = F8 ? 0x7b7b7b7b : 0x7f7f7f7f;
        SchedStd S; S.T.init(128, 4, GRID, bid); S.A = F8 ? (const char*)WSP(unsigned char, WS_ACT8) : (const char*)WSP(bf16_t, WS_OL);
        S.B = F8 ? (const char*)(WSP(unsigned char, WS_WO8) + (size_t)j * 1024 * 1024) : (const char*)(WSP(bf16_t, WS_WO) + (size_t)j * 1024 * 1024); S.sA = 256 * LD; S.sB = 256 * LD;
        EpiResid E{OUTP, gate1, 0}; pg8::gemm_phase<EpiResid, SchedStd, false, F8, SW, SX>(lds, wv, KP, LD, LD, S, E);
    }
    if constexpr (PH == PH_NB) phase_norm_b(C, l);
    if constexpr (PH == PH_MOE1) {
        moe_tile_prefix(C, l);
        SchedMoE S{(const LAS int*)(lds + LDS_TAB), (const char*)WSP(unsigned char, WS_XN), (const char*)(WSP(unsigned char, WS_WGU) + (size_t)l * 16 * 1024 * 1024), (size_t)1024 * 1024, (size_t)256 * 1024, 0, WSP(int, WS_IDX), GRID, vcu, true};
        EpiGU8 E{WSP(unsigned char, WS_HDN)}; pg8::gemm_phase<EpiGU8, SchedMoE, true, true, 0x79797979, 0x7d7d7d7d>(lds, wv, 512, 1024u, 1024u, S, E);
    }
    if constexpr (PH == PH_MOE2) {
        moe_tile_prefix(C, l);
        SchedMoE S{(const LAS int*)(lds + LDS_TAB), (const char*)WSP(unsigned char, WS_HDN), (const char*)(WSP(unsigned char, WS_WDN) + (size_t)l * 16 * 1024 * 512), (size_t)1024 * 512, (size_t)256 * 512, (size_t)256 * 512, WSP(int, WS_IDX), GRID, vcu, false};
        EpiPlain E{WSP(bf16_t, WS_YB), 1024}; pg8::gemm_phase<EpiPlain, SchedMoE, false, true, 0x79797979, 0x7d7d7d7d>(lds, wv, 256, 512u, 512u, S, E);
    }
}

template <int PH> __global__ void __launch_bounds__(NTHREADS, 2) phase_kernel(Args args) {
    extern __shared__ __attribute__((aligned(16))) unsigned char lds_raw[];
    Ctx C; make_ctx(C, lds_raw); (void)args;
    run_phase<PH>(C, args.l, args.hf);
}
__global__ void __launch_bounds__(NTHREADS, 2) fwd_kernel(Args args) {
    extern __shared__ __attribute__((aligned(16))) unsigned char lds_raw[];
    Ctx C; make_ctx(C, lds_raw); (void)args;
    if (threadIdx.x < 64) ((LAS unsigned*)(C.lds + LDS_MISC))[threadIdx.x] = 0u;
    __syncthreads();
    XcdBarrier bar = xcd_barrier_post((unsigned*)((unsigned char*)args.ws + WS_CTL) + CW_BAR, (volatile LAS unsigned*)(C.lds + LDS_MISC));
#define SEAM() xcd_barrier(bar, C.wave)
#ifndef PROBE_PH
#define PROBE_PH -1
#define PROBE_N 0
#endif
#define RUNP(PH, l, hf) do { run_phase<PH>(C, l, hf); SEAM(); if constexpr (PH == PROBE_PH) { _Pragma("unroll 1") for (int rp_ = 0; rp_ < PROBE_N; ++rp_) { run_phase<PH>(C, l, hf, 1); SEAM(); } } } while (0)
    RUNP(PH_PRO, 0, 0);
    for (int l = 0; l < 4; ++l) {
        RUNP(PH_NA, l, 0);
        if (l < 2) {
            for (int hf = 0; hf < 2; ++hf) { RUNP(PH_R2, l, hf); RUNP(PH_R3, l, hf); RUNP(PH_R4, l, hf); RUNP(PH_R5, l, hf); RUNP(PH_R6, l, hf); RUNP(PH_R7, l, hf); }
        } else { RUNP(PH_M2, l, 0); RUNP(PH_M3, l, 0); RUNP(PH_M4, l, 0); RUNP(PH_M5, l, 0); }
        RUNP(PH_NB, l, 0); RUNP(PH_MOE1, l, 0); RUNP(PH_MOE2, l, 0);
    }
    run_phase<PH_NA>(C, 4, 0);
#undef RUNP
#undef SEAM
}

template <int PH> static void launch_phase(Args& a, int l, int hf, hipStream_t stream) {
    static bool attr = false;
    if (!attr) { (void)hipFuncSetAttribute((const void*)phase_kernel<PH>, hipFuncAttributeMaxDynamicSharedMemorySize, LDS_BYTES); attr = true; }
    a.l = l; a.hf = hf;
    hipLaunchKernelGGL(phase_kernel<PH>, dim3(GRID), dim3(NTHREADS), LDS_BYTES, stream, a);
}
extern "C" void kernel_launch(void* const* d_in, const int* in_sizes, int n_in, void* d_out, int out_size, void* d_ws, size_t ws_size, hipStream_t stream) {
    static int ok = 0;
    if (ok == 0) {
        if (n_in != 25 || out_size != NTOK * DM || ws_size < WS_END) { fprintf(stderr, "kernel_launch: unexpected problem (n_in %d, out %d, ws %zu < %zu)\n", n_in, out_size, ws_size, (size_t)WS_END); ok = -1; return; }
        int dev = 0, cus = 0;
        if (hipGetDevice(&dev) != hipSuccess || hipDeviceGetAttribute(&cus, hipDeviceAttributeMultiprocessorCount, dev) != hipSuccess || cus < GRID) { fprintf(stderr, "kernel_launch: needs %d CUs, device has %d\n", GRID, cus); ok = -1; return; }
        ok = 1;
    }
    if (ok < 0) return;
    (void)hipMemsetAsync((char*)d_ws + WS_CTL, 0, CTL_BYTES, stream);
    Args a{};
    for (int i = 0; i < 25; ++i) a.in[i] = d_in[i];
    a.out = (float*)d_out; a.ws = (unsigned char*)d_ws; a.lo = 0; a.hi = 0;
#if MK_SINGLE
    static bool attr = false;
    if (!attr) { (void)hipFuncSetAttribute((const void*)fwd_kernel, hipFuncAttributeMaxDynamicSharedMemorySize, LDS_BYTES); attr = true; }
    hipLaunchKernelGGL(fwd_kernel, dim3(GRID), dim3(NTHREADS), LDS_BYTES, stream, a);
    return;
#endif
    launch_phase<PH_PRO>(a, 0, 0, stream);
    for (int l = 0; l < 4; ++l) {
        launch_phase<PH_NA>(a, l, 0, stream);
        if (l < 2) {
            for (int hf = 0; hf < 2; ++hf) {
                launch_phase<PH_R2>(a, l, hf, stream); launch_phase<PH_R3>(a, l, hf, stream); launch_phase<PH_R4>(a, l, hf, stream);
                launch_phase<PH_R5>(a, l, hf, stream); launch_phase<PH_R6>(a, l, hf, stream); launch_phase<PH_R7>(a, l, hf, stream);
            }
        } else {
            launch_phase<PH_M2>(a, l, 0, stream); launch_phase<PH_M3>(a, l, 0, stream); launch_phase<PH_M4>(a, l, 0, stream); launch_phase<PH_M5>(a, l, 0, stream);
        }
        launch_phase<PH_NB>(a, l, 0, stream); launch_phase<PH_MOE1>(a, l, 0, stream); launch_phase<PH_MOE2>(a, l, 0, stream);
    }
    launch_phase<PH_NA>(a, 4, 0, stream);
}
```

```cpp
#include <hip/hip_runtime.h>
#include <cstdio>
#include <cstdint>

#ifndef MK_SINGLE
#define MK_SINGLE 1
#endif
#ifndef FP8_R2
#define FP8_R2 0
#define FP8_R6 1
#define FP8_R7 1
#define FP8_M2 0
#define FP8_M5 1
#endif
#ifndef MK_CHECK
#define MK_CHECK 0
#endif

#define GAS __attribute__((address_space(1)))
#define LAS __attribute__((address_space(3)))
typedef unsigned short bf16_t;
typedef short bf16x8 __attribute__((ext_vector_type(8)));
typedef short s16x4 __attribute__((ext_vector_type(4)));
typedef float f32x4 __attribute__((ext_vector_type(4)));
typedef float f32x2 __attribute__((ext_vector_type(2)));
typedef float f32x16 __attribute__((ext_vector_type(16)));
typedef unsigned u32x4 __attribute__((ext_vector_type(4)));
typedef unsigned u32x2 __attribute__((ext_vector_type(2)));

constexpr int NB = 4, SEQ = 8192, DM = 1024, NTOK = NB * SEQ, THALF = NTOK / 2;
constexpr int NEXP = 16, DEXP = 512;
constexpr int RH = 4, RDK = 256, RDV = 512, RV = 2048;
constexpr int MH = 8, QLORA = 256, KVL = 128, ROPE = 64, QKD = 192;
constexpr float EPS = 1e-6f;
constexpr int NWAVES = 8, NTHREADS = 512, GRID = 256;
constexpr int MAXSLOTS = 69632;

constexpr size_t MiB = 1u << 20;
constexpr size_t WS_CTL = 0, CTL_BYTES = 1 * MiB;
constexpr size_t WS_MOD = 1 * MiB;
constexpr size_t WS_ROUTE = 2 * MiB;
constexpr size_t WS_SSQ = 3 * MiB;
constexpr size_t WS_STATS = 4 * MiB;
constexpr size_t WS_IDX = 8 * MiB;
constexpr size_t WS_WIN = 10 * MiB;
constexpr size_t WS_WOUT = 34 * MiB;
constexpr size_t WS_WQA = 42 * MiB;
constexpr size_t WS_WKVA = 43 * MiB;
constexpr size_t WS_WQB = 44 * MiB;
constexpr size_t WS_WO = 46 * MiB;
constexpr size_t WS_WGU = 50 * MiB;
constexpr size_t WS_WDN = 178 * MiB;
constexpr size_t WS_XN = 242 * MiB;
constexpr size_t WS_L = 306 * MiB;
constexpr size_t WS_END = 690 * MiB;
constexpr size_t WS_A2 = WS_L, WS_KR = WS_L + 64 * MiB, WS_KT = WS_L + 96 * MiB, WS_B2T = WS_L + 128 * MiB;
constexpr size_t WS_HDN = WS_L, WS_YB = WS_L + 68 * MiB;
constexpr size_t WS_HN = WS_L, WS_QA = WS_L + 64 * MiB, WS_AKV = WS_L + 80 * MiB, WS_Q = WS_L + 112 * MiB, WS_OL = WS_L + 208 * MiB, WS_KP = WS_L + 300 * MiB;
constexpr size_t WS_XN8 = 114 * MiB;
constexpr size_t WS_WIN8 = 146 * MiB;
constexpr size_t WS_WOUT8 = 158 * MiB;
constexpr size_t WS_WQA8 = 162 * MiB;
constexpr size_t WS_WO8 = 163 * MiB;
constexpr size_t WS_ACT8 = 210 * MiB;
constexpr int CW_BAR = 4096;
constexpr int CW_CNT = 16384;
constexpr int CW_CHK = 32768;

constexpr int LDS_STAGE = 131072;
constexpr int LDS_MISC = LDS_STAGE;
constexpr int LDS_TAB = LDS_STAGE + 256;
constexpr int LDS_BYTES = 147456;

#define LDS_WAIT() asm volatile("s_waitcnt lgkmcnt(0)" ::: "memory")
#define VM_WAIT() asm volatile("s_waitcnt vmcnt(0)" ::: "memory")
__device__ __forceinline__ unsigned cvt_pk_bf16(float lo, float hi) { unsigned r; asm volatile("v_cvt_pk_bf16_f32 %0, %1, %2" : "=v"(r) : "v"(lo), "v"(hi)); return r; }
__device__ __forceinline__ unsigned pk4_fp8(float a, float b, float c2, float d) { int w = __builtin_amdgcn_cvt_pk_fp8_f32(a, b, 0, false); return (unsigned)__builtin_amdgcn_cvt_pk_fp8_f32(c2, d, w, true); }
__device__ __forceinline__ float bf2f(unsigned short b) { return __uint_as_float((unsigned)b << 16); }
__device__ __forceinline__ float bflo(unsigned w) { return __uint_as_float(w << 16); }
__device__ __forceinline__ float bfhi(unsigned w) { return __uint_as_float(w & 0xffff0000u); }
template <int CTRL> __device__ __forceinline__ float dpp_f(float v) { return __int_as_float(__builtin_amdgcn_mov_dpp(__float_as_int(v), CTRL, 0xf, 0xf, true)); }
__device__ __forceinline__ float rows_sum(float v) {
    { auto t = __builtin_amdgcn_permlane16_swap(__float_as_uint(v), __float_as_uint(v), false, false); v = __uint_as_float(t[0]) + __uint_as_float(t[1]); }
    { auto t = __builtin_amdgcn_permlane32_swap(__float_as_uint(v), __float_as_uint(v), false, false); v = __uint_as_float(t[0]) + __uint_as_float(t[1]); }
    return v;
}
__device__ __forceinline__ float wave_sum(float v) {
    v += dpp_f<0xB1>(v);
    v += dpp_f<0x4E>(v);
    v += dpp_f<0x141>(v);
    v += dpp_f<0x140>(v);
    return rows_sum(v);
}
__device__ __forceinline__ void sincos_rad(float ang, float& s, float& c) {
    float r = __builtin_amdgcn_fractf(ang * 0.15915494309189535f);
    s = __builtin_amdgcn_sinf(r); c = __builtin_amdgcn_cosf(r);
}
__device__ __forceinline__ float silu_f(float x) { return x / (1.0f + __expf(-x)); }
__device__ __forceinline__ float log2_gamma(int h) { return h == 0 ? -0.04580368961312479f : (h == 1 ? -0.02272007650008353f : (h == 2 ? -0.011315313227834146f : -0.005646563141142063f)); }
constexpr float LOG2_THETA = 13.287712379549449f;

__device__ __forceinline__ int lane_id() { return (int)__builtin_amdgcn_mbcnt_hi(~0u, __builtin_amdgcn_mbcnt_lo(~0u, 0u)); }
#define XB_TMO      128
#define XB_XCNT(j)  (256  + 64 * (j))
#define XB_XSUB(j)  (1280 + 64 * (j))
#define XB_XGEN(j)  (2304 + 64 * (j))
#define XB_TOP      3328
#define XB_TOPGEN   3392
#define XCD_BAR_WORDS 3456
#define XB_SPIN_CAP (1u << 18)
__device__ __forceinline__ unsigned xb_ld(unsigned* p)              { return __hip_atomic_load(p, __ATOMIC_RELAXED, __HIP_MEMORY_SCOPE_AGENT); }
__device__ __forceinline__ unsigned xb_add(unsigned* p, unsigned v) { return __hip_atomic_fetch_add(p, v, __ATOMIC_RELAXED, __HIP_MEMORY_SCOPE_AGENT); }
__device__ __forceinline__ unsigned xb_xcc_id() { return (unsigned)__builtin_amdgcn_s_getreg((3 << 11) | 20) & 0xFu; }
#define XB_SPIN(cond, bar) do { unsigned _sp = 0; while (cond) { __builtin_amdgcn_s_sleep(1); \
    if ((++_sp & 255u) == 0u) { if (xb_ld(&(bar)[XB_TMO])) break; if (_sp > XB_SPIN_CAP) { atomicAdd(&(bar)[XB_TMO], 1u); break; } } } } while (0)
struct XcdBarrier { unsigned* bar; unsigned x; volatile LAS unsigned* st; };
__device__ __forceinline__ XcdBarrier xcd_barrier_post(unsigned* bar, volatile LAS unsigned* st) {
    XcdBarrier b; b.bar = bar; b.x = xb_xcc_id(); b.st = st;
    if (threadIdx.x == 0) (void)xb_add(&bar[XB_XCNT(b.x)], 1u);
    return b;
}
__device__ __forceinline__ void xcd_barrier_complete(unsigned* bar, unsigned x, unsigned& nloc, unsigned& nx) {
    const unsigned G = gridDim.x * gridDim.y * gridDim.z;
    unsigned sum, cnt, mine, sp = 0u;
    for (;;) {
        sum = 0u; cnt = 0u; mine = 0u;
#pragma unroll
        for (unsigned j = 0; j < 16; ++j) { const unsigned c = xb_ld(&bar[XB_XCNT(j)]); sum += c; cnt += (c > 0u) ? 1u : 0u; mine = (j == x) ? c : mine; }
        if (sum == G) break;
        __builtin_amdgcn_s_sleep(1);
        if ((++sp & 255u) == 0u) { if (xb_ld(&bar[XB_TMO])) break; if (sp > XB_SPIN_CAP) { atomicAdd(&bar[XB_TMO], 1u); break; } }
    }
    nloc = mine > 0u ? mine : 1u; nx = cnt > 0u ? cnt : 1u;
}
__device__ __forceinline__ void xcd_barrier(const XcdBarrier& b, const int wave) {
    asm volatile("s_waitcnt vmcnt(0)" ::: "memory");
    __syncthreads();
    if (wave == 0 && lane_id() == 0) {
        unsigned* bar = b.bar; unsigned bx = b.x; asm volatile("" : "+s"(bar), "+s"(bx));
        __builtin_amdgcn_s_waitcnt(0);
        unsigned nloc = b.st[0], nx = b.st[1];
        if (nloc == 0u) { xcd_barrier_complete(bar, bx, nloc, nx); b.st[0] = nloc; b.st[1] = nx; }
        const unsigned old = xb_add(&bar[XB_XSUB(bx)], 1u);
        const unsigned gen = old / nloc;
        if (old + 1u == (gen + 1u) * nloc) {
            __builtin_amdgcn_fence(__ATOMIC_RELEASE, "agent");
            asm volatile("s_waitcnt vmcnt(0)" ::: "memory");
            const unsigned og = xb_add(&bar[XB_TOP], 1u);
            const unsigned tg = og / nx;
            if (og + 1u == (tg + 1u) * nx) xb_add(&bar[XB_TOPGEN], 1u);
            else XB_SPIN(xb_ld(&bar[XB_TOPGEN]) == tg, bar);
            __builtin_amdgcn_fence(__ATOMIC_ACQUIRE, "agent");
            xb_add(&bar[XB_XGEN(bx)], 1u);
            asm volatile("s_waitcnt vmcnt(0)" ::: "memory");
        } else {
            XB_SPIN(xb_ld(&bar[XB_XGEN(bx)]) == gen, bar);
            __builtin_amdgcn_fence(__ATOMIC_ACQUIRE, "agent");
            asm volatile("s_waitcnt vmcnt(0)" ::: "memory");
        }
    }
    __syncthreads();
}

namespace pg8 {
constexpr int BM = 256, BK = 64, HALF = 128, HTB = HALF * BK * 2, STAGE_BYTES = 8 * HTB;
__host__ __device__ __forceinline__ int lds_byte(int r, int c) { const int st = (r >> 4) * 2 + (c >> 5), rr = r & 15, cc = c & 31, ob = rr * 64 + cc * 2; return st * 1024 + (ob ^ (((ob >> 9) & 1) << 5)); }
__host__ __device__ __forceinline__ void stage_rc(int b, int& R, int& C) { const int st = b / 1024, sb = b % 1024, swz = sb ^ (((sb >> 9) & 1) << 5); R = (st >> 1) * 16 + swz / 64; C = (st & 1) * 32 + (swz % 64) / 2; }
__host__ __device__ __forceinline__ int perm32(int rho) { const int n = rho >> 4, i = rho & 15; return 8 * (i >> 2) + 4 * n + (i & 3); }

struct Unit { const char* A; const char* B; int pm, pn, aux; };

struct TileOrder {
    int nM, nN, nwg, G, c;
    __device__ void init(int nM_, int nN_, int G_, int c_) { nM = nM_; nN = nN_; nwg = nM * nN; G = G_; c = c_; }
    __device__ bool tile(int i, int& pm, int& pn) const {
        const long L = (long)i * G + c; if (L >= nwg) return false;
        int wgid = (int)L; { const int q = nwg / 8, r = nwg % 8, xcd = wgid % 8, off = wgid / 8; wgid = (xcd < r ? xcd * (q + 1) : r * (q + 1) + (xcd - r) * q) + off; }
        const int nig = 8 * nN, gid = wgid / nig, fm = gid * 8, gsz = (nM - fm) < 8 ? (nM - fm) : 8;
        pm = fm + ((wgid % nig) % gsz); pn = (wgid % nig) / gsz; return true;
    }
};

typedef int i32x8 __attribute__((ext_vector_type(8)));
typedef int i32x4 __attribute__((ext_vector_type(4)));
__device__ __forceinline__ i32x8 cat8(bf16x8 lo, bf16x8 hi) { const i32x4 a = __builtin_bit_cast(i32x4, lo), b = __builtin_bit_cast(i32x4, hi); return __builtin_shufflevector(a, b, 0, 1, 2, 3, 4, 5, 6, 7); }
template <class Epi, class Sched, bool GATHER, bool FP8 = false, int SCW = 0x7f7f7f7f, int SCX = 0x7f7f7f7f>
__device__ __forceinline__ void gemm_phase(LAS unsigned char* lds, const int wid, const int K, const unsigned lda, const unsigned ldb, const Sched& S, const Epi& E) {
    int lane_ = (int)__builtin_amdgcn_mbcnt_hi(~0u, __builtin_amdgcn_mbcnt_lo(~0u, 0u)); asm volatile("" : "+v"(lane_));
    const int lane = lane_, tid = wid * 64 + lane, wr = wid >> 2, wc = wid & 3, fr = lane & 15, fq = lane >> 4;
    const int nt = K / BK;
    unsigned voffA[2], voffB[2]; int RA[2], CA[2];
#pragma unroll
    for (int i = 0; i < 2; ++i) { int R, C; stage_rc(tid * 16 + i * 8192, R, C); const int Rb = Epi::PERM ? ((R & ~31) + perm32(R & 31)) : R;
        RA[i] = R; CA[i] = C; voffA[i] = (unsigned)R * lda + (unsigned)C * 2u; voffB[i] = (unsigned)Rb * ldb + (unsigned)C * 2u; }
    const size_t kstep = (size_t)(BK * 2);
    const size_t hstepA = (size_t)HALF * lda, hstepB = (size_t)HALF * ldb;
    const unsigned ldsw = (unsigned)wid * 1024u;
    const int aoff = lds_byte(wr * 64 + fr, fq * 8), boff = lds_byte(wc * 32 + fr, fq * 8);
#define PG8_SA(b, h) (((b) * 2 + (h)) * HTB)
#define PG8_SB(b, h) ((4 + (b) * 2 + (h)) * HTB)
#define PG8_GLDS(gp, bufoff, i) __builtin_amdgcn_global_load_lds((const unsigned*)(gp), (LAS unsigned*)(lds + (bufoff) + ldsw + (i) * 8192), 16, 0, 0)
#define PG8_STAGE_B(bufoff, gbase) do { _Pragma("unroll") for (int _i = 0; _i < 2; ++_i) PG8_GLDS((const char*)(gbase) + voffB[_i], bufoff, _i); } while (0)
#define PG8_STAGE_A(bufoff, gbase, h, GO) do { _Pragma("unroll") for (int _i = 0; _i < 2; ++_i) { \
        if constexpr (GATHER) PG8_GLDS((const char*)(gbase) + GO[h][_i], bufoff, _i); else PG8_GLDS((const char*)(gbase) + (size_t)(h) * hstepA + voffA[_i], bufoff, _i); } } while (0)
#define PG8_LDA(dst, b, h) do { _Pragma("unroll") for (int m = 0; m < 4; ++m) _Pragma("unroll") for (int k = 0; k < 2; ++k) dst[m][k] = *(const LAS bf16x8*)(lds + PG8_SA(b, h) + aoff + m * 2048 + k * 1024); } while (0)
#define PG8_LDB(dst, b, h) do { _Pragma("unroll") for (int n = 0; n < 2; ++n) _Pragma("unroll") for (int k = 0; k < 2; ++k) dst[n][k] = *(const LAS bf16x8*)(lds + PG8_SB(b, h) + boff + n * 2048 + k * 1024); } while (0)
#define PG8_MFMA8(ACC, W8, X8) asm volatile("v_mfma_scale_f32_16x16x128_f8f6f4 %0, %1, %2, %0, %3, %4 op_sel_hi:[0,0,0]" : "+v"(ACC) : "v"(W8), "v"(X8), "v"(scw_), "v"(scx_))
#define PG8_MMA(ai, bj, At, Bt) do { __builtin_amdgcn_s_setprio(1); if constexpr (FP8) { i32x8 a8_[4], b8_[2]; _Pragma("unroll") for (int m = 0; m < 4; ++m) a8_[m] = cat8(At[m][0], At[m][1]); \
        _Pragma("unroll") for (int n = 0; n < 2; ++n) b8_[n] = cat8(Bt[n][0], Bt[n][1]); asm volatile("s_nop 3" ::: "memory"); \
        _Pragma("unroll") for (int m = 0; m < 4; ++m) _Pragma("unroll") for (int n = 0; n < 2; ++n) PG8_MFMA8(acc[ai][bj][m][n], b8_[n], a8_[m]); } else { \
        _Pragma("unroll") for (int m = 0; m < 4; ++m) _Pragma("unroll") for (int n = 0; n < 2; ++n) _Pragma("unroll") for (int k = 0; k < 2; ++k) \
        acc[ai][bj][m][n] = __builtin_amdgcn_mfma_f32_16x16x32_bf16(Bt[n][k], At[m][k], acc[ai][bj][m][n], 0, 0, 0); } __builtin_amdgcn_s_setprio(0); } while (0)
#define PG8_WAIT_V(n) asm volatile("s_waitcnt vmcnt(" #n ")" ::: "memory")
#define PG8_WAIT_L(n) asm volatile("s_waitcnt lgkmcnt(" #n ")" ::: "memory")
#define PG8_BAR __builtin_amdgcn_s_barrier()
#define PG8_SCHED __builtin_amdgcn_sched_barrier(0)
    Unit cur, nxt; int ui = 0;
    if (!S.next(0, cur)) return;
    int scw_ = SCW, scx_ = SCX; asm volatile("" : "+v"(scw_), "+v"(scx_)); (void)scw_; (void)scx_;
    unsigned goff[2][2] = {{0u, 0u}, {0u, 0u}}, ngoff[2][2] = {{0u, 0u}, {0u, 0u}};
    if constexpr (GATHER) {
#pragma unroll
        for (int h = 0; h < 2; ++h)
#pragma unroll
            for (int i = 0; i < 2; ++i) goff[h][i] = (unsigned)S.tok(cur, h * HALF + RA[i]) * lda + (unsigned)CA[i] * 2u;
    }
    f32x4 acc[2][2][4][2];
#pragma unroll
    for (int a = 0; a < 2; ++a)
#pragma unroll
        for (int b = 0; b < 2; ++b)
#pragma unroll
            for (int m = 0; m < 4; ++m)
#pragma unroll
                for (int n = 0; n < 2; ++n) acc[a][b][m][n] = (f32x4){0.f, 0.f, 0.f, 0.f};
    bf16x8 At[4][2], B0[2][2], B1[2][2];
    const char* cA = cur.A; const char* cB = cur.B;
    PG8_STAGE_B(PG8_SB(0, 0), cB); PG8_STAGE_B(PG8_SB(0, 1), cB + hstepB); PG8_STAGE_A(PG8_SA(0, 0), cA, 0, goff); PG8_STAGE_A(PG8_SA(0, 1), cA, 1, goff);
    if (wr == 1) PG8_BAR;
    PG8_WAIT_V(2); PG8_BAR;
    PG8_STAGE_B(PG8_SB(1, 0), cB + kstep); PG8_STAGE_A(PG8_SA(1, 0), cA + kstep, 0, goff); PG8_STAGE_B(PG8_SB(1, 1), cB + hstepB + kstep);
    PG8_WAIT_V(6); PG8_BAR;
    for (;;) {
        const bool has_next = S.next(ui + 1, nxt);
        const char* nA = has_next ? nxt.A : cA; const char* nB = has_next ? nxt.B : cB;
        if constexpr (GATHER) {
#pragma unroll
            for (int h = 0; h < 2; ++h)
#pragma unroll
                for (int i = 0; i < 2; ++i) ngoff[h][i] = has_next ? (unsigned)S.tok(nxt, h * HALF + RA[i]) * lda + (unsigned)CA[i] * 2u : goff[h][i];
        }
#pragma unroll 1
        for (int t = 0; t < nt; t += 2) {
            const bool last = (t == nt - 2);
            const char* a1 = cA + (size_t)(t + 1) * kstep;
            const char* a2 = last ? nA : cA + (size_t)(t + 2) * kstep; const char* b2 = last ? nB : cB + (size_t)(t + 2) * kstep;
            const char* a3 = a2 + kstep; const char* b3 = b2 + kstep;
            unsigned g2[2][2];
#pragma unroll
            for (int h = 0; h < 2; ++h)
#pragma unroll
                for (int i = 0; i < 2; ++i) g2[h][i] = last ? ngoff[h][i] : goff[h][i];
            PG8_LDB(B0, 0, 0); PG8_LDB(B1, 0, 1); PG8_SCHED; PG8_LDA(At, 0, 0); PG8_STAGE_A(PG8_SA(1, 1), a1, 1, goff);
            PG8_WAIT_V(8); PG8_WAIT_L(0); PG8_BAR; PG8_MMA(0, 0, At, B0); PG8_MMA(0, 1, At, B1); PG8_BAR; PG8_SCHED;
            PG8_LDA(At, 0, 1); PG8_STAGE_B(PG8_SB(0, 0), b2); PG8_STAGE_B(PG8_SB(0, 1), b2 + hstepB); PG8_STAGE_A(PG8_SA(0, 0), a2, 0, g2);
            PG8_WAIT_V(8); PG8_WAIT_L(0); PG8_BAR; PG8_MMA(1, 0, At, B0); PG8_MMA(1, 1, At, B1); PG8_BAR; PG8_SCHED;
            PG8_LDB(B0, 1, 0); PG8_LDB(B1, 1, 1); PG8_SCHED; PG8_LDA(At, 1, 0); PG8_STAGE_A(PG8_SA(0, 1), a2, 1, g2);
            PG8_WAIT_V(8); PG8_WAIT_L(0); PG8_BAR; PG8_MMA(0, 0, At, B0); PG8_MMA(0, 1, At, B1); PG8_BAR; PG8_SCHED;
            PG8_LDA(At, 1, 1); PG8_STAGE_B(PG8_SB(1, 0), b3); PG8_STAGE_B(PG8_SB(1, 1), b3 + hstepB); PG8_STAGE_A(PG8_SA(1, 0), a3, 0, g2);
            PG8_WAIT_V(8); PG8_WAIT_L(0); PG8_BAR; PG8_MMA(1, 0, At, B0); PG8_MMA(1, 1, At, B1); PG8_BAR; PG8_SCHED;
        }
        if (wr == 0) PG8_BAR;
        if constexpr (FP8) asm volatile("s_nop 7\n\ts_nop 7" ::: "memory");
        { int fr2 = fr, fq2 = fq; asm volatile("" : "+v"(fr2), "+v"(fq2)); E(acc, cur, wr, wc, fr2, fq2); }
        if (!has_next) break;
#pragma unroll
        for (int a = 0; a < 2; ++a)
#pragma unroll
            for (int b = 0; b < 2; ++b)
#pragma unroll
                for (int m = 0; m < 4; ++m)
#pragma unroll
                    for (int n = 0; n < 2; ++n) acc[a][b][m][n] = (f32x4){0.f, 0.f, 0.f, 0.f};
        cur = nxt; cA = nA; cB = nB; ++ui;
        if constexpr (GATHER) {
#pragma unroll
            for (int h = 0; h < 2; ++h)
#pragma unroll
                for (int i = 0; i < 2; ++i) goff[h][i] = ngoff[h][i];
        }
        if (wr == 1) PG8_BAR;
    }
    PG8_WAIT_V(0);
    PG8_BAR;
#undef PG8_SA
#undef PG8_SB
#undef PG8_GLDS
#undef PG8_STAGE_A
#undef PG8_STAGE_B
#undef PG8_LDA
#undef PG8_LDB
#undef PG8_MMA
#undef PG8_MFMA8
#undef PG8_WAIT_V
#undef PG8_WAIT_L
#undef PG8_BAR
#undef PG8_SCHED
}
}
__device__ __forceinline__ const char* uni_ptr(const char* p) {
    unsigned long long v = (unsigned long long)p; unsigned lo = __builtin_amdgcn_readfirstlane((unsigned)v), hi = __builtin_amdgcn_readfirstlane((unsigned)(v >> 32));
    return (const char*)(((unsigned long long)hi << 32) | lo);
}
struct SchedStd {
    pg8::TileOrder T; const char* A; const char* B; size_t sA, sB;
    __device__ __forceinline__ bool next(int i, pg8::Unit& u) const { int pm, pn; if (!T.tile(i, pm, pn)) return false; u.pm = pm; u.pn = pn; u.aux = 0; u.A = A + (size_t)pm * sA; u.B = B + (size_t)pn * sB; return true; }
    __device__ __forceinline__ int tok(const pg8::Unit&, int) const { return 0; }
};
struct SchedBatch {
    const char* A; const char* B; size_t sA, sB, vA, vB; int nunits, nvt, G, c;
    __device__ __forceinline__ bool next(int i, pg8::Unit& u) const { const int L = i * G + c; if (L >= nunits * nvt) return false; const int uu = L / nvt, vt = L % nvt; u.pm = uu; u.pn = vt; u.aux = 0;
        u.A = A + (size_t)uu * sA + (size_t)vt * vA; u.B = B + (size_t)uu * sB + (size_t)vt * vB; return true; }
    __device__ __forceinline__ int tok(const pg8::Unit&, int) const { return 0; }
};
struct SchedMoE {
    const LAS int* tab; const char* A; const char* Bw; size_t sE, sPN, sRT; const int* idx; int G, c; bool gather;
    __device__ __forceinline__ bool next(int i, pg8::Unit& u) const {
        const int L = i * G + c, rt = L >> 2, pn = L & 3;
        const int ntile = __builtin_amdgcn_readfirstlane(tab[32]); if (rt >= ntile) return false;
        int e = 0;
#pragma unroll
        for (int k = 1; k < 16; ++k) e += (rt >= __builtin_amdgcn_readfirstlane(tab[16 + k])) ? 1 : 0;
        e = __builtin_amdgcn_readfirstlane(e);
        u.pm = rt; u.pn = pn; u.aux = e; u.A = gather ? A : A + (size_t)rt * sRT; u.B = Bw + (size_t)e * sE + (size_t)pn * sPN; return true;
    }
    __device__ __forceinline__ int tok(const pg8::Unit& u, int r) const {
        const int e = u.aux, p = (u.pm - __builtin_amdgcn_readfirstlane(tab[16 + e])) * 256 + r, n = __builtin_amdgcn_readfirstlane(tab[e]);
        return p < n ? idx[e * NTOK + p] : 0;
    }
};

typedef const f32x4 (&AccRef)[2][2][4][2];
__device__ __forceinline__ int launder(int x) { asm volatile("" : "+v"(x)); return x; }
__device__ __forceinline__ void st8(bf16_t* p, f32x4 v0, f32x4 v1) {
    u32x4 w; w.x = cvt_pk_bf16(v0[0], v0[1]); w.y = cvt_pk_bf16(v0[2], v0[3]); w.z = cvt_pk_bf16(v1[0], v1[1]); w.w = cvt_pk_bf16(v1[2], v1[3]); *(u32x4*)p = w;
}
struct EpiPlain {
    static constexpr bool PERM = true; bf16_t* out; int ld;
    __device__ __forceinline__ void operator()(AccRef acc, const pg8::Unit& u, int wr, int wc, int fr, int fq) const {
#pragma unroll
        for (int ai = 0; ai < 2; ++ai)
#pragma unroll
            for (int m = 0; m < 4; ++m) { const int r = ai * 128 + wr * 64 + m * 16 + fr; bf16_t* rp = out + (size_t)(u.pm * 256 + r) * ld + u.pn * 256 + wc * 32 + fq * 8;
#pragma unroll
                for (int bj = 0; bj < 2; ++bj) st8(rp + bj * 128, acc[ai][bj][m][0], acc[ai][bj][m][1]); }
    }
};
template <int MODE> struct EpiRopeQK {
    static constexpr bool PERM = true; bf16_t* out; const int* pos; int half; bf16_t* outT;
    __device__ __forceinline__ void operator()(AccRef acc, const pg8::Unit& u, int wr, int wc, int fr, int fq) const {
        const int pm = u.pm, h = u.pn, uu = ((pm >> 5) * 4 + h) * 32 + (pm & 31); const float l2g = log2_gamma(h);
        constexpr int LD = MODE == 0 ? 512 : 256;
        float inv[8]; const int f0 = launder(wc * 32 + fq * 8);
#pragma unroll
        for (int k = 0; k < 8; ++k) inv[k] = __builtin_amdgcn_exp2f(-(float)(f0 + k) * (LOG2_THETA / 128.0f));
#pragma unroll
        for (int ai = 0; ai < 2; ++ai)
#pragma unroll
            for (int m = 0; m < 4; ++m) { const int r = ai * 128 + wr * 64 + m * 16 + fr; const float p = (float)pos[half * THALF + pm * 256 + r];
                const float dec = MODE == 0 ? __builtin_amdgcn_exp2f((float)r * l2g) : __builtin_amdgcn_exp2f(-(float)r * l2g) * 0.0625f;
                f32x4 o1[2], o2[2];
#pragma unroll
                for (int n = 0; n < 2; ++n)
#pragma unroll
                    for (int j = 0; j < 4; ++j) { float s, c; sincos_rad(p * inv[n * 4 + j], s, c); const float x1 = acc[ai][0][m][n][j], x2 = acc[ai][1][m][n][j];
                        o1[n][j] = (x1 * c - x2 * s) * dec; o2[n][j] = (x1 * s + x2 * c) * dec; }
                bf16_t* rp = out + (size_t)uu * (256 * LD) + (size_t)r * LD + wc * 32 + fq * 8;
                st8(rp, o1[0], o1[1]); st8(rp + 128, o2[0], o2[1]);
                if constexpr (MODE == 1) { bf16_t* tp = outT + (size_t)uu * 65536 + (size_t)(wc * 32 + fq * 8) * 256 + r;
#pragma unroll
                    for (int n = 0; n < 2; ++n) { const unsigned a01 = cvt_pk_bf16(o1[n][0], o1[n][1]), a23 = cvt_pk_bf16(o1[n][2], o1[n][3]), b01 = cvt_pk_bf16(o2[n][0], o2[n][1]), b23 = cvt_pk_bf16(o2[n][2], o2[n][3]);
                        tp[(n * 4 + 0) * 256] = (bf16_t)(a01 & 0xffffu); tp[(n * 4 + 1) * 256] = (bf16_t)(a01 >> 16); tp[(n * 4 + 2) * 256] = (bf16_t)(a23 & 0xffffu); tp[(n * 4 + 3) * 256] = (bf16_t)(a23 >> 16);
                        tp[(128 + n * 4 + 0) * 256] = (bf16_t)(b01 & 0xffffu); tp[(128 + n * 4 + 1) * 256] = (bf16_t)(b01 >> 16); tp[(128 + n * 4 + 2) * 256] = (bf16_t)(b23 & 0xffffu); tp[(128 + n * 4 + 3) * 256] = (bf16_t)(b23 >> 16); } }
                __builtin_amdgcn_sched_barrier(0); }
    }
};
struct EpiRopeKT {
    static constexpr bool PERM = true; bf16_t* out; const int* pos; int half;
    __device__ __forceinline__ void operator()(AccRef acc, const pg8::Unit& u, int wr, int wc, int fr, int fq) const {
        const int h = u.pm, pn = u.pn, uu = ((pn >> 5) * 4 + h) * 32 + (pn & 31); const float l2g = log2_gamma(h);
        float pp[2][8], dec[2][8]; const int c00 = launder(wc * 32 + fq * 8), i00 = launder(wr * 64 + fr);
#pragma unroll
        for (int bj = 0; bj < 2; ++bj)
#pragma unroll
            for (int k = 0; k < 8; ++k) { const int c = bj * 128 + c00 + k; pp[bj][k] = (float)pos[half * THALF + pn * 256 + c]; dec[bj][k] = __builtin_amdgcn_exp2f(-(float)c * l2g) * 0.0625f; }
#pragma unroll
        for (int m = 0; m < 4; ++m) { const int i = i00 + m * 16; const float inv = __builtin_amdgcn_exp2f(-(float)i * (LOG2_THETA / 128.0f));
#pragma unroll
            for (int bj = 0; bj < 2; ++bj) { f32x4 o1[2], o2[2];
#pragma unroll
                for (int n = 0; n < 2; ++n)
#pragma unroll
                    for (int j = 0; j < 4; ++j) { float s, c; sincos_rad(pp[bj][n * 4 + j] * inv, s, c); const float x1 = acc[0][bj][m][n][j], x2 = acc[1][bj][m][n][j], d = dec[bj][n * 4 + j];
                        o1[n][j] = (x1 * c - x2 * s) * d; o2[n][j] = (x1 * s + x2 * c) * d; }
                bf16_t* rp = out + (size_t)uu * 65536 + (size_t)i * 256 + bj * 128 + c00;
                st8(rp, o1[0], o1[1]); st8(rp + 128 * 256, o2[0], o2[1]); __builtin_amdgcn_sched_barrier(0); } }
    }
};
struct EpiVT {
    static constexpr bool PERM = true; bf16_t* out;
    __device__ __forceinline__ void operator()(AccRef acc, const pg8::Unit& u, int wr, int wc, int fr, int fq) const {
        const int h = u.pm >> 1, vt = u.pm & 1, pn = u.pn, uu = ((pn >> 5) * 4 + h) * 32 + (pn & 31);
#pragma unroll
        for (int ai = 0; ai < 2; ++ai)
#pragma unroll
            for (int m = 0; m < 4; ++m) { const int r = ai * 128 + wr * 64 + m * 16 + fr; bf16_t* rp = out + (size_t)uu * 262144 + (size_t)(vt * 256 + r) * 512 + 256 + wc * 32 + fq * 8;
#pragma unroll
                for (int bj = 0; bj < 2; ++bj) st8(rp + bj * 128, acc[ai][bj][m][0], acc[ai][bj][m][1]); }
    }
};
struct EpiS {
    static constexpr bool PERM = true; bf16_t* out;
    __device__ __forceinline__ void operator()(AccRef acc, const pg8::Unit& u, int wr, int wc, int fr, int fq) const {
        const int uu = u.pm;
#pragma unroll
        for (int ai = 0; ai < 2; ++ai)
#pragma unroll
            for (int m = 0; m < 4; ++m) { const int r = ai * 128 + wr * 64 + m * 16 + fr; bf16_t* rp = out + (size_t)uu * 131072 + (size_t)r * 512 + 256 + wc * 32 + fq * 8;
#pragma unroll
                for (int bj = 0; bj < 2; ++bj) { const int c0 = bj * 128 + wc * 32 + fq * 8; f32x4 v0 = acc[ai][bj][m][0], v1 = acc[ai][bj][m][1];
#pragma unroll
                    for (int j = 0; j < 4; ++j) { if (c0 + j > r) v0[j] = 0.f; if (c0 + 4 + j > r) v1[j] = 0.f; }
                    st8(rp + bj * 128, v0, v1); } }
    }
};
struct EpiKV {
    static constexpr bool PERM = true; bf16_t* out;
    __device__ __forceinline__ void operator()(AccRef acc, const pg8::Unit& u, int wr, int wc, int fr, int fq) const {
        const int uu = u.pm, vt = u.pn, h = (uu >> 5) & 3; const float sc = __builtin_amdgcn_exp2f(255.0f * log2_gamma(h));
#pragma unroll
        for (int ai = 0; ai < 2; ++ai)
#pragma unroll
            for (int m = 0; m < 4; ++m) { const int r = ai * 128 + wr * 64 + m * 16 + fr; bf16_t* rp = out + (size_t)uu * 262144 + (size_t)(vt * 256 + r) * 512 + wc * 32 + fq * 8;
#pragma unroll
                for (int bj = 0; bj < 2; ++bj) st8(rp + bj * 128, acc[ai][bj][m][0] * sc, acc[ai][bj][m][1] * sc); }
    }
};
struct EpiFin {
    static constexpr bool PERM = true; bf16_t* out; float* stats;
    __device__ __forceinline__ void operator()(AccRef acc, const pg8::Unit& u, int wr, int wc, int fr, int fq) const {
        const int uu = u.pm, vt = u.pn, bl = uu >> 7, h = (uu >> 5) & 3, ch = uu & 31;
#pragma unroll
        for (int ai = 0; ai < 2; ++ai)
#pragma unroll
            for (int m = 0; m < 4; ++m) { const int r = ai * 128 + wr * 64 + m * 16 + fr; bf16_t* rp = out + (size_t)uu * 262144 + (size_t)(vt * 256 + r) * 512 + wc * 32 + fq * 8;
                float s = 0.f, q = 0.f;
#pragma unroll
                for (int bj = 0; bj < 2; ++bj) { const f32x4 v0 = acc[ai][bj][m][0], v1 = acc[ai][bj][m][1];
                    s += (v0[0] + v0[1]) + (v0[2] + v0[3]) + (v1[0] + v1[1]) + (v1[2] + v1[3]);
                    q += (v0[0] * v0[0] + v0[1] * v0[1]) + (v0[2] * v0[2] + v0[3] * v0[3]) + (v1[0] * v1[0] + v1[1] * v1[1]) + (v1[2] * v1[2] + v1[3] * v1[3]);
                    st8(rp + bj * 128, v0, v1); }
                s = rows_sum(s); q = rows_sum(q);
                const int tokl = bl * SEQ + ch * 256 + r;
                if (fq == 0) *(f32x2*)(stats + ((size_t)(tokl * 4 + h) * 8 + vt * 4 + wc) * 2) = (f32x2){s, q}; }
    }
};
template <bool F8> struct EpiGate {
    static constexpr bool PERM = true; const bf16_t* o; const float* stats; bf16_t* y; unsigned char* y8;
    __device__ __forceinline__ void operator()(AccRef acc, const pg8::Unit& u, int wr, int wc, int fr, int fq) const {
        const int pm = u.pm, h = u.pn >> 1, vt = u.pn & 1, uu = ((pm >> 5) * 4 + h) * 32 + (pm & 31);
#pragma unroll
        for (int ai = 0; ai < 2; ++ai)
#pragma unroll
            for (int m = 0; m < 4; ++m) { const int r = ai * 128 + wr * 64 + m * 16 + fr, tokl = pm * 256 + r;
                const f32x4* sp = (const f32x4*)(stats + (size_t)(tokl * 4 + h) * 16); const f32x4 a = sp[0], b = sp[1], c = sp[2], d = sp[3];
                const float mean = ((a[0] + a[2]) + (b[0] + b[2]) + (c[0] + c[2]) + (d[0] + d[2])) * (1.0f / 512.0f);
                const float ex2 = ((a[1] + a[3]) + (b[1] + b[3]) + (c[1] + c[3]) + (d[1] + d[3])) * (1.0f / 512.0f);
                const float rstd = __builtin_amdgcn_rsqf(fmaxf(ex2 - mean * mean, 0.f) + EPS);
                const bf16_t* op = o + (size_t)uu * 262144 + (size_t)(vt * 256 + r) * 512 + wc * 32 + fq * 8;
                bf16_t* yp = y + (size_t)tokl * 2048 + h * 512 + vt * 256 + wc * 32 + fq * 8;
#pragma unroll
                for (int bj = 0; bj < 2; ++bj) { const u32x4 ow = *(const u32x4*)(op + bj * 128); const f32x4 g0 = acc[ai][bj][m][0], g1 = acc[ai][bj][m][1];
                    f32x4 y0, y1;
                    y0[0] = silu_f(g0[0]) * (bflo(ow.x) - mean) * rstd; y0[1] = silu_f(g0[1]) * (bfhi(ow.x) - mean) * rstd; y0[2] = silu_f(g0[2]) * (bflo(ow.y) - mean) * rstd; y0[3] = silu_f(g0[3]) * (bfhi(ow.y) - mean) * rstd;
                    y1[0] = silu_f(g1[0]) * (bflo(ow.z) - mean) * rstd; y1[1] = silu_f(g1[1]) * (bfhi(ow.z) - mean) * rstd; y1[2] = silu_f(g1[2]) * (bflo(ow.w) - mean) * rstd; y1[3] = silu_f(g1[3]) * (bfhi(ow.w) - mean) * rstd;
                    if constexpr (F8) { u32x2 w; w.x = pk4_fp8(4.0f * y0[0], 4.0f * y0[1], 4.0f * y0[2], 4.0f * y0[3]); w.y = pk4_fp8(4.0f * y1[0], 4.0f * y1[1], 4.0f * y1[2], 4.0f * y1[3]);
                        *(u32x2*)(y8 + (size_t)tokl * 2048 + h * 512 + vt * 256 + wc * 32 + fq * 8 + bj * 128) = w; }
                    else st8(yp + bj * 128, y0, y1); } __builtin_amdgcn_sched_barrier(0); }
    }
};
struct EpiResid {
    static constexpr bool PERM = false; float* h; const float* gate; int tok0;
    __device__ __forceinline__ void operator()(AccRef acc, const pg8::Unit& u, int wr, int wc, int fr, int fq) const {
#pragma unroll
        for (int ai = 0; ai < 2; ++ai)
#pragma unroll
            for (int m = 0; m < 4; ++m) { const int row = tok0 + u.pm * 256 + ai * 128 + wr * 64 + m * 16 + fr, b = row >> 13;
#pragma unroll
                for (int bj = 0; bj < 2; ++bj)
#pragma unroll
                    for (int n = 0; n < 2; ++n) { const int c = u.pn * 256 + bj * 128 + wc * 32 + n * 16 + fq * 4; const f32x4 gv = *(const f32x4*)(gate + b * 6144 + c);
                        f32x4* hp = (f32x4*)(h + (size_t)row * DM + c); *hp = *hp + gv * acc[ai][bj][m][n]; } }
    }
};
struct EpiGU {
    static constexpr bool PERM = true; bf16_t* hdn;
    __device__ __forceinline__ void operator()(AccRef acc, const pg8::Unit& u, int wr, int wc, int fr, int fq) const {
#pragma unroll
        for (int ai = 0; ai < 2; ++ai)
#pragma unroll
            for (int m = 0; m < 4; ++m) { const int r = ai * 128 + wr * 64 + m * 16 + fr; f32x4 o0, o1;
#pragma unroll
                for (int j = 0; j < 4; ++j) { o0[j] = silu_f(acc[ai][0][m][0][j]) * acc[ai][1][m][0][j]; o1[j] = silu_f(acc[ai][0][m][1][j]) * acc[ai][1][m][1][j]; }
                st8(hdn + (size_t)(u.pm * 256 + r) * DEXP + u.pn * 128 + wc * 32 + fq * 8, o0, o1); }
    }
};
struct EpiGU8 {
    static constexpr bool PERM = true; unsigned char* hdn;
    __device__ __forceinline__ void operator()(AccRef acc, const pg8::Unit& u, int wr, int wc, int fr, int fq) const {
#pragma unroll
        for (int ai = 0; ai < 2; ++ai)
#pragma unroll
            for (int m = 0; m < 4; ++m) { const int r = ai * 128 + wr * 64 + m * 16 + fr; f32x4 o0, o1;
#pragma unroll
                for (int j = 0; j < 4; ++j) { o0[j] = 4.0f * silu_f(acc[ai][0][m][0][j]) * acc[ai][1][m][0][j]; o1[j] = 4.0f * silu_f(acc[ai][0][m][1][j]) * acc[ai][1][m][1][j]; }
                u32x2 w; w.x = pk4_fp8(o0[0], o0[1], o0[2], o0[3]); w.y = pk4_fp8(o1[0], o1[1], o1[2], o1[3]);
                *(u32x2*)(hdn + (size_t)(u.pm * 256 + r) * DEXP + u.pn * 128 + wc * 32 + fq * 8) = w; }
    }
};
struct EpiQA {
    static constexpr bool PERM = true; bf16_t* out; float* ssq;
    __device__ __forceinline__ void operator()(AccRef acc, const pg8::Unit& u, int wr, int wc, int fr, int fq) const {
#pragma unroll
        for (int ai = 0; ai < 2; ++ai)
#pragma unroll
            for (int m = 0; m < 4; ++m) { const int row = u.pm * 256 + ai * 128 + wr * 64 + m * 16 + fr; bf16_t* rp = out + (size_t)row * 256 + wc * 32 + fq * 8; float q = 0.f;
#pragma unroll
                for (int bj = 0; bj < 2; ++bj) { const f32x4 v0 = acc[ai][bj][m][0], v1 = acc[ai][bj][m][1];
                    q += (v0[0] * v0[0] + v0[1] * v0[1]) + (v0[2] * v0[2] + v0[3] * v0[3]) + (v1[0] * v1[0] + v1[1] * v1[1]) + (v1[2] * v1[2] + v1[3] * v1[3]);
                    st8(rp + bj * 128, v0, v1); }
                q = rows_sum(q);
                if (fq == 0) ssq[(size_t)row * 4 + wc] = q; }
    }
};
struct EpiF32 {
    static constexpr bool PERM = false; float* out;
    __device__ __forceinline__ void operator()(AccRef acc, const pg8::Unit& u, int wr, int wc, int fr, int fq) const {
#pragma unroll
        for (int ai = 0; ai < 2; ++ai)
#pragma unroll
            for (int m = 0; m < 4; ++m) { const int row = u.pm * 256 + ai * 128 + wr * 64 + m * 16 + fr;
#pragma unroll
                for (int bj = 0; bj < 2; ++bj)
#pragma unroll
                    for (int n = 0; n < 2; ++n) *(f32x4*)(out + (size_t)row * 256 + bj * 128 + wc * 32 + n * 16 + fq * 4) = acc[ai][bj][m][n]; }
    }
};
struct EpiQB {
    static constexpr bool PERM = true; bf16_t* Q; const float* ssq; const int* pos;
    __device__ __forceinline__ void operator()(AccRef acc, const pg8::Unit& u, int wr, int wc, int fr, int fq) const {
        constexpr float QS = 0.10411754627697264f;
        const int pn = u.pn;
        float inv[8]; const int f0 = launder(fq * 8);
#pragma unroll
        for (int k = 0; k < 8; ++k) inv[k] = __builtin_amdgcn_exp2f(-(float)(f0 + k) * (LOG2_THETA / 32.0f));
#pragma unroll
        for (int ai = 0; ai < 2; ++ai)
#pragma unroll
            for (int m = 0; m < 4; ++m) { const int row = u.pm * 256 + ai * 128 + wr * 64 + m * 16 + fr; const f32x4 sq = *(const f32x4*)(ssq + (size_t)row * 4);
                const float rs = __builtin_amdgcn_rsqf(((sq[0] + sq[1]) + (sq[2] + sq[3])) * (1.0f / 256.0f) + EPS) * QS;
                if (pn < 4) {
#pragma unroll
                    for (int bj = 0; bj < 2; ++bj) st8(Q + (size_t)row * 1536 + (2 * pn + bj) * QKD + wc * 32 + fq * 8, acc[ai][bj][m][0] * rs, acc[ai][bj][m][1] * rs);
                } else {
                    const float p = (float)pos[row]; f32x4 o1[2], o2[2];
#pragma unroll
                    for (int n = 0; n < 2; ++n)
#pragma unroll
                        for (int j = 0; j < 4; ++j) { float s, c; sincos_rad(p * inv[n * 4 + j], s, c); const float x1 = acc[ai][0][m][n][j] * rs, x2 = acc[ai][1][m][n][j] * rs;
                            o1[n][j] = x1 * c - x2 * s; o2[n][j] = x1 * s + x2 * c; }
                    bf16_t* qp = Q + (size_t)row * 1536 + (4 * (pn - 4) + wc) * QKD + 128 + fq * 8;
                    st8(qp, o1[0], o1[1]); st8(qp + 32, o2[0], o2[1]); } __builtin_amdgcn_sched_barrier(0); }
    }
};
typedef const char __attribute__((address_space(4)))* kaptr_t;
struct Ctx { kaptr_t ka; LAS unsigned char* lds; int wave, vcu; };
__device__ __forceinline__ const void* ld_ka(kaptr_t ka, int off) { return *(const void* const __attribute__((address_space(4)))*)(ka + off); }
#define INF(k) ((const float*)ld_ka(ka, (k) * 8))
#define INI(k) ((const int*)ld_ka(ka, (k) * 8))
#define OUTP ((float*)ld_ka(ka, 200))
#define WSB ((unsigned char*)ld_ka(ka, 208))
#define CTLP ((unsigned*)(WSB + WS_CTL))
#define PHASE_ENTRY() kaptr_t ka = C.ka; asm volatile("" : "+s"(ka)); int lane_ = lane_id(); asm volatile("" : "+v"(lane_)); int wave_ = C.wave, vcu_ = C.vcu; asm volatile("" : "+s"(wave_), "+s"(vcu_)); \
    const int lane = lane_, wave = wave_, vcu = vcu_, tid = wave * 64 + lane; LAS unsigned char* const ldsb = C.lds; (void)tid; (void)lane; (void)vcu; (void)ldsb
#define WSP(T, off) ((T*)(WSB + (off)))

__device__ __forceinline__ void transpose_block(const float* W, int N, int k0, int n0, bf16_t* dst, int ldd, int drow, LAS float* scr, int lane) {
#pragma unroll 8
    for (int i = 0; i < 32; ++i) { const int kk = 2 * i + (lane >> 5); scr[kk * 33 + (lane & 31)] = W[(size_t)(k0 + kk) * N + n0 + (lane & 31)]; }
    LDS_WAIT(); asm volatile("" ::: "memory");
    const int c = lane & 7;
#pragma unroll
    for (int j = 0; j < 4; ++j) { const int n = (lane >> 3) + 8 * j; const LAS float* s = scr + (8 * c) * 33 + n;
        u32x4 o; o.x = cvt_pk_bf16(s[0 * 33], s[1 * 33]); o.y = cvt_pk_bf16(s[2 * 33], s[3 * 33]); o.z = cvt_pk_bf16(s[4 * 33], s[5 * 33]); o.w = cvt_pk_bf16(s[6 * 33], s[7 * 33]);
        *(u32x4*)(dst + (size_t)(drow + n) * ldd + k0 + 8 * c) = o; }
    LDS_WAIT(); asm volatile("" ::: "memory");
}
__device__ __forceinline__ void transpose_block_f8(const float* W, int N, int k0, int n0, unsigned char* dst, int ldd, int drow, float sc, LAS float* scr, int lane) {
#pragma unroll 8
    for (int i = 0; i < 32; ++i) { const int kk = 2 * i + (lane >> 5); scr[kk * 33 + (lane & 31)] = W[(size_t)(k0 + kk) * N + n0 + (lane & 31)]; }
    LDS_WAIT(); asm volatile("" ::: "memory");
    const int c = lane & 7;
#pragma unroll
    for (int j = 0; j < 4; ++j) { const int n = (lane >> 3) + 8 * j; const LAS float* s = scr + (8 * c) * 33 + n;
        u32x2 o; o.x = pk4_fp8(sc * s[0 * 33], sc * s[1 * 33], sc * s[2 * 33], sc * s[3 * 33]); o.y = pk4_fp8(sc * s[4 * 33], sc * s[5 * 33], sc * s[6 * 33], sc * s[7 * 33]);
        *(u32x2*)(dst + (size_t)(drow + n) * ldd + k0 + 8 * c) = o; }
    LDS_WAIT(); asm volatile("" ::: "memory");
}
__device__ __forceinline__ void phase_prologue(Ctx& C) {
    PHASE_ENTRY();
    LAS float* cact = (LAS float*)ldsb;
    LAS float* red = (LAS float*)(ldsb + 16384);
    for (int i = tid; i < 4096; i += NTHREADS) cact[i] = silu_f(INF(1)[i]);
    __syncthreads();
    float* mod = WSP(float, WS_MOD);
    for (int g = vcu; g < 416; g += GRID) {
        const int col = g * 64 + lane; const float* W; int N, cc; const float* bias; float* dst; int dstride;
        if (col < 24576) { const int l = col / 6144; cc = col - l * 6144; W = INF(3) + (size_t)l * 1024 * 6144; N = 6144; bias = INF(4) + l * 6144; dst = mod + (size_t)l * 4 * 6144; dstride = 6144; }
        else { cc = col - 24576; W = INF(9); N = 2048; bias = INF(10); dst = mod + 4 * 4 * 6144; dstride = 2048; }
        float a0 = 0.f, a1 = 0.f, a2 = 0.f, a3 = 0.f;
        const float* wp = W + (size_t)(wave * 128) * N + cc;
#pragma unroll 16
        for (int k = 0; k < 128; ++k) { const float w = wp[(size_t)k * N]; const int kk = wave * 128 + k; a0 += cact[kk] * w; a1 += cact[1024 + kk] * w; a2 += cact[2048 + kk] * w; a3 += cact[3072 + kk] * w; }
        red[(wave * 4 + 0) * 64 + lane] = a0; red[(wave * 4 + 1) * 64 + lane] = a1; red[(wave * 4 + 2) * 64 + lane] = a2; red[(wave * 4 + 3) * 64 + lane] = a3;
        __syncthreads();
        if (tid < 256) { const int b = tid >> 6, ln = tid & 63; float s = 0.f;
#pragma unroll
            for (int w = 0; w < 8; ++w) s += red[(w * 4 + b) * 64 + ln];
            const int c2 = g * 64 + ln; const int cc2 = c2 < 24576 ? c2 % 6144 : c2 - 24576;
            dst[(size_t)b * dstride + cc2] = s + bias[cc2]; }
        __syncthreads();
    }
    LAS float* scr = (LAS float*)(ldsb + wave * 16384);
    const int gw = vcu * NWAVES + wave, NGW = GRID * NWAVES;
    constexpr int NIT = 8544 + 64 * 768;
    for (int it = gw; it < NIT; it += NGW) {
        if (it < 6144) { const int l = it / 3072, r = it % 3072, kb = r / 192, nb = r % 192;
            transpose_block(INF(7) + (size_t)l * 1024 * 6144, 6144, 64 * kb, 32 * nb, WSP(bf16_t, WS_WIN) + (size_t)l * 6144 * 1024, 1024, 32 * nb, scr, lane);
            transpose_block_f8(INF(7) + (size_t)l * 1024 * 6144, 6144, 64 * kb, 32 * nb, WSP(unsigned char, WS_WIN8) + (size_t)l * 6144 * 1024, 1024, 32 * nb, 64.0f, scr, lane); }
        else if (it < 8192) { const int r0 = it - 6144, l = r0 / 1024, r = r0 % 1024, kb = r / 32, nb = r % 32;
            transpose_block_f8(INF(8) + (size_t)l * 2048 * 1024, 1024, 64 * kb, 32 * nb, WSP(unsigned char, WS_WOUT8) + (size_t)l * 1024 * 2048, 2048, 32 * nb, 64.0f, scr, lane);
            transpose_block(INF(8) + (size_t)l * 2048 * 1024, 1024, 64 * kb, 32 * nb, WSP(bf16_t, WS_WOUT) + (size_t)l * 1024 * 2048, 2048, 32 * nb, scr, lane); }
        else if (it < 8448) { const int r0 = it - 8192, j = r0 / 128, r = r0 % 128, kb = r / 8, nb = r % 8;
            transpose_block_f8(INF(15) + (size_t)j * 1024 * 256, 256, 64 * kb, 32 * nb, WSP(unsigned char, WS_WQA8) + (size_t)j * 256 * 1024, 1024, 32 * nb, 64.0f, scr, lane);
            transpose_block(INF(15) + (size_t)j * 1024 * 256, 256, 64 * kb, 32 * nb, WSP(bf16_t, WS_WQA) + (size_t)j * 256 * 1024, 1024, 32 * nb, scr, lane); }
        else if (it < 8544) { const int r = it - 8448, kb = r / 6, nb = r % 6;
            transpose_block(INF(12), 192, 64 * kb, 32 * nb, WSP(bf16_t, WS_WKVA), 1024, 32 * nb, scr, lane); }
        else { const int r0 = it - 8544, le = r0 / 768, r = r0 % 768;
            if (r < 512) { const int up = r >> 8, rr = r & 255, kb = rr / 16, nb = rr % 16, n0 = 32 * nb;
                transpose_block_f8((up ? INF(22) : INF(21)) + (size_t)le * 1024 * 512, 512, 64 * kb, n0, WSP(unsigned char, WS_WGU) + (size_t)le * 1024 * 1024, 1024, (n0 >> 7) * 256 + (n0 & 127) + up * 128, 64.0f, scr, lane); }
            else { const int rr = r - 512, kb = rr / 32, nb = rr % 32;
                transpose_block_f8(INF(23) + (size_t)le * 512 * 1024, 1024, 64 * kb, 32 * nb, WSP(unsigned char, WS_WDN) + (size_t)le * 1024 * 512, 512, 32 * nb, 64.0f, scr, lane); } }
    }
    const int gt = vcu * NTHREADS + tid, NGT = GRID * NTHREADS;
    for (int i = gt; i < 64 * 1024 / 8; i += NGT) *(u32x4*)(WSP(bf16_t, WS_WKVA) + 192 * 1024 + (size_t)i * 8) = (u32x4){0u, 0u, 0u, 0u};
    for (int i = gt; i < 2 * 1536 * 256; i += NGT) {
        const int k = i & 255, n = (i >> 8) % 1536, j = i / (1536 * 256);
        const float* wq = INF(17) + ((size_t)j * 256 + k) * 1536; float v;
        if (n < 1024) { const int head = n >> 7, cdim = n & 127; const float* a = wq + head * QKD; const float* b = INF(14) + (size_t)cdim * 2048 + head * 256; float s = 0.f;
#pragma unroll 8
            for (int d = 0; d < 128; d += 4) { const f32x4 av = *(const f32x4*)(a + d), bv = *(const f32x4*)(b + d); s += av[0] * bv[0] + av[1] * bv[1] + av[2] * bv[2] + av[3] * bv[3]; }
            v = s; }
        else { const int np = (n - 1024) & 255, pn = (n - 1024) >> 8, half = np >> 7, wcc = (np & 127) >> 5, ii = np & 31; v = wq[(4 * pn + wcc) * QKD + 128 + half * 32 + ii]; }
        v *= INF(16)[j * 256 + k];
        WSP(bf16_t, WS_WQB)[i] = (bf16_t)(cvt_pk_bf16(v, 0.f) & 0xffffu);
    }
    for (int it = vcu * NWAVES + wave; it < 2 * 8 * 16 * 4; it += GRID * NWAVES) {
        const int nq = it & 3, cb = (it >> 2) & 15, hh = (it >> 6) & 7, j = it >> 9, n0 = nq * 256 + 4 * lane, c0 = cb * 8;
        const float* a = INF(14) + (size_t)c0 * 2048 + hh * 256 + 128; const float* bq = INF(18) + ((size_t)j * 1024 + hh * 128) * 1024 + n0;
        f32x4 acc[8];
#pragma unroll
        for (int c = 0; c < 8; ++c) acc[c] = (f32x4){0.f, 0.f, 0.f, 0.f};
#pragma unroll 4
        for (int v = 0; v < 128; ++v) { const f32x4 bv = *(const f32x4*)(bq + (size_t)v * 1024);
#pragma unroll
            for (int c = 0; c < 8; ++c) acc[c] = acc[c] + bv * a[(size_t)c * 2048 + v]; }
        bf16_t* o = WSP(bf16_t, WS_WO) + ((size_t)j * 1024 + n0) * 1024 + hh * 128 + c0;
#pragma unroll
        for (int q = 0; q < 4; ++q) { u32x4 w; w.x = cvt_pk_bf16(acc[0][q], acc[1][q]); w.y = cvt_pk_bf16(acc[2][q], acc[3][q]); w.z = cvt_pk_bf16(acc[4][q], acc[5][q]); w.w = cvt_pk_bf16(acc[6][q], acc[7][q]);
            *(u32x4*)(o + (size_t)q * 1024) = w;
            u32x2 w8; w8.x = pk4_fp8(64.f * acc[0][q], 64.f * acc[1][q], 64.f * acc[2][q], 64.f * acc[3][q]); w8.y = pk4_fp8(64.f * acc[4][q], 64.f * acc[5][q], 64.f * acc[6][q], 64.f * acc[7][q]);
            *(u32x2*)(WSP(unsigned char, WS_WO8) + ((size_t)j * 1024 + n0 + q) * 1024 + hh * 128 + c0) = w8; }
    }
}

__device__ __forceinline__ void moe_tile_prefix(Ctx& C, int l) {
    PHASE_ENTRY();
    LAS int* tab = (LAS int*)(ldsb + LDS_TAB);
    if (tid == 0) { int acc = 0;
        for (int e = 0; e < 16; ++e) { const int n = (int)__hip_atomic_load(CTLP + CW_CNT + 64 * l + e, __ATOMIC_RELAXED, __HIP_MEMORY_SCOPE_AGENT); tab[e] = n; tab[16 + e] = acc; acc += (n + 255) >> 8; }
        tab[32] = acc; }
    __syncthreads();
}
__device__ __forceinline__ void store_fp8_row(unsigned char* row, int lane, const f32x4 (&v)[4], float sc) {
#pragma unroll
    for (int j = 0; j < 4; ++j) *(unsigned*)(row + 4 * lane + 256 * j) = pk4_fp8(sc * v[j][0], sc * v[j][1], sc * v[j][2], sc * v[j][3]);
}
__device__ __forceinline__ void store_bf16_row(bf16_t* row, int lane, const f32x4 (&v)[4]) {
#pragma unroll
    for (int j = 0; j < 4; ++j) { u32x2 w; w.x = cvt_pk_bf16(v[j][0], v[j][1]); w.y = cvt_pk_bf16(v[j][2], v[j][3]); *(u32x2*)(row + 4 * lane + 256 * j) = w; }
}
__device__ __forceinline__ void moe_combine_row(const LAS int* tab, const unsigned* route, const bf16_t* yb, int lane, int tok, const f32x4 (&G2)[4], f32x4 (&v)[4]) {
    const u32x4 rt = *(const u32x4*)(route + (size_t)tok * 4);
    const int e0 = rt.x >> 15, p0 = rt.x & 32767, e1 = rt.y >> 15, p1 = rt.y & 32767; const float w0 = __uint_as_float(rt.z), w1 = __uint_as_float(rt.w);
    const bf16_t* y0 = yb + (size_t)(tab[16 + e0] * 256 + p0) * DM; const bf16_t* y1 = yb + (size_t)(tab[16 + e1] * 256 + p1) * DM;
#pragma unroll
    for (int j = 0; j < 4; ++j) { const u32x2 a = *(const u32x2*)(y0 + 4 * lane + 256 * j), b = *(const u32x2*)(y1 + 4 * lane + 256 * j);
        v[j][0] += G2[j][0] * (w0 * bflo(a.x) + w1 * bflo(b.x)); v[j][1] += G2[j][1] * (w0 * bfhi(a.x) + w1 * bfhi(b.x));
        v[j][2] += G2[j][2] * (w0 * bflo(a.y) + w1 * bflo(b.y)); v[j][3] += G2[j][3] * (w0 * bfhi(a.y) + w1 * bfhi(b.y)); }
}
__device__ __forceinline__ float row_rstd(const f32x4 (&v)[4]) {
    float s = 0.f;
#pragma unroll
    for (int j = 0; j < 4; ++j) s += (v[j][0] * v[j][0] + v[j][1] * v[j][1]) + (v[j][2] * v[j][2] + v[j][3] * v[j][3]);
    return __builtin_amdgcn_rsqf(wave_sum(s) * (1.0f / DM) + EPS);
}
__device__ __forceinline__ void phase_norm_a(Ctx& C, int l, int rep = 0) {
    PHASE_ENTRY(); const int b = vcu >> 6; const float* mod = WSP(float, WS_MOD);
    const float* xin = INF(0); float* hout = OUTP; bf16_t* xnp = WSP(bf16_t, WS_XN); unsigned char* xn8p = WSP(unsigned char, WS_XN8); bf16_t* hnp = WSP(bf16_t, WS_HN); const unsigned* route = WSP(unsigned, WS_ROUTE); const bf16_t* ybp = WSP(bf16_t, WS_YB);
    f32x4 Am[4], Bm[4], G2[4], Ak[4], Bk[4];
#pragma unroll
    for (int j = 0; j < 4; ++j) { const int c = 4 * lane + 256 * j;
        if (l < 4) { const float* ml = mod + (size_t)(l * 4 + b) * 6144; const f32x4 g = *(const f32x4*)(INF(5) + l * DM + c), sc = *(const f32x4*)(ml + 1024 + c); Am[j] = g * (1.0f + sc); Bm[j] = *(const f32x4*)(ml + c); }
        else { Am[j] = *(const f32x4*)(INF(24) + c); Bm[j] = (f32x4){0.f, 0.f, 0.f, 0.f}; }
        if (l > 0 && !rep) G2[j] = *(const f32x4*)(mod + (size_t)((l - 1) * 4 + b) * 6144 + 5 * 1024 + c); else G2[j] = (f32x4){0.f, 0.f, 0.f, 0.f};
        if (l == 2) { const float* mk = mod + 4 * 4 * 6144 + b * 2048; const f32x4 g = *(const f32x4*)(INF(11) + c), sc = *(const f32x4*)(mk + 1024 + c); Ak[j] = g * (1.0f + sc); Bk[j] = *(const f32x4*)(mk + c); }
        else { Ak[j] = Am[j]; Bk[j] = Bm[j]; } }
    if (l > 0) moe_tile_prefix(C, l - 1);
    for (int rr = 0; rr < 16; ++rr) {
        const int tok = vcu * 128 + wave * 16 + rr; f32x4 v[4];
        const float* src = (l == 0 ? xin : hout) + (size_t)tok * DM;
#pragma unroll
        for (int j = 0; j < 4; ++j) v[j] = *(const f32x4*)(src + 4 * lane + 256 * j);
        if (l > 0) moe_combine_row((const LAS int*)(ldsb + LDS_TAB), route, ybp, lane, tok, G2, v);
        const float rstd = row_rstd(v);
        if (l < 4) {
#pragma unroll
            for (int j = 0; j < 4; ++j) *(f32x4*)(hout + (size_t)tok * DM + 4 * lane + 256 * j) = v[j];
            f32x4 o[4];
#pragma unroll
            for (int j = 0; j < 4; ++j) o[j] = v[j] * rstd * Am[j] + Bm[j];
            store_bf16_row(xnp + (size_t)tok * DM, lane, o); store_fp8_row(xn8p + (size_t)tok * DM, lane, o, 4.0f);
            if (l == 2) {
#pragma unroll
                for (int j = 0; j < 4; ++j) o[j] = v[j] * rstd * Ak[j] + Bk[j];
                store_bf16_row(hnp + (size_t)tok * DM, lane, o); }
        } else {
#pragma unroll
            for (int j = 0; j < 4; ++j) *(f32x4*)(hout + (size_t)tok * DM + 4 * lane + 256 * j) = v[j] * rstd * Am[j];
        }
    }
}
constexpr int NBR = 4;
template <int CTRL> __device__ __forceinline__ float dpp_add(float v) { return v + dpp_f<CTRL>(v); }
__device__ __forceinline__ void phase_norm_b(Ctx& C, int l) {
    PHASE_ENTRY(); const int b = vcu >> 6; const float* ml = WSP(float, WS_MOD) + (size_t)(l * 4 + b) * 6144;
    const float* hin = OUTP; bf16_t* xnp = WSP(bf16_t, WS_XN);
    LAS float* wrT = (LAS float*)ldsb;
    LAS float* lgt = (LAS float*)(ldsb + 65536);
    LAS int* rec_e = (LAS int*)(ldsb + 65536 + 8192);
    LAS float* rec_w = (LAS float*)(ldsb + 65536 + 8192 + 1024);
    LAS int* rec_p = (LAS int*)(ldsb + 65536 + 8192 + 2048);
    LAS int* lcnt = (LAS int*)(ldsb + 65536 + 8192 + 3072);
    LAS int* gbase = (LAS int*)(ldsb + 65536 + 8192 + 3072 + 64);
    for (int i = tid; i < 4096; i += NTHREADS) { const f32x4 w = *(const f32x4*)(INF(19) + (size_t)i * 4); const int col = i >> 2, e4 = (i & 3) * 4;
        wrT[(e4 + 0) * 1024 + col] = w[0]; wrT[(e4 + 1) * 1024 + col] = w[1]; wrT[(e4 + 2) * 1024 + col] = w[2]; wrT[(e4 + 3) * 1024 + col] = w[3]; }
    if (tid < 16) lcnt[tid] = 0;
    f32x4 Am[4], Bm[4];
#pragma unroll
    for (int j = 0; j < 4; ++j) { const int c = 4 * lane + 256 * j; const f32x4 g = *(const f32x4*)(INF(6) + l * DM + c), sc = *(const f32x4*)(ml + 4 * 1024 + c); Am[j] = g * (1.0f + sc); Bm[j] = *(const f32x4*)(ml + 3 * 1024 + c); }
    const float* hrow = hin + (size_t)(vcu * 128 + wave * 16) * DM + 4 * lane;
    __syncthreads();
#pragma unroll 1
    for (int g = 0; g < 16 / NBR; ++g) {
        asm volatile("" ::: "memory");
        f32x4 v[NBR][4];
#pragma unroll
        for (int i = 0; i < NBR; ++i)
#pragma unroll
            for (int j = 0; j < 4; ++j) v[i][j] = *(const f32x4*)(hrow + (size_t)(g * NBR + i) * DM + 256 * j);
#pragma unroll
        for (int i = 0; i < NBR; ++i) { const float rstd = row_rstd(v[i]);
#pragma unroll
            for (int j = 0; j < 4; ++j) v[i][j] = v[i][j] * rstd * Am[j] + Bm[j];
            { unsigned char* xr = (unsigned char*)xnp + (size_t)(vcu * 128 + wave * 16 + g * NBR + i) * DM;
#pragma unroll
              for (int j = 0; j < 4; ++j) *(unsigned*)(xr + 4 * lane + 256 * j) = pk4_fp8(4.0f * v[i][j][0], 4.0f * v[i][j][1], 4.0f * v[i][j][2], 4.0f * v[i][j][3]); } }
        float p[NBR][16];
#pragma unroll
        for (int e = 0; e < 16; ++e) { f32x4 w[4];
#pragma unroll
            for (int j = 0; j < 4; ++j) w[j] = *(const LAS f32x4*)(wrT + e * 1024 + 4 * lane + 256 * j);
#pragma unroll
            for (int i = 0; i < NBR; ++i) { float a = 0.f;
#pragma unroll
                for (int j = 0; j < 4; ++j) a += (v[i][j][0] * w[j][0] + v[i][j][1] * w[j][1]) + (v[i][j][2] * w[j][2] + v[i][j][3] * w[j][3]);
                p[i][e] = a; asm volatile("" : "+v"(p[i][e])); }
            __builtin_amdgcn_sched_barrier(0); }
#pragma unroll
        for (int i = 0; i < NBR; ++i) {
            float q[8], r[4];
#pragma unroll
            for (int k = 0; k < 8; ++k) { auto t = __builtin_amdgcn_permlane32_swap(__float_as_uint(p[i][k]), __float_as_uint(p[i][k + 8]), false, false); q[k] = __uint_as_float(t[0]) + __uint_as_float(t[1]); }
#pragma unroll
            for (int k = 0; k < 4; ++k) { auto t = __builtin_amdgcn_permlane16_swap(__float_as_uint(q[k]), __float_as_uint(q[k + 4]), false, false); r[k] = __uint_as_float(t[0]) + __uint_as_float(t[1]); }
#pragma unroll
            for (int k = 0; k < 4; ++k) { r[k] = dpp_add<0xB1>(r[k]); r[k] = dpp_add<0x4E>(r[k]); r[k] = dpp_add<0x141>(r[k]); r[k] = dpp_add<0x140>(r[k]); }
            if ((lane & 15) == 0) { const int rho = lane >> 4; *(LAS f32x4*)(lgt + (wave * 16 + g * NBR + i) * 16 + 4 * (rho & 1) + 8 * (rho >> 1)) = (f32x4){r[0], r[1], r[2], r[3]}; }
        }
    }
    LDS_WAIT();
    if (lane < 16) {
        const int rl = wave * 16 + lane; float sc[16], bs[16];
#pragma unroll
        for (int e4 = 0; e4 < 4; ++e4) { const f32x4 lg = *(const LAS f32x4*)(lgt + rl * 16 + e4 * 4); const f32x4 rbv = *(const f32x4*)(INF(20) + e4 * 4);
#pragma unroll
            for (int k = 0; k < 4; ++k) { sc[e4 * 4 + k] = 1.0f / (1.0f + __expf(-lg[k])); bs[e4 * 4 + k] = sc[e4 * 4 + k] + rbv[k]; } }
        float gs[4];
#pragma unroll
        for (int g = 0; g < 4; ++g) { const float a = bs[4 * g], bq = bs[4 * g + 1], c = bs[4 * g + 2], d = bs[4 * g + 3];
            const float h1 = fmaxf(a, bq), l1 = fminf(a, bq), h2 = fmaxf(c, d), l2 = fminf(c, d); gs[g] = fmaxf(h1, h2) + fmaxf(fminf(h1, h2), fmaxf(l1, l2)); }
        int gi = 0; float best = gs[0];
#pragma unroll
        for (int g = 1; g < 4; ++g) if (gs[g] > best) { best = gs[g]; gi = g; }
        float iv[4], uv[4];
#pragma unroll
        for (int k = 0; k < 4; ++k) { iv[k] = gi == 0 ? bs[k] : (gi == 1 ? bs[4 + k] : (gi == 2 ? bs[8 + k] : bs[12 + k])); uv[k] = gi == 0 ? sc[k] : (gi == 1 ? sc[4 + k] : (gi == 2 ? sc[8 + k] : sc[12 + k])); }
        int i1 = 0; float b1 = iv[0];
#pragma unroll
        for (int k = 1; k < 4; ++k) if (iv[k] > b1) { b1 = iv[k]; i1 = k; }
        int i2 = -1; float b2 = 0.f;
#pragma unroll
        for (int k = 0; k < 4; ++k) if (k != i1 && (i2 < 0 || iv[k] > b2)) { b2 = iv[k]; i2 = k; }
        const float u1 = i1 == 0 ? uv[0] : (i1 == 1 ? uv[1] : (i1 == 2 ? uv[2] : uv[3])), u2 = i2 == 0 ? uv[0] : (i2 == 1 ? uv[1] : (i2 == 2 ? uv[2] : uv[3]));
        const float rs = 1.0f / (u1 + u2);
        rec_e[rl * 2] = gi * 4 + i1; rec_e[rl * 2 + 1] = gi * 4 + i2; rec_w[rl * 2] = u1 * rs; rec_w[rl * 2 + 1] = u2 * rs;
    }
    __syncthreads();
    if (tid < 128) { rec_p[tid * 2] = atomicAdd((int*)&lcnt[rec_e[tid * 2]], 1); rec_p[tid * 2 + 1] = atomicAdd((int*)&lcnt[rec_e[tid * 2 + 1]], 1); }
    __syncthreads();
    if (tid < 16) gbase[tid] = (int)__hip_atomic_fetch_add(CTLP + CW_CNT + 64 * l + tid, (unsigned)lcnt[tid], __ATOMIC_RELAXED, __HIP_MEMORY_SCOPE_AGENT);
    __syncthreads();
    if (tid < 128) { const int tok = vcu * 128 + tid, e0 = rec_e[tid * 2], e1 = rec_e[tid * 2 + 1], p0 = gbase[e0] + rec_p[tid * 2], p1 = gbase[e1] + rec_p[tid * 2 + 1];
        int* idx = WSP(int, WS_IDX); idx[e0 * NTOK + p0] = tok; idx[e1 * NTOK + p1] = tok;
        *(u32x4*)(WSP(unsigned, WS_ROUTE) + (size_t)tok * 4) = (u32x4){(unsigned)(e0 << 15 | p0), (unsigned)(e1 << 15 | p1), __float_as_uint(rec_w[tid * 2]), __float_as_uint(rec_w[tid * 2 + 1])}; }
    __syncthreads();
}
__device__ __forceinline__ void phase_prefix(Ctx& C) {
    PHASE_ENTRY(); const int g = vcu * NTHREADS + tid, dkv = g & 31, v = (g >> 5) & 511, bh = g >> 14, h = bh & 3;
    const float gam = __builtin_amdgcn_exp2f(log2_gamma(h)), gam256 = __builtin_amdgcn_exp2f(256.0f * log2_gamma(h));
    bf16_t* p = WSP(bf16_t, WS_B2T) + (size_t)bh * 32 * 262144 + (size_t)v * 512 + dkv * 8;
    float s[8];
#pragma unroll
    for (int k = 0; k < 8; ++k) s[k] = 0.f;
    for (int c0 = 0; c0 < 32; c0 += 4) {
        u32x4 kv[4];
#pragma unroll
        for (int i = 0; i < 4; ++i) kv[i] = *(const u32x4*)(p + (size_t)(c0 + i) * 262144);
#pragma unroll
        for (int i = 0; i < 4; ++i) {
            u32x4 o; o.x = cvt_pk_bf16(s[0] * gam, s[1] * gam); o.y = cvt_pk_bf16(s[2] * gam, s[3] * gam); o.z = cvt_pk_bf16(s[4] * gam, s[5] * gam); o.w = cvt_pk_bf16(s[6] * gam, s[7] * gam);
            *(u32x4*)(p + (size_t)(c0 + i) * 262144) = o;
            s[0] = s[0] * gam256 + bflo(kv[i].x); s[1] = s[1] * gam256 + bfhi(kv[i].x); s[2] = s[2] * gam256 + bflo(kv[i].y); s[3] = s[3] * gam256 + bfhi(kv[i].y);
            s[4] = s[4] * gam256 + bflo(kv[i].z); s[5] = s[5] * gam256 + bfhi(kv[i].z); s[6] = s[6] * gam256 + bflo(kv[i].w); s[7] = s[7] * gam256 + bfhi(kv[i].w); }
    }
}
__device__ __forceinline__ void phase_kvfin(Ctx& C) {
    PHASE_ENTRY(); const float* akv = WSP(float, WS_AKV); bf16_t* kpp = WSP(bf16_t, WS_KP); const int* posp = INI(2); const float g0 = INF(13)[2 * lane], g1 = INF(13)[2 * lane + 1];
    const float inv = __builtin_amdgcn_exp2f(-(float)(lane & 31) * (LOG2_THETA / 32.0f));
    for (int rr = 0; rr < 16; ++rr) {
        const int tok = vcu * 128 + wave * 16 + rr; const float* a = akv + (size_t)tok * 256; bf16_t* kp = kpp + (size_t)tok * QKD;
        const f32x2 cv = *(const f32x2*)(a + 2 * lane); const float rstd = __builtin_amdgcn_rsqf(wave_sum(cv[0] * cv[0] + cv[1] * cv[1]) * (1.0f / 128.0f) + EPS);
        *(unsigned*)(kp + 2 * lane) = cvt_pk_bf16(cv[0] * rstd * g0, cv[1] * rstd * g1);
        const float x1 = a[128 + (lane & 31)], x2 = a[160 + (lane & 31)]; float s, c; sincos_rad((float)posp[tok] * inv, s, c);
        const float o = lane < 32 ? x1 * c - x2 * s : x1 * s + x2 * c;
        kp[128 + lane] = (bf16_t)(cvt_pk_bf16(o, 0.f) & 0xffffu);
    }
}
namespace att {
constexpr int SHM_V = 16384, SHM_K = 24576, OFF_V = 0, OFF_K = 2 * SHM_V, OFF_WS = OFF_K + 2 * SHM_K, OFF_Q = OFF_WS + 2048;
constexpr float THR = 8.0f;
#define KSWZ(row, colB) ((row) * 384 + ((colB) ^ ((((row) >> 1) & 7) << 4)))
#define SBAR() __builtin_amdgcn_sched_barrier(0)
__device__ __forceinline__ int crow(int r, int hi) { return (r & 3) + 8 * (r >> 2) + 4 * hi; }
__device__ __forceinline__ void partialSM(f32x16& p0, f32x16& p1, float& m_reg, float& mn, float& alpha) {
    float pmax = p0[0];
#pragma unroll
    for (int r = 1; r < 16; ++r) pmax = fmaxf(pmax, p0[r]);
#pragma unroll
    for (int r = 0; r < 16; ++r) pmax = fmaxf(pmax, p1[r]);
    { auto rr = __builtin_amdgcn_permlane32_swap(__float_as_uint(pmax), __float_as_uint(pmax), false, false); pmax = fmaxf(__uint_as_float(rr[0]), __uint_as_float(rr[1])); }
    if (__builtin_expect(__all(pmax - m_reg <= THR), 1)) { mn = m_reg; alpha = 1.f; }
    else { mn = fmaxf(m_reg, pmax); alpha = __builtin_amdgcn_exp2f(m_reg - mn); m_reg = mn; }
#pragma unroll
    for (int r = 0; r < 16; ++r) p0[r] = p0[r] - mn;
#pragma unroll
    for (int r = 0; r < 16; ++r) p1[r] = p1[r] - mn;
#pragma unroll
    for (int r = 0; r < 16; ++r) p0[r] = __builtin_amdgcn_exp2f(p0[r]);
}
__device__ __forceinline__ void finishSM(f32x16& p0, f32x16& p1, float alpha, float& l_reg, bf16x8& pa0, bf16x8& pa1, bf16x8& pa2, bf16x8& pa3) {
#pragma unroll
    for (int r = 0; r < 16; ++r) p1[r] = __builtin_amdgcn_exp2f(p1[r]);
    float ps = 0;
#pragma unroll
    for (int r = 0; r < 16; ++r) ps += p0[r];
#pragma unroll
    for (int r = 0; r < 16; ++r) ps += p1[r];
    { auto rr = __builtin_amdgcn_permlane32_swap(__float_as_uint(ps), __float_as_uint(ps), false, false); ps = __uint_as_float(rr[0]) + __uint_as_float(rr[1]); }
    l_reg = l_reg * alpha + ps;
#define PK4(P, BASE, OUT) do { unsigned a0 = cvt_pk_bf16(P[BASE + 0], P[BASE + 1]), a1 = cvt_pk_bf16(P[BASE + 2], P[BASE + 3]);   \
    unsigned b0 = cvt_pk_bf16(P[BASE + 4], P[BASE + 5]), b1 = cvt_pk_bf16(P[BASE + 6], P[BASE + 7]);                              \
    auto r0 = __builtin_amdgcn_permlane32_swap(a0, b0, false, false); auto r1 = __builtin_amdgcn_permlane32_swap(a1, b1, false, false); \
    u32x4 w = {r0[0], r1[0], r0[1], r1[1]}; OUT = *reinterpret_cast<bf16x8*>(&w); } while (0)
    PK4(p0, 0, pa0); PK4(p0, 8, pa1); PK4(p1, 0, pa2); PK4(p1, 8, pa3);
#undef PK4
}
template <int BUF> __device__ __forceinline__ void qkt(f32x16& p0, f32x16& p1, const LAS char* const (&kb4)[4], const bf16x8* qr, const LAS char* ql) {
    p0 = f32x16{}; p1 = f32x16{};
#pragma unroll
    for (int d0 = 0; d0 < 12; ++d0) {
        const bf16x8 b0 = *reinterpret_cast<const LAS bf16x8*>(kb4[d0 & 3] + BUF * SHM_K + (d0 >> 2) * 128);
        const bf16x8 b1 = *reinterpret_cast<const LAS bf16x8*>(kb4[d0 & 3] + BUF * SHM_K + (d0 >> 2) * 128 + 32 * 384);
        const bf16x8 qf = d0 < 8 ? qr[d0 < 8 ? d0 : 0] : *reinterpret_cast<const LAS bf16x8*>(ql + (d0 - 8) * 1024);
        p0 = __builtin_amdgcn_mfma_f32_32x32x16_bf16(b0, qf, p0, 0, 0, 0);
        p1 = __builtin_amdgcn_mfma_f32_32x32x16_bf16(b1, qf, p1, 0, 0, 0); }
}
__device__ __forceinline__ int v_st(int k, int c) { const int kk = (k & ~0xC) | ((k & 4) << 1) | ((k & 8) >> 1); return ((kk >> 3) * 4 + (c >> 5)) * 512 + ((kk & 7) * 32 + (c & 31)) * 2; }
__device__ __forceinline__ int v_rd_base(int lane) { return ((lane & 3) << 3) | (((lane >> 2) & 3) << 6) | (((lane >> 4) & 1) << 5) | (((lane >> 5) & 1) << 8); }
constexpr int v_rd_off(int d0, int ks, int half) { return d0 * 512 + ks * 4096 + half * 2048; }
template <int OFF> __device__ __forceinline__ s16x4 tr_read(int vb) { s16x4 r; asm volatile("ds_read_b64_tr_b16 %0, %1 offset:%2" : "=&v"(r) : "v"(vb), "i"(OFF) : "memory"); return r; }
template <int D0> __device__ __forceinline__ void pv_one(f32x16& od, int vb, bf16x8 pa0, bf16x8 pa1, bf16x8 pa2, bf16x8 pa3) {
    const s16x4 l0 = tr_read<v_rd_off(D0, 0, 0)>(vb), h0 = tr_read<v_rd_off(D0, 0, 1)>(vb), l1 = tr_read<v_rd_off(D0, 1, 0)>(vb), h1 = tr_read<v_rd_off(D0, 1, 1)>(vb);
    const s16x4 l2 = tr_read<v_rd_off(D0, 2, 0)>(vb), h2 = tr_read<v_rd_off(D0, 2, 1)>(vb), l3 = tr_read<v_rd_off(D0, 3, 0)>(vb), h3 = tr_read<v_rd_off(D0, 3, 1)>(vb);
    asm volatile("s_waitcnt lgkmcnt(0)" ::: "memory"); SBAR();
#define PK(L, H) (bf16x8){L[0], L[1], L[2], L[3], H[0], H[1], H[2], H[3]}
    od = __builtin_amdgcn_mfma_f32_32x32x16_bf16(pa0, PK(l0, h0), od, 0, 0, 0);
    od = __builtin_amdgcn_mfma_f32_32x32x16_bf16(pa1, PK(l1, h1), od, 0, 0, 0);
    od = __builtin_amdgcn_mfma_f32_32x32x16_bf16(pa2, PK(l2, h2), od, 0, 0, 0);
    od = __builtin_amdgcn_mfma_f32_32x32x16_bf16(pa3, PK(l3, h3), od, 0, 0, 0);
#undef PK
}
__device__ __forceinline__ void pv_d0(f32x16* o, int vb, bf16x8 pa0, bf16x8 pa1, bf16x8 pa2, bf16x8 pa3) {
    pv_one<0>(o[0], vb, pa0, pa1, pa2, pa3); pv_one<1>(o[1], vb, pa0, pa1, pa2, pa3); pv_one<2>(o[2], vb, pa0, pa1, pa2, pa3); pv_one<3>(o[3], vb, pa0, pa1, pa2, pa3);
}
template <bool O8> __device__ __forceinline__ void attn_unit(const bf16_t* __restrict__ Q, const bf16_t* __restrict__ Kp, bf16_t* __restrict__ O, int t0, int kbase, int nt_real, LAS char* lds, int wid) {
    int lane_ = (int)__builtin_amdgcn_mbcnt_hi(~0u, __builtin_amdgcn_mbcnt_lo(~0u, 0u)); asm volatile("" : "+v"(lane_));
    const int lane = lane_, tid = wid * 64 + lane, r32 = lane & 31, hi = lane >> 5;
    LAS char* V_lds = lds + OFF_V; LAS char* K_lds = lds + OFF_K;
    LAS float* ws = (LAS float*)(lds + OFF_WS) + wid * 64; LAS float* li_l = ws; LAS float* al_l = ws + 32;
    float m_reg = -1e30f, l_reg = 0; f32x16 o[4] = {}; bf16x8 qr[8];
    LAS char* qlds = lds + OFF_Q + wid * 4096 + lane * 16;
    const char* Qs = (const char*)Q + (size_t)t0 * 3072 + wid * (QKD * 2); const unsigned qlo = (unsigned)(r32 * 3072 + hi * 16);
#pragma unroll
    for (int d0 = 0; d0 < 8; ++d0) qr[d0] = *reinterpret_cast<const bf16x8*>(Qs + qlo + d0 * 32);
    __syncthreads();
#pragma unroll
    for (int d0 = 8; d0 < 12; ++d0) *reinterpret_cast<LAS bf16x8*>(qlds + (d0 - 8) * 1024) = *reinterpret_cast<const bf16x8*>(Qs + qlo + d0 * 32);
    const int vb0 = (int)(uintptr_t)V_lds + v_rd_base(lane);
    const LAS char* kb4[4];
#pragma unroll
    for (int q = 0; q < 4; ++q) kb4[q] = K_lds + r32 * 384 + ((q * 32 + hi * 16) ^ (((r32 >> 1) & 7) << 4));
    const int NT = (nt_real + 1) & ~1;
    const bool dummy = (NT != nt_real);
    bf16x8 sr_[1][3];
    const char* Kg = (const char*)(Kp + (size_t)kbase * QKD);
#define SLOAD(s, kt) do { _Pragma("unroll") for (int i = 0; i < 3; ++i) sr_[s][i] = *reinterpret_cast<const bf16x8*>(Kg + (size_t)(kt) * SHM_K + i * 8192 + (unsigned)(tid * 16)); } while (0)
#define SWRITE(b, s) do { int tl_ = (int)__builtin_amdgcn_mbcnt_hi(~0u, __builtin_amdgcn_mbcnt_lo(~0u, 0u)); asm volatile("" : "+v"(tl_)); tl_ += wid * 64; _Pragma("unroll") for (int i = 0; i < 3; ++i) { const int p_ = tl_ + 512 * i, row_ = p_ / 24, c16_ = p_ - row_ * 24; \
        *(LAS bf16x8*)(K_lds + (b) * SHM_K + KSWZ(row_, c16_ * 16)) = sr_[s][i]; if (c16_ < 16) *(LAS bf16x8*)(V_lds + (b) * SHM_V + v_st(row_, c16_ * 8)) = sr_[s][i]; } } while (0)
#define SWAIT() asm volatile("s_waitcnt vmcnt(0)" ::: "memory")
#define RESC(a) do { if (__any((a) < 1.f)) { if (hi == 0) al_l[r32] = (a); asm volatile("s_waitcnt lgkmcnt(0)" ::: "memory"); \
    _Pragma("unroll") for (int d = 0; d < 4; ++d) _Pragma("unroll") for (int r = 0; r < 16; ++r) o[d][r] *= al_l[crow(r, hi)]; } } while (0)
    f32x16 pA0, pA1, pB0, pB1; float mnA, mnB, alA, alB; bf16x8 pa0, pa1, pa2, pa3;
    SLOAD(0, 0); SWAIT(); SWRITE(0, 0); __syncthreads();
    qkt<0>(pA0, pA1, kb4, qr, qlds); partialSM(pA0, pA1, m_reg, mnA, alA);
    SLOAD(0, 1); SWAIT(); SWRITE(1, 0); __syncthreads();
    for (int j = 1; j + 1 < NT; j += 2) {
        SBAR(); qkt<1>(pB0, pB1, kb4, qr, qlds);
        finishSM(pA0, pA1, alA, l_reg, pa0, pa1, pa2, pa3); SBAR();
        SLOAD(0, j + 1); SBAR();
        pv_d0(o, vb0, pa0, pa1, pa2, pa3); partialSM(pB0, pB1, m_reg, mnB, alB);
        __syncthreads(); SWAIT(); SWRITE(0, 0);
        RESC(alB); __syncthreads();
        SBAR(); qkt<0>(pA0, pA1, kb4, qr, qlds);
        finishSM(pB0, pB1, alB, l_reg, pa0, pa1, pa2, pa3); SBAR();
        SLOAD(0, j + 2); SBAR();
        pv_d0(o, vb0 + SHM_V, pa0, pa1, pa2, pa3); partialSM(pA0, pA1, m_reg, mnA, alA);
        __syncthreads(); SWAIT(); SWRITE(1, 0);
        RESC(alA); __syncthreads();
    }
    SBAR(); qkt<1>(pB0, pB1, kb4, qr, qlds);
    if (dummy) {
#pragma unroll
        for (int r = 0; r < 16; ++r) { pB0[r] = -INFINITY; pB1[r] = -INFINITY; } }
    finishSM(pA0, pA1, alA, l_reg, pa0, pa1, pa2, pa3); SBAR();
    pv_d0(o, vb0, pa0, pa1, pa2, pa3); partialSM(pB0, pB1, m_reg, mnB, alB);
    __syncthreads(); RESC(alB);
    finishSM(pB0, pB1, alB, l_reg, pa0, pa1, pa2, pa3); SBAR();
    pv_d0(o, vb0 + SHM_V, pa0, pa1, pa2, pa3);
    {
        int lanee = (int)__builtin_amdgcn_mbcnt_hi(~0u, __builtin_amdgcn_mbcnt_lo(~0u, 0u)); asm volatile("" : "+v"(lanee));
        const int wide = wid, r32e = lanee & 31, hie = lanee >> 5;
        LAS float* lie = (LAS float*)(lds + OFF_WS) + wide * 64;
        if (hie == 0) lie[r32e] = l_reg; asm volatile("s_waitcnt lgkmcnt(0)" ::: "memory");
        char* Os = (char*)O + (size_t)t0 * (O8 ? 1024 : 2048) + wide * (O8 ? 128 : 256); const unsigned olo = (unsigned)(r32e * (O8 ? 1 : 2));
#pragma unroll
        for (int r = 0; r < 16; ++r) { const int orow = crow(r, hie); const float rl = __builtin_amdgcn_rcpf(lie[orow]);
#pragma unroll
            for (int d0 = 0; d0 < 4; ++d0) { if constexpr (O8) *(unsigned char*)(Os + olo + (unsigned)(orow * 1024) + d0 * 32) = (unsigned char)(pk4_fp8(16.0f * o[d0][r] * rl, 0.f, 0.f, 0.f) & 0xffu);
                else *(bf16_t*)(Os + olo + (unsigned)(orow * 2048) + d0 * 64) = (bf16_t)(cvt_pk_bf16(o[d0][r] * rl, 0.f) & 0xffffu); } }
    }
#undef SLOAD
#undef SWRITE
#undef SWAIT
#undef RESC
}
}
struct Args { const void* in[25]; float* out; unsigned char* ws; int lo, hi, l, hf; };
enum { PH_PRO = 0, PH_NA, PH_R2, PH_R3, PH_R4, PH_R5, PH_R6, PH_R7, PH_M2, PH_M3, PH_M4, PH_M5, PH_NB, PH_MOE1, PH_MOE2, PH_COUNT };

__device__ __forceinline__ void make_ctx(Ctx& C, unsigned char* lds_raw) {
    C.ka = (kaptr_t)__builtin_amdgcn_kernarg_segment_ptr(); C.lds = (LAS unsigned char*)lds_raw;
    C.wave = __builtin_amdgcn_readfirstlane((int)threadIdx.x >> 6);
    { const int bx = blockIdx.x; C.vcu = (bx & 7) * (GRID / 8) + (bx >> 3); }
}

template <int PH> __device__ __forceinline__ void run_phase(Ctx& C, const int l, const int hf, const int rep = 0) {
    PHASE_ENTRY(); const int wv = wave;
    LAS unsigned char* lds = ldsb; int bid_ = blockIdx.x; asm volatile("" : "+s"(bid_)); const int bid = bid_; const unsigned LD1K = 2048u;
    const float* gate1 = rep ? (const float*)(WSB + WS_CTL + 512 * 1024) : WSP(float, WS_MOD) + (size_t)l * 4 * 6144 + 2 * 1024;
    const bf16_t* win = WSP(bf16_t, WS_WIN) + (size_t)(l & 1) * 6144 * 1024;
    const bf16_t* xnh = WSP(bf16_t, WS_XN) + (size_t)hf * THALF * DM;
    const int j = l & 1;
    if constexpr (PH == PH_PRO) phase_prologue(C);
    if constexpr (PH == PH_NA) phase_norm_a(C, l, rep);
    if constexpr (PH == PH_R2) {
        constexpr bool F8 = FP8_R2 != 0; constexpr unsigned LD = F8 ? 1024u : 2048u; constexpr int KP = F8 ? 512 : 1024; constexpr int SW = F8 ? 0x79797979 : 0x7f7f7f7f, SX = F8 ? 0x7d7d7d7d : 0x7f7f7f7f;
        const char* X = F8 ? (const char*)(WSP(unsigned char, WS_XN8) + (size_t)hf * THALF * DM) : (const char*)xnh;
        const char* W = F8 ? (const char*)(WSP(unsigned char, WS_WIN8) + (size_t)(l & 1) * 6144 * 1024) : (const char*)win;
        { SchedStd S; S.T.init(64, 4, GRID, bid); S.A = X; S.B = W; S.sA = 256 * LD; S.sB = 256 * LD;
          EpiRopeQK<0> E{WSP(bf16_t, WS_A2), INI(2), hf, nullptr}; pg8::gemm_phase<EpiRopeQK<0>, SchedStd, false, F8, SW, SX>(lds, wv, KP, LD, LD, S, E); }
        { SchedStd S; S.T.init(64, 4, GRID, bid); S.A = X; S.B = W + (size_t)1024 * LD; S.sA = 256 * LD; S.sB = 256 * LD;
          EpiRopeQK<1> E{WSP(bf16_t, WS_KR), INI(2), hf, WSP(bf16_t, WS_KT)}; pg8::gemm_phase<EpiRopeQK<1>, SchedStd, false, F8, SW, SX>(lds, wv, KP, LD, LD, S, E); }
        { SchedStd S; S.T.init(8, 64, GRID, bid); S.A = W + (size_t)2048 * LD; S.B = X; S.sA = 256 * LD; S.sB = 256 * LD;
          EpiVT E{WSP(bf16_t, WS_B2T)}; pg8::gemm_phase<EpiVT, SchedStd, false, F8, SW, SX>(lds, wv, KP, LD, LD, S, E); }
    }
    if constexpr (PH == PH_R3) {
        { SchedBatch S{(const char*)WSP(bf16_t, WS_A2), (const char*)WSP(bf16_t, WS_KR), 256 * 1024, 256 * 512, 0, 0, 256, 1, GRID, vcu};
          EpiS E{WSP(bf16_t, WS_A2)}; pg8::gemm_phase<EpiS, SchedBatch, false>(lds, wv, 256, 1024u, 512u, S, E); }
        { SchedBatch S{(const char*)(WSP(bf16_t, WS_B2T) + 256), (const char*)WSP(bf16_t, WS_KT), 512 * 1024, 256 * 512, 256 * 1024, 0, 256, 2, GRID, vcu};
          EpiKV E{WSP(bf16_t, WS_B2T)}; pg8::gemm_phase<EpiKV, SchedBatch, false>(lds, wv, 256, 1024u, 512u, S, E); }
    }
    if constexpr (PH == PH_R4) phase_prefix(C);
    if constexpr (PH == PH_R5) {
        SchedBatch S{(const char*)WSP(bf16_t, WS_A2), (const char*)WSP(bf16_t, WS_B2T), 256 * 1024, 512 * 1024, 0, 256 * 1024, 256, 2, GRID, vcu};
        EpiFin E{WSP(bf16_t, WS_B2T), WSP(float, WS_STATS)}; pg8::gemm_phase<EpiFin, SchedBatch, false>(lds, wv, 512, 1024u, 1024u, S, E);
    }
    if constexpr (PH == PH_R6) {
        constexpr bool F8 = FP8_R6 != 0; constexpr unsigned LD = F8 ? 1024u : 2048u; constexpr int KP = F8 ? 512 : 1024; constexpr int SW = F8 ? 0x79797979 : 0x7f7f7f7f, SX = F8 ? 0x7d7d7d7d : 0x7f7f7f7f;
        const char* X = F8 ? (const char*)(WSP(unsigned char, WS_XN8) + (size_t)hf * THALF * DM) : (const char*)xnh;
        const char* W = F8 ? (const char*)(WSP(unsigned char, WS_WIN8) + (size_t)(l & 1) * 6144 * 1024) : (const char*)win;
        SchedStd S; S.T.init(64, 8, GRID, bid); S.A = X; S.B = W + (size_t)4096 * LD; S.sA = 256 * LD; S.sB = 256 * LD;
        EpiGate<FP8_R7 != 0> E{WSP(bf16_t, WS_B2T), WSP(float, WS_STATS), WSP(bf16_t, WS_A2), WSP(unsigned char, WS_ACT8)}; pg8::gemm_phase<EpiGate<FP8_R7 != 0>, SchedStd, false, F8, SW, SX>(lds, wv, KP, LD, LD, S, E);
    }
    if constexpr (PH == PH_R7) {
        constexpr bool F8 = FP8_R7 != 0; constexpr unsigned LD = F8 ? 2048u : 4096u; constexpr int KP = F8 ? 1024 : 2048; constexpr int SW = F8 ? 0x79797979 : 0x7f7f7f7f, SX = F8 ? 0x7d7d7d7d : 0x7f7f7f7f;
        SchedStd S; S.T.init(64, 4, GRID, bid); S.A = F8 ? (const char*)WSP(unsigned char, WS_ACT8) : (const char*)WSP(bf16_t, WS_A2);
        S.B = F8 ? (const char*)(WSP(unsigned char, WS_WOUT8) + (size_t)l * 1024 * 2048) : (const char*)(WSP(bf16_t, WS_WOUT) + (size_t)l * 1024 * 2048); S.sA = 256 * LD; S.sB = 256 * LD;
        EpiResid E{OUTP, gate1, hf * THALF}; pg8::gemm_phase<EpiResid, SchedStd, false, F8, SW, SX>(lds, wv, KP, LD, LD, S, E);
    }
    if constexpr (PH == PH_M2) {
        { constexpr bool F8 = FP8_M2 != 0; constexpr unsigned LD = F8 ? 1024u : 2048u; constexpr int KP = F8 ? 512 : 1024; constexpr int SW = F8 ? 0x79797979 : 0x7f7f7f7f, SX = F8 ? 0x7d7d7d7d : 0x7f7f7f7f;
          SchedStd S; S.T.init(128, 1, GRID, bid); S.A = F8 ? (const char*)WSP(unsigned char, WS_XN8) : (const char*)WSP(bf16_t, WS_XN);
          S.B = F8 ? (const char*)(WSP(unsigned char, WS_WQA8) + (size_t)j * 256 * 1024) : (const char*)(WSP(bf16_t, WS_WQA) + (size_t)j * 256 * 1024); S.sA = 256 * LD; S.sB = 256 * LD;
          EpiQA E{WSP(bf16_t, WS_QA), WSP(float, WS_SSQ)}; pg8::gemm_phase<EpiQA, SchedStd, false, F8, SW, SX>(lds, wv, KP, LD, LD, S, E); }
        if (l == 2) { SchedStd S; S.T.init(128, 1, GRID, (bid + 128) & 255); S.A = (const char*)WSP(bf16_t, WS_HN); S.B = (const char*)WSP(bf16_t, WS_WKVA); S.sA = 256 * 2048; S.sB = 256 * 2048;
          EpiF32 E{WSP(float, WS_AKV)}; pg8::gemm_phase<EpiF32, SchedStd, false>(lds, wv, 1024, LD1K, LD1K, S, E); }
    }
    if constexpr (PH == PH_M3) {
        if (l == 2) phase_kvfin(C);
        SchedStd S; S.T.init(128, 6, GRID, bid); S.A = (const char*)WSP(bf16_t, WS_QA); S.B = (const char*)(WSP(bf16_t, WS_WQB) + (size_t)j * 1536 * 256); S.sA = 256 * 512; S.sB = 256 * 512;
        EpiQB E{WSP(bf16_t, WS_Q), WSP(float, WS_SSQ), INI(2)}; pg8::gemm_phase<EpiQB, SchedStd, false>(lds, wv, 256, 512u, 512u, S, E);
    }
    if constexpr (PH == PH_M4) {
        const int b = vcu >> 6, i = vcu & 63;
#pragma unroll 1
        for (int uq = 0; uq < 4; ++uq) { const int cch = (uq < 2) ? (127 - i) : i, half = uq & 1;
            att::attn_unit<FP8_M5 != 0>(WSP(bf16_t, WS_Q), WSP(bf16_t, WS_KP), FP8_M5 ? (bf16_t*)WSP(unsigned char, WS_ACT8) : WSP(bf16_t, WS_OL), b * SEQ + cch * 64 + half * 32, b * SEQ, cch + 1, (LAS char*)lds, wave); }
        __syncthreads();
    }
    if constexpr (PH == PH_M5) {
        constexpr bool F8 = FP8_M5 != 0; constexpr unsigned LD = F8 ? 1024u : 2048u; constexpr int KP = F8 ? 512 : 1024; constexpr int SW = F8 ? 0x79797979 : 0x7f7f7f7f, SX = F8 ? 0x7b7b7b7b : 0x7f7f7f7f;
        SchedStd S; S.T.init(128, 4, GRID, bid); S.A = F8 ? (const char*)WSP(unsigned char, WS_ACT8) : (const char*)WSP(bf16_t, WS_OL);
        S.B = F8 ? (const char*)(WSP(unsigned char, WS_WO8) + (size_t)j * 1024 * 1024) : (const char*)(WSP(bf16_t, WS_WO) + (size_t)j * 1024 * 1024); S.sA = 256 * LD; S.sB = 256 * LD;
        EpiResid E{OUTP, gate1, 0}; pg8::gemm_phase<EpiResid, SchedStd, false, F8, SW, SX>(lds, wv, KP, LD, LD, S, E);
    }
    if constexpr (PH == PH_NB) phase_norm_b(C, l);
    if constexpr (PH == PH_MOE1) {
        moe_tile_prefix(C, l);
        SchedMoE S{(const LAS int*)(lds + LDS_TAB), (const char*)WSP(unsigned char, WS_XN), (const char*)(WSP(unsigned char, WS_WGU) + (size_t)l * 16 * 1024 * 1024), (size_t)1024 * 1024, (size_t)256 * 1024, 0, WSP(int, WS_IDX), GRID, vcu, true};
        EpiGU8 E{WSP(unsigned char, WS_HDN)}; pg8::gemm_phase<EpiGU8, SchedMoE, true, true, 0x79797979, 0x7d7d7d7d>(lds, wv, 512, 1024u, 1024u, S, E);
    }
    if constexpr (PH == PH_MOE2) {
        moe_tile_prefix(C, l);
        SchedMoE S{(const LAS int*)(lds + LDS_TAB), (const char*)WSP(unsigned char, WS_HDN), (const char*)(WSP(unsigned char, WS_WDN) + (size_t)l * 16 * 1024 * 512), (size_t)1024 * 512, (size_t)256 * 512, (size_t)256 * 512, WSP(int, WS_IDX), GRID, vcu, false};
        EpiPlain E{WSP(bf16_t, WS_YB), 1024}; pg8::gemm_phase<EpiPlain, SchedMoE, false, true, 0x79797979, 0x7d7d7d7d>(lds, wv, 256, 512u, 512u, S, E);
    }
}

template <int PH> __global__ void __launch_bounds__(NTHREADS, 2) phase_kernel(Args args) {
    extern __shared__ __attribute__((aligned(16))) unsigned char lds_raw[];
    Ctx C; make_ctx(C, lds_raw); (void)args;
    run_phase<PH>(C, args.l, args.hf);
}
__global__ void __launch_bounds__(NTHREADS, 2) fwd_kernel(Args args) {
    extern __shared__ __attribute__((aligned(16))) unsigned char lds_raw[];
    Ctx C; make_ctx(C, lds_raw); (void)args;
    if (threadIdx.x < 64) ((LAS unsigned*)(C.lds + LDS_MISC))[threadIdx.x] = 0u;
    __syncthreads();
    XcdBarrier bar = xcd_barrier_post((unsigned*)((unsigned char*)args.ws + WS_CTL) + CW_BAR, (volatile LAS unsigned*)(C.lds + LDS_MISC));
#define SEAM() xcd_barrier(bar, C.wave)
#ifndef PROBE_PH
#define PROBE_PH -1
#define PROBE_N 0
#endif
#define RUNP(PH, l, hf) do { run_phase<PH>(C, l, hf); SEAM(); if constexpr (PH == PROBE_PH) { _Pragma("unroll 1") for (int rp_ = 0; rp_ < PROBE_N; ++rp_) { run_phase<PH>(C, l, hf, 1); SEAM(); } } } while (0)
    RUNP(PH_PRO, 0, 0);
    for (int l = 0; l < 4; ++l) {
        RUNP(PH_NA, l, 0);
        if (l < 2) {
            for (int hf = 0; hf < 2; ++hf) { RUNP(PH_R2, l, hf); RUNP(PH_R3, l, hf); RUNP(PH_R4, l, hf); RUNP(PH_R5, l, hf); RUNP(PH_R6, l, hf); RUNP(PH_R7, l, hf); }
        } else { RUNP(PH_M2, l, 0); RUNP(PH_M3, l, 0); RUNP(PH_M4, l, 0); RUNP(PH_M5, l, 0); }
        RUNP(PH_NB, l, 0); RUNP(PH_MOE1, l, 0); RUNP(PH_MOE2, l, 0);
    }
    run_phase<PH_NA>(C, 4, 0);
#undef RUNP
#undef SEAM
}

template <int PH> static void launch_phase(Args& a, int l, int hf, hipStream_t stream) {
    static bool attr = false;
    if (!attr) { (void)hipFuncSetAttribute((const void*)phase_kernel<PH>, hipFuncAttributeMaxDynamicSharedMemorySize, LDS_BYTES); attr = true; }
    a.l = l; a.hf = hf;
    hipLaunchKernelGGL(phase_kernel<PH>, dim3(GRID), dim3(NTHREADS), LDS_BYTES, stream, a);
}
extern "C" void kernel_launch(void* const* d_in, const int* in_sizes, int n_in, void* d_out, int out_size, void* d_ws, size_t ws_size, hipStream_t stream) {
    static int ok = 0;
    if (ok == 0) {
        if (n_in != 25 || out_size != NTOK * DM || ws_size < WS_END) { fprintf(stderr, "kernel_launch: unexpected problem (n_in %d, out %d, ws %zu < %zu)\n", n_in, out_size, ws_size, (size_t)WS_END); ok = -1; return; }
        int dev = 0, cus = 0;
        if (hipGetDevice(&dev) != hipSuccess || hipDeviceGetAttribute(&cus, hipDeviceAttributeMultiprocessorCount, dev) != hipSuccess || cus < GRID) { fprintf(stderr, "kernel_launch: needs %d CUs, device has %d\n", GRID, cus); ok = -1; return; }
        ok = 1;
    }
    if (ok < 0) return;
    (void)hipMemsetAsync((char*)d_ws + WS_CTL, 0, CTL_BYTES, stream);
    Args a{};
    for (int i = 0; i < 25; ++i) a.in[i] = d_in[i];
    a.out = (float*)d_out; a.ws = (unsigned char*)d_ws; a.lo = 0; a.hi = 0;
#if MK_SINGLE
    static bool attr = false;
    if (!attr) { (void)hipFuncSetAttribute((const void*)fwd_kernel, hipFuncAttributeMaxDynamicSharedMemorySize, LDS_BYTES); attr = true; }
    hipLaunchKernelGGL(fwd_kernel, dim3(GRID), dim3(NTHREADS), LDS_BYTES, stream, a);
    return;
#endif
    launch_phase<PH_PRO>(a, 0, 0, stream);
    for (int l = 0; l < 4; ++l) {
        launch_phase<PH_NA>(a, l, 0, stream);
        if (l < 2) {
            for (int hf = 0; hf < 2; ++hf) {
                launch_phase<PH_R2>(a, l, hf, stream); launch_phase<PH_R3>(a, l, hf, stream); launch_phase<PH_R4>(a, l, hf, stream);
                launch_phase<PH_R5>(a, l, hf, stream); launch_phase<PH_R6>(a, l, hf, stream); launch_phase<PH_R7>(a, l, hf, stream);
            }
        } else {
            launch_phase<PH_M2>(a, l, 0, stream); launch_phase<PH_M3>(a, l, 0, stream); launch_phase<PH_M4>(a, l, 0, stream); launch_phase<PH_M5>(a, l, 0, stream);
        }
        launch_phase<PH_NB>(a, l, 0, stream); launch_phase<PH_MOE1>(a, l, 0, stream); launch_phase<PH_MOE2>(a, l, 0, stream);
    }
    launch_phase<PH_NA>(a, 4, 0, stream);
}
```

```cpp
#include <hip/hip_runtime.h>
#include <cstdio>
#include <cstdint>

#ifndef MK_SINGLE
#define MK_SINGLE 1
#endif
#ifndef FP8_R2
#define FP8_R2 0
#define FP8_R6 1
#define FP8_R7 1
#define FP8_M2 0
#define FP8_M5 1
#endif
#ifndef MK_CHECK
#define MK_CHECK 0
#endif

#define GAS __attribute__((address_space(1)))
#define LAS __attribute__((address_space(3)))
typedef unsigned short bf16_t;
typedef short bf16x8 __attribute__((ext_vector_type(8)));
typedef short s16x4 __attribute__((ext_vector_type(4)));
typedef float f32x4 __attribute__((ext_vector_type(4)));
typedef float f32x2 __attribute__((ext_vector_type(2)));
typedef float f32x16 __attribute__((ext_vector_type(16)));
typedef unsigned u32x4 __attribute__((ext_vector_type(4)));
typedef unsigned u32x2 __attribute__((ext_vector_type(2)));

constexpr int NB = 4, SEQ = 8192, DM = 1024, NTOK = NB * SEQ, THALF = NTOK / 2;
constexpr int NEXP = 16, DEXP = 512;
constexpr int RH = 4, RDK = 256, RDV = 512, RV = 2048;
constexpr int MH = 8, QLORA = 256, KVL = 128, ROPE = 64, QKD = 192;
constexpr float EPS = 1e-6f;
constexpr int NWAVES = 8, NTHREADS = 512, GRID = 256;
constexpr int MAXSLOTS = 69632;

constexpr size_t MiB = 1u << 20;
constexpr size_t WS_CTL = 0, CTL_BYTES = 1 * MiB;
constexpr size_t WS_MOD = 1 * MiB;
constexpr size_t WS_ROUTE = 2 * MiB;
constexpr size_t WS_SSQ = 3 * MiB;
constexpr size_t WS_STATS = 4 * MiB;
constexpr size_t WS_IDX = 8 * MiB;
constexpr size_t WS_WIN = 10 * MiB;
constexpr size_t WS_WOUT = 34 * MiB;
constexpr size_t WS_WQA = 42 * MiB;
constexpr size_t WS_WKVA = 43 * MiB;
constexpr size_t WS_WQB = 44 * MiB;
constexpr size_t WS_WO = 46 * MiB;
constexpr size_t WS_WGU = 50 * MiB;
constexpr size_t WS_WDN = 178 * MiB;
constexpr size_t WS_XN = 242 * MiB;
constexpr size_t WS_L = 306 * MiB;
constexpr size_t WS_END = 690 * MiB;
constexpr size_t WS_A2 = WS_L, WS_KR = WS_L + 64 * MiB, WS_KT = WS_L + 96 * MiB, WS_B2T = WS_L + 128 * MiB;
constexpr size_t WS_HDN = WS_L, WS_YB = WS_L + 68 * MiB;
constexpr size_t WS_HN = WS_L, WS_QA = WS_L + 64 * MiB, WS_AKV = WS_L + 80 * MiB, WS_Q = WS_L + 112 * MiB, WS_OL = WS_L + 208 * MiB, WS_KP = WS_L + 300 * MiB;
constexpr size_t WS_XN8 = 114 * MiB;
constexpr size_t WS_WIN8 = 146 * MiB;
constexpr size_t WS_WOUT8 = 158 * MiB;
constexpr size_t WS_WQA8 = 162 * MiB;
constexpr size_t WS_WO8 = 163 * MiB;
constexpr size_t WS_ACT8 = 210 * MiB;
constexpr int CW_BAR = 4096;
constexpr int CW_CNT = 16384;
constexpr int CW_CHK = 32768;

constexpr int LDS_STAGE = 131072;
constexpr int LDS_MISC = LDS_STAGE;
constexpr int LDS_TAB = LDS_STAGE + 256;
constexpr int LDS_BYTES = 147456;

#define LDS_WAIT() asm volatile("s_waitcnt lgkmcnt(0)" ::: "memory")
#define VM_WAIT() asm volatile("s_waitcnt vmcnt(0)" ::: "memory")
__device__ __forceinline__ unsigned cvt_pk_bf16(float lo, float hi) { unsigned r; asm volatile("v_cvt_pk_bf16_f32 %0, %1, %2" : "=v"(r) : "v"(lo), "v"(hi)); return r; }
__device__ __forceinline__ unsigned pk4_fp8(float a, float b, float c2, float d) { int w = __builtin_amdgcn_cvt_pk_fp8_f32(a, b, 0, false); return (unsigned)__builtin_amdgcn_cvt_pk_fp8_f32(c2, d, w, true); }
__device__ __forceinline__ float bf2f(unsigned short b) { return __uint_as_float((unsigned)b << 16); }
__device__ __forceinline__ float bflo(unsigned w) { return __uint_as_float(w << 16); }
__device__ __forceinline__ float bfhi(unsigned w) { return __uint_as_float(w & 0xffff0000u); }
template <int CTRL> __device__ __forceinline__ float dpp_f(float v) { return __int_as_float(__builtin_amdgcn_mov_dpp(__float_as_int(v), CTRL, 0xf, 0xf, true)); }
__device__ __forceinline__ float rows_sum(float v) {
    { auto t = __builtin_amdgcn_permlane16_swap(__float_as_uint(v), __float_as_uint(v), false, false); v = __uint_as_float(t[0]) + __uint_as_float(t[1]); }
    { auto t = __builtin_amdgcn_permlane32_swap(__float_as_uint(v), __float_as_uint(v), false, false); v = __uint_as_float(t[0]) + __uint_as_float(t[1]); }
    return v;
}
__device__ __forceinline__ float wave_sum(float v) {
    v += dpp_f<0xB1>(v);
    v += dpp_f<0x4E>(v);
    v += dpp_f<0x141>(v);
    v += dpp_f<0x140>(v);
    return rows_sum(v);
}
__device__ __forceinline__ void sincos_rad(float ang, float& s, float& c) {
    float r = __builtin_amdgcn_fractf(ang * 0.15915494309189535f);
    s = __builtin_amdgcn_sinf(r); c = __builtin_amdgcn_cosf(r);
}
__device__ __forceinline__ float silu_f(float x) { return x / (1.0f + __expf(-x)); }
__device__ __forceinline__ float log2_gamma(int h) { return h == 0 ? -0.04580368961312479f : (h == 1 ? -0.02272007650008353f : (h == 2 ? -0.011315313227834146f : -0.005646563141142063f)); }
constexpr float LOG2_THETA = 13.287712379549449f;

__device__ __forceinline__ int lane_id() { return (int)__builtin_amdgcn_mbcnt_hi(~0u, __builtin_amdgcn_mbcnt_lo(~0u, 0u)); }
#define XB_TMO      128
#define XB_XCNT(j)  (256  + 64 * (j))
#define XB_XSUB(j)  (1280 + 64 * (j))
#define XB_XGEN(j)  (2304 + 64 * (j))
#define XB_TOP      3328
#define XB_TOPGEN   3392
#define XCD_BAR_WORDS 3456
#define XB_SPIN_CAP (1u << 18)
__device__ __forceinline__ unsigned xb_ld(unsigned* p)              { return __hip_atomic_load(p, __ATOMIC_RELAXED, __HIP_MEMORY_SCOPE_AGENT); }
__device__ __forceinline__ unsigned xb_add(unsigned* p, unsigned v) { return __hip_atomic_fetch_add(p, v, __ATOMIC_RELAXED, __HIP_MEMORY_SCOPE_AGENT); }
__device__ __forceinline__ unsigned xb_xcc_id() { return (unsigned)__builtin_amdgcn_s_getreg((3 << 11) | 20) & 0xFu; }
#define XB_SPIN(cond, bar) do { unsigned _sp = 0; while (cond) { __builtin_amdgcn_s_sleep(1); \
    if ((++_sp & 255u) == 0u) { if (xb_ld(&(bar)[XB_TMO])) break; if (_sp > XB_SPIN_CAP) { atomicAdd(&(bar)[XB_TMO], 1u); break; } } } } while (0)
struct XcdBarrier { unsigned* bar; unsigned x; volatile LAS unsigned* st; };
__device__ __forceinline__ XcdBarrier xcd_barrier_post(unsigned* bar, volatile LAS unsigned* st) {
    XcdBarrier b; b.bar = bar; b.x = xb_xcc_id(); b.st = st;
    if (threadIdx.x == 0) (void)xb_add(&bar[XB_XCNT(b.x)], 1u);
    return b;
}
__device__ __forceinline__ void xcd_barrier_complete(unsigned* bar, unsigned x, unsigned& nloc, unsigned& nx) {
    const unsigned G = gridDim.x * gridDim.y * gridDim.z;
    unsigned sum, cnt, mine, sp = 0u;
    for (;;) {
        sum = 0u; cnt = 0u; mine = 0u;
#pragma unroll
        for (unsigned j = 0; j < 16; ++j) { const unsigned c = xb_ld(&bar[XB_XCNT(j)]); sum += c; cnt += (c > 0u) ? 1u : 0u; mine = (j == x) ? c : mine; }
        if (sum == G) break;
        __builtin_amdgcn_s_sleep(1);
        if ((++sp & 255u) == 0u) { if (xb_ld(&bar[XB_TMO])) break; if (sp > XB_SPIN_CAP) { atomicAdd(&bar[XB_TMO], 1u); break; } }
    }
    nloc = mine > 0u ? mine : 1u; nx = cnt > 0u ? cnt : 1u;
}
__device__ __forceinline__ void xcd_barrier(const XcdBarrier& b, const int wave) {
    asm volatile("s_waitcnt vmcnt(0)" ::: "memory");
    __syncthreads();
    if (wave == 0 && lane_id() == 0) {
        unsigned* bar = b.bar; unsigned bx = b.x; asm volatile("" : "+s"(bar), "+s"(bx));
        __builtin_amdgcn_s_waitcnt(0);
        unsigned nloc = b.st[0], nx = b.st[1];
        if (nloc == 0u) { xcd_barrier_complete(bar, bx, nloc, nx); b.st[0] = nloc; b.st[1] = nx; }
        const unsigned old = xb_add(&bar[XB_XSUB(bx)], 1u);
        const unsigned gen = old / nloc;
        if (old + 1u == (gen + 1u) * nloc) {
            __builtin_amdgcn_fence(__ATOMIC_RELEASE, "agent");
            asm volatile("s_waitcnt vmcnt(0)" ::: "memory");
            const unsigned og = xb_add(&bar[XB_TOP], 1u);
            const unsigned tg = og / nx;
            if (og + 1u == (tg + 1u) * nx) xb_add(&bar[XB_TOPGEN], 1u);
            else XB_SPIN(xb_ld(&bar[XB_TOPGEN]) == tg, bar);
            __builtin_amdgcn_fence(__ATOMIC_ACQUIRE, "agent");
            xb_add(&bar[XB_XGEN(bx)], 1u);
            asm volatile("s_waitcnt vmcnt(0)" ::: "memory");
        } else {
            XB_SPIN(xb_ld(&bar[XB_XGEN(bx)]) == gen, bar);
            __builtin_amdgcn_fence(__ATOMIC_ACQUIRE, "agent");
            asm volatile("s_waitcnt vmcnt(0)" ::: "memory");
        }
    }
    __syncthreads();
}

namespace pg8 {
constexpr int BM = 256, BK = 64, HALF = 128, HTB = HALF * BK * 2, STAGE_BYTES = 8 * HTB;
__host__ __device__ __forceinline__ int lds_byte(int r, int c) { const int st = (r >> 4) * 2 + (c >> 5), rr = r & 15, cc = c & 31, ob = rr * 64 + cc * 2; return st * 1024 + (ob ^ (((ob >> 9) & 1) << 5)); }
__host__ __device__ __forceinline__ void stage_rc(int b, int& R, int& C) { const int st = b / 1024, sb = b % 1024, swz = sb ^ (((sb >> 9) & 1) << 5); R = (st >> 1) * 16 + swz / 64; C = (st & 1) * 32 + (swz % 64) / 2; }
__host__ __device__ __forceinline__ int perm32(int rho) { const int n = rho >> 4, i = rho & 15; return 8 * (i >> 2) + 4 * n + (i & 3); }

struct Unit { const char* A; const char* B; int pm, pn, aux; };

struct TileOrder {
    int nM, nN, nwg, G, c;
    __device__ void init(int nM_, int nN_, int G_, int c_) { nM = nM_; nN = nN_; nwg = nM * nN; G = G_; c = c_; }
    __device__ bool tile(int i, int& pm, int& pn) const {
        const long L = (long)i * G + c; if (L >= nwg) return false;
        int wgid = (int)L; { const int q = nwg / 8, r = nwg % 8, xcd = wgid % 8, off = wgid / 8; wgid = (xcd < r ? xcd * (q + 1) : r * (q + 1) + (xcd - r) * q) + off; }
        const int nig = 8 * nN, gid = wgid / nig, fm = gid * 8, gsz = (nM - fm) < 8 ? (nM - fm) : 8;
        pm = fm + ((wgid % nig) % gsz); pn = (wgid % nig) / gsz; return true;
    }
};

typedef int i32x8 __attribute__((ext_vector_type(8)));
typedef int i32x4 __attribute__((ext_vector_type(4)));
__device__ __forceinline__ i32x8 cat8(bf16x8 lo, bf16x8 hi) { const i32x4 a = __builtin_bit_cast(i32x4, lo), b = __builtin_bit_cast(i32x4, hi); return __builtin_shufflevector(a, b, 0, 1, 2, 3, 4, 5, 6, 7); }
template <class Epi, class Sched, bool GATHER, bool FP8 = false, int SCW = 0x7f7f7f7f, int SCX = 0x7f7f7f7f>
__device__ __forceinline__ void gemm_phase(LAS unsigned char* lds, const int wid, const int K, const unsigned lda, const unsigned ldb, const Sched& S, const Epi& E) {
    int lane_ = (int)__builtin_amdgcn_mbcnt_hi(~0u, __builtin_amdgcn_mbcnt_lo(~0u, 0u)); asm volatile("" : "+v"(lane_));
    const int lane = lane_, tid = wid * 64 + lane, wr = wid >> 2, wc = wid & 3, fr = lane & 15, fq = lane >> 4;
    const int nt = K / BK;
    unsigned voffA[2], voffB[2]; int RA[2], CA[2];
#pragma unroll
    for (int i = 0; i < 2; ++i) { int R, C; stage_rc(tid * 16 + i * 8192, R, C); const int Rb = Epi::PERM ? ((R & ~31) + perm32(R & 31)) : R;
        RA[i] = R; CA[i] = C; voffA[i] = (unsigned)R * lda + (unsigned)C * 2u; voffB[i] = (unsigned)Rb * ldb + (unsigned)C * 2u; }
    const size_t kstep = (size_t)(BK * 2);
    const size_t hstepA = (size_t)HALF * lda, hstepB = (size_t)HALF * ldb;
    const unsigned ldsw = (unsigned)wid * 1024u;
    const int aoff = lds_byte(wr * 64 + fr, fq * 8), boff = lds_byte(wc * 32 + fr, fq * 8);
#define PG8_SA(b, h) (((b) * 2 + (h)) * HTB)
#define PG8_SB(b, h) ((4 + (b) * 2 + (h)) * HTB)
#define PG8_GLDS(gp, bufoff, i) __builtin_amdgcn_global_load_lds((const unsigned*)(gp), (LAS unsigned*)(lds + (bufoff) + ldsw + (i) * 8192), 16, 0, 0)
#define PG8_STAGE_B(bufoff, gbase) do { _Pragma("unroll") for (int _i = 0; _i < 2; ++_i) PG8_GLDS((const char*)(gbase) + voffB[_i], bufoff, _i); } while (0)
#define PG8_STAGE_A(bufoff, gbase, h, GO) do { _Pragma("unroll") for (int _i = 0; _i < 2; ++_i) { \
        if constexpr (GATHER) PG8_GLDS((const char*)(gbase) + GO[h][_i], bufoff, _i); else PG8_GLDS((const char*)(gbase) + (size_t)(h) * hstepA + voffA[_i], bufoff, _i); } } while (0)
#define PG8_LDA(dst, b, h) do { _Pragma("unroll") for (int m = 0; m < 4; ++m) _Pragma("unroll") for (int k = 0; k < 2; ++k) dst[m][k] = *(const LAS bf16x8*)(lds + PG8_SA(b, h) + aoff + m * 2048 + k * 1024); } while (0)
#define PG8_LDB(dst, b, h) do { _Pragma("unroll") for (int n = 0; n < 2; ++n) _Pragma("unroll") for (int k = 0; k < 2; ++k) dst[n][k] = *(const LAS bf16x8*)(lds + PG8_SB(b, h) + boff + n * 2048 + k * 1024); } while (0)
#define PG8_MFMA8(ACC, W8, X8) asm volatile("v_mfma_scale_f32_16x16x128_f8f6f4 %0, %1, %2, %0, %3, %4 op_sel_hi:[0,0,0]" : "+v"(ACC) : "v"(W8), "v"(X8), "v"(scw_), "v"(scx_))
#define PG8_MMA(ai, bj, At, Bt) do { __builtin_amdgcn_s_setprio(1); if constexpr (FP8) { i32x8 a8_[4], b8_[2]; _Pragma("unroll") for (int m = 0; m < 4; ++m) a8_[m] = cat8(At[m][0], At[m][1]); \
        _Pragma("unroll") for (int n = 0; n < 2; ++n) b8_[n] = cat8(Bt[n][0], Bt[n][1]); asm volatile("s_nop 3" ::: "memory"); \
        _Pragma("unroll") for (int m = 0; m < 4; ++m) _Pragma("unroll") for (int n = 0; n < 2; ++n) PG8_MFMA8(acc[ai][bj][m][n], b8_[n], a8_[m]); } else { \
        _Pragma("unroll") for (int m = 0; m < 4; ++m) _Pragma("unroll") for (int n = 0; n < 2; ++n) _Pragma("unroll") for (int k = 0; k < 2; ++k) \
        acc[ai][bj][m][n] = __builtin_amdgcn_mfma_f32_16x16x32_bf16(Bt[n][k], At[m][k], acc[ai][bj][m][n], 0, 0, 0); } __builtin_amdgcn_s_setprio(0); } while (0)
#define PG8_WAIT_V(n) asm volatile("s_waitcnt vmcnt(" #n ")" ::: "memory")
#define PG8_WAIT_L(n) asm volatile("s_waitcnt lgkmcnt(" #n ")" ::: "memory")
#define PG8_BAR __builtin_amdgcn_s_barrier()
#define PG8_SCHED __builtin_amdgcn_sched_barrier(0)
    Unit cur, nxt; int ui = 0;
    if (!S.next(0, cur)) return;
    int scw_ = SCW, scx_ = SCX; asm volatile("" : "+v"(scw_), "+v"(scx_)); (void)scw_; (void)scx_;
    unsigned goff[2][2] = {{0u, 0u}, {0u, 0u}}, ngoff[2][2] = {{0u, 0u}, {0u, 0u}};
    if constexpr (GATHER) {
#pragma unroll
        for (int h = 0; h < 2; ++h)
#pragma unroll
            for (int i = 0; i < 2; ++i) goff[h][i] = (unsigned)S.tok(cur, h * HALF + RA[i]) * lda + (unsigned)CA[i] * 2u;
    }
    f32x4 acc[2][2][4][2];
#pragma unroll
    for (int a = 0; a < 2; ++a)
#pragma unroll
        for (int b = 0; b < 2; ++b)
#pragma unroll
            for (int m = 0; m < 4; ++m)
#pragma unroll
                for (int n = 0; n < 2; ++n) acc[a][b][m][n] = (f32x4){0.f, 0.f, 0.f, 0.f};
    bf16x8 At[4][2], B0[2][2], B1[2][2];
    const char* cA = cur.A; const char* cB = cur.B;
    PG8_STAGE_B(PG8_SB(0, 0), cB); PG8_STAGE_B(PG8_SB(0, 1), cB + hstepB); PG8_STAGE_A(PG8_SA(0, 0), cA, 0, goff); PG8_STAGE_A(PG8_SA(0, 1), cA, 1, goff);
    if (wr == 1) PG8_BAR;
    PG8_WAIT_V(2); PG8_BAR;
    PG8_STAGE_B(PG8_SB(1, 0), cB + kstep); PG8_STAGE_A(PG8_SA(1, 0), cA + kstep, 0, goff); PG8_STAGE_B(PG8_SB(1, 1), cB + hstepB + kstep);
    PG8_WAIT_V(6); PG8_BAR;
    for (;;) {
        const bool has_next = S.next(ui + 1, nxt);
        const char* nA = has_next ? nxt.A : cA; const char* nB = has_next ? nxt.B : cB;
        if constexpr (GATHER) {
#pragma unroll
            for (int h = 0; h < 2; ++h)
#pragma unroll
                for (int i = 0; i < 2; ++i) ngoff[h][i] = has_next ? (unsigned)S.tok(nxt, h * HALF + RA[i]) * lda + (unsigned)CA[i] * 2u : goff[h][i];
        }
#pragma unroll 1
        for (int t = 0; t < nt; t += 2) {
            const bool last = (t == nt - 2);
            const char* a1 = cA + (size_t)(t + 1) * kstep;
            const char* a2 = last ? nA : cA + (size_t)(t + 2) * kstep; const char* b2 = last ? nB : cB + (size_t)(t + 2) * kstep;
            const char* a3 = a2 + kstep; const char* b3 = b2 + kstep;
            unsigned g2[2][2];
#pragma unroll
            for (int h = 0; h < 2; ++h)
#pragma unroll
                for (int i = 0; i < 2; ++i) g2[h][i] = last ? ngoff[h][i] : goff[h][i];
            PG8_LDB(B0, 0, 0); PG8_LDB(B1, 0, 1); PG8_SCHED; PG8_LDA(At, 0, 0); PG8_STAGE_A(PG8_SA(1, 1), a1, 1, goff);
            PG8_WAIT_V(8); PG8_WAIT_L(0); PG8_BAR; PG8_MMA(0, 0, At, B0); PG8_MMA(0, 1, At, B1); PG8_BAR; PG8_SCHED;
            PG8_LDA(At, 0, 1); PG8_STAGE_B(PG8_SB(0, 0), b2); PG8_STAGE_B(PG8_SB(0, 1), b2 + hstepB); PG8_STAGE_A(PG8_SA(0, 0), a2, 0, g2);
            PG8_WAIT_V(8); PG8_WAIT_L(0); PG8_BAR; PG8_MMA(1, 0, At, B0); PG8_MMA(1, 1, At, B1); PG8_BAR; PG8_SCHED;
            PG8_LDB(B0, 1, 0); PG8_LDB(B1, 1, 1); PG8_SCHED; PG8_LDA(At, 1, 0); PG8_STAGE_A(PG8_SA(0, 1), a2, 1, g2);
            PG8_WAIT_V(8); PG8_WAIT_L(0); PG8_BAR; PG8_MMA(0, 0, At, B0); PG8_MMA(0, 1, At, B1); PG8_BAR; PG8_SCHED;
            PG8_LDA(At, 1, 1); PG8_STAGE_B(PG8_SB(1, 0), b3); PG8_STAGE_B(PG8_SB(1, 1), b3 + hstepB); PG8_STAGE_A(PG8_SA(1, 0), a3, 0, g2);
            PG8_WAIT_V(8); PG8_WAIT_L(0); PG8_BAR; PG8_MMA(1, 0, At, B0); PG8_MMA(1, 1, At, B1); PG8_BAR; PG8_SCHED;
        }
        if (wr == 0) PG8_BAR;
        if constexpr (FP8) asm volatile("s_nop 7\n\ts_nop 7" ::: "memory");
        { int fr2 = fr, fq2 = fq; asm volatile("" : "+v"(fr2), "+v"(fq2)); E(acc, cur, wr, wc, fr2, fq2); }
        if (!has_next) break;
#pragma unroll
        for (int a = 0; a < 2; ++a)
#pragma unroll
            for (int b = 0; b < 2; ++b)
#pragma unroll
                for (int m = 0; m < 4; ++m)
#pragma unroll
                    for (int n = 0; n < 2; ++n) acc[a][b][m][n] = (f32x4){0.f, 0.f, 0.f, 0.f};
        cur = nxt; cA = nA; cB = nB; ++ui;
        if constexpr (GATHER) {
#pragma unroll
            for (int h = 0; h < 2; ++h)
#pragma unroll
                for (int i = 0; i < 2; ++i) goff[h][i] = ngoff[h][i];
        }
        if (wr == 1) PG8_BAR;
    }
    PG8_WAIT_V(0);
    PG8_BAR;
#undef PG8_SA
#undef PG8_SB
#undef PG8_GLDS
#undef PG8_STAGE_A
#undef PG8_STAGE_B
#undef PG8_LDA
#undef PG8_LDB
#undef PG8_MMA
#undef PG8_MFMA8
#undef PG8_WAIT_V
#undef PG8_WAIT_L
#undef PG8_BAR
#undef PG8_SCHED
}
}
__device__ __forceinline__ const char* uni_ptr(const char* p) {
    unsigned long long v = (unsigned long long)p; unsigned lo = __builtin_amdgcn_readfirstlane((unsigned)v), hi = __builtin_amdgcn_readfirstlane((unsigned)(v >> 32));
    return (const char*)(((unsigned long long)hi << 32) | lo);
}
struct SchedStd {
    pg8::TileOrder T; const char* A; const char* B; size_t sA, sB;
    __device__ __forceinline__ bool next(int i, pg8::Unit& u) const { int pm, pn; if (!T.tile(i, pm, pn)) return false; u.pm = pm; u.pn = pn; u.aux = 0; u.A = A + (size_t)pm * sA; u.B = B + (size_t)pn * sB; return true; }
    __device__ __forceinline__ int tok(const pg8::Unit&, int) const { return 0; }
};
struct SchedBatch {
    const char* A; const char* B; size_t sA, sB, vA, vB; int nunits, nvt, G, c;
    __device__ __forceinline__ bool next(int i, pg8::Unit& u) const { const int L = i * G + c; if (L >= nunits * nvt) return false; const int uu = L / nvt, vt = L % nvt; u.pm = uu; u.pn = vt; u.aux = 0;
        u.A = A + (size_t)uu * sA + (size_t)vt * vA; u.B = B + (size_t)uu * sB + (size_t)vt * vB; return true; }
    __device__ __forceinline__ int tok(const pg8::Unit&, int) const { return 0; }
};
struct SchedMoE {
    const LAS int* tab; const char* A; const char* Bw; size_t sE, sPN, sRT; const int* idx; int G, c; bool gather;
    __device__ __forceinline__ bool next(int i, pg8::Unit& u) const {
        const int L = i * G + c, rt = L >> 2, pn = L & 3;
        const int ntile = __builtin_amdgcn_readfirstlane(tab[32]); if (rt >= ntile) return false;
        int e = 0;
#pragma unroll
        for (int k = 1; k < 16; ++k) e += (rt >= __builtin_amdgcn_readfirstlane(tab[16 + k])) ? 1 : 0;
        e = __builtin_amdgcn_readfirstlane(e);
        u.pm = rt; u.pn = pn; u.aux = e; u.A = gather ? A : A + (size_t)rt * sRT; u.B = Bw + (size_t)e * sE + (size_t)pn * sPN; return true;
    }
    __device__ __forceinline__ int tok(const pg8::Unit& u, int r) const {
        const int e = u.aux, p = (u.pm - __builtin_amdgcn_readfirstlane(tab[16 + e])) * 256 + r, n = __builtin_amdgcn_readfirstlane(tab[e]);
        return p < n ? idx[e * NTOK + p] : 0;
    }
};

typedef const f32x4 (&AccRef)[2][2][4][2];
__device__ __forceinline__ int launder(int x) { asm volatile("" : "+v"(x)); return x; }
__device__ __forceinline__ void st8(bf16_t* p, f32x4 v0, f32x4 v1) {
    u32x4 w; w.x = cvt_pk_bf16(v0[0], v0[1]); w.y = cvt_pk_bf16(v0[2], v0[3]); w.z = cvt_pk_bf16(v1[0], v1[1]); w.w = cvt_pk_bf16(v1[2], v1[3]); *(u32x4*)p = w;
}
struct EpiPlain {
    static constexpr bool PERM = true; bf16_t* out; int ld;
    __device__ __forceinline__ void operator()(AccRef acc, const pg8::Unit& u, int wr, int wc, int fr, int fq) const {
#pragma unroll
        for (int ai = 0; ai < 2; ++ai)
#pragma unroll
            for (int m = 0; m < 4; ++m) { const int r = ai * 128 + wr * 64 + m * 16 + fr; bf16_t* rp = out + (size_t)(u.pm * 256 + r) * ld + u.pn * 256 + wc * 32 + fq * 8;
#pragma unroll
                for (int bj = 0; bj < 2; ++bj) st8(rp + bj * 128, acc[ai][bj][m][0], acc[ai][bj][m][1]); }
    }
};
template <int MODE> struct EpiRopeQK {
    static constexpr bool PERM = true; bf16_t* out; const int* pos; int half; bf16_t* outT;
    __device__ __forceinline__ void operator()(AccRef acc, const pg8::Unit& u, int wr, int wc, int fr, int fq) const {
        const int pm = u.pm, h = u.pn, uu = ((pm >> 5) * 4 + h) * 32 + (pm & 31); const float l2g = log2_gamma(h);
        constexpr int LD = MODE == 0 ? 512 : 256;
        float inv[8]; const int f0 = launder(wc * 32 + fq * 8);
#pragma unroll
        for (int k = 0; k < 8; ++k) inv[k] = __builtin_amdgcn_exp2f(-(float)(f0 + k) * (LOG2_THETA / 128.0f));
#pragma unroll
        for (int ai = 0; ai < 2; ++ai)
#pragma unroll
            for (int m = 0; m < 4; ++m) { const int r = ai * 128 + wr * 64 + m * 16 + fr; const float p = (float)pos[half * THALF + pm * 256 + r];
                const float dec = MODE == 0 ? __builtin_amdgcn_exp2f((float)r * l2g) : __builtin_amdgcn_exp2f(-(float)r * l2g) * 0.0625f;
                f32x4 o1[2], o2[2];
#pragma unroll
                for (int n = 0; n < 2; ++n)
#pragma unroll
                    for (int j = 0; j < 4; ++j) { float s, c; sincos_rad(p * inv[n * 4 + j], s, c); const float x1 = acc[ai][0][m][n][j], x2 = acc[ai][1][m][n][j];
                        o1[n][j] = (x1 * c - x2 * s) * dec; o2[n][j] = (x1 * s + x2 * c) * dec; }
                bf16_t* rp = out + (size_t)uu * (256 * LD) + (size_t)r * LD + wc * 32 + fq * 8;
                st8(rp, o1[0], o1[1]); st8(rp + 128, o2[0], o2[1]);
                if constexpr (MODE == 1) { bf16_t* tp = outT + (size_t)uu * 65536 + (size_t)(wc * 32 + fq * 8) * 256 + r;
#pragma unroll
                    for (int n = 0; n < 2; ++n) { const unsigned a01 = cvt_pk_bf16(o1[n][0], o1[n][1]), a23 = cvt_pk_bf16(o1[n][2], o1[n][3]), b01 = cvt_pk_bf16(o2[n][0], o2[n][1]), b23 = cvt_pk_bf16(o2[n][2], o2[n][3]);
                        tp[(n * 4 + 0) * 256] = (bf16_t)(a01 & 0xffffu); tp[(n * 4 + 1) * 256] = (bf16_t)(a01 >> 16); tp[(n * 4 + 2) * 256] = (bf16_t)(a23 & 0xffffu); tp[(n * 4 + 3) * 256] = (bf16_t)(a23 >> 16);
                        tp[(128 + n * 4 + 0) * 256] = (bf16_t)(b01 & 0xffffu); tp[(128 + n * 4 + 1) * 256] = (bf16_t)(b01 >> 16); tp[(128 + n * 4 + 2) * 256] = (bf16_t)(b23 & 0xffffu); tp[(128 + n * 4 + 3) * 256] = (bf16_t)(b23 >> 16); } }
                __builtin_amdgcn_sched_barrier(0); }
    }
};
struct EpiRopeKT {
    static constexpr bool PERM = true; bf16_t* out; const int* pos; int half;
    __device__ __forceinline__ void operator()(AccRef acc, const pg8::Unit& u, int wr, int wc, int fr, int fq) const {
        const int h = u.pm, pn = u.pn, uu = ((pn >> 5) * 4 + h) * 32 + (pn & 31); const float l2g = log2_gamma(h);
        float pp[2][8], dec[2][8]; const int c00 = launder(wc * 32 + fq * 8), i00 = launder(wr * 64 + fr);
#pragma unroll
        for (int bj = 0; bj < 2; ++bj)
#pragma unroll
            for (int k = 0; k < 8; ++k) { const int c = bj * 128 + c00 + k; pp[bj][k] = (float)pos[half * THALF + pn * 256 + c]; dec[bj][k] = __builtin_amdgcn_exp2f(-(float)c * l2g) * 0.0625f; }
#pragma unroll
        for (int m = 0; m < 4; ++m) { const int i = i00 + m * 16; const float inv = __builtin_amdgcn_exp2f(-(float)i * (LOG2_THETA / 128.0f));
#pragma unroll
            for (int bj = 0; bj < 2; ++bj) { f32x4 o1[2], o2[2];
#pragma unroll
                for (int n = 0; n < 2; ++n)
#pragma unroll
                    for (int j = 0; j < 4; ++j) { float s, c; sincos_rad(pp[bj][n * 4 + j] * inv, s, c); const float x1 = acc[0][bj][m][n][j], x2 = acc[1][bj][m][n][j], d = dec[bj][n * 4 + j];
                        o1[n][j] = (x1 * c - x2 * s) * d; o2[n][j] = (x1 * s + x2 * c) * d; }
                bf16_t* rp = out + (size_t)uu * 65536 + (size_t)i * 256 + bj * 128 + c00;
                st8(rp, o1[0], o1[1]); st8(rp + 128 * 256, o2[0], o2[1]); __builtin_amdgcn_sched_barrier(0); } }
    }
};
struct EpiVT {
    static constexpr bool PERM = true; bf16_t* out;
    __device__ __forceinline__ void operator()(AccRef acc, const pg8::Unit& u, int wr, int wc, int fr, int fq) const {
        const int h = u.pm >> 1, vt = u.pm & 1, pn = u.pn, uu = ((pn >> 5) * 4 + h) * 32 + (pn & 31);
#pragma unroll
        for (int ai = 0; ai < 2; ++ai)
#pragma unroll
            for (int m = 0; m < 4; ++m) { const int r = ai * 128 + wr * 64 + m * 16 + fr; bf16_t* rp = out + (size_t)uu * 262144 + (size_t)(vt * 256 + r) * 512 + 256 + wc * 32 + fq * 8;
#pragma unroll
                for (int bj = 0; bj < 2; ++bj) st8(rp + bj * 128, acc[ai][bj][m][0], acc[ai][bj][m][1]); }
    }
};
struct EpiS {
    static constexpr bool PERM = true; bf16_t* out;
    __device__ __forceinline__ void operator()(AccRef acc, const pg8::Unit& u, int wr, int wc, int fr, int fq) const {
        const int uu = u.pm;
#pragma unroll
        for (int ai = 0; ai < 2; ++ai)
#pragma unroll
            for (int m = 0; m < 4; ++m) { const int r = ai * 128 + wr * 64 + m * 16 + fr; bf16_t* rp = out + (size_t)uu * 131072 + (size_t)r * 512 + 256 + wc * 32 + fq * 8;
#pragma unroll
                for (int bj = 0; bj < 2; ++bj) { const int c0 = bj * 128 + wc * 32 + fq * 8; f32x4 v0 = acc[ai][bj][m][0], v1 = acc[ai][bj][m][1];
#pragma unroll
                    for (int j = 0; j < 4; ++j) { if (c0 + j > r) v0[j] = 0.f; if (c0 + 4 + j > r) v1[j] = 0.f; }
                    st8(rp + bj * 128, v0, v1); } }
    }
};
struct EpiKV {
    static constexpr bool PERM = true; bf16_t* out;
    __device__ __forceinline__ void operator()(AccRef acc, const pg8::Unit& u, int wr, int wc, int fr, int fq) const {
        const int uu = u.pm, vt = u.pn, h = (uu >> 5) & 3; const float sc = __builtin_amdgcn_exp2f(255.0f * log2_gamma(h));
#pragma unroll
        for (int ai = 0; ai < 2; ++ai)
#pragma unroll
            for (int m = 0; m < 4; ++m) { const int r = ai * 128 + wr * 64 + m * 16 + fr; bf16_t* rp = out + (size_t)uu * 262144 + (size_t)(vt * 256 + r) * 512 + wc * 32 + fq * 8;
#pragma unroll
                for (int bj = 0; bj < 2; ++bj) st8(rp + bj * 128, acc[ai][bj][m][0] * sc, acc[ai][bj][m][1] * sc); }
    }
};
struct EpiFin {
    static constexpr bool PERM = true; bf16_t* out; float* stats; int rep;
    __device__ __forceinline__ void operator()(AccRef acc, const pg8::Unit& u, int wr, int wc, int fr, int fq) const {
        const int uu = u.pm, vt = u.pn, bl = uu >> 7, h = (uu >> 5) & 3, ch = uu & 31;
#pragma unroll
        for (int ai = 0; ai < 2; ++ai)
#pragma unroll
            for (int m = 0; m < 4; ++m) { const int r = ai * 128 + wr * 64 + m * 16 + fr; bf16_t* rp = out + (size_t)uu * 262144 + (size_t)(vt * 256 + r) * 512 + wc * 32 + fq * 8;
                float s = 0.f, q = 0.f;
#pragma unroll
                for (int bj = 0; bj < 2; ++bj) { const f32x4 v0 = acc[ai][bj][m][0], v1 = acc[ai][bj][m][1];
                    s += (v0[0] + v0[1]) + (v0[2] + v0[3]) + (v1[0] + v1[1]) + (v1[2] + v1[3]);
                    q += (v0[0] * v0[0] + v0[1] * v0[1]) + (v0[2] * v0[2] + v0[3] * v0[3]) + (v1[0] * v1[0] + v1[1] * v1[1]) + (v1[2] * v1[2] + v1[3] * v1[3]);
                    if (!rep) st8(rp + bj * 128, v0, v1); }
                s = rows_sum(s); q = rows_sum(q);
                const int tokl = bl * SEQ + ch * 256 + r;
                if (fq == 0 && !rep) *(f32x2*)(stats + ((size_t)(tokl * 4 + h) * 8 + vt * 4 + wc) * 2) = (f32x2){s, q}; }
    }
};
template <bool F8> struct EpiGate {
    static constexpr bool PERM = true; const bf16_t* o; const float* stats; bf16_t* y; unsigned char* y8;
    __device__ __forceinline__ void operator()(AccRef acc, const pg8::Unit& u, int wr, int wc, int fr, int fq) const {
        const int pm = u.pm, h = u.pn >> 1, vt = u.pn & 1, uu = ((pm >> 5) * 4 + h) * 32 + (pm & 31);
#pragma unroll
        for (int ai = 0; ai < 2; ++ai)
#pragma unroll
            for (int m = 0; m < 4; ++m) { const int r = ai * 128 + wr * 64 + m * 16 + fr, tokl = pm * 256 + r;
                const f32x4* sp = (const f32x4*)(stats + (size_t)(tokl * 4 + h) * 16); const f32x4 a = sp[0], b = sp[1], c = sp[2], d = sp[3];
                const float mean = ((a[0] + a[2]) + (b[0] + b[2]) + (c[0] + c[2]) + (d[0] + d[2])) * (1.0f / 512.0f);
                const float ex2 = ((a[1] + a[3]) + (b[1] + b[3]) + (c[1] + c[3]) + (d[1] + d[3])) * (1.0f / 512.0f);
                const float rstd = __builtin_amdgcn_rsqf(fmaxf(ex2 - mean * mean, 0.f) + EPS);
                const bf16_t* op = o + (size_t)uu * 262144 + (size_t)(vt * 256 + r) * 512 + wc * 32 + fq * 8;
                bf16_t* yp = y + (size_t)tokl * 2048 + h * 512 + vt * 256 + wc * 32 + fq * 8;
#pragma unroll
                for (int bj = 0; bj < 2; ++bj) { const u32x4 ow = *(const u32x4*)(op + bj * 128); const f32x4 g0 = acc[ai][bj][m][0], g1 = acc[ai][bj][m][1];
                    f32x4 y0, y1;
                    y0[0] = silu_f(g0[0]) * (bflo(ow.x) - mean) * rstd; y0[1] = silu_f(g0[1]) * (bfhi(ow.x) - mean) * rstd; y0[2] = silu_f(g0[2]) * (bflo(ow.y) - mean) * rstd; y0[3] = silu_f(g0[3]) * (bfhi(ow.y) - mean) * rstd;
                    y1[0] = silu_f(g1[0]) * (bflo(ow.z) - mean) * rstd; y1[1] = silu_f(g1[1]) * (bfhi(ow.z) - mean) * rstd; y1[2] = silu_f(g1[2]) * (bflo(ow.w) - mean) * rstd; y1[3] = silu_f(g1[3]) * (bfhi(ow.w) - mean) * rstd;
                    if constexpr (F8) { u32x2 w; w.x = pk4_fp8(4.0f * y0[0], 4.0f * y0[1], 4.0f * y0[2], 4.0f * y0[3]); w.y = pk4_fp8(4.0f * y1[0], 4.0f * y1[1], 4.0f * y1[2], 4.0f * y1[3]);
                        *(u32x2*)(y8 + (size_t)tokl * 2048 + h * 512 + vt * 256 + wc * 32 + fq * 8 + bj * 128) = w; }
                    else st8(yp + bj * 128, y0, y1); } __builtin_amdgcn_sched_barrier(0); }
    }
};
struct EpiResid {
    static constexpr bool PERM = false; float* h; const float* gate; int tok0;
    __device__ __forceinline__ void operator()(AccRef acc, const pg8::Unit& u, int wr, int wc, int fr, int fq) const {
#pragma unroll
        for (int ai = 0; ai < 2; ++ai)
#pragma unroll
            for (int m = 0; m < 4; ++m) { const int row = tok0 + u.pm * 256 + ai * 128 + wr * 64 + m * 16 + fr, b = row >> 13;
#pragma unroll
                for (int bj = 0; bj < 2; ++bj)
#pragma unroll
                    for (int n = 0; n < 2; ++n) { const int c = u.pn * 256 + bj * 128 + wc * 32 + n * 16 + fq * 4; const f32x4 gv = *(const f32x4*)(gate + b * 6144 + c);
                        f32x4* hp = (f32x4*)(h + (size_t)row * DM + c); *hp = *hp + gv * acc[ai][bj][m][n]; } }
    }
};
struct EpiGU {
    static constexpr bool PERM = true; bf16_t* hdn;
    __device__ __forceinline__ void operator()(AccRef acc, const pg8::Unit& u, int wr, int wc, int fr, int fq) const {
#pragma unroll
        for (int ai = 0; ai < 2; ++ai)
#pragma unroll
            for (int m = 0; m < 4; ++m) { const int r = ai * 128 + wr * 64 + m * 16 + fr; f32x4 o0, o1;
#pragma unroll
                for (int j = 0; j < 4; ++j) { o0[j] = silu_f(acc[ai][0][m][0][j]) * acc[ai][1][m][0][j]; o1[j] = silu_f(acc[ai][0][m][1][j]) * acc[ai][1][m][1][j]; }
                st8(hdn + (size_t)(u.pm * 256 + r) * DEXP + u.pn * 128 + wc * 32 + fq * 8, o0, o1); }
    }
};
struct EpiGU8 {
    static constexpr bool PERM = true; unsigned char* hdn;
    __device__ __forceinline__ void operator()(AccRef acc, const pg8::Unit& u, int wr, int wc, int fr, int fq) const {
#pragma unroll
        for (int ai = 0; ai < 2; ++ai)
#pragma unroll
            for (int m = 0; m < 4; ++m) { const int r = ai * 128 + wr * 64 + m * 16 + fr; f32x4 o0, o1;
#pragma unroll
                for (int j = 0; j < 4; ++j) { o0[j] = 4.0f * silu_f(acc[ai][0][m][0][j]) * acc[ai][1][m][0][j]; o1[j] = 4.0f * silu_f(acc[ai][0][m][1][j]) * acc[ai][1][m][1][j]; }
                u32x2 w; w.x = pk4_fp8(o0[0], o0[1], o0[2], o0[3]); w.y = pk4_fp8(o1[0], o1[1], o1[2], o1[3]);
                *(u32x2*)(hdn + (size_t)(u.pm * 256 + r) * DEXP + u.pn * 128 + wc * 32 + fq * 8) = w; }
    }
};
struct EpiQA {
    static constexpr bool PERM = true; bf16_t* out; float* ssq;
    __device__ __forceinline__ void operator()(AccRef acc, const pg8::Unit& u, int wr, int wc, int fr, int fq) const {
#pragma unroll
        for (int ai = 0; ai < 2; ++ai)
#pragma unroll
            for (int m = 0; m < 4; ++m) { const int row = u.pm * 256 + ai * 128 + wr * 64 + m * 16 + fr; bf16_t* rp = out + (size_t)row * 256 + wc * 32 + fq * 8; float q = 0.f;
#pragma unroll
                for (int bj = 0; bj < 2; ++bj) { const f32x4 v0 = acc[ai][bj][m][0], v1 = acc[ai][bj][m][1];
                    q += (v0[0] * v0[0] + v0[1] * v0[1]) + (v0[2] * v0[2] + v0[3] * v0[3]) + (v1[0] * v1[0] + v1[1] * v1[1]) + (v1[2] * v1[2] + v1[3] * v1[3]);
                    st8(rp + bj * 128, v0, v1); }
                q = rows_sum(q);
                if (fq == 0) ssq[(size_t)row * 4 + wc] = q; }
    }
};
struct EpiF32 {
    static constexpr bool PERM = false; float* out;
    __device__ __forceinline__ void operator()(AccRef acc, const pg8::Unit& u, int wr, int wc, int fr, int fq) const {
#pragma unroll
        for (int ai = 0; ai < 2; ++ai)
#pragma unroll
            for (int m = 0; m < 4; ++m) { const int row = u.pm * 256 + ai * 128 + wr * 64 + m * 16 + fr;
#pragma unroll
                for (int bj = 0; bj < 2; ++bj)
#pragma unroll
                    for (int n = 0; n < 2; ++n) *(f32x4*)(out + (size_t)row * 256 + bj * 128 + wc * 32 + n * 16 + fq * 4) = acc[ai][bj][m][n]; }
    }
};
struct EpiQB {
    static constexpr bool PERM = true; bf16_t* Q; const float* ssq; const int* pos;
    __device__ __forceinline__ void operator()(AccRef acc, const pg8::Unit& u, int wr, int wc, int fr, int fq) const {
        constexpr float QS = 0.10411754627697264f;
        const int pn = u.pn;
        float inv[8]; const int f0 = launder(fq * 8);
#pragma unroll
        for (int k = 0; k < 8; ++k) inv[k] = __builtin_amdgcn_exp2f(-(float)(f0 + k) * (LOG2_THETA / 32.0f));
#pragma unroll
        for (int ai = 0; ai < 2; ++ai)
#pragma unroll
            for (int m = 0; m < 4; ++m) { const int row = u.pm * 256 + ai * 128 + wr * 64 + m * 16 + fr; const f32x4 sq = *(const f32x4*)(ssq + (size_t)row * 4);
                const float rs = __builtin_amdgcn_rsqf(((sq[0] + sq[1]) + (sq[2] + sq[3])) * (1.0f / 256.0f) + EPS) * QS;
                if (pn < 4) {
#pragma unroll
                    for (int bj = 0; bj < 2; ++bj) st8(Q + (size_t)row * 1536 + (2 * pn + bj) * QKD + wc * 32 + fq * 8, acc[ai][bj][m][0] * rs, acc[ai][bj][m][1] * rs);
                } else {
                    const float p = (float)pos[row]; f32x4 o1[2], o2[2];
#pragma unroll
                    for (int n = 0; n < 2; ++n)
#pragma unroll
                        for (int j = 0; j < 4; ++j) { float s, c; sincos_rad(p * inv[n * 4 + j], s, c); const float x1 = acc[ai][0][m][n][j] * rs, x2 = acc[ai][1][m][n][j] * rs;
                            o1[n][j] = x1 * c - x2 * s; o2[n][j] = x1 * s + x2 * c; }
                    bf16_t* qp = Q + (size_t)row * 1536 + (4 * (pn - 4) + wc) * QKD + 128 + fq * 8;
                    st8(qp, o1[0], o1[1]); st8(qp + 32, o2[0], o2[1]); } __builtin_amdgcn_sched_barrier(0); }
    }
};
typedef const char __attribute__((address_space(4)))* kaptr_t;
struct Ctx { kaptr_t ka; LAS unsigned char* lds; int wave, vcu; };
__device__ __forceinline__ const void* ld_ka(kaptr_t ka, int off) { return *(const void* const __attribute__((address_space(4)))*)(ka + off); }
#define INF(k) ((const float*)ld_ka(ka, (k) * 8))
#define INI(k) ((const int*)ld_ka(ka, (k) * 8))
#define OUTP ((float*)ld_ka(ka, 200))
#define WSB ((unsigned char*)ld_ka(ka, 208))
#define CTLP ((unsigned*)(WSB + WS_CTL))
#define PHASE_ENTRY() kaptr_t ka = C.ka; asm volatile("" : "+s"(ka)); int lane_ = lane_id(); asm volatile("" : "+v"(lane_)); int wave_ = C.wave, vcu_ = C.vcu; asm volatile("" : "+s"(wave_), "+s"(vcu_)); \
    const int lane = lane_, wave = wave_, vcu = vcu_, tid = wave * 64 + lane; LAS unsigned char* const ldsb = C.lds; (void)tid; (void)lane; (void)vcu; (void)ldsb
#define WSP(T, off) ((T*)(WSB + (off)))

__device__ __forceinline__ void transpose_block(const float* W, int N, int k0, int n0, bf16_t* dst, int ldd, int drow, LAS float* scr, int lane) {
#pragma unroll 8
    for (int i = 0; i < 32; ++i) { const int kk = 2 * i + (lane >> 5); scr[kk * 33 + (lane & 31)] = W[(size_t)(k0 + kk) * N + n0 + (lane & 31)]; }
    LDS_WAIT(); asm volatile("" ::: "memory");
    const int c = lane & 7;
#pragma unroll
    for (int j = 0; j < 4; ++j) { const int n = (lane >> 3) + 8 * j; const LAS float* s = scr + (8 * c) * 33 + n;
        u32x4 o; o.x = cvt_pk_bf16(s[0 * 33], s[1 * 33]); o.y = cvt_pk_bf16(s[2 * 33], s[3 * 33]); o.z = cvt_pk_bf16(s[4 * 33], s[5 * 33]); o.w = cvt_pk_bf16(s[6 * 33], s[7 * 33]);
        *(u32x4*)(dst + (size_t)(drow + n) * ldd + k0 + 8 * c) = o; }
    LDS_WAIT(); asm volatile("" ::: "memory");
}
__device__ __forceinline__ void transpose_block_f8(const float* W, int N, int k0, int n0, unsigned char* dst, int ldd, int drow, float sc, LAS float* scr, int lane) {
#pragma unroll 8
    for (int i = 0; i < 32; ++i) { const int kk = 2 * i + (lane >> 5); scr[kk * 33 + (lane & 31)] = W[(size_t)(k0 + kk) * N + n0 + (lane & 31)]; }
    LDS_WAIT(); asm volatile("" ::: "memory");
    const int c = lane & 7;
#pragma unroll
    for (int j = 0; j < 4; ++j) { const int n = (lane >> 3) + 8 * j; const LAS float* s = scr + (8 * c) * 33 + n;
        u32x2 o; o.x = pk4_fp8(sc * s[0 * 33], sc * s[1 * 33], sc * s[2 * 33], sc * s[3 * 33]); o.y = pk4_fp8(sc * s[4 * 33], sc * s[5 * 33], sc * s[6 * 33], sc * s[7 * 33]);
        *(u32x2*)(dst + (size_t)(drow + n) * ldd + k0 + 8 * c) = o; }
    LDS_WAIT(); asm volatile("" ::: "memory");
}
__device__ __forceinline__ void phase_prologue(Ctx& C) {
    PHASE_ENTRY();
    LAS float* cact = (LAS float*)ldsb;
    LAS float* red = (LAS float*)(ldsb + 16384);
    for (int i = tid; i < 4096; i += NTHREADS) cact[i] = silu_f(INF(1)[i]);
    __syncthreads();
    float* mod = WSP(float, WS_MOD);
    for (int g = vcu; g < 416; g += GRID) {
        const int col = g * 64 + lane; const float* W; int N, cc; const float* bias; float* dst; int dstride;
        if (col < 24576) { const int l = col / 6144; cc = col - l * 6144; W = INF(3) + (size_t)l * 1024 * 6144; N = 6144; bias = INF(4) + l * 6144; dst = mod + (size_t)l * 4 * 6144; dstride = 6144; }
        else { cc = col - 24576; W = INF(9); N = 2048; bias = INF(10); dst = mod + 4 * 4 * 6144; dstride = 2048; }
        float a0 = 0.f, a1 = 0.f, a2 = 0.f, a3 = 0.f;
        const float* wp = W + (size_t)(wave * 128) * N + cc;
#pragma unroll 16
        for (int k = 0; k < 128; ++k) { const float w = wp[(size_t)k * N]; const int kk = wave * 128 + k; a0 += cact[kk] * w; a1 += cact[1024 + kk] * w; a2 += cact[2048 + kk] * w; a3 += cact[3072 + kk] * w; }
        red[(wave * 4 + 0) * 64 + lane] = a0; red[(wave * 4 + 1) * 64 + lane] = a1; red[(wave * 4 + 2) * 64 + lane] = a2; red[(wave * 4 + 3) * 64 + lane] = a3;
        __syncthreads();
        if (tid < 256) { const int b = tid >> 6, ln = tid & 63; float s = 0.f;
#pragma unroll
            for (int w = 0; w < 8; ++w) s += red[(w * 4 + b) * 64 + ln];
            const int c2 = g * 64 + ln; const int cc2 = c2 < 24576 ? c2 % 6144 : c2 - 24576;
            dst[(size_t)b * dstride + cc2] = s + bias[cc2]; }
        __syncthreads();
    }
    LAS float* scr = (LAS float*)(ldsb + wave * 16384);
    const int gw = vcu * NWAVES + wave, NGW = GRID * NWAVES;
    constexpr int NIT = 8544 + 64 * 768;
    for (int it = gw; it < NIT; it += NGW) {
        if (it < 6144) { const int l = it / 3072, r = it % 3072, kb = r / 192, nb = r % 192;
            transpose_block(INF(7) + (size_t)l * 1024 * 6144, 6144, 64 * kb, 32 * nb, WSP(bf16_t, WS_WIN) + (size_t)l * 6144 * 1024, 1024, 32 * nb, scr, lane);
            transpose_block_f8(INF(7) + (size_t)l * 1024 * 6144, 6144, 64 * kb, 32 * nb, WSP(unsigned char, WS_WIN8) + (size_t)l * 6144 * 1024, 1024, 32 * nb, 64.0f, scr, lane); }
        else if (it < 8192) { const int r0 = it - 6144, l = r0 / 1024, r = r0 % 1024, kb = r / 32, nb = r % 32;
            transpose_block_f8(INF(8) + (size_t)l * 2048 * 1024, 1024, 64 * kb, 32 * nb, WSP(unsigned char, WS_WOUT8) + (size_t)l * 1024 * 2048, 2048, 32 * nb, 64.0f, scr, lane);
            transpose_block(INF(8) + (size_t)l * 2048 * 1024, 1024, 64 * kb, 32 * nb, WSP(bf16_t, WS_WOUT) + (size_t)l * 1024 * 2048, 2048, 32 * nb, scr, lane); }
        else if (it < 8448) { const int r0 = it - 8192, j = r0 / 128, r = r0 % 128, kb = r / 8, nb = r % 8;
            transpose_block_f8(INF(15) + (size_t)j * 1024 * 256, 256, 64 * kb, 32 * nb, WSP(unsigned char, WS_WQA8) + (size_t)j * 256 * 1024, 1024, 32 * nb, 64.0f, scr, lane);
            transpose_block(INF(15) + (size_t)j * 1024 * 256, 256, 64 * kb, 32 * nb, WSP(bf16_t, WS_WQA) + (size_t)j * 256 * 1024, 1024, 32 * nb, scr, lane); }
        else if (it < 8544) { const int r = it - 8448, kb = r / 6, nb = r % 6;
            transpose_block(INF(12), 192, 64 * kb, 32 * nb, WSP(bf16_t, WS_WKVA), 1024, 32 * nb, scr, lane); }
        else { const int r0 = it - 8544, le = r0 / 768, r = r0 % 768;
            if (r < 512) { const int up = r >> 8, rr = r & 255, kb = rr / 16, nb = rr % 16, n0 = 32 * nb;
                transpose_block_f8((up ? INF(22) : INF(21)) + (size_t)le * 1024 * 512, 512, 64 * kb, n0, WSP(unsigned char, WS_WGU) + (size_t)le * 1024 * 1024, 1024, (n0 >> 7) * 256 + (n0 & 127) + up * 128, 64.0f, scr, lane); }
            else { const int rr = r - 512, kb = rr / 32, nb = rr % 32;
                transpose_block_f8(INF(23) + (size_t)le * 512 * 1024, 1024, 64 * kb, 32 * nb, WSP(unsigned char, WS_WDN) + (size_t)le * 1024 * 512, 512, 32 * nb, 64.0f, scr, lane); } }
    }
    const int gt = vcu * NTHREADS + tid, NGT = GRID * NTHREADS;
    for (int i = gt; i < 64 * 1024 / 8; i += NGT) *(u32x4*)(WSP(bf16_t, WS_WKVA) + 192 * 1024 + (size_t)i * 8) = (u32x4){0u, 0u, 0u, 0u};
    for (int i = gt; i < 2 * 1536 * 256; i += NGT) {
        const int k = i & 255, n = (i >> 8) % 1536, j = i / (1536 * 256);
        const float* wq = INF(17) + ((size_t)j * 256 + k) * 1536; float v;
        if (n < 1024) { const int head = n >> 7, cdim = n & 127; const float* a = wq + head * QKD; const float* b = INF(14) + (size_t)cdim * 2048 + head * 256; float s = 0.f;
#pragma unroll 8
            for (int d = 0; d < 128; d += 4) { const f32x4 av = *(const f32x4*)(a + d), bv = *(const f32x4*)(b + d); s += av[0] * bv[0] + av[1] * bv[1] + av[2] * bv[2] + av[3] * bv[3]; }
            v = s; }
        else { const int np = (n - 1024) & 255, pn = (n - 1024) >> 8, half = np >> 7, wcc = (np & 127) >> 5, ii = np & 31; v = wq[(4 * pn + wcc) * QKD + 128 + half * 32 + ii]; }
        v *= INF(16)[j * 256 + k];
        WSP(bf16_t, WS_WQB)[i] = (bf16_t)(cvt_pk_bf16(v, 0.f) & 0xffffu);
    }
    for (int it = vcu * NWAVES + wave; it < 2 * 8 * 16 * 4; it += GRID * NWAVES) {
        const int nq = it & 3, cb = (it >> 2) & 15, hh = (it >> 6) & 7, j = it >> 9, n0 = nq * 256 + 4 * lane, c0 = cb * 8;
        const float* a = INF(14) + (size_t)c0 * 2048 + hh * 256 + 128; const float* bq = INF(18) + ((size_t)j * 1024 + hh * 128) * 1024 + n0;
        f32x4 acc[8];
#pragma unroll
        for (int c = 0; c < 8; ++c) acc[c] = (f32x4){0.f, 0.f, 0.f, 0.f};
#pragma unroll 4
        for (int v = 0; v < 128; ++v) { const f32x4 bv = *(const f32x4*)(bq + (size_t)v * 1024);
#pragma unroll
            for (int c = 0; c < 8; ++c) acc[c] = acc[c] + bv * a[(size_t)c * 2048 + v]; }
        bf16_t* o = WSP(bf16_t, WS_WO) + ((size_t)j * 1024 + n0) * 1024 + hh * 128 + c0;
#pragma unroll
        for (int q = 0; q < 4; ++q) { u32x4 w; w.x = cvt_pk_bf16(acc[0][q], acc[1][q]); w.y = cvt_pk_bf16(acc[2][q], acc[3][q]); w.z = cvt_pk_bf16(acc[4][q], acc[5][q]); w.w = cvt_pk_bf16(acc[6][q], acc[7][q]);
            *(u32x4*)(o + (size_t)q * 1024) = w;
            u32x2 w8; w8.x = pk4_fp8(64.f * acc[0][q], 64.f * acc[1][q], 64.f * acc[2][q], 64.f * acc[3][q]); w8.y = pk4_fp8(64.f * acc[4][q], 64.f * acc[5][q], 64.f * acc[6][q], 64.f * acc[7][q]);
            *(u32x2*)(WSP(unsigned char, WS_WO8) + ((size_t)j * 1024 + n0 + q) * 1024 + hh * 128 + c0) = w8; }
    }
}

__device__ __forceinline__ void moe_tile_prefix(Ctx& C, int l) {
    PHASE_ENTRY();
    LAS int* tab = (LAS int*)(ldsb + LDS_TAB);
    if (tid == 0) { int acc = 0;
        for (int e = 0; e < 16; ++e) { const int n = (int)__hip_atomic_load(CTLP + CW_CNT + 64 * l + e, __ATOMIC_RELAXED, __HIP_MEMORY_SCOPE_AGENT); tab[e] = n; tab[16 + e] = acc; acc += (n + 255) >> 8; }
        tab[32] = acc; }
    __syncthreads();
}
__device__ __forceinline__ void store_fp8_row(unsigned char* row, int lane, const f32x4 (&v)[4], float sc) {
#pragma unroll
    for (int j = 0; j < 4; ++j) *(unsigned*)(row + 4 * lane + 256 * j) = pk4_fp8(sc * v[j][0], sc * v[j][1], sc * v[j][2], sc * v[j][3]);
}
__device__ __forceinline__ void store_bf16_row(bf16_t* row, int lane, const f32x4 (&v)[4]) {
#pragma unroll
    for (int j = 0; j < 4; ++j) { u32x2 w; w.x = cvt_pk_bf16(v[j][0], v[j][1]); w.y = cvt_pk_bf16(v[j][2], v[j][3]); *(u32x2*)(row + 4 * lane + 256 * j) = w; }
}
__device__ __forceinline__ void moe_combine_row(const LAS int* tab, const unsigned* route, const bf16_t* yb, int lane, int tok, const f32x4 (&G2)[4], f32x4 (&v)[4]) {
    const u32x4 rt = *(const u32x4*)(route + (size_t)tok * 4);
    const int e0 = rt.x >> 15, p0 = rt.x & 32767, e1 = rt.y >> 15, p1 = rt.y & 32767; const float w0 = __uint_as_float(rt.z), w1 = __uint_as_float(rt.w);
    const bf16_t* y0 = yb + (size_t)(tab[16 + e0] * 256 + p0) * DM; const bf16_t* y1 = yb + (size_t)(tab[16 + e1] * 256 + p1) * DM;
#pragma unroll
    for (int j = 0; j < 4; ++j) { const u32x2 a = *(const u32x2*)(y0 + 4 * lane + 256 * j), b = *(const u32x2*)(y1 + 4 * lane + 256 * j);
        v[j][0] += G2[j][0] * (w0 * bflo(a.x) + w1 * bflo(b.x)); v[j][1] += G2[j][1] * (w0 * bfhi(a.x) + w1 * bfhi(b.x));
        v[j][2] += G2[j][2] * (w0 * bflo(a.y) + w1 * bflo(b.y)); v[j][3] += G2[j][3] * (w0 * bfhi(a.y) + w1 * bfhi(b.y)); }
}
__device__ __forceinline__ float row_rstd(const f32x4 (&v)[4]) {
    float s = 0.f;
#pragma unroll
    for (int j = 0; j < 4; ++j) s += (v[j][0] * v[j][0] + v[j][1] * v[j][1]) + (v[j][2] * v[j][2] + v[j][3] * v[j][3]);
    return __builtin_amdgcn_rsqf(wave_sum(s) * (1.0f / DM) + EPS);
}
__device__ __forceinline__ void phase_norm_a(Ctx& C, int l, int rep = 0) {
    PHASE_ENTRY(); const int b = vcu >> 6; const float* mod = WSP(float, WS_MOD);
    const float* xin = INF(0); float* hout = OUTP; bf16_t* xnp = WSP(bf16_t, WS_XN); unsigned char* xn8p = WSP(unsigned char, WS_XN8); bf16_t* hnp = WSP(bf16_t, WS_HN); const unsigned* route = WSP(unsigned, WS_ROUTE); const bf16_t* ybp = WSP(bf16_t, WS_YB);
    f32x4 Am[4], Bm[4], G2[4], Ak[4], Bk[4];
#pragma unroll
    for (int j = 0; j < 4; ++j) { const int c = 4 * lane + 256 * j;
        if (l < 4) { const float* ml = mod + (size_t)(l * 4 + b) * 6144; const f32x4 g = *(const f32x4*)(INF(5) + l * DM + c), sc = *(const f32x4*)(ml + 1024 + c); Am[j] = g * (1.0f + sc); Bm[j] = *(const f32x4*)(ml + c); }
        else { Am[j] = *(const f32x4*)(INF(24) + c); Bm[j] = (f32x4){0.f, 0.f, 0.f, 0.f}; }
        if (l > 0 && !rep) G2[j] = *(const f32x4*)(mod + (size_t)((l - 1) * 4 + b) * 6144 + 5 * 1024 + c); else G2[j] = (f32x4){0.f, 0.f, 0.f, 0.f};
        if (l == 2) { const float* mk = mod + 4 * 4 * 6144 + b * 2048; const f32x4 g = *(const f32x4*)(INF(11) + c), sc = *(const f32x4*)(mk + 1024 + c); Ak[j] = g * (1.0f + sc); Bk[j] = *(const f32x4*)(mk + c); }
        else { Ak[j] = Am[j]; Bk[j] = Bm[j]; } }
    if (l > 0) moe_tile_prefix(C, l - 1);
    for (int rr = 0; rr < 16; ++rr) {
        const int tok = vcu * 128 + wave * 16 + rr; f32x4 v[4];
        const float* src = (l == 0 ? xin : hout) + (size_t)tok * DM;
#pragma unroll
        for (int j = 0; j < 4; ++j) v[j] = *(const f32x4*)(src + 4 * lane + 256 * j);
        if (l > 0) moe_combine_row((const LAS int*)(ldsb + LDS_TAB), route, ybp, lane, tok, G2, v);
        const float rstd = row_rstd(v);
        if (l < 4) {
#pragma unroll
            for (int j = 0; j < 4; ++j) *(f32x4*)(hout + (size_t)tok * DM + 4 * lane + 256 * j) = v[j];
            f32x4 o[4];
#pragma unroll
            for (int j = 0; j < 4; ++j) o[j] = v[j] * rstd * Am[j] + Bm[j];
            store_bf16_row(xnp + (size_t)tok * DM, lane, o); store_fp8_row(xn8p + (size_t)tok * DM, lane, o, 4.0f);
            if (l == 2) {
#pragma unroll
                for (int j = 0; j < 4; ++j) o[j] = v[j] * rstd * Ak[j] + Bk[j];
                store_bf16_row(hnp + (size_t)tok * DM, lane, o); }
        } else {
#pragma unroll
            for (int j = 0; j < 4; ++j) *(f32x4*)(hout + (size_t)tok * DM + 4 * lane + 256 * j) = v[j] * rstd * Am[j];
        }
    }
}
constexpr int NBR = 4;
template <int CTRL> __device__ __forceinline__ float dpp_add(float v) { return v + dpp_f<CTRL>(v); }
__device__ __forceinline__ void phase_norm_b(Ctx& C, int l, int rep = 0) {
    PHASE_ENTRY(); const int b = vcu >> 6; const float* ml = WSP(float, WS_MOD) + (size_t)(l * 4 + b) * 6144;
    const float* hin = OUTP; bf16_t* xnp = WSP(bf16_t, WS_XN);
    LAS float* wrT = (LAS float*)ldsb;
    LAS float* lgt = (LAS float*)(ldsb + 65536);
    LAS int* rec_e = (LAS int*)(ldsb + 65536 + 8192);
    LAS float* rec_w = (LAS float*)(ldsb + 65536 + 8192 + 1024);
    LAS int* rec_p = (LAS int*)(ldsb + 65536 + 8192 + 2048);
    LAS int* lcnt = (LAS int*)(ldsb + 65536 + 8192 + 3072);
    LAS int* gbase = (LAS int*)(ldsb + 65536 + 8192 + 3072 + 64);
    for (int i = tid; i < 4096; i += NTHREADS) { const f32x4 w = *(const f32x4*)(INF(19) + (size_t)i * 4); const int col = i >> 2, e4 = (i & 3) * 4;
        wrT[(e4 + 0) * 1024 + col] = w[0]; wrT[(e4 + 1) * 1024 + col] = w[1]; wrT[(e4 + 2) * 1024 + col] = w[2]; wrT[(e4 + 3) * 1024 + col] = w[3]; }
    if (tid < 16) lcnt[tid] = 0;
    f32x4 Am[4], Bm[4];
#pragma unroll
    for (int j = 0; j < 4; ++j) { const int c = 4 * lane + 256 * j; const f32x4 g = *(const f32x4*)(INF(6) + l * DM + c), sc = *(const f32x4*)(ml + 4 * 1024 + c); Am[j] = g * (1.0f + sc); Bm[j] = *(const f32x4*)(ml + 3 * 1024 + c); }
    const float* hrow = hin + (size_t)(vcu * 128 + wave * 16) * DM + 4 * lane;
    __syncthreads();
#pragma unroll 1
    for (int g = 0; g < 16 / NBR; ++g) {
        asm volatile("" ::: "memory");
        f32x4 v[NBR][4];
#pragma unroll
        for (int i = 0; i < NBR; ++i)
#pragma unroll
            for (int j = 0; j < 4; ++j) v[i][j] = *(const f32x4*)(hrow + (size_t)(g * NBR + i) * DM + 256 * j);
#pragma unroll
        for (int i = 0; i < NBR; ++i) { const float rstd = row_rstd(v[i]);
#pragma unroll
            for (int j = 0; j < 4; ++j) v[i][j] = v[i][j] * rstd * Am[j] + Bm[j];
            if (!rep) { unsigned char* xr = (unsigned char*)xnp + (size_t)(vcu * 128 + wave * 16 + g * NBR + i) * DM;
#pragma unroll
              for (int j = 0; j < 4; ++j) *(unsigned*)(xr + 4 * lane + 256 * j) = pk4_fp8(4.0f * v[i][j][0], 4.0f * v[i][j][1], 4.0f * v[i][j][2], 4.0f * v[i][j][3]); } }
        float p[NBR][16];
#pragma unroll
        for (int e = 0; e < 16; ++e) { f32x4 w[4];
#pragma unroll
            for (int j = 0; j < 4; ++j) w[j] = *(const LAS f32x4*)(wrT + e * 1024 + 4 * lane + 256 * j);
#pragma unroll
            for (int i = 0; i < NBR; ++i) { float a = 0.f;
#pragma unroll
                for (int j = 0; j < 4; ++j) a += (v[i][j][0] * w[j][0] + v[i][j][1] * w[j][1]) + (v[i][j][2] * w[j][2] + v[i][j][3] * w[j][3]);
                p[i][e] = a; asm volatile("" : "+v"(p[i][e])); }
            __builtin_amdgcn_sched_barrier(0); }
#pragma unroll
        for (int i = 0; i < NBR; ++i) {
            float q[8], r[4];
#pragma unroll
            for (int k = 0; k < 8; ++k) { auto t = __builtin_amdgcn_permlane32_swap(__float_as_uint(p[i][k]), __float_as_uint(p[i][k + 8]), false, false); q[k] = __uint_as_float(t[0]) + __uint_as_float(t[1]); }
#pragma unroll
            for (int k = 0; k < 4; ++k) { auto t = __builtin_amdgcn_permlane16_swap(__float_as_uint(q[k]), __float_as_uint(q[k + 4]), false, false); r[k] = __uint_as_float(t[0]) + __uint_as_float(t[1]); }
#pragma unroll
            for (int k = 0; k < 4; ++k) { r[k] = dpp_add<0xB1>(r[k]); r[k] = dpp_add<0x4E>(r[k]); r[k] = dpp_add<0x141>(r[k]); r[k] = dpp_add<0x140>(r[k]); }
            if ((lane & 15) == 0) { const int rho = lane >> 4; *(LAS f32x4*)(lgt + (wave * 16 + g * NBR + i) * 16 + 4 * (rho & 1) + 8 * (rho >> 1)) = (f32x4){r[0], r[1], r[2], r[3]}; }
        }
    }
    LDS_WAIT();
    if (lane < 16) {
        const int rl = wave * 16 + lane; float sc[16], bs[16];
#pragma unroll
        for (int e4 = 0; e4 < 4; ++e4) { const f32x4 lg = *(const LAS f32x4*)(lgt + rl * 16 + e4 * 4); const f32x4 rbv = *(const f32x4*)(INF(20) + e4 * 4);
#pragma unroll
            for (int k = 0; k < 4; ++k) { sc[e4 * 4 + k] = 1.0f / (1.0f + __expf(-lg[k])); bs[e4 * 4 + k] = sc[e4 * 4 + k] + rbv[k]; } }
        float gs[4];
#pragma unroll
        for (int g = 0; g < 4; ++g) { const float a = bs[4 * g], bq = bs[4 * g + 1], c = bs[4 * g + 2], d = bs[4 * g + 3];
            const float h1 = fmaxf(a, bq), l1 = fminf(a, bq), h2 = fmaxf(c, d), l2 = fminf(c, d); gs[g] = fmaxf(h1, h2) + fmaxf(fminf(h1, h2), fmaxf(l1, l2)); }
        int gi = 0; float best = gs[0];
#pragma unroll
        for (int g = 1; g < 4; ++g) if (gs[g] > best) { best = gs[g]; gi = g; }
        float iv[4], uv[4];
#pragma unroll
        for (int k = 0; k < 4; ++k) { iv[k] = gi == 0 ? bs[k] : (gi == 1 ? bs[4 + k] : (gi == 2 ? bs[8 + k] : bs[12 + k])); uv[k] = gi == 0 ? sc[k] : (gi == 1 ? sc[4 + k] : (gi == 2 ? sc[8 + k] : sc[12 + k])); }
        int i1 = 0; float b1 = iv[0];
#pragma unroll
        for (int k = 1; k < 4; ++k) if (iv[k] > b1) { b1 = iv[k]; i1 = k; }
        int i2 = -1; float b2 = 0.f;
#pragma unroll
        for (int k = 0; k < 4; ++k) if (k != i1 && (i2 < 0 || iv[k] > b2)) { b2 = iv[k]; i2 = k; }
        const float u1 = i1 == 0 ? uv[0] : (i1 == 1 ? uv[1] : (i1 == 2 ? uv[2] : uv[3])), u2 = i2 == 0 ? uv[0] : (i2 == 1 ? uv[1] : (i2 == 2 ? uv[2] : uv[3]));
        const float rs = 1.0f / (u1 + u2);
        rec_e[rl * 2] = gi * 4 + i1; rec_e[rl * 2 + 1] = gi * 4 + i2; rec_w[rl * 2] = u1 * rs; rec_w[rl * 2 + 1] = u2 * rs;
    }
    __syncthreads();
    if (rep) return;
    if (tid < 128) { rec_p[tid * 2] = atomicAdd((int*)&lcnt[rec_e[tid * 2]], 1); rec_p[tid * 2 + 1] = atomicAdd((int*)&lcnt[rec_e[tid * 2 + 1]], 1); }
    __syncthreads();
    if (tid < 16) gbase[tid] = (int)__hip_atomic_fetch_add(CTLP + CW_CNT + 64 * l + tid, (unsigned)lcnt[tid], __ATOMIC_RELAXED, __HIP_MEMORY_SCOPE_AGENT);
    __syncthreads();
    if (tid < 128) { const int tok = vcu * 128 + tid, e0 = rec_e[tid * 2], e1 = rec_e[tid * 2 + 1], p0 = gbase[e0] + rec_p[tid * 2], p1 = gbase[e1] + rec_p[tid * 2 + 1];
        int* idx = WSP(int, WS_IDX); idx[e0 * NTOK + p0] = tok; idx[e1 * NTOK + p1] = tok;
        *(u32x4*)(WSP(unsigned, WS_ROUTE) + (size_t)tok * 4) = (u32x4){(unsigned)(e0 << 15 | p0), (unsigned)(e1 << 15 | p1), __float_as_uint(rec_w[tid * 2]), __float_as_uint(rec_w[tid * 2 + 1])}; }
    __syncthreads();
}
__device__ __forceinline__ void phase_prefix(Ctx& C, int rep = 0) {
    PHASE_ENTRY(); const int g = vcu * NTHREADS + tid, dkv = g & 31, v = (g >> 5) & 511, bh = g >> 14, h = bh & 3;
    const float gam = __builtin_amdgcn_exp2f(log2_gamma(h)), gam256 = __builtin_amdgcn_exp2f(256.0f * log2_gamma(h));
    bf16_t* p = WSP(bf16_t, WS_B2T) + (size_t)bh * 32 * 262144 + (size_t)v * 512 + dkv * 8;
    float s[8];
#pragma unroll
    for (int k = 0; k < 8; ++k) s[k] = 0.f;
    for (int c0 = 0; c0 < 32; c0 += 4) {
        u32x4 kv[4];
#pragma unroll
        for (int i = 0; i < 4; ++i) kv[i] = *(const u32x4*)(p + (size_t)(c0 + i) * 262144);
#pragma unroll
        for (int i = 0; i < 4; ++i) {
            u32x4 o; o.x = cvt_pk_bf16(s[0] * gam, s[1] * gam); o.y = cvt_pk_bf16(s[2] * gam, s[3] * gam); o.z = cvt_pk_bf16(s[4] * gam, s[5] * gam); o.w = cvt_pk_bf16(s[6] * gam, s[7] * gam);
            if (!rep) *(u32x4*)(p + (size_t)(c0 + i) * 262144) = o;
            s[0] = s[0] * gam256 + bflo(kv[i].x); s[1] = s[1] * gam256 + bfhi(kv[i].x); s[2] = s[2] * gam256 + bflo(kv[i].y); s[3] = s[3] * gam256 + bfhi(kv[i].y);
            s[4] = s[4] * gam256 + bflo(kv[i].z); s[5] = s[5] * gam256 + bfhi(kv[i].z); s[6] = s[6] * gam256 + bflo(kv[i].w); s[7] = s[7] * gam256 + bfhi(kv[i].w); }
    }
}
__device__ __forceinline__ void phase_kvfin(Ctx& C) {
    PHASE_ENTRY(); const float* akv = WSP(float, WS_AKV); bf16_t* kpp = WSP(bf16_t, WS_KP); const int* posp = INI(2); const float g0 = INF(13)[2 * lane], g1 = INF(13)[2 * lane + 1];
    const float inv = __builtin_amdgcn_exp2f(-(float)(lane & 31) * (LOG2_THETA / 32.0f));
    for (int rr = 0; rr < 16; ++rr) {
        const int tok = vcu * 128 + wave * 16 + rr; const float* a = akv + (size_t)tok * 256; bf16_t* kp = kpp + (size_t)tok * QKD;
        const f32x2 cv = *(const f32x2*)(a + 2 * lane); const float rstd = __builtin_amdgcn_rsqf(wave_sum(cv[0] * cv[0] + cv[1] * cv[1]) * (1.0f / 128.0f) + EPS);
        *(unsigned*)(kp + 2 * lane) = cvt_pk_bf16(cv[0] * rstd * g0, cv[1] * rstd * g1);
        const float x1 = a[128 + (lane & 31)], x2 = a[160 + (lane & 31)]; float s, c; sincos_rad((float)posp[tok] * inv, s, c);
        const float o = lane < 32 ? x1 * c - x2 * s : x1 * s + x2 * c;
        kp[128 + lane] = (bf16_t)(cvt_pk_bf16(o, 0.f) & 0xffffu);
    }
}
namespace att {
constexpr int SHM_V = 16384, SHM_K = 24576, OFF_V = 0, OFF_K = 2 * SHM_V, OFF_WS = OFF_K + 2 * SHM_K, OFF_Q = OFF_WS + 2048;
constexpr float THR = 8.0f;
#define KSWZ(row, colB) ((row) * 384 + ((colB) ^ ((((row) >> 1) & 7) << 4)))
#define SBAR() __builtin_amdgcn_sched_barrier(0)
__device__ __forceinline__ int crow(int r, int hi) { return (r & 3) + 8 * (r >> 2) + 4 * hi; }
__device__ __forceinline__ void partialSM(f32x16& p0, f32x16& p1, float& m_reg, float& mn, float& alpha) {
    float pmax = p0[0];
#pragma unroll
    for (int r = 1; r < 16; ++r) pmax = fmaxf(pmax, p0[r]);
#pragma unroll
    for (int r = 0; r < 16; ++r) pmax = fmaxf(pmax, p1[r]);
    { auto rr = __builtin_amdgcn_permlane32_swap(__float_as_uint(pmax), __float_as_uint(pmax), false, false); pmax = fmaxf(__uint_as_float(rr[0]), __uint_as_float(rr[1])); }
    if (__builtin_expect(__all(pmax - m_reg <= THR), 1)) { mn = m_reg; alpha = 1.f; }
    else { mn = fmaxf(m_reg, pmax); alpha = __builtin_amdgcn_exp2f(m_reg - mn); m_reg = mn; }
#pragma unroll
    for (int r = 0; r < 16; ++r) p0[r] = p0[r] - mn;
#pragma unroll
    for (int r = 0; r < 16; ++r) p1[r] = p1[r] - mn;
#pragma unroll
    for (int r = 0; r < 16; ++r) p0[r] = __builtin_amdgcn_exp2f(p0[r]);
}
__device__ __forceinline__ void finishSM(f32x16& p0, f32x16& p1, float alpha, float& l_reg, bf16x8& pa0, bf16x8& pa1, bf16x8& pa2, bf16x8& pa3) {
#pragma unroll
    for (int r = 0; r < 16; ++r) p1[r] = __builtin_amdgcn_exp2f(p1[r]);
    float ps = 0;
#pragma unroll
    for (int r = 0; r < 16; ++r) ps += p0[r];
#pragma unroll
    for (int r = 0; r < 16; ++r) ps += p1[r];
    { auto rr = __builtin_amdgcn_permlane32_swap(__float_as_uint(ps), __float_as_uint(ps), false, false); ps = __uint_as_float(rr[0]) + __uint_as_float(rr[1]); }
    l_reg = l_reg * alpha + ps;
#define PK4(P, BASE, OUT) do { unsigned a0 = cvt_pk_bf16(P[BASE + 0], P[BASE + 1]), a1 = cvt_pk_bf16(P[BASE + 2], P[BASE + 3]);   \
    unsigned b0 = cvt_pk_bf16(P[BASE + 4], P[BASE + 5]), b1 = cvt_pk_bf16(P[BASE + 6], P[BASE + 7]);                              \
    auto r0 = __builtin_amdgcn_permlane32_swap(a0, b0, false, false); auto r1 = __builtin_amdgcn_permlane32_swap(a1, b1, false, false); \
    u32x4 w = {r0[0], r1[0], r0[1], r1[1]}; OUT = *reinterpret_cast<bf16x8*>(&w); } while (0)
    PK4(p0, 0, pa0); PK4(p0, 8, pa1); PK4(p1, 0, pa2); PK4(p1, 8, pa3);
#undef PK4
}
template <int BUF> __device__ __forceinline__ void qkt(f32x16& p0, f32x16& p1, const LAS char* const (&kb4)[4], const bf16x8* qr, const LAS char* ql) {
    p0 = f32x16{}; p1 = f32x16{};
#pragma unroll
    for (int d0 = 0; d0 < 12; ++d0) {
        const bf16x8 b0 = *reinterpret_cast<const LAS bf16x8*>(kb4[d0 & 3] + BUF * SHM_K + (d0 >> 2) * 128);
        const bf16x8 b1 = *reinterpret_cast<const LAS bf16x8*>(kb4[d0 & 3] + BUF * SHM_K + (d0 >> 2) * 128 + 32 * 384);
        const bf16x8 qf = d0 < 8 ? qr[d0 < 8 ? d0 : 0] : *reinterpret_cast<const LAS bf16x8*>(ql + (d0 - 8) * 1024);
        p0 = __builtin_amdgcn_mfma_f32_32x32x16_bf16(b0, qf, p0, 0, 0, 0);
        p1 = __builtin_amdgcn_mfma_f32_32x32x16_bf16(b1, qf, p1, 0, 0, 0); }
}
__device__ __forceinline__ int v_st(int k, int c) { const int kk = (k & ~0xC) | ((k & 4) << 1) | ((k & 8) >> 1); return ((kk >> 3) * 4 + (c >> 5)) * 512 + ((kk & 7) * 32 + (c & 31)) * 2; }
__device__ __forceinline__ int v_rd_base(int lane) { return ((lane & 3) << 3) | (((lane >> 2) & 3) << 6) | (((lane >> 4) & 1) << 5) | (((lane >> 5) & 1) << 8); }
constexpr int v_rd_off(int d0, int ks, int half) { return d0 * 512 + ks * 4096 + half * 2048; }
template <int OFF> __device__ __forceinline__ s16x4 tr_read(int vb) { s16x4 r; asm volatile("ds_read_b64_tr_b16 %0, %1 offset:%2" : "=&v"(r) : "v"(vb), "i"(OFF) : "memory"); return r; }
template <int D0> __device__ __forceinline__ void pv_one(f32x16& od, int vb, bf16x8 pa0, bf16x8 pa1, bf16x8 pa2, bf16x8 pa3) {
    const s16x4 l0 = tr_read<v_rd_off(D0, 0, 0)>(vb), h0 = tr_read<v_rd_off(D0, 0, 1)>(vb), l1 = tr_read<v_rd_off(D0, 1, 0)>(vb), h1 = tr_read<v_rd_off(D0, 1, 1)>(vb);
    const s16x4 l2 = tr_read<v_rd_off(D0, 2, 0)>(vb), h2 = tr_read<v_rd_off(D0, 2, 1)>(vb), l3 = tr_read<v_rd_off(D0, 3, 0)>(vb), h3 = tr_read<v_rd_off(D0, 3, 1)>(vb);
    asm volatile("s_waitcnt lgkmcnt(0)" ::: "memory"); SBAR();
#define PK(L, H) (bf16x8){L[0], L[1], L[2], L[3], H[0], H[1], H[2], H[3]}
    od = __builtin_amdgcn_mfma_f32_32x32x16_bf16(pa0, PK(l0, h0), od, 0, 0, 0);
    od = __builtin_amdgcn_mfma_f32_32x32x16_bf16(pa1, PK(l1, h1), od, 0, 0, 0);
    od = __builtin_amdgcn_mfma_f32_32x32x16_bf16(pa2, PK(l2, h2), od, 0, 0, 0);
    od = __builtin_amdgcn_mfma_f32_32x32x16_bf16(pa3, PK(l3, h3), od, 0, 0, 0);
#undef PK
}
__device__ __forceinline__ void pv_d0(f32x16* o, int vb, bf16x8 pa0, bf16x8 pa1, bf16x8 pa2, bf16x8 pa3) {
    pv_one<0>(o[0], vb, pa0, pa1, pa2, pa3); pv_one<1>(o[1], vb, pa0, pa1, pa2, pa3); pv_one<2>(o[2], vb, pa0, pa1, pa2, pa3); pv_one<3>(o[3], vb, pa0, pa1, pa2, pa3);
}
template <bool O8> __device__ __forceinline__ void attn_unit(const bf16_t* __restrict__ Q, const bf16_t* __restrict__ Kp, bf16_t* __restrict__ O, int t0, int kbase, int nt_real, LAS char* lds, int wid) {
    int lane_ = (int)__builtin_amdgcn_mbcnt_hi(~0u, __builtin_amdgcn_mbcnt_lo(~0u, 0u)); asm volatile("" : "+v"(lane_));
    const int lane = lane_, tid = wid * 64 + lane, r32 = lane & 31, hi = lane >> 5;
    LAS char* V_lds = lds + OFF_V; LAS char* K_lds = lds + OFF_K;
    LAS float* ws = (LAS float*)(lds + OFF_WS) + wid * 64; LAS float* li_l = ws; LAS float* al_l = ws + 32;
    float m_reg = -1e30f, l_reg = 0; f32x16 o[4] = {}; bf16x8 qr[8];
    LAS char* qlds = lds + OFF_Q + wid * 4096 + lane * 16;
    const char* Qs = (const char*)Q + (size_t)t0 * 3072 + wid * (QKD * 2); const unsigned qlo = (unsigned)(r32 * 3072 + hi * 16);
#pragma unroll
    for (int d0 = 0; d0 < 8; ++d0) qr[d0] = *reinterpret_cast<const bf16x8*>(Qs + qlo + d0 * 32);
    __syncthreads();
#pragma unroll
    for (int d0 = 8; d0 < 12; ++d0) *reinterpret_cast<LAS bf16x8*>(qlds + (d0 - 8) * 1024) = *reinterpret_cast<const bf16x8*>(Qs + qlo + d0 * 32);
    const int vb0 = (int)(uintptr_t)V_lds + v_rd_base(lane);
    const LAS char* kb4[4];
#pragma unroll
    for (int q = 0; q < 4; ++q) kb4[q] = K_lds + r32 * 384 + ((q * 32 + hi * 16) ^ (((r32 >> 1) & 7) << 4));
    const int NT = (nt_real + 1) & ~1;
    const bool dummy = (NT != nt_real);
    bf16x8 sr_[1][3];
    const char* Kg = (const char*)(Kp + (size_t)kbase * QKD);
#define SLOAD(s, kt) do { _Pragma("unroll") for (int i = 0; i < 3; ++i) sr_[s][i] = *reinterpret_cast<const bf16x8*>(Kg + (size_t)(kt) * SHM_K + i * 8192 + (unsigned)(tid * 16)); } while (0)
#define SWRITE(b, s) do { int tl_ = (int)__builtin_amdgcn_mbcnt_hi(~0u, __builtin_amdgcn_mbcnt_lo(~0u, 0u)); asm volatile("" : "+v"(tl_)); tl_ += wid * 64; _Pragma("unroll") for (int i = 0; i < 3; ++i) { const int p_ = tl_ + 512 * i, row_ = p_ / 24, c16_ = p_ - row_ * 24; \
        *(LAS bf16x8*)(K_lds + (b) * SHM_K + KSWZ(row_, c16_ * 16)) = sr_[s][i]; if (c16_ < 16) *(LAS bf16x8*)(V_lds + (b) * SHM_V + v_st(row_, c16_ * 8)) = sr_[s][i]; } } while (0)
#define SWAIT() asm volatile("s_waitcnt vmcnt(0)" ::: "memory")
#define RESC(a) do { if (__any((a) < 1.f)) { if (hi == 0) al_l[r32] = (a); asm volatile("s_waitcnt lgkmcnt(0)" ::: "memory"); \
    _Pragma("unroll") for (int d = 0; d < 4; ++d) _Pragma("unroll") for (int r = 0; r < 16; ++r) o[d][r] *= al_l[crow(r, hi)]; } } while (0)
    f32x16 pA0, pA1, pB0, pB1; float mnA, mnB, alA, alB; bf16x8 pa0, pa1, pa2, pa3;
    SLOAD(0, 0); SWAIT(); SWRITE(0, 0); __syncthreads();
    qkt<0>(pA0, pA1, kb4, qr, qlds); partialSM(pA0, pA1, m_reg, mnA, alA);
    SLOAD(0, 1); SWAIT(); SWRITE(1, 0); __syncthreads();
    for (int j = 1; j + 1 < NT; j += 2) {
        SBAR(); qkt<1>(pB0, pB1, kb4, qr, qlds);
        finishSM(pA0, pA1, alA, l_reg, pa0, pa1, pa2, pa3); SBAR();
        SLOAD(0, j + 1); SBAR();
        pv_d0(o, vb0, pa0, pa1, pa2, pa3); partialSM(pB0, pB1, m_reg, mnB, alB);
        __syncthreads(); SWAIT(); SWRITE(0, 0);
        RESC(alB); __syncthreads();
        SBAR(); qkt<0>(pA0, pA1, kb4, qr, qlds);
        finishSM(pB0, pB1, alB, l_reg, pa0, pa1, pa2, pa3); SBAR();
        SLOAD(0, j + 2); SBAR();
        pv_d0(o, vb0 + SHM_V, pa0, pa1, pa2, pa3); partialSM(pA0, pA1, m_reg, mnA, alA);
        __syncthreads(); SWAIT(); SWRITE(1, 0);
        RESC(alA); __syncthreads();
    }
    SBAR(); qkt<1>(pB0, pB1, kb4, qr, qlds);
    if (dummy) {
#pragma unroll
        for (int r = 0; r < 16; ++r) { pB0[r] = -INFINITY; pB1[r] = -INFINITY; } }
    finishSM(pA0, pA1, alA, l_reg, pa0, pa1, pa2, pa3); SBAR();
    pv_d0(o, vb0, pa0, pa1, pa2, pa3); partialSM(pB0, pB1, m_reg, mnB, alB);
    __syncthreads(); RESC(alB);
    finishSM(pB0, pB1, alB, l_reg, pa0, pa1, pa2, pa3); SBAR();
    pv_d0(o, vb0 + SHM_V, pa0, pa1, pa2, pa3);
    {
        int lanee = (int)__builtin_amdgcn_mbcnt_hi(~0u, __builtin_amdgcn_mbcnt_lo(~0u, 0u)); asm volatile("" : "+v"(lanee));
        const int wide = wid, r32e = lanee & 31, hie = lanee >> 5;
        LAS float* lie = (LAS float*)(lds + OFF_WS) + wide * 64;
        if (hie == 0) lie[r32e] = l_reg; asm volatile("s_waitcnt lgkmcnt(0)" ::: "memory");
        char* Os = (char*)O + (size_t)t0 * (O8 ? 1024 : 2048) + wide * (O8 ? 128 : 256); const unsigned olo = (unsigned)(r32e * (O8 ? 1 : 2));
#pragma unroll
        for (int r = 0; r < 16; ++r) { const int orow = crow(r, hie); const float rl = __builtin_amdgcn_rcpf(lie[orow]);
#pragma unroll
            for (int d0 = 0; d0 < 4; ++d0) { if constexpr (O8) *(unsigned char*)(Os + olo + (unsigned)(orow * 1024) + d0 * 32) = (unsigned char)(pk4_fp8(16.0f * o[d0][r] * rl, 0.f, 0.f, 0.f) & 0xffu);
                else *(bf16_t*)(Os + olo + (unsigned)(orow * 2048) + d0 * 64) = (bf16_t)(cvt_pk_bf16(o[d0][r] * rl, 0.f) & 0xffffu); } }
    }
#undef SLOAD
#undef SWRITE
#undef SWAIT
#undef RESC
}
constexpr int SLOT = 24576, ROPE_OFF = 16384, NSLOT = 3, OFF_WS2 = NSLOT * SLOT, OFF_Q2 = OFF_WS2 + 2048;
__device__ __forceinline__ unsigned xrow(unsigned row) { return ((row & 3u) << 2) | ((row >> 2) & 3u); }
__device__ __forceinline__ void qkt2(f32x16& p0, f32x16& p1, const unsigned rb, const unsigned rr, const bf16x8* qr, const LAS char* ql) {
    p0 = f32x16{}; p1 = f32x16{};
#pragma unroll
    for (int d0 = 0; d0 < 12; ++d0) {
        const unsigned ad = d0 < 8 ? (rb ^ (unsigned)(d0 << 5)) : (rr ^ (unsigned)((d0 - 8) << 5));
        const bf16x8 b0 = *reinterpret_cast<const LAS bf16x8*>((LAS char*)(uintptr_t)ad);
        const bf16x8 b1 = *reinterpret_cast<const LAS bf16x8*>((LAS char*)(uintptr_t)(ad + (d0 < 8 ? 8192u : 4096u)));
        const bf16x8 qf = d0 < 8 ? qr[d0 < 8 ? d0 : 0] : *reinterpret_cast<const LAS bf16x8*>(ql + (d0 - 8) * 1024);
        p0 = __builtin_amdgcn_mfma_f32_32x32x16_bf16(b0, qf, p0, 0, 0, 0);
        p1 = __builtin_amdgcn_mfma_f32_32x32x16_bf16(b1, qf, p1, 0, 0, 0); }
}
__device__ __forceinline__ s16x4 tr_rd(unsigned ad) { s16x4 r; asm volatile("ds_read_b64_tr_b16 %0, %1" : "=&v"(r) : "v"(ad) : "memory"); return r; }
template <int KS> __device__ __forceinline__ s16x4 tr_rdo(unsigned ad) { s16x4 r; asm volatile("ds_read_b64_tr_b16 %0, %1 offset:%2" : "=&v"(r) : "v"(ad), "i"(KS * 4096) : "memory"); return r; }
template <int D0> __device__ __forceinline__ void pv_one2(f32x16& od, const unsigned bt0, const unsigned bt1, bf16x8 pa0, bf16x8 pa1, bf16x8 pa2, bf16x8 pa3) {
    const unsigned a0 = bt0 ^ (unsigned)(D0 << 6), a1 = bt1 ^ (unsigned)(D0 << 6);
    const s16x4 l0 = tr_rdo<0>(a0), h0 = tr_rdo<0>(a1), l1 = tr_rdo<1>(a0), h1 = tr_rdo<1>(a1), l2 = tr_rdo<2>(a0), h2 = tr_rdo<2>(a1), l3 = tr_rdo<3>(a0), h3 = tr_rdo<3>(a1);
    asm volatile("s_waitcnt lgkmcnt(0)" ::: "memory"); SBAR();
#define PK(L, H) (bf16x8){L[0], L[1], L[2], L[3], H[0], H[1], H[2], H[3]}
    od = __builtin_amdgcn_mfma_f32_32x32x16_bf16(pa0, PK(l0, h0), od, 0, 0, 0);
    od = __builtin_amdgcn_mfma_f32_32x32x16_bf16(pa1, PK(l1, h1), od, 0, 0, 0);
    od = __builtin_amdgcn_mfma_f32_32x32x16_bf16(pa2, PK(l2, h2), od, 0, 0, 0);
    od = __builtin_amdgcn_mfma_f32_32x32x16_bf16(pa3, PK(l3, h3), od, 0, 0, 0);
#undef PK
}
__device__ __forceinline__ void pv2(f32x16* o, const unsigned bt0, const unsigned bt1, bf16x8 pa0, bf16x8 pa1, bf16x8 pa2, bf16x8 pa3) {
    pv_one2<0>(o[0], bt0, bt1, pa0, pa1, pa2, pa3); pv_one2<1>(o[1], bt0, bt1, pa0, pa1, pa2, pa3); pv_one2<2>(o[2], bt0, bt1, pa0, pa1, pa2, pa3); pv_one2<3>(o[3], bt0, bt1, pa0, pa1, pa2, pa3);
}
template <bool O8> __device__ __forceinline__ void attn_unit2(const bf16_t* __restrict__ Q, const bf16_t* __restrict__ Kp, bf16_t* __restrict__ O, int t0, int kbase, int nt_real, LAS char* lds, int wid) {
    int lane_ = (int)__builtin_amdgcn_mbcnt_hi(~0u, __builtin_amdgcn_mbcnt_lo(~0u, 0u)); asm volatile("" : "+v"(lane_));
    const int lane = lane_, r32 = lane & 31, hi = lane >> 5;
    LAS float* ws = (LAS float*)(lds + OFF_WS2) + wid * 64; LAS float* al_l = ws + 32;
    float m_reg = -1e30f, l_reg = 0; f32x16 o[4] = {}; bf16x8 qr[8];
    LAS char* qlds = lds + OFF_Q2 + wid * 4096 + lane * 16;
    const char* Qs = (const char*)Q + (size_t)t0 * 3072 + wid * (QKD * 2); const unsigned qlo = (unsigned)(r32 * 3072 + hi * 16);
#pragma unroll
    for (int d0 = 0; d0 < 8; ++d0) qr[d0] = *reinterpret_cast<const bf16x8*>(Qs + qlo + d0 * 32);
    bf16x8 qt[4];
#pragma unroll
    for (int d0 = 8; d0 < 12; ++d0) qt[d0 - 8] = *reinterpret_cast<const bf16x8*>(Qs + qlo + d0 * 32);
    asm volatile("s_waitcnt vmcnt(0)" ::: "memory");
    __builtin_amdgcn_s_barrier(); asm volatile("" ::: "memory");
#pragma unroll
    for (int d0 = 0; d0 < 4; ++d0) *reinterpret_cast<LAS bf16x8*>(qlds + d0 * 1024) = qt[d0];
    const unsigned lds0 = (unsigned)(uintptr_t)lds;
    const unsigned rb0 = lds0 + 256u * r32 + 16u * ((unsigned)hi ^ xrow(r32));
    const unsigned rr0 = lds0 + ROPE_OFF + 128u * r32 + 16u * ((unsigned)hi ^ ((r32 >> 1) & 7u));
    const unsigned tq = (lane & 15) >> 2, tp = lane & 3, tblk = (lane >> 4) & 1;
    const unsigned bt00 = lds0 + 256u * (8u * hi + tq) + 64u * tq + 16u * ((2u * tblk + (tp >> 1)) ^ (2u * hi)) + 8u * (tp & 1);
    const unsigned bt10 = lds0 + 256u * (8u * hi + 4u + tq) + 64u * tq + 16u * ((2u * tblk + (tp >> 1)) ^ (2u * hi + 1u)) + 8u * (tp & 1);
    unsigned so[3];
    { const unsigned q0 = (unsigned)wid * 64u + lane, q1 = q0 + 512u; const unsigned r0 = q0 >> 4, r1 = q1 >> 4, r2 = q0 >> 3;
      so[0] = r0 * 384u + 16u * ((q0 & 15u) ^ xrow(r0)); so[1] = r1 * 384u + 16u * ((q1 & 15u) ^ xrow(r1)); so[2] = r2 * 384u + 256u + 16u * ((q0 & 7u) ^ ((r2 >> 1) & 7u)); }
    const char* Kg = (const char*)(Kp + (size_t)kbase * QKD);
    const int NT = (nt_real + 1) & ~1; const bool dummy = (NT != nt_real);
#define DMA(kt, sl) do { const char* tb_ = Kg + (size_t)(kt) * SLOT; LAS char* db_ = lds + (sl) + wid * 1024; \
        __builtin_amdgcn_global_load_lds((const unsigned*)(tb_ + so[0]), (LAS unsigned*)(db_), 16, 0, 0); \
        __builtin_amdgcn_global_load_lds((const unsigned*)(tb_ + so[1]), (LAS unsigned*)(db_ + 8192), 16, 0, 0); \
        __builtin_amdgcn_global_load_lds((const unsigned*)(tb_ + so[2]), (LAS unsigned*)(db_ + ROPE_OFF), 16, 0, 0); } while (0)
#define WAITBAR() do { asm volatile("s_waitcnt vmcnt(0) lgkmcnt(0)" ::: "memory"); __builtin_amdgcn_s_barrier(); asm volatile("" ::: "memory"); } while (0)
#define RESC(a) do { if (__any((a) < 1.f)) { if (hi == 0) al_l[r32] = (a); asm volatile("s_waitcnt lgkmcnt(0)" ::: "memory"); \
    _Pragma("unroll") for (int d = 0; d < 4; ++d) _Pragma("unroll") for (int r = 0; r < 16; ++r) o[d][r] *= al_l[crow(r, hi)]; } } while (0)
    f32x16 pA0, pA1, pB0, pB1; float mnA, mnB, alA, alB; bf16x8 pa0, pa1, pa2, pa3;
    int sc = 0, sn = SLOT, sp = 2 * SLOT;
#define ROT() do { const int t_ = sp; sp = sc; sc = sn; sn = t_; } while (0)
    DMA(0, 0);
    WAITBAR(); DMA(1, sn);
    qkt2(pA0, pA1, rb0 + sc, rr0 + sc, qr, qlds); partialSM(pA0, pA1, m_reg, mnA, alA);
    ROT();
#pragma unroll 1
    for (int j = 1; j + 1 < NT; j += 2) {
        WAITBAR(); DMA(j + 1, sn);
        SBAR(); qkt2(pB0, pB1, rb0 + sc, rr0 + sc, qr, qlds);
        finishSM(pA0, pA1, alA, l_reg, pa0, pa1, pa2, pa3); SBAR();
        pv2(o, bt00 + sp, bt10 + sp, pa0, pa1, pa2, pa3); partialSM(pB0, pB1, m_reg, mnB, alB);
        RESC(alB); ROT();
        WAITBAR(); DMA(j + 2, sn);
        SBAR(); qkt2(pA0, pA1, rb0 + sc, rr0 + sc, qr, qlds);
        finishSM(pB0, pB1, alB, l_reg, pa0, pa1, pa2, pa3); SBAR();
        pv2(o, bt00 + sp, bt10 + sp, pa0, pa1, pa2, pa3); partialSM(pA0, pA1, m_reg, mnA, alA);
        RESC(alA); ROT();
    }
    WAITBAR();
    SBAR(); qkt2(pB0, pB1, rb0 + sc, rr0 + sc, qr, qlds);
    if (dummy) {
#pragma unroll
        for (int r = 0; r < 16; ++r) { pB0[r] = -INFINITY; pB1[r] = -INFINITY; } }
    finishSM(pA0, pA1, alA, l_reg, pa0, pa1, pa2, pa3); SBAR();
    pv2(o, bt00 + sp, bt10 + sp, pa0, pa1, pa2, pa3); partialSM(pB0, pB1, m_reg, mnB, alB);
    RESC(alB);
    finishSM(pB0, pB1, alB, l_reg, pa0, pa1, pa2, pa3); SBAR();
    pv2(o, bt00 + sc, bt10 + sc, pa0, pa1, pa2, pa3);
    {
        int lanee = (int)__builtin_amdgcn_mbcnt_hi(~0u, __builtin_amdgcn_mbcnt_lo(~0u, 0u)); asm volatile("" : "+v"(lanee));
        const int wide = wid, r32e = lanee & 31, hie = lanee >> 5;
        LAS float* lie = (LAS float*)(lds + OFF_WS2) + wide * 64;
        if (hie == 0) lie[r32e] = l_reg; asm volatile("s_waitcnt lgkmcnt(0)" ::: "memory");
        char* Os = (char*)O + (size_t)t0 * (O8 ? 1024 : 2048) + wide * (O8 ? 128 : 256); const unsigned olo = (unsigned)(r32e * (O8 ? 1 : 2));
#pragma unroll
        for (int r = 0; r < 16; ++r) { const int orow = crow(r, hie); const float rl = __builtin_amdgcn_rcpf(lie[orow]);
#pragma unroll
            for (int d0 = 0; d0 < 4; ++d0) { if constexpr (O8) *(unsigned char*)(Os + olo + (unsigned)(orow * 1024) + d0 * 32) = (unsigned char)(pk4_fp8(16.0f * o[d0][r] * rl, 0.f, 0.f, 0.f) & 0xffu);
                else *(bf16_t*)(Os + olo + (unsigned)(orow * 2048) + d0 * 64) = (bf16_t)(cvt_pk_bf16(o[d0][r] * rl, 0.f) & 0xffffu); } }
    }
#undef DMA
#undef WAITBAR
#undef RESC
#undef ROT
}
}
struct Args { const void* in[25]; float* out; unsigned char* ws; int lo, hi, l, hf; };
enum { PH_PRO = 0, PH_NA, PH_R2, PH_R3, PH_R4, PH_R5, PH_R6, PH_R7, PH_M2, PH_M3, PH_M4, PH_M5, PH_NB, PH_MOE1, PH_MOE2, PH_COUNT };

__device__ __forceinline__ void make_ctx(Ctx& C, unsigned char* lds_raw) {
    C.ka = (kaptr_t)__builtin_amdgcn_kernarg_segment_ptr(); C.lds = (LAS unsigned char*)lds_raw;
    C.wave = __builtin_amdgcn_readfirstlane((int)threadIdx.x >> 6);
    { const int bx = blockIdx.x; C.vcu = (bx & 7) * (GRID / 8) + (bx >> 3); }
}

template <int PH> __device__ __forceinline__ void run_phase(Ctx& C, const int l, const int hf, const int rep = 0) {
    PHASE_ENTRY(); const int wv = wave;
    LAS unsigned char* lds = ldsb; int bid_ = blockIdx.x; asm volatile("" : "+s"(bid_)); const int bid = bid_; const unsigned LD1K = 2048u;
    const float* gate1 = rep ? (const float*)(WSB + WS_CTL + 512 * 1024) : WSP(float, WS_MOD) + (size_t)l * 4 * 6144 + 2 * 1024;
    const bf16_t* win = WSP(bf16_t, WS_WIN) + (size_t)(l & 1) * 6144 * 1024;
    const bf16_t* xnh = WSP(bf16_t, WS_XN) + (size_t)hf * THALF * DM;
    const int j = l & 1;
    if constexpr (PH == PH_PRO) phase_prologue(C);
    if constexpr (PH == PH_NA) phase_norm_a(C, l, rep);
    if constexpr (PH == PH_R2) {
        constexpr bool F8 = FP8_R2 != 0; constexpr unsigned LD = F8 ? 1024u : 2048u; constexpr int KP = F8 ? 512 : 1024; constexpr int SW = F8 ? 0x79797979 : 0x7f7f7f7f, SX = F8 ? 0x7d7d7d7d : 0x7f7f7f7f;
        const char* X = F8 ? (const char*)(WSP(unsigned char, WS_XN8) + (size_t)hf * THALF * DM) : (const char*)xnh;
        const char* W = F8 ? (const char*)(WSP(unsigned char, WS_WIN8) + (size_t)(l & 1) * 6144 * 1024) : (const char*)win;
        { SchedStd S; S.T.init(64, 4, GRID, bid); S.A = X; S.B = W; S.sA = 256 * LD; S.sB = 256 * LD;
          EpiRopeQK<0> E{WSP(bf16_t, WS_A2), INI(2), hf, nullptr}; pg8::gemm_phase<EpiRopeQK<0>, SchedStd, false, F8, SW, SX>(lds, wv, KP, LD, LD, S, E); }
        { SchedStd S; S.T.init(64, 4, GRID, bid); S.A = X; S.B = W + (size_t)1024 * LD; S.sA = 256 * LD; S.sB = 256 * LD;
          EpiRopeQK<1> E{WSP(bf16_t, WS_KR), INI(2), hf, WSP(bf16_t, WS_KT)}; pg8::gemm_phase<EpiRopeQK<1>, SchedStd, false, F8, SW, SX>(lds, wv, KP, LD, LD, S, E); }
        { SchedStd S; S.T.init(8, 64, GRID, bid); S.A = W + (size_t)2048 * LD; S.B = X; S.sA = 256 * LD; S.sB = 256 * LD;
          EpiVT E{WSP(bf16_t, WS_B2T)}; pg8::gemm_phase<EpiVT, SchedStd, false, F8, SW, SX>(lds, wv, KP, LD, LD, S, E); }
    }
    if constexpr (PH == PH_R3) {
        { SchedBatch S{(const char*)WSP(bf16_t, WS_A2), (const char*)WSP(bf16_t, WS_KR), 256 * 1024, 256 * 512, 0, 0, 256, 1, GRID, vcu};
          EpiS E{WSP(bf16_t, WS_A2)}; pg8::gemm_phase<EpiS, SchedBatch, false>(lds, wv, 256, 1024u, 512u, S, E); }
        { SchedBatch S{(const char*)(WSP(bf16_t, WS_B2T) + 256), (const char*)WSP(bf16_t, WS_KT), 512 * 1024, 256 * 512, 256 * 1024, 0, 256, 2, GRID, vcu};
          EpiKV E{WSP(bf16_t, WS_B2T)}; pg8::gemm_phase<EpiKV, SchedBatch, false>(lds, wv, 256, 1024u, 512u, S, E); }
    }
    if constexpr (PH == PH_R4) phase_prefix(C, rep);
    if constexpr (PH == PH_R5) {
        SchedBatch S{(const char*)WSP(bf16_t, WS_A2), (const char*)WSP(bf16_t, WS_B2T), 256 * 1024, 512 * 1024, 0, 256 * 1024, 256, 2, GRID, vcu};
        EpiFin E{WSP(bf16_t, WS_B2T), WSP(float, WS_STATS), rep}; pg8::gemm_phase<EpiFin, SchedBatch, false>(lds, wv, 512, 1024u, 1024u, S, E);
    }
    if constexpr (PH == PH_R6) {
        constexpr bool F8 = FP8_R6 != 0; constexpr unsigned LD = F8 ? 1024u : 2048u; constexpr int KP = F8 ? 512 : 1024; constexpr int SW = F8 ? 0x79797979 : 0x7f7f7f7f, SX = F8 ? 0x7d7d7d7d : 0x7f7f7f7f;
        const char* X = F8 ? (const char*)(WSP(unsigned char, WS_XN8) + (size_t)hf * THALF * DM) : (const char*)xnh;
        const char* W = F8 ? (const char*)(WSP(unsigned char, WS_WIN8) + (size_t)(l & 1) * 6144 * 1024) : (const char*)win;
        SchedStd S; S.T.init(64, 8, GRID, bid); S.A = X; S.B = W + (size_t)4096 * LD; S.sA = 256 * LD; S.sB = 256 * LD;
        EpiGate<FP8_R7 != 0> E{WSP(bf16_t, WS_B2T), WSP(float, WS_STATS), WSP(bf16_t, WS_A2), WSP(unsigned char, WS_ACT8)}; pg8::gemm_phase<EpiGate<FP8_R7 != 0>, SchedStd, false, F8, SW, SX>(lds, wv, KP, LD, LD, S, E);
    }
    if constexpr (PH == PH_R7) {
        constexpr bool F8 = FP8_R7 != 0; constexpr unsigned LD = F8 ? 2048u : 4096u; constexpr int KP = F8 ? 1024 : 2048; constexpr int SW = F8 ? 0x79797979 : 0x7f7f7f7f, SX = F8 ? 0x7d7d7d7d : 0x7f7f7f7f;
        SchedStd S; S.T.init(64, 4, GRID, bid); S.A = F8 ? (const char*)WSP(unsigned char, WS_ACT8) : (const char*)WSP(bf16_t, WS_A2);
        S.B = F8 ? (const char*)(WSP(unsigned char, WS_WOUT8) + (size_t)l * 1024 * 2048) : (const char*)(WSP(bf16_t, WS_WOUT) + (size_t)l * 1024 * 2048); S.sA = 256 * LD; S.sB = 256 * LD;
        EpiResid E{OUTP, gate1, hf * THALF}; pg8::gemm_phase<EpiResid, SchedStd, false, F8, SW, SX>(lds, wv, KP, LD, LD, S, E);
    }
    if constexpr (PH == PH_M2) {
        { constexpr bool F8 = FP8_M2 != 0; constexpr unsigned LD = F8 ? 1024u : 2048u; constexpr int KP = F8 ? 512 : 1024; constexpr int SW = F8 ? 0x79797979 : 0x7f7f7f7f, SX = F8 ? 0x7d7d7d7d : 0x7f7f7f7f;
          SchedStd S; S.T.init(128, 1, GRID, bid); S.A = F8 ? (const char*)WSP(unsigned char, WS_XN8) : (const char*)WSP(bf16_t, WS_XN);
          S.B = F8 ? (const char*)(WSP(unsigned char, WS_WQA8) + (size_t)j * 256 * 1024) : (const char*)(WSP(bf16_t, WS_WQA) + (size_t)j * 256 * 1024); S.sA = 256 * LD; S.sB = 256 * LD;
          EpiQA E{WSP(bf16_t, WS_QA), WSP(float, WS_SSQ)}; pg8::gemm_phase<EpiQA, SchedStd, false, F8, SW, SX>(lds, wv, KP, LD, LD, S, E); }
        if (l == 2) { SchedStd S; S.T.init(128, 1, GRID, (bid + 128) & 255); S.A = (const char*)WSP(bf16_t, WS_HN); S.B = (const char*)WSP(bf16_t, WS_WKVA); S.sA = 256 * 2048; S.sB = 256 * 2048;
          EpiF32 E{WSP(float, WS_AKV)}; pg8::gemm_phase<EpiF32, SchedStd, false>(lds, wv, 1024, LD1K, LD1K, S, E); }
    }
    if constexpr (PH == PH_M3) {
        if (l == 2) phase_kvfin(C);
        SchedStd S; S.T.init(128, 6, GRID, bid); S.A = (const char*)WSP(bf16_t, WS_QA); S.B = (const char*)(WSP(bf16_t, WS_WQB) + (size_t)j * 1536 * 256); S.sA = 256 * 512; S.sB = 256 * 512;
        EpiQB E{WSP(bf16_t, WS_Q), WSP(float, WS_SSQ), INI(2)}; pg8::gemm_phase<EpiQB, SchedStd, false>(lds, wv, 256, 512u, 512u, S, E);
    }
    if constexpr (PH == PH_M4) {
        const int b = vcu >> 6, i = vcu & 63;
#pragma unroll 1
        for (int uq = 0; uq < 4; ++uq) { const int cch = (uq < 2) ? (127 - i) : i, half = uq & 1;
            att::attn_unit2<FP8_M5 != 0>(WSP(bf16_t, WS_Q), WSP(bf16_t, WS_KP), FP8_M5 ? (bf16_t*)WSP(unsigned char, WS_ACT8) : WSP(bf16_t, WS_OL), b * SEQ + cch * 64 + half * 32, b * SEQ, cch + 1, (LAS char*)lds, wave); }
        __syncthreads();
    }
    if constexpr (PH == PH_M5) {
        constexpr bool F8 = FP8_M5 != 0; constexpr unsigned LD = F8 ? 1024u : 2048u; constexpr int KP = F8 ? 512 : 1024; constexpr int SW = F8 ? 0x79797979 : 0x7f7f7f7f, SX = F8 ? 0x7b7b7b7b : 0x7f7f7f7f;
        SchedStd S; S.T.init(128, 4, GRID, bid); S.A = F8 ? (const char*)WSP(unsigned char, WS_ACT8) : (const char*)WSP(bf16_t, WS_OL);
        S.B = F8 ? (const char*)(WSP(unsigned char, WS_WO8) + (size_t)j * 1024 * 1024) : (const char*)(WSP(bf16_t, WS_WO) + (size_t)j * 1024 * 1024); S.sA = 256 * LD; S.sB = 256 * LD;
        EpiResid E{OUTP, gate1, 0}; pg8::gemm_phase<EpiResid, SchedStd, false, F8, SW, SX>(lds, wv, KP, LD, LD, S, E);
    }
    if constexpr (PH == PH_NB) phase_norm_b(C, l, rep);
    if constexpr (PH == PH_MOE1) {
        moe_tile_prefix(C, l);
        SchedMoE S{(const LAS int*)(lds + LDS_TAB), (const char*)WSP(unsigned char, WS_XN), (const char*)(WSP(unsigned char, WS_WGU) + (size_t)l * 16 * 1024 * 1024), (size_t)1024 * 1024, (size_t)256 * 1024, 0, WSP(int, WS_IDX), GRID, vcu, true};
        EpiGU8 E{WSP(unsigned char, WS_HDN)}; pg8::gemm_phase<EpiGU8, SchedMoE, true, true, 0x79797979, 0x7d7d7d7d>(lds, wv, 512, 1024u, 1024u, S, E);
    }
    if constexpr (PH == PH_MOE2) {
        moe_tile_prefix(C, l);
        SchedMoE S{(const LAS int*)(lds + LDS_TAB), (const char*)WSP(unsigned char, WS_HDN), (const char*)(WSP(unsigned char, WS_WDN) + (size_t)l * 16 * 1024 * 512), (size_t)1024 * 512, (size_t)256 * 512, (size_t)256 * 512, WSP(int, WS_IDX), GRID, vcu, false};
        EpiPlain E{WSP(bf16_t, WS_YB), 1024}; pg8::gemm_phase<EpiPlain, SchedMoE, false, true, 0x79797979, 0x7d7d7d7d>(lds, wv, 256, 512u, 512u, S, E);
    }
}

template <int PH> __global__ void __launch_bounds__(NTHREADS, 2) phase_kernel(Args args) {
    extern __shared__ __attribute__((aligned(16))) unsigned char lds_raw[];
    Ctx C; make_ctx(C, lds_raw); (void)args;
    run_phase<PH>(C, args.l, args.hf);
}
__global__ void __launch_bounds__(NTHREADS, 2) fwd_kernel(Args args) {
    extern __shared__ __attribute__((aligned(16))) unsigned char lds_raw[];
    Ctx C; make_ctx(C, lds_raw); (void)args;
    if (threadIdx.x < 64) ((LAS unsigned*)(C.lds + LDS_MISC))[threadIdx.x] = 0u;
    __syncthreads();
    XcdBarrier bar = xcd_barrier_post((unsigned*)((unsigned char*)args.ws + WS_CTL) + CW_BAR, (volatile LAS unsigned*)(C.lds + LDS_MISC));
#define SEAM() xcd_barrier(bar, C.wave)
#ifndef PROBE_PH
#define PROBE_PH -1
#define PROBE_N 0
#endif
#define RUNP(PH, l, hf) do { run_phase<PH>(C, l, hf); SEAM(); if constexpr (PH == PROBE_PH) { _Pragma("unroll 1") for (int rp_ = 0; rp_ < PROBE_N; ++rp_) { run_phase<PH>(C, l, hf, 1); SEAM(); } } } while (0)
    RUNP(PH_PRO, 0, 0);
    for (int l = 0; l < 4; ++l) {
        RUNP(PH_NA, l, 0);
        if (l < 2) {
            for (int hf = 0; hf < 2; ++hf) { RUNP(PH_R2, l, hf); RUNP(PH_R3, l, hf); RUNP(PH_R4, l, hf); RUNP(PH_R5, l, hf); RUNP(PH_R6, l, hf); RUNP(PH_R7, l, hf); }
        } else { RUNP(PH_M2, l, 0); RUNP(PH_M3, l, 0); RUNP(PH_M4, l, 0); RUNP(PH_M5, l, 0); }
        RUNP(PH_NB, l, 0); RUNP(PH_MOE1, l, 0); RUNP(PH_MOE2, l, 0);
    }
    run_phase<PH_NA>(C, 4, 0);
#undef RUNP
#undef SEAM
}

template <int PH> static void launch_phase(Args& a, int l, int hf, hipStream_t stream) {
    static bool attr = false;
    if (!attr) { (void)hipFuncSetAttribute((const void*)phase_kernel<PH>, hipFuncAttributeMaxDynamicSharedMemorySize, LDS_BYTES); attr = true; }
    a.l = l; a.hf = hf;
    hipLaunchKernelGGL(phase_kernel<PH>, dim3(GRID), dim3(NTHREADS), LDS_BYTES, stream, a);
}
extern "C" void kernel_launch(void* const* d_in, const int* in_sizes, int n_in, void* d_out, int out_size, void* d_ws, size_t ws_size, hipStream_t stream) {
    static int ok = 0;
    if (ok == 0) {
        if (n_in != 25 || out_size != NTOK * DM || ws_size < WS_END) { fprintf(stderr, "kernel_launch: unexpected problem (n_in %d, out %d, ws %zu < %zu)\n", n_in, out_size, ws_size, (size_t)WS_END); ok = -1; return; }
        int dev = 0, cus = 0;
        if (hipGetDevice(&dev) != hipSuccess || hipDeviceGetAttribute(&cus, hipDeviceAttributeMultiprocessorCount, dev) != hipSuccess || cus < GRID) { fprintf(stderr, "kernel_launch: needs %d CUs, device has %d\n", GRID, cus); ok = -1; return; }
        ok = 1;
    }
    if (ok < 0) return;
    (void)hipMemsetAsync((char*)d_ws + WS_CTL, 0, CTL_BYTES, stream);
    Args a{};
    for (int i = 0; i < 25; ++i) a.in[i] = d_in[i];
    a.out = (float*)d_out; a.ws = (unsigned char*)d_ws; a.lo = 0; a.hi = 0;
#if MK_SINGLE
    static bool attr = false;
    if (!attr) { (void)hipFuncSetAttribute((const void*)fwd_kernel, hipFuncAttributeMaxDynamicSharedMemorySize, LDS_BYTES); attr = true; }
    hipLaunchKernelGGL(fwd_kernel, dim3(GRID), dim3(NTHREADS), LDS_BYTES, stream, a);
    return;
#endif
    launch_phase<PH_PRO>(a, 0, 0, stream);
    for (int l = 0; l < 4; ++l) {
        launch_phase<PH_NA>(a, l, 0, stream);
        if (l < 2) {
            for (int hf = 0; hf < 2; ++hf) {
                launch_phase<PH_R2>(a, l, hf, stream); launch_phase<PH_R3>(a, l, hf, stream); launch_phase<PH_R4>(a, l, hf, stream);
                launch_phase<PH_R5>(a, l, hf, stream); launch_phase<PH_R6>(a, l, hf, stream); launch_phase<PH_R7>(a, l, hf, stream);
            }
        } else {
            launch_phase<PH_M2>(a, l, 0, stream); launch_phase<PH_M3>(a, l, 0, stream); launch_phase<PH_M4>(a, l, 0, stream); launch_phase<PH_M5>(a, l, 0, stream);
        }
        launch_phase<PH_NB>(a, l, 0, stream); launch_phase<PH_MOE1>(a, l, 0, stream); launch_phase<PH_MOE2>(a, l, 0, stream);
    }
    launch_phase<PH_NA>(a, 4, 0, stream);
}
```

```cpp
#include <hip/hip_runtime.h>
#include <cstdio>
#include <cstdint>

#ifndef MK_SINGLE
#define MK_SINGLE 1
#endif
#ifndef FP8_R2
#define FP8_R2 3
#define FP8_R6 1
#define FP8_R7 1
#define FP8_M2 1
#define FP8_M5 1
#define FP8_M3 1
#endif
#ifndef ATT_FP8
#define ATT_FP8 1
#endif
#ifndef MK_CHECK
#define MK_CHECK 0
#endif

#define GAS __attribute__((address_space(1)))
#define LAS __attribute__((address_space(3)))
typedef unsigned short bf16_t;
typedef short bf16x8 __attribute__((ext_vector_type(8)));
typedef short s16x4 __attribute__((ext_vector_type(4)));
typedef float f32x4 __attribute__((ext_vector_type(4)));
typedef float f32x2 __attribute__((ext_vector_type(2)));
typedef float f32x16 __attribute__((ext_vector_type(16)));
typedef unsigned u32x4 __attribute__((ext_vector_type(4)));
typedef unsigned u32x2 __attribute__((ext_vector_type(2)));

constexpr int NB = 4, SEQ = 8192, DM = 1024, NTOK = NB * SEQ, THALF = NTOK / 2;
constexpr int NEXP = 16, DEXP = 512;
constexpr int RH = 4, RDK = 256, RDV = 512, RV = 2048;
constexpr int MH = 8, QLORA = 256, KVL = 128, ROPE = 64, QKD = 192;
constexpr float EPS = 1e-6f;
constexpr int NWAVES = 8, NTHREADS = 512, GRID = 256;
constexpr int MAXSLOTS = 69632;

constexpr size_t MiB = 1u << 20;
constexpr size_t WS_CTL = 0, CTL_BYTES = 1 * MiB;
constexpr size_t WS_MOD = 1 * MiB;
constexpr size_t WS_ROUTE = 2 * MiB;
constexpr size_t WS_SSQ = 3 * MiB;
constexpr size_t WS_STATS = 4 * MiB;
constexpr size_t WS_IDX = 8 * MiB;
constexpr size_t WS_WIN = 10 * MiB;
constexpr size_t WS_WOUT = 34 * MiB;
constexpr size_t WS_WQA = 42 * MiB;
constexpr size_t WS_WKVA = 43 * MiB;
constexpr size_t WS_WQB = 44 * MiB;
constexpr size_t WS_WO = 46 * MiB;
constexpr size_t WS_WGU = 50 * MiB;
constexpr size_t WS_WDN = 178 * MiB;
constexpr size_t WS_XN = 242 * MiB;
constexpr size_t WS_L = 306 * MiB;
constexpr size_t WS_END = 690 * MiB;
constexpr size_t WS_A2 = WS_L, WS_KR = WS_L + 64 * MiB, WS_KT = WS_L + 96 * MiB, WS_B2T = WS_L + 128 * MiB;
constexpr size_t WS_HDN = WS_L, WS_YB = WS_L + 68 * MiB;
constexpr size_t WS_HN = WS_L, WS_QA = WS_L + 64 * MiB, WS_AKV = WS_L + 80 * MiB, WS_Q = WS_L + 112 * MiB, WS_OL = WS_L + 208 * MiB, WS_KP = WS_L + 300 * MiB;
constexpr size_t WS_XN8 = 114 * MiB;
constexpr size_t WS_WIN8 = 146 * MiB;
constexpr size_t WS_WOUT8 = 158 * MiB;
constexpr size_t WS_WQA8 = 162 * MiB;
constexpr size_t WS_WO8 = 163 * MiB;
constexpr size_t WS_QA8 = WS_L + 160 * MiB;
constexpr size_t WS_WQB8 = 46 * MiB;
static_assert(!FP8_M3 || (FP8_M5 && ATT_FP8), "the fp8 q_b buffers overlay regions that are free only with fp8 w_o and fp8 Q");
constexpr size_t WS_ACT8 = 210 * MiB;
constexpr size_t WS_K8 = WS_L + 300 * MiB, WS_V8T = WS_L + 306 * MiB;
constexpr size_t WS_H16 = WS_L + 320 * MiB;
constexpr int CW_BAR = 4096;
constexpr int CW_CNT = 16384;
constexpr int CW_CHK = 32768;

constexpr int LDS_STAGE = 131072;
constexpr int LDS_MISC = LDS_STAGE;
constexpr int LDS_TAB = LDS_STAGE + 256;
constexpr int LDS_BYTES = 147456;

#define LDS_WAIT() asm volatile("s_waitcnt lgkmcnt(0)" ::: "memory")
#define VM_WAIT() asm volatile("s_waitcnt vmcnt(0)" ::: "memory")
__device__ __forceinline__ unsigned cvt_pk_bf16(float lo, float hi) { unsigned r; asm volatile("v_cvt_pk_bf16_f32 %0, %1, %2" : "=v"(r) : "v"(lo), "v"(hi)); return r; }
__device__ __forceinline__ unsigned pk4_fp8(float a, float b, float c2, float d) { int w = __builtin_amdgcn_cvt_pk_fp8_f32(a, b, 0, false); return (unsigned)__builtin_amdgcn_cvt_pk_fp8_f32(c2, d, w, true); }
__device__ __forceinline__ f32x4 bf4_to_f32(u32x2 w) { return (f32x4){__uint_as_float(w.x << 16), __uint_as_float(w.x & 0xffff0000u), __uint_as_float(w.y << 16), __uint_as_float(w.y & 0xffff0000u)}; }
__device__ __forceinline__ float bf2f(unsigned short b) { return __uint_as_float((unsigned)b << 16); }
__device__ __forceinline__ float bflo(unsigned w) { return __uint_as_float(w << 16); }
__device__ __forceinline__ float bfhi(unsigned w) { return __uint_as_float(w & 0xffff0000u); }
template <int CTRL> __device__ __forceinline__ float dpp_f(float v) { return __int_as_float(__builtin_amdgcn_mov_dpp(__float_as_int(v), CTRL, 0xf, 0xf, true)); }
__device__ __forceinline__ float rows_sum(float v) {
    { auto t = __builtin_amdgcn_permlane16_swap(__float_as_uint(v), __float_as_uint(v), false, false); v = __uint_as_float(t[0]) + __uint_as_float(t[1]); }
    { auto t = __builtin_amdgcn_permlane32_swap(__float_as_uint(v), __float_as_uint(v), false, false); v = __uint_as_float(t[0]) + __uint_as_float(t[1]); }
    return v;
}
__device__ __forceinline__ float wave_sum(float v) {
    v += dpp_f<0xB1>(v);
    v += dpp_f<0x4E>(v);
    v += dpp_f<0x141>(v);
    v += dpp_f<0x140>(v);
    return rows_sum(v);
}
__device__ __forceinline__ void sincos_rad(float ang, float& s, float& c) {
    float r = __builtin_amdgcn_fractf(ang * 0.15915494309189535f);
    s = __builtin_amdgcn_sinf(r); c = __builtin_amdgcn_cosf(r);
}
__device__ __forceinline__ float silu_f(float x) { return x * __builtin_amdgcn_rcpf(1.0f + __builtin_amdgcn_exp2f(-1.4426950408889634f * x)); }
__device__ __forceinline__ float log2_gamma(int h) { return h == 0 ? -0.04580368961312479f : (h == 1 ? -0.02272007650008353f : (h == 2 ? -0.011315313227834146f : -0.005646563141142063f)); }
constexpr float LOG2_THETA = 13.287712379549449f;

__device__ __forceinline__ int lane_id() { int r; asm volatile("v_mbcnt_lo_u32_b32 %0, -1, 0\n\tv_mbcnt_hi_u32_b32 %0, -1, %0" : "=v"(r)); return r; }
#define XB_TMO      128
#define XB_XCNT(j)  (256  + 64 * (j))
#define XB_XSUB(j)  (1280 + 64 * (j))
#define XB_XGEN(j)  (2304 + 64 * (j))
#define XB_TOP      3328
#define XB_TOPGEN   3392
#define XCD_BAR_WORDS 3456
#define XB_SPIN_CAP (1u << 18)
__device__ __forceinline__ unsigned xb_ld(unsigned* p)              { return __hip_atomic_load(p, __ATOMIC_RELAXED, __HIP_MEMORY_SCOPE_AGENT); }
__device__ __forceinline__ unsigned xb_add(unsigned* p, unsigned v) { return __hip_atomic_fetch_add(p, v, __ATOMIC_RELAXED, __HIP_MEMORY_SCOPE_AGENT); }
__device__ __forceinline__ unsigned xb_xcc_id() { return (unsigned)__builtin_amdgcn_s_getreg((3 << 11) | 20) & 0xFu; }
#define XB_SPIN(cond, bar) do { unsigned _sp = 0; while (cond) { __builtin_amdgcn_s_sleep(1); \
    if ((++_sp & 255u) == 0u) { if (xb_ld(&(bar)[XB_TMO])) break; if (_sp > XB_SPIN_CAP) { atomicAdd(&(bar)[XB_TMO], 1u); break; } } } } while (0)
struct XcdBarrier { unsigned* bar; unsigned x; volatile LAS unsigned* st; };
__device__ __forceinline__ XcdBarrier xcd_barrier_post(unsigned* bar, volatile LAS unsigned* st) {
    XcdBarrier b; b.bar = bar; b.x = xb_xcc_id(); b.st = st;
    if (threadIdx.x == 0) (void)xb_add(&bar[XB_XCNT(b.x)], 1u);
    return b;
}
__device__ __forceinline__ void xcd_barrier_complete(unsigned* bar, unsigned x, unsigned& nloc, unsigned& nx) {
    const unsigned G = gridDim.x * gridDim.y * gridDim.z;
    unsigned sum, cnt, mine, sp = 0u;
    for (;;) {
        sum = 0u; cnt = 0u; mine = 0u;
#pragma unroll
        for (unsigned j = 0; j < 16; ++j) { const unsigned c = xb_ld(&bar[XB_XCNT(j)]); sum += c; cnt += (c > 0u) ? 1u : 0u; mine = (j == x) ? c : mine; }
        if (sum == G) break;
        __builtin_amdgcn_s_sleep(1);
        if ((++sp & 255u) == 0u) { if (xb_ld(&bar[XB_TMO])) break; if (sp > XB_SPIN_CAP) { atomicAdd(&bar[XB_TMO], 1u); break; } }
    }
    nloc = mine > 0u ? mine : 1u; nx = cnt > 0u ? cnt : 1u;
}
__device__ __forceinline__ void xcd_barrier(const XcdBarrier& b, const int wave) {
    asm volatile("s_waitcnt vmcnt(0)" ::: "memory");
    __syncthreads();
    if (wave == 0 && lane_id() == 0) {
        unsigned* bar = b.bar; unsigned bx = b.x; asm volatile("" : "+s"(bar), "+s"(bx));
        __builtin_amdgcn_s_waitcnt(0);
        unsigned nloc = b.st[0], nx = b.st[1];
        if (nloc == 0u) { xcd_barrier_complete(bar, bx, nloc, nx); b.st[0] = nloc; b.st[1] = nx; }
        const unsigned old = xb_add(&bar[XB_XSUB(bx)], 1u);
        const unsigned gen = old / nloc;
        if (old + 1u == (gen + 1u) * nloc) {
            __builtin_amdgcn_fence(__ATOMIC_RELEASE, "agent");
            asm volatile("s_waitcnt vmcnt(0)" ::: "memory");
            const unsigned og = xb_add(&bar[XB_TOP], 1u);
            const unsigned tg = og / nx;
            if (og + 1u == (tg + 1u) * nx) xb_add(&bar[XB_TOPGEN], 1u);
            else XB_SPIN(xb_ld(&bar[XB_TOPGEN]) == tg, bar);
            __builtin_amdgcn_fence(__ATOMIC_ACQUIRE, "agent");
            xb_add(&bar[XB_XGEN(bx)], 1u);
            asm volatile("s_waitcnt vmcnt(0)" ::: "memory");
        } else {
            XB_SPIN(xb_ld(&bar[XB_XGEN(bx)]) == gen, bar);
            __builtin_amdgcn_fence(__ATOMIC_ACQUIRE, "agent");
            asm volatile("s_waitcnt vmcnt(0)" ::: "memory");
        }
    }
    __syncthreads();
}

namespace pg8 {
constexpr int BM = 256, BK = 64, HALF = 128, HTB = HALF * BK * 2, STAGE_BYTES = 8 * HTB;
__host__ __device__ __forceinline__ int lds_byte(int r, int c) { const int st = (r >> 4) * 2 + (c >> 5), rr = r & 15, cc = c & 31, ob = rr * 64 + cc * 2; return st * 1024 + (ob ^ (((ob >> 9) & 1) << 5)); }
__host__ __device__ __forceinline__ void stage_rc(int b, int& R, int& C) { const int st = b / 1024, sb = b % 1024, swz = sb ^ (((sb >> 9) & 1) << 5); R = (st >> 1) * 16 + swz / 64; C = (st & 1) * 32 + (swz % 64) / 2; }
__host__ __device__ __forceinline__ int perm32(int rho) { const int n = rho >> 4, i = rho & 15; return 8 * (i >> 2) + 4 * n + (i & 3); }

struct Unit { const char* A; const char* B; int pm, pn, aux; };

struct TileOrder {
    int nM, nN, nwg, G, c;
    __device__ void init(int nM_, int nN_, int G_, int c_) { nM = nM_; nN = nN_; nwg = nM * nN; G = G_; c = c_; }
    __device__ bool tile(int i, int& pm, int& pn) const {
        const long L = (long)i * G + c; if (L >= nwg) return false;
        int wgid = (int)L; { const int q = nwg / 8, r = nwg % 8, xcd = wgid % 8, off = wgid / 8; wgid = (xcd < r ? xcd * (q + 1) : r * (q + 1) + (xcd - r) * q) + off; }
        const int nig = 8 * nN, gid = wgid / nig, fm = gid * 8, gsz = (nM - fm) < 8 ? (nM - fm) : 8;
        pm = fm + ((wgid % nig) % gsz); pn = (wgid % nig) / gsz; return true;
    }
};

typedef int i32x8 __attribute__((ext_vector_type(8)));
typedef int i32x4 __attribute__((ext_vector_type(4)));
__device__ __forceinline__ i32x8 cat8(bf16x8 lo, bf16x8 hi) { const i32x4 a = __builtin_bit_cast(i32x4, lo), b = __builtin_bit_cast(i32x4, hi); return __builtin_shufflevector(a, b, 0, 1, 2, 3, 4, 5, 6, 7); }
template <class Epi, class Sched, bool GATHER, bool FP8 = false, int SCW = 0x7f7f7f7f, int SCX = 0x7f7f7f7f>
__device__ __forceinline__ void gemm_phase(LAS unsigned char* lds, const int wid, const int K, const unsigned lda, const unsigned ldb, const Sched& S, const Epi& E) {
    int lane_ = lane_id(); asm volatile("" : "+v"(lane_));
    const int lane = lane_, tid = wid * 64 + lane, wr = wid >> 2, wc = wid & 3, fr = lane & 15, fq = lane >> 4;
    const int nt = K / BK;
    unsigned voffA[2], voffB[2]; int RA[2], CA[2];
#pragma unroll
    for (int i = 0; i < 2; ++i) { int R, C; stage_rc(tid * 16 + i * 8192, R, C); const int Rb = Epi::PERM ? ((R & ~31) + perm32(R & 31)) : R;
        RA[i] = R; CA[i] = C; voffA[i] = (unsigned)R * lda + (unsigned)C * 2u; voffB[i] = (unsigned)Rb * ldb + (unsigned)C * 2u; }
    const size_t kstep = (size_t)(BK * 2);
    const size_t hstepA = (size_t)HALF * lda, hstepB = (size_t)HALF * ldb;
    const unsigned ldsw = (unsigned)wid * 1024u;
    const int aoff = lds_byte(wr * 64 + fr, fq * 8), boff = lds_byte(wc * 32 + fr, fq * 8);
#define PG8_SA(b, h) (((b) * 2 + (h)) * HTB)
#define PG8_SB(b, h) ((4 + (b) * 2 + (h)) * HTB)
#define PG8_GLDS(gp, bufoff, i) __builtin_amdgcn_global_load_lds((const unsigned*)(gp), (LAS unsigned*)(lds + (bufoff) + ldsw + (i) * 8192), 16, 0, 0)
#define PG8_STAGE_B(bufoff, gbase) do { _Pragma("unroll") for (int _i = 0; _i < 2; ++_i) PG8_GLDS((const char*)(gbase) + voffB[_i], bufoff, _i); } while (0)
#define PG8_STAGE_A(bufoff, gbase, h, GO) do { _Pragma("unroll") for (int _i = 0; _i < 2; ++_i) { \
        if constexpr (GATHER) PG8_GLDS((const char*)(gbase) + GO[h][_i], bufoff, _i); else PG8_GLDS((const char*)(gbase) + (size_t)(h) * hstepA + voffA[_i], bufoff, _i); } } while (0)
#define PG8_LDA(dst, b, h) do { _Pragma("unroll") for (int m = 0; m < 4; ++m) _Pragma("unroll") for (int k = 0; k < 2; ++k) dst[m][k] = *(const LAS bf16x8*)(lds + PG8_SA(b, h) + aoff + m * 2048 + k * 1024); } while (0)
#define PG8_LDB(dst, b, h) do { _Pragma("unroll") for (int n = 0; n < 2; ++n) _Pragma("unroll") for (int k = 0; k < 2; ++k) dst[n][k] = *(const LAS bf16x8*)(lds + PG8_SB(b, h) + boff + n * 2048 + k * 1024); } while (0)
#define PG8_MFMA8(ACC, W8, X8) asm volatile("v_mfma_scale_f32_16x16x128_f8f6f4 %0, %1, %2, %0, %3, %4 op_sel_hi:[0,0,0]" : "+v"(ACC) : "v"(W8), "v"(X8), "v"(scw_), "v"(scx_))
#define PG8_MMA(ai, bj, At, Bt) do { __builtin_amdgcn_s_setprio(1); if constexpr (FP8) { i32x8 a8_[4], b8_[2]; _Pragma("unroll") for (int m = 0; m < 4; ++m) a8_[m] = cat8(At[m][0], At[m][1]); \
        _Pragma("unroll") for (int n = 0; n < 2; ++n) b8_[n] = cat8(Bt[n][0], Bt[n][1]); asm volatile("s_nop 3" ::: "memory"); \
        _Pragma("unroll") for (int m = 0; m < 4; ++m) _Pragma("unroll") for (int n = 0; n < 2; ++n) PG8_MFMA8(acc[ai][bj][m][n], b8_[n], a8_[m]); } else { \
        _Pragma("unroll") for (int m = 0; m < 4; ++m) _Pragma("unroll") for (int n = 0; n < 2; ++n) _Pragma("unroll") for (int k = 0; k < 2; ++k) \
        acc[ai][bj][m][n] = __builtin_amdgcn_mfma_f32_16x16x32_bf16(Bt[n][k], At[m][k], acc[ai][bj][m][n], 0, 0, 0); } __builtin_amdgcn_s_setprio(0); } while (0)
#define PG8_WAIT_V(n) asm volatile("s_waitcnt vmcnt(" #n ")" ::: "memory")
#define PG8_WAIT_L(n) asm volatile("s_waitcnt lgkmcnt(" #n ")" ::: "memory")
#define PG8_BAR __builtin_amdgcn_s_barrier()
#define PG8_SCHED __builtin_amdgcn_sched_barrier(0)
    Unit cur, nxt; int ui = 0;
    if (!S.next(0, cur)) return;
    int scw_ = SCW, scx_ = SCX; asm volatile("" : "+v"(scw_), "+v"(scx_)); (void)scw_; (void)scx_;
    unsigned goff[2][2] = {{0u, 0u}, {0u, 0u}}, ngoff[2][2] = {{0u, 0u}, {0u, 0u}};
    if constexpr (GATHER) {
#pragma unroll
        for (int h = 0; h < 2; ++h)
#pragma unroll
            for (int i = 0; i < 2; ++i) goff[h][i] = (unsigned)S.tok(cur, h * HALF + RA[i]) * lda + (unsigned)CA[i] * 2u;
    }
    f32x4 acc[2][2][4][2];
#pragma unroll
    for (int a = 0; a < 2; ++a)
#pragma unroll
        for (int b = 0; b < 2; ++b)
#pragma unroll
            for (int m = 0; m < 4; ++m)
#pragma unroll
                for (int n = 0; n < 2; ++n) acc[a][b][m][n] = (f32x4){0.f, 0.f, 0.f, 0.f};
    bf16x8 At[4][2], B0[2][2], B1[2][2];
    const char* cA = cur.A; const char* cB = cur.B;
    PG8_STAGE_B(PG8_SB(0, 0), cB); PG8_STAGE_B(PG8_SB(0, 1), cB + hstepB); PG8_STAGE_A(PG8_SA(0, 0), cA, 0, goff); PG8_STAGE_A(PG8_SA(0, 1), cA, 1, goff);
    if (wr == 1) PG8_BAR;
    PG8_WAIT_V(2); PG8_BAR;
    PG8_STAGE_B(PG8_SB(1, 0), cB + kstep); PG8_STAGE_A(PG8_SA(1, 0), cA + kstep, 0, goff); PG8_STAGE_B(PG8_SB(1, 1), cB + hstepB + kstep);
    PG8_WAIT_V(6); PG8_BAR;
    for (;;) {
        const bool has_next = S.next(ui + 1, nxt);
        const char* nA = has_next ? nxt.A : cA; const char* nB = has_next ? nxt.B : cB;
        if constexpr (GATHER) {
#pragma unroll
            for (int h = 0; h < 2; ++h)
#pragma unroll
                for (int i = 0; i < 2; ++i) ngoff[h][i] = has_next ? (unsigned)S.tok(nxt, h * HALF + RA[i]) * lda + (unsigned)CA[i] * 2u : goff[h][i];
        }
#pragma unroll 1
        for (int t = 0; t < nt; t += 2) {
            const bool last = (t == nt - 2);
            const char* a1 = cA + (size_t)(t + 1) * kstep;
            const char* a2 = last ? nA : cA + (size_t)(t + 2) * kstep; const char* b2 = last ? nB : cB + (size_t)(t + 2) * kstep;
            const char* a3 = a2 + kstep; const char* b3 = b2 + kstep;
            unsigned g2[2][2];
#pragma unroll
            for (int h = 0; h < 2; ++h)
#pragma unroll
                for (int i = 0; i < 2; ++i) g2[h][i] = last ? ngoff[h][i] : goff[h][i];
            PG8_LDB(B0, 0, 0); PG8_LDB(B1, 0, 1); PG8_SCHED; PG8_LDA(At, 0, 0); PG8_STAGE_A(PG8_SA(1, 1), a1, 1, goff);
            PG8_WAIT_V(8); PG8_WAIT_L(0); PG8_BAR; PG8_MMA(0, 0, At, B0); PG8_MMA(0, 1, At, B1); PG8_BAR; PG8_SCHED;
            PG8_LDA(At, 0, 1); PG8_STAGE_B(PG8_SB(0, 0), b2); PG8_STAGE_B(PG8_SB(0, 1), b2 + hstepB); PG8_STAGE_A(PG8_SA(0, 0), a2, 0, g2);
            PG8_WAIT_V(8); PG8_WAIT_L(0); PG8_BAR; PG8_MMA(1, 0, At, B0); PG8_MMA(1, 1, At, B1); PG8_BAR; PG8_SCHED;
            PG8_LDB(B0, 1, 0); PG8_LDB(B1, 1, 1); PG8_SCHED; PG8_LDA(At, 1, 0); PG8_STAGE_A(PG8_SA(0, 1), a2, 1, g2);
            PG8_WAIT_V(8); PG8_WAIT_L(0); PG8_BAR; PG8_MMA(0, 0, At, B0); PG8_MMA(0, 1, At, B1); PG8_BAR; PG8_SCHED;
            PG8_LDA(At, 1, 1); PG8_STAGE_B(PG8_SB(1, 0), b3); PG8_STAGE_B(PG8_SB(1, 1), b3 + hstepB); PG8_STAGE_A(PG8_SA(1, 0), a3, 0, g2);
            PG8_WAIT_V(8); PG8_WAIT_L(0); PG8_BAR; PG8_MMA(1, 0, At, B0); PG8_MMA(1, 1, At, B1); PG8_BAR; PG8_SCHED;
        }
        if (wr == 0) PG8_BAR;
        if constexpr (FP8) asm volatile("s_nop 7\n\ts_nop 7" ::: "memory");
        { int fr2 = fr, fq2 = fq; asm volatile("" : "+v"(fr2), "+v"(fq2)); E(acc, cur, wr, wc, fr2, fq2); }
        if (!has_next) break;
#pragma unroll
        for (int a = 0; a < 2; ++a)
#pragma unroll
            for (int b = 0; b < 2; ++b)
#pragma unroll
                for (int m = 0; m < 4; ++m)
#pragma unroll
                    for (int n = 0; n < 2; ++n) acc[a][b][m][n] = (f32x4){0.f, 0.f, 0.f, 0.f};
        cur = nxt; cA = nA; cB = nB; ++ui;
        if constexpr (GATHER) {
#pragma unroll
            for (int h = 0; h < 2; ++h)
#pragma unroll
                for (int i = 0; i < 2; ++i) goff[h][i] = ngoff[h][i];
        }
        if (wr == 1) PG8_BAR;
    }
    PG8_WAIT_V(0);
    PG8_BAR;
#undef PG8_SA
#undef PG8_SB
#undef PG8_GLDS
#undef PG8_STAGE_A
#undef PG8_STAGE_B
#undef PG8_LDA
#undef PG8_LDB
#undef PG8_MMA
#undef PG8_MFMA8
#undef PG8_WAIT_V
#undef PG8_WAIT_L
#undef PG8_BAR
#undef PG8_SCHED
}
}
__device__ __forceinline__ const char* uni_ptr(const char* p) {
    unsigned long long v = (unsigned long long)p; unsigned lo = __builtin_amdgcn_readfirstlane((unsigned)v), hi = __builtin_amdgcn_readfirstlane((unsigned)(v >> 32));
    return (const char*)(((unsigned long long)hi << 32) | lo);
}
struct SchedStd {
    pg8::TileOrder T; const char* A; const char* B; size_t sA, sB;
    __device__ __forceinline__ bool next(int i, pg8::Unit& u) const { int pm, pn; if (!T.tile(i, pm, pn)) return false; u.pm = pm; u.pn = pn; u.aux = 0; u.A = A + (size_t)pm * sA; u.B = B + (size_t)pn * sB; return true; }
    __device__ __forceinline__ int tok(const pg8::Unit&, int) const { return 0; }
};
struct SchedBatch {
    const char* A; const char* B; size_t sA, sB, vA, vB; int nunits, nvt, G, c;
    __device__ __forceinline__ bool next(int i, pg8::Unit& u) const { const int L = i * G + c; if (L >= nunits * nvt) return false; const int uu = L / nvt, vt = L % nvt; u.pm = uu; u.pn = vt; u.aux = 0;
        u.A = A + (size_t)uu * sA + (size_t)vt * vA; u.B = B + (size_t)uu * sB + (size_t)vt * vB; return true; }
    __device__ __forceinline__ int tok(const pg8::Unit&, int) const { return 0; }
};
struct SchedMoE {
    const LAS int* tab; const char* A; const char* Bw; size_t sE, sPN, sRT; const int* idx; int G, c; bool gather;
    __device__ __forceinline__ bool next(int i, pg8::Unit& u) const {
        const int L = i * G + c, rt = L >> 2, pn = L & 3;
        const int ntile = __builtin_amdgcn_readfirstlane(tab[32]); if (rt >= ntile) return false;
        int e = 0;
#pragma unroll
        for (int k = 1; k < 16; ++k) e += (rt >= __builtin_amdgcn_readfirstlane(tab[16 + k])) ? 1 : 0;
        e = __builtin_amdgcn_readfirstlane(e);
        u.pm = rt; u.pn = pn; u.aux = e; u.A = gather ? A : A + (size_t)rt * sRT; u.B = Bw + (size_t)e * sE + (size_t)pn * sPN; return true;
    }
    __device__ __forceinline__ int tok(const pg8::Unit& u, int r) const {
        const int e = u.aux, p = (u.pm - __builtin_amdgcn_readfirstlane(tab[16 + e])) * 256 + r, n = __builtin_amdgcn_readfirstlane(tab[e]);
        return p < n ? idx[e * NTOK + p] : 0;
    }
};

typedef const f32x4 (&AccRef)[2][2][4][2];
__device__ __forceinline__ int launder(int x) { asm volatile("" : "+v"(x)); return x; }
__device__ __forceinline__ void st8(bf16_t* p, f32x4 v0, f32x4 v1) {
    u32x4 w; w.x = cvt_pk_bf16(v0[0], v0[1]); w.y = cvt_pk_bf16(v0[2], v0[3]); w.z = cvt_pk_bf16(v1[0], v1[1]); w.w = cvt_pk_bf16(v1[2], v1[3]); *(u32x4*)p = w;
}
struct EpiPlain {
    static constexpr bool PERM = true; bf16_t* out; int ld;
    __device__ __forceinline__ void operator()(AccRef acc, const pg8::Unit& u, int wr, int wc, int fr, int fq) const {
#pragma unroll
        for (int ai = 0; ai < 2; ++ai)
#pragma unroll
            for (int m = 0; m < 4; ++m) { const int r = ai * 128 + wr * 64 + m * 16 + fr; bf16_t* rp = out + (size_t)(u.pm * 256 + r) * ld + u.pn * 256 + wc * 32 + fq * 8;
#pragma unroll
                for (int bj = 0; bj < 2; ++bj) st8(rp + bj * 128, acc[ai][bj][m][0], acc[ai][bj][m][1]); }
    }
};
struct EpiPlain8 {
    static constexpr bool PERM = true; unsigned char* out; int ld;
    __device__ __forceinline__ void operator()(AccRef acc, const pg8::Unit& u, int wr, int wc, int fr, int fq) const {
#pragma unroll
        for (int ai = 0; ai < 2; ++ai)
#pragma unroll
            for (int m = 0; m < 4; ++m) { const int r = ai * 128 + wr * 64 + m * 16 + fr; unsigned char* rp = out + (size_t)(u.pm * 256 + r) * ld + u.pn * 256 + wc * 32 + fq * 8;
#pragma unroll
                for (int bj = 0; bj < 2; ++bj) { const f32x4 v0 = acc[ai][bj][m][0], v1 = acc[ai][bj][m][1]; u32x2 w; w.x = pk4_fp8(v0[0], v0[1], v0[2], v0[3]); w.y = pk4_fp8(v1[0], v1[1], v1[2], v1[3]);
                    *(u32x2*)(rp + bj * 128) = w; } }
    }
};
template <int MODE> struct EpiRopeQK {
    static constexpr bool PERM = true; bf16_t* out; const int* pos; int half; bf16_t* outT;
    __device__ __forceinline__ void operator()(AccRef acc, const pg8::Unit& u, int wr, int wc, int fr, int fq) const {
        const int pm = u.pm, h = u.pn, uu = ((pm >> 5) * 4 + h) * 32 + (pm & 31); const float l2g = log2_gamma(h);
        constexpr int LD = MODE == 0 ? 512 : 256;
        float inv[8]; const int f0 = launder(wc * 32 + fq * 8);
#pragma unroll
        for (int k = 0; k < 8; ++k) inv[k] = __builtin_amdgcn_exp2f(-(float)(f0 + k) * (LOG2_THETA / 128.0f)) * 0.15915494309189535f;
        float pp[2][4];
#pragma unroll
        for (int ai = 0; ai < 2; ++ai)
#pragma unroll
            for (int m = 0; m < 4; ++m) pp[ai][m] = (float)pos[half * THALF + pm * 256 + ai * 128 + wr * 64 + m * 16 + fr];
#pragma unroll
        for (int ai = 0; ai < 2; ++ai)
#pragma unroll
            for (int m = 0; m < 4; ++m) { const int r = ai * 128 + wr * 64 + m * 16 + fr; const float p = pp[ai][m];
                const float dec = MODE == 0 ? __builtin_amdgcn_exp2f((float)r * l2g) : __builtin_amdgcn_exp2f(-(float)r * l2g) * 0.0625f;
                f32x4 o1[2], o2[2];
#pragma unroll
                for (int n = 0; n < 2; ++n)
#pragma unroll
                    for (int j = 0; j < 4; ++j) { const float tr = __builtin_amdgcn_fractf(p * inv[n * 4 + j]); const float s = __builtin_amdgcn_sinf(tr) * dec, c = __builtin_amdgcn_cosf(tr) * dec;
                        const float x1 = acc[ai][0][m][n][j], x2 = acc[ai][1][m][n][j];
                        o1[n][j] = x1 * c - x2 * s; o2[n][j] = x1 * s + x2 * c; }
                bf16_t* rp = out + (size_t)uu * (256 * LD) + (size_t)r * LD + wc * 32 + fq * 8;
                st8(rp, o1[0], o1[1]); st8(rp + 128, o2[0], o2[1]);
                if constexpr (MODE == 1) { bf16_t* tp = outT + (size_t)uu * 65536 + (size_t)(wc * 32 + fq * 8) * 256 + r;
#pragma unroll
                    for (int n = 0; n < 2; ++n) { const unsigned a01 = cvt_pk_bf16(o1[n][0], o1[n][1]), a23 = cvt_pk_bf16(o1[n][2], o1[n][3]), b01 = cvt_pk_bf16(o2[n][0], o2[n][1]), b23 = cvt_pk_bf16(o2[n][2], o2[n][3]);
                        tp[(n * 4 + 0) * 256] = (bf16_t)(a01 & 0xffffu); tp[(n * 4 + 1) * 256] = (bf16_t)(a01 >> 16); tp[(n * 4 + 2) * 256] = (bf16_t)(a23 & 0xffffu); tp[(n * 4 + 3) * 256] = (bf16_t)(a23 >> 16);
                        tp[(128 + n * 4 + 0) * 256] = (bf16_t)(b01 & 0xffffu); tp[(128 + n * 4 + 1) * 256] = (bf16_t)(b01 >> 16); tp[(128 + n * 4 + 2) * 256] = (bf16_t)(b23 & 0xffffu); tp[(128 + n * 4 + 3) * 256] = (bf16_t)(b23 >> 16); } }
                __builtin_amdgcn_sched_barrier(0); }
    }
};
struct EpiRopeKT {
    static constexpr bool PERM = true; bf16_t* out; const int* pos; int half;
    __device__ __forceinline__ void operator()(AccRef acc, const pg8::Unit& u, int wr, int wc, int fr, int fq) const {
        const int h = u.pm, pn = u.pn, uu = ((pn >> 5) * 4 + h) * 32 + (pn & 31); const float l2g = log2_gamma(h);
        float pp[2][8], dec[2][8]; const int c00 = launder(wc * 32 + fq * 8), i00 = launder(wr * 64 + fr);
#pragma unroll
        for (int bj = 0; bj < 2; ++bj)
#pragma unroll
            for (int k = 0; k < 8; ++k) { const int c = bj * 128 + c00 + k; pp[bj][k] = (float)pos[half * THALF + pn * 256 + c]; dec[bj][k] = __builtin_amdgcn_exp2f(-(float)c * l2g) * 0.0625f; }
#pragma unroll
        for (int m = 0; m < 4; ++m) { const int i = i00 + m * 16; const float inv = __builtin_amdgcn_exp2f(-(float)i * (LOG2_THETA / 128.0f));
#pragma unroll
            for (int bj = 0; bj < 2; ++bj) { f32x4 o1[2], o2[2];
#pragma unroll
                for (int n = 0; n < 2; ++n)
#pragma unroll
                    for (int j = 0; j < 4; ++j) { float s, c; sincos_rad(pp[bj][n * 4 + j] * inv, s, c); const float x1 = acc[0][bj][m][n][j], x2 = acc[1][bj][m][n][j], d = dec[bj][n * 4 + j];
                        o1[n][j] = (x1 * c - x2 * s) * d; o2[n][j] = (x1 * s + x2 * c) * d; }
                bf16_t* rp = out + (size_t)uu * 65536 + (size_t)i * 256 + bj * 128 + c00;
                st8(rp, o1[0], o1[1]); st8(rp + 128 * 256, o2[0], o2[1]); __builtin_amdgcn_sched_barrier(0); } }
    }
};
struct EpiVT {
    static constexpr bool PERM = true; bf16_t* out;
    __device__ __forceinline__ void operator()(AccRef acc, const pg8::Unit& u, int wr, int wc, int fr, int fq) const {
        const int h = u.pm >> 1, vt = u.pm & 1, pn = u.pn, uu = ((pn >> 5) * 4 + h) * 32 + (pn & 31);
#pragma unroll
        for (int ai = 0; ai < 2; ++ai)
#pragma unroll
            for (int m = 0; m < 4; ++m) { const int r = ai * 128 + wr * 64 + m * 16 + fr; bf16_t* rp = out + (size_t)uu * 262144 + (size_t)(vt * 256 + r) * 512 + 256 + wc * 32 + fq * 8;
#pragma unroll
                for (int bj = 0; bj < 2; ++bj) st8(rp + bj * 128, acc[ai][bj][m][0], acc[ai][bj][m][1]); }
    }
};
struct EpiS {
    static constexpr bool PERM = true; bf16_t* out;
    __device__ __forceinline__ void operator()(AccRef acc, const pg8::Unit& u, int wr, int wc, int fr, int fq) const {
        const int uu = u.pm;
#pragma unroll
        for (int ai = 0; ai < 2; ++ai)
#pragma unroll
            for (int m = 0; m < 4; ++m) { const int r = ai * 128 + wr * 64 + m * 16 + fr; bf16_t* rp = out + (size_t)uu * 131072 + (size_t)r * 512 + 256 + wc * 32 + fq * 8;
#pragma unroll
                for (int bj = 0; bj < 2; ++bj) { const int c0 = bj * 128 + wc * 32 + fq * 8; f32x4 v0 = acc[ai][bj][m][0], v1 = acc[ai][bj][m][1];
#pragma unroll
                    for (int j = 0; j < 4; ++j) { if (c0 + j > r) v0[j] = 0.f; if (c0 + 4 + j > r) v1[j] = 0.f; }
                    st8(rp + bj * 128, v0, v1); } }
    }
};
struct EpiKV {
    static constexpr bool PERM = true; bf16_t* out;
    __device__ __forceinline__ void operator()(AccRef acc, const pg8::Unit& u, int wr, int wc, int fr, int fq) const {
        const int uu = u.pm, vt = u.pn, h = (uu >> 5) & 3; const float sc = __builtin_amdgcn_exp2f(255.0f * log2_gamma(h));
#pragma unroll
        for (int ai = 0; ai < 2; ++ai)
#pragma unroll
            for (int m = 0; m < 4; ++m) { const int r = ai * 128 + wr * 64 + m * 16 + fr; bf16_t* rp = out + (size_t)uu * 262144 + (size_t)(vt * 256 + r) * 512 + wc * 32 + fq * 8;
#pragma unroll
                for (int bj = 0; bj < 2; ++bj) st8(rp + bj * 128, acc[ai][bj][m][0] * sc, acc[ai][bj][m][1] * sc); }
    }
};
struct EpiFin {
    static constexpr bool PERM = true; bf16_t* out; float* stats; int rep;
    __device__ __forceinline__ void operator()(AccRef acc, const pg8::Unit& u, int wr, int wc, int fr, int fq) const {
        const int uu = u.pm, vt = u.pn, bl = uu >> 7, h = (uu >> 5) & 3, ch = uu & 31;
#pragma unroll
        for (int ai = 0; ai < 2; ++ai)
#pragma unroll
            for (int m = 0; m < 4; ++m) { const int r = ai * 128 + wr * 64 + m * 16 + fr; bf16_t* rp = out + (size_t)uu * 262144 + (size_t)(vt * 256 + r) * 512 + wc * 32 + fq * 8;
                float s = 0.f, q = 0.f;
#pragma unroll
                for (int bj = 0; bj < 2; ++bj) { const f32x4 v0 = acc[ai][bj][m][0], v1 = acc[ai][bj][m][1];
                    s += (v0[0] + v0[1]) + (v0[2] + v0[3]) + (v1[0] + v1[1]) + (v1[2] + v1[3]);
                    q += (v0[0] * v0[0] + v0[1] * v0[1]) + (v0[2] * v0[2] + v0[3] * v0[3]) + (v1[0] * v1[0] + v1[1] * v1[1]) + (v1[2] * v1[2] + v1[3] * v1[3]);
                    if (!rep) st8(rp + bj * 128, v0, v1); }
                s = rows_sum(s); q = rows_sum(q);
                const int tokl = bl * SEQ + ch * 256 + r;
                if (fq == 0 && !rep) *(f32x2*)(stats + ((size_t)(tokl * 4 + h) * 8 + vt * 4 + wc) * 2) = (f32x2){s, q}; }
    }
};
__device__ __forceinline__ f32x2 silu2_mul(const f32x2 g, const f32x2 t, const float invk) {
    const f32x2 x = g * (f32x2){-1.4426950408889634f, -1.4426950408889634f};
    f32x2 e; e[0] = __builtin_amdgcn_exp2f(x[0]); e[1] = __builtin_amdgcn_exp2f(x[1]);
    const f32x2 d = __builtin_elementwise_fma(e, (f32x2){invk, invk}, (f32x2){invk, invk});
    f32x2 r; r[0] = __builtin_amdgcn_rcpf(d[0]); r[1] = __builtin_amdgcn_rcpf(d[1]);
    return (g * t) * r;
}
template <bool F8> struct EpiGate {
    static constexpr bool PERM = true; const bf16_t* o; const float* stats; bf16_t* y; unsigned char* y8;
    __device__ __forceinline__ void operator()(AccRef acc, const pg8::Unit& u, int wr, int wc, int fr, int fq) const {
        const int pm = u.pm, h = u.pn >> 1, vt = u.pn & 1, uu = ((pm >> 5) * 4 + h) * 32 + (pm & 31);
        float mean[2][4], rstd[2][4];
#pragma unroll
        for (int ai = 0; ai < 2; ++ai) { f32x4 st[4][4];
#pragma unroll
            for (int m = 0; m < 4; ++m) { const f32x4* sp = (const f32x4*)(stats + (size_t)((pm * 256 + ai * 128 + wr * 64 + m * 16 + fr) * 4 + h) * 16);
#pragma unroll
                for (int k = 0; k < 4; ++k) st[m][k] = sp[k]; }
#pragma unroll
            for (int m = 0; m < 4; ++m) { const f32x4 a = st[m][0], b = st[m][1], c = st[m][2], d = st[m][3];
                const float mu = ((a[0] + a[2]) + (b[0] + b[2]) + (c[0] + c[2]) + (d[0] + d[2])) * (1.0f / 512.0f);
                const float ex2 = ((a[1] + a[3]) + (b[1] + b[3]) + (c[1] + c[3]) + (d[1] + d[3])) * (1.0f / 512.0f);
                mean[ai][m] = mu; rstd[ai][m] = __builtin_amdgcn_rsqf(fmaxf(ex2 - mu * mu, 0.f) + EPS); } }
        const bf16_t* ob = o + (size_t)uu * 262144 + (size_t)(vt * 256 + wr * 64 + fr) * 512 + wc * 32 + fq * 8;
        u32x4 on[2] = {*(const u32x4*)(ob), *(const u32x4*)(ob + 128)};
#pragma unroll
        for (int ai = 0; ai < 2; ++ai)
#pragma unroll
            for (int m = 0; m < 4; ++m) { const int r = ai * 128 + wr * 64 + m * 16 + fr, tokl = pm * 256 + r; const float ka = (F8 ? 4.0f : 1.0f) * rstd[ai][m], kb = -mean[ai][m] * ka;
                const u32x4 oc[2] = {on[0], on[1]};
                if (ai * 4 + m < 7) { const int ni = ai * 4 + m + 1, nai = ni >> 2, nm = ni & 3; const bf16_t* np = ob + (size_t)(nai * 128 + nm * 16) * 512; on[0] = *(const u32x4*)(np); on[1] = *(const u32x4*)(np + 128); }
                bf16_t* yp = y + (size_t)tokl * 2048 + h * 512 + vt * 256 + wc * 32 + fq * 8;
#pragma unroll
                for (int bj = 0; bj < 2; ++bj) { const u32x4 ow = oc[bj]; const f32x4 g0 = acc[ai][bj][m][0], g1 = acc[ai][bj][m][1];
                    const f32x2 na = {ka, ka}, nb = {kb, kb};
                    const f32x2 t0 = __builtin_elementwise_fma((f32x2){bflo(ow.x), bfhi(ow.x)}, na, nb), t1 = __builtin_elementwise_fma((f32x2){bflo(ow.y), bfhi(ow.y)}, na, nb);
                    const f32x2 t2 = __builtin_elementwise_fma((f32x2){bflo(ow.z), bfhi(ow.z)}, na, nb), t3 = __builtin_elementwise_fma((f32x2){bflo(ow.w), bfhi(ow.w)}, na, nb);
                    const f32x2 q0 = silu2_mul((f32x2){g0[0], g0[1]}, t0, 1.0f), q1 = silu2_mul((f32x2){g0[2], g0[3]}, t1, 1.0f), q2 = silu2_mul((f32x2){g1[0], g1[1]}, t2, 1.0f), q3 = silu2_mul((f32x2){g1[2], g1[3]}, t3, 1.0f);
                    if constexpr (F8) { u32x2 w; w.x = pk4_fp8(q0[0], q0[1], q1[0], q1[1]); w.y = pk4_fp8(q2[0], q2[1], q3[0], q3[1]);
                        *(u32x2*)(y8 + (size_t)tokl * 2048 + h * 512 + vt * 256 + wc * 32 + fq * 8 + bj * 128) = w; }
                    else st8(yp + bj * 128, (f32x4){q0[0], q0[1], q1[0], q1[1]}, (f32x4){q2[0], q2[1], q3[0], q3[1]}); } }
    }
};
struct EpiResid {
    static constexpr bool PERM = false; bf16_t* h; const float* gate; int tok0; const float* xin;
    __device__ __forceinline__ void operator()(AccRef acc, const pg8::Unit& u, int wr, int wc, int fr, int fq) const {
#pragma unroll
        for (int ai = 0; ai < 2; ++ai)
#pragma unroll
            for (int m = 0; m < 4; ++m) { const int row = tok0 + u.pm * 256 + ai * 128 + wr * 64 + m * 16 + fr, b = row >> 13;
#pragma unroll
                for (int bj = 0; bj < 2; ++bj)
#pragma unroll
                    for (int n = 0; n < 2; ++n) { const int c = u.pn * 256 + bj * 128 + wc * 32 + n * 16 + fq * 4; const f32x4 gv = *(const f32x4*)(gate + b * 6144 + c);
                        bf16_t* hp = h + (size_t)row * DM + c;
                        const f32x4 s = xin ? *(const f32x4*)(xin + (size_t)row * DM + c) : bf4_to_f32(*(const u32x2*)hp);
                        const f32x4 r = s + gv * acc[ai][bj][m][n]; u32x2 w; w.x = cvt_pk_bf16(r[0], r[1]); w.y = cvt_pk_bf16(r[2], r[3]); *(u32x2*)hp = w; } }
    }
};
struct EpiGU {
    static constexpr bool PERM = true; bf16_t* hdn;
    __device__ __forceinline__ void operator()(AccRef acc, const pg8::Unit& u, int wr, int wc, int fr, int fq) const {
#pragma unroll
        for (int ai = 0; ai < 2; ++ai)
#pragma unroll
            for (int m = 0; m < 4; ++m) { const int r = ai * 128 + wr * 64 + m * 16 + fr; f32x4 o0, o1;
#pragma unroll
                for (int j = 0; j < 4; ++j) { o0[j] = silu_f(acc[ai][0][m][0][j]) * acc[ai][1][m][0][j]; o1[j] = silu_f(acc[ai][0][m][1][j]) * acc[ai][1][m][1][j]; }
                st8(hdn + (size_t)(u.pm * 256 + r) * DEXP + u.pn * 128 + wc * 32 + fq * 8, o0, o1); }
    }
};
struct EpiGU8 {
    static constexpr bool PERM = true; unsigned char* hdn;
    __device__ __forceinline__ void operator()(AccRef acc, const pg8::Unit& u, int wr, int wc, int fr, int fq) const {
#pragma unroll
        for (int ai = 0; ai < 2; ++ai)
#pragma unroll
            for (int m = 0; m < 4; ++m) { const int r = ai * 128 + wr * 64 + m * 16 + fr; f32x4 o0, o1;
#pragma unroll
                for (int j = 0; j < 4; j += 2) {
                    const f32x2 a0 = silu2_mul((f32x2){acc[ai][0][m][0][j], acc[ai][0][m][0][j + 1]}, (f32x2){acc[ai][1][m][0][j], acc[ai][1][m][0][j + 1]}, 0.25f);
                    const f32x2 a1 = silu2_mul((f32x2){acc[ai][0][m][1][j], acc[ai][0][m][1][j + 1]}, (f32x2){acc[ai][1][m][1][j], acc[ai][1][m][1][j + 1]}, 0.25f);
                    o0[j] = a0[0]; o0[j + 1] = a0[1]; o1[j] = a1[0]; o1[j + 1] = a1[1]; }
                u32x2 w; w.x = pk4_fp8(o0[0], o0[1], o0[2], o0[3]); w.y = pk4_fp8(o1[0], o1[1], o1[2], o1[3]);
                *(u32x2*)(hdn + (size_t)(u.pm * 256 + r) * DEXP + u.pn * 128 + wc * 32 + fq * 8) = w; }
    }
};
struct EpiQA {
    static constexpr bool PERM = true; bf16_t* out; float* ssq; unsigned char* out8;
    __device__ __forceinline__ void operator()(AccRef acc, const pg8::Unit& u, int wr, int wc, int fr, int fq) const {
#pragma unroll
        for (int ai = 0; ai < 2; ++ai)
#pragma unroll
            for (int m = 0; m < 4; ++m) { const int row = u.pm * 256 + ai * 128 + wr * 64 + m * 16 + fr; bf16_t* rp = out + (size_t)row * 256 + wc * 32 + fq * 8; float q = 0.f;
#pragma unroll
                for (int bj = 0; bj < 2; ++bj) { const f32x4 v0 = acc[ai][bj][m][0], v1 = acc[ai][bj][m][1];
                    q += (v0[0] * v0[0] + v0[1] * v0[1]) + (v0[2] * v0[2] + v0[3] * v0[3]) + (v1[0] * v1[0] + v1[1] * v1[1]) + (v1[2] * v1[2] + v1[3] * v1[3]);
                    if (out8) { u32x2 w; w.x = pk4_fp8(4.0f * v0[0], 4.0f * v0[1], 4.0f * v0[2], 4.0f * v0[3]); w.y = pk4_fp8(4.0f * v1[0], 4.0f * v1[1], 4.0f * v1[2], 4.0f * v1[3]);
                        *(u32x2*)(out8 + (size_t)row * 256 + wc * 32 + fq * 8 + bj * 128) = w; }
                    else st8(rp + bj * 128, v0, v1); }
                q = rows_sum(q);
                if (fq == 0) ssq[(size_t)row * 4 + wc] = q; }
    }
};
struct EpiF32 {
    static constexpr bool PERM = false; float* out;
    __device__ __forceinline__ void operator()(AccRef acc, const pg8::Unit& u, int wr, int wc, int fr, int fq) const {
#pragma unroll
        for (int ai = 0; ai < 2; ++ai)
#pragma unroll
            for (int m = 0; m < 4; ++m) { const int row = u.pm * 256 + ai * 128 + wr * 64 + m * 16 + fr;
#pragma unroll
                for (int bj = 0; bj < 2; ++bj)
#pragma unroll
                    for (int n = 0; n < 2; ++n) *(f32x4*)(out + (size_t)row * 256 + bj * 128 + wc * 32 + n * 16 + fq * 4) = acc[ai][bj][m][n]; }
    }
};
template <bool Q8> struct EpiQB {
    static constexpr bool PERM = true; bf16_t* Q; const float* ssq; const int* pos;
    __device__ __forceinline__ void operator()(AccRef acc, const pg8::Unit& u, int wr, int wc, int fr, int fq) const {
        constexpr float QS = 0.10411754627697264f;
        const int pn = u.pn;
        float inv[8]; const int f0 = launder(fq * 8);
#pragma unroll
        for (int k = 0; k < 8; ++k) inv[k] = __builtin_amdgcn_exp2f(-(float)(f0 + k) * (LOG2_THETA / 32.0f)) * 0.15915494309189535f;
        float rs8[2][4], pp[2][4];
#pragma unroll
        for (int ai = 0; ai < 2; ++ai)
#pragma unroll
            for (int m = 0; m < 4; ++m) { const int row = u.pm * 256 + ai * 128 + wr * 64 + m * 16 + fr; const f32x4 sq = *(const f32x4*)(ssq + (size_t)row * 4);
                rs8[ai][m] = __builtin_amdgcn_rsqf(((sq[0] + sq[1]) + (sq[2] + sq[3])) * (1.0f / 256.0f) + EPS) * (Q8 ? 8.0f * QS : QS); pp[ai][m] = (float)pos[row]; }
#pragma unroll
        for (int ai = 0; ai < 2; ++ai)
#pragma unroll
            for (int m = 0; m < 4; ++m) { const int row = u.pm * 256 + ai * 128 + wr * 64 + m * 16 + fr; const float rs = rs8[ai][m];
                if (pn < 4) {
#pragma unroll
                    for (int bj = 0; bj < 2; ++bj) { const f32x4 v0 = acc[ai][bj][m][0] * rs, v1 = acc[ai][bj][m][1] * rs;
                        if constexpr (Q8) { u32x2 w; w.x = pk4_fp8(v0[0], v0[1], v0[2], v0[3]); w.y = pk4_fp8(v1[0], v1[1], v1[2], v1[3]); *(u32x2*)((unsigned char*)Q + (size_t)row * 1536 + (2 * pn + bj) * QKD + wc * 32 + fq * 8) = w; }
                        else st8(Q + (size_t)row * 1536 + (2 * pn + bj) * QKD + wc * 32 + fq * 8, v0, v1); }
                } else {
                    const float p = pp[ai][m]; f32x4 o1[2], o2[2];
#pragma unroll
                    for (int n = 0; n < 2; ++n)
#pragma unroll
                        for (int j = 0; j < 4; ++j) { const float tr = __builtin_amdgcn_fractf(p * inv[n * 4 + j]); const float s = __builtin_amdgcn_sinf(tr) * rs, c = __builtin_amdgcn_cosf(tr) * rs;
                            const float x1 = acc[ai][0][m][n][j], x2 = acc[ai][1][m][n][j];
                            o1[n][j] = x1 * c - x2 * s; o2[n][j] = x1 * s + x2 * c; }
                    if constexpr (Q8) { unsigned char* qp = (unsigned char*)Q + (size_t)row * 1536 + (4 * (pn - 4) + wc) * QKD + 128 + fq * 8; u32x2 w;
                        w.x = pk4_fp8(o1[0][0], o1[0][1], o1[0][2], o1[0][3]); w.y = pk4_fp8(o1[1][0], o1[1][1], o1[1][2], o1[1][3]); *(u32x2*)qp = w;
                        w.x = pk4_fp8(o2[0][0], o2[0][1], o2[0][2], o2[0][3]); w.y = pk4_fp8(o2[1][0], o2[1][1], o2[1][2], o2[1][3]); *(u32x2*)(qp + 32) = w; }
                    else { bf16_t* qp = Q + (size_t)row * 1536 + (4 * (pn - 4) + wc) * QKD + 128 + fq * 8;
                        st8(qp, o1[0], o1[1]); st8(qp + 32, o2[0], o2[1]); } } __builtin_amdgcn_sched_barrier(0); }
    }
};
typedef const char __attribute__((address_space(4)))* kaptr_t;
struct Ctx { kaptr_t ka; LAS unsigned char* lds; int wave, vcu; };
__device__ __forceinline__ const void* ld_ka(kaptr_t ka, int off) { return *(const void* const __attribute__((address_space(4)))*)(ka + off); }
#define INF(k) ((const float*)ld_ka(ka, (k) * 8))
#define INI(k) ((const int*)ld_ka(ka, (k) * 8))
#define OUTP ((float*)ld_ka(ka, 200))
#define WSB ((unsigned char*)ld_ka(ka, 208))
#define CTLP ((unsigned*)(WSB + WS_CTL))
#define PHASE_ENTRY() kaptr_t ka = C.ka; asm volatile("" : "+s"(ka)); int lane_ = lane_id(); asm volatile("" : "+v"(lane_)); int wave_ = C.wave, vcu_ = C.vcu; asm volatile("" : "+s"(wave_), "+s"(vcu_)); \
    const int lane = lane_, wave = wave_, vcu = vcu_, tid = wave * 64 + lane; LAS unsigned char* const ldsb = C.lds; (void)tid; (void)lane; (void)vcu; (void)ldsb
#define WSP(T, off) ((T*)(WSB + (off)))

__device__ __forceinline__ void transpose_block(const float* W, int N, int k0, int n0, bf16_t* dst, int ldd, int drow, LAS float* scr, int lane) {
    (void)scr; const int r = lane >> 3, cg = lane & 7; const float* src = W + (size_t)(k0 + 8 * r) * N + n0 + 4 * cg;
    f32x4 v[8];
#pragma unroll
    for (int i = 0; i < 8; ++i) v[i] = *(const f32x4*)(src + (size_t)i * N);
#pragma unroll
    for (int j = 0; j < 4; ++j) { u32x4 o; o.x = cvt_pk_bf16(v[0][j], v[1][j]); o.y = cvt_pk_bf16(v[2][j], v[3][j]); o.z = cvt_pk_bf16(v[4][j], v[5][j]); o.w = cvt_pk_bf16(v[6][j], v[7][j]);
        *(u32x4*)(dst + (size_t)(drow + 4 * cg + j) * ldd + k0 + 8 * r) = o; }
}
__device__ __forceinline__ void transpose_block_f8(const float* W, int N, int k0, int n0, unsigned char* dst, int ldd, int drow, float sc, LAS float* scr, int lane) {
    (void)scr; const int r = lane >> 3, cg = lane & 7; const float* src = W + (size_t)(k0 + 8 * r) * N + n0 + 4 * cg;
    f32x4 v[8];
#pragma unroll
    for (int i = 0; i < 8; ++i) v[i] = *(const f32x4*)(src + (size_t)i * N);
#pragma unroll
    for (int j = 0; j < 4; ++j) { u32x2 o; o.x = pk4_fp8(sc * v[0][j], sc * v[1][j], sc * v[2][j], sc * v[3][j]); o.y = pk4_fp8(sc * v[4][j], sc * v[5][j], sc * v[6][j], sc * v[7][j]);
        *(u32x2*)(dst + (size_t)(drow + 4 * cg + j) * ldd + k0 + 8 * r) = o; }
}
__device__ __forceinline__ void moe_weight_block(kaptr_t ka, const int le, const int r, LAS float* scr, const int lane) {
    if (r < 512) { const int up = r >> 8, rr = r & 255, kb = rr / 16, nb = rr % 16, n0 = 32 * nb;
        transpose_block_f8((up ? INF(22) : INF(21)) + (size_t)le * 1024 * 512, 512, 64 * kb, n0, WSP(unsigned char, WS_WGU) + (size_t)le * 1024 * 1024, 1024, (n0 >> 7) * 256 + (n0 & 127) + up * 128, 64.0f, scr, lane); }
    else { const int rr = r - 512, kb = rr / 32, nb = rr % 32;
        transpose_block_f8(INF(23) + (size_t)le * 512 * 1024, 1024, 64 * kb, 32 * nb, WSP(unsigned char, WS_WDN) + (size_t)le * 1024 * 512, 512, 32 * nb, 64.0f, scr, lane); }
}
__device__ __forceinline__ void moe_convert_tail(Ctx& C, const int lnext, const int lo, const int hi) {
    PHASE_ENTRY();
    __syncthreads();
    const LAS int* tab = (const LAS int*)(ldsb + LDS_TAB);
    const int total = __builtin_amdgcn_readfirstlane(tab[32]) * 4, rem = total % GRID;
    int nidle = GRID, rank = vcu;
    if (rem != 0 && GRID - rem >= 96) { nidle = GRID - rem; rank = vcu - rem; }
    if (rank < 0) return;
    LAS float* scr = (LAS float*)(ldsb + wave * 16384);
    for (int it = lo + rank * NWAVES + wave; it < hi; it += nidle * NWAVES) moe_weight_block(ka, lnext * 16 + it / 768, it % 768, scr, lane);
}
__device__ __forceinline__ void phase_prologue(Ctx& C) {
    PHASE_ENTRY();
    LAS float* cact = (LAS float*)ldsb;
    LAS float* red = (LAS float*)(ldsb + 16384);
    for (int i = tid; i < 4096; i += NTHREADS) cact[i] = silu_f(INF(1)[i]);
    __syncthreads();
    float* mod = WSP(float, WS_MOD);
    for (int g = vcu; g < 416; g += GRID) {
        const int col = g * 64 + lane; const float* W; int N, cc; const float* bias; float* dst; int dstride;
        if (col < 24576) { const int l = col / 6144; cc = col - l * 6144; W = INF(3) + (size_t)l * 1024 * 6144; N = 6144; bias = INF(4) + l * 6144; dst = mod + (size_t)l * 4 * 6144; dstride = 6144; }
        else { cc = col - 24576; W = INF(9); N = 2048; bias = INF(10); dst = mod + 4 * 4 * 6144; dstride = 2048; }
        float a0 = 0.f, a1 = 0.f, a2 = 0.f, a3 = 0.f;
        const float* wp = W + (size_t)(wave * 128) * N + cc;
#pragma unroll 32
        for (int k = 0; k < 128; ++k) { const float w = wp[(size_t)k * N]; const int kk = wave * 128 + k; a0 += cact[kk] * w; a1 += cact[1024 + kk] * w; a2 += cact[2048 + kk] * w; a3 += cact[3072 + kk] * w; }
        red[(wave * 4 + 0) * 64 + lane] = a0; red[(wave * 4 + 1) * 64 + lane] = a1; red[(wave * 4 + 2) * 64 + lane] = a2; red[(wave * 4 + 3) * 64 + lane] = a3;
        __syncthreads();
        if (tid < 256) { const int b = tid >> 6, ln = tid & 63; float s = 0.f;
#pragma unroll
            for (int w = 0; w < 8; ++w) s += red[(w * 4 + b) * 64 + ln];
            const int c2 = g * 64 + ln; const int cc2 = c2 < 24576 ? c2 % 6144 : c2 - 24576;
            dst[(size_t)b * dstride + cc2] = s + bias[cc2]; }
        __syncthreads();
    }
    LAS float* scr = (LAS float*)(ldsb + wave * 16384);
    const int gw = vcu * NWAVES + wave, NGW = GRID * NWAVES;
    constexpr int NIT = 8544 + 16 * 768;
    for (int it = gw; it < NIT; it += NGW) {
        if (it < 6144) { const int l = it / 3072, r = it % 3072, kb = r / 192, nb = r % 192;
            const bool need16 = (nb < 64) ? ((FP8_R2 & 1) == 0) : (nb < 128 ? ((FP8_R2 & 2) == 0) : (FP8_R6 == 0)), need8 = (nb < 64) ? ((FP8_R2 & 1) != 0) : (nb < 128 ? ((FP8_R2 & 2) != 0) : (FP8_R6 != 0));
            if (need16) transpose_block(INF(7) + (size_t)l * 1024 * 6144, 6144, 64 * kb, 32 * nb, WSP(bf16_t, WS_WIN) + (size_t)l * 6144 * 1024, 1024, 32 * nb, scr, lane);
            if (need8) transpose_block_f8(INF(7) + (size_t)l * 1024 * 6144, 6144, 64 * kb, 32 * nb, WSP(unsigned char, WS_WIN8) + (size_t)l * 6144 * 1024, 1024, 32 * nb, 64.0f, scr, lane); }
        else if (it < 8192) { const int r0 = it - 6144, l = r0 / 1024, r = r0 % 1024, kb = r / 32, nb = r % 32;
            if (FP8_R7) transpose_block_f8(INF(8) + (size_t)l * 2048 * 1024, 1024, 64 * kb, 32 * nb, WSP(unsigned char, WS_WOUT8) + (size_t)l * 1024 * 2048, 2048, 32 * nb, 64.0f, scr, lane);
            else transpose_block(INF(8) + (size_t)l * 2048 * 1024, 1024, 64 * kb, 32 * nb, WSP(bf16_t, WS_WOUT) + (size_t)l * 1024 * 2048, 2048, 32 * nb, scr, lane); }
        else if (it < 8448) { const int r0 = it - 8192, j = r0 / 128, r = r0 % 128, kb = r / 8, nb = r % 8;
            if (FP8_M2) transpose_block_f8(INF(15) + (size_t)j * 1024 * 256, 256, 64 * kb, 32 * nb, WSP(unsigned char, WS_WQA8) + (size_t)j * 256 * 1024, 1024, 32 * nb, 64.0f, scr, lane);
            else transpose_block(INF(15) + (size_t)j * 1024 * 256, 256, 64 * kb, 32 * nb, WSP(bf16_t, WS_WQA) + (size_t)j * 256 * 1024, 1024, 32 * nb, scr, lane); }
        else if (it < 8544) { const int r = it - 8448, kb = r / 6, nb = r % 6;
            transpose_block(INF(12), 192, 64 * kb, 32 * nb, WSP(bf16_t, WS_WKVA), 1024, 32 * nb, scr, lane); }
        else { const int r0 = it - 8544; moe_weight_block(ka, r0 / 768, r0 % 768, scr, lane); }
    }
    const int gt = vcu * NTHREADS + tid, NGT = GRID * NTHREADS;
    for (int i = gt; i < 64 * 1024 / 8; i += NGT) *(u32x4*)(WSP(bf16_t, WS_WKVA) + 192 * 1024 + (size_t)i * 8) = (u32x4){0u, 0u, 0u, 0u};
    for (int i = gt; i < 2 * 1536 * 256; i += NGT) {
        const int k = i & 255, n = (i >> 8) % 1536, j = i / (1536 * 256);
        const float* wq = INF(17) + ((size_t)j * 256 + k) * 1536; float v;
        if (n < 1024) { const int head = n >> 7, cdim = n & 127; const float* a = wq + head * QKD; const float* b = INF(14) + (size_t)cdim * 2048 + head * 256; float s = 0.f;
#pragma unroll 8
            for (int d = 0; d < 128; d += 4) { const f32x4 av = *(const f32x4*)(a + d), bv = *(const f32x4*)(b + d); s += av[0] * bv[0] + av[1] * bv[1] + av[2] * bv[2] + av[3] * bv[3]; }
            v = s; }
        else { const int np = (n - 1024) & 255, pn = (n - 1024) >> 8, half = np >> 7, wcc = (np & 127) >> 5, ii = np & 31; v = wq[(4 * pn + wcc) * QKD + 128 + half * 32 + ii]; }
        v *= INF(16)[j * 256 + k];
        if (FP8_M3) WSP(unsigned char, WS_WQB8)[i] = (unsigned char)(pk4_fp8(64.0f * v, 0.f, 0.f, 0.f) & 0xffu);
        else WSP(bf16_t, WS_WQB)[i] = (bf16_t)(cvt_pk_bf16(v, 0.f) & 0xffffu);
    }
    for (int it = vcu * NWAVES + wave; it < 2 * 8 * 16 * 8; it += GRID * NWAVES) {
        const int nq = it & 7, cb = (it >> 3) & 15, hh = (it >> 7) & 7, j = it >> 10, n0 = nq * 128 + 2 * lane, c0 = cb * 8;
        const float* a = INF(14) + (size_t)c0 * 2048 + hh * 256 + 128; const float* bq = INF(18) + ((size_t)j * 1024 + hh * 128) * 1024 + n0;
        f32x2 acc[8];
#pragma unroll
        for (int c = 0; c < 8; ++c) acc[c] = (f32x2){0.f, 0.f};
#pragma unroll 8
        for (int v = 0; v < 128; ++v) { const f32x2 bv = *(const f32x2*)(bq + (size_t)v * 1024);
#pragma unroll
            for (int c = 0; c < 8; ++c) acc[c] = acc[c] + bv * a[(size_t)c * 2048 + v]; }
        bf16_t* o = WSP(bf16_t, WS_WO) + ((size_t)j * 1024 + n0) * 1024 + hh * 128 + c0;
#pragma unroll
        for (int q = 0; q < 2; ++q) { u32x4 w; w.x = cvt_pk_bf16(acc[0][q], acc[1][q]); w.y = cvt_pk_bf16(acc[2][q], acc[3][q]); w.z = cvt_pk_bf16(acc[4][q], acc[5][q]); w.w = cvt_pk_bf16(acc[6][q], acc[7][q]);
            if (!FP8_M5) *(u32x4*)(o + (size_t)q * 1024) = w;
            u32x2 w8; w8.x = pk4_fp8(64.f * acc[0][q], 64.f * acc[1][q], 64.f * acc[2][q], 64.f * acc[3][q]); w8.y = pk4_fp8(64.f * acc[4][q], 64.f * acc[5][q], 64.f * acc[6][q], 64.f * acc[7][q]);
            if (FP8_M5) *(u32x2*)(WSP(unsigned char, WS_WO8) + ((size_t)j * 1024 + n0 + q) * 1024 + hh * 128 + c0) = w8; }
    }
}

__device__ __forceinline__ void moe_tile_prefix(Ctx& C, int l) {
    PHASE_ENTRY();
    LAS int* tab = (LAS int*)(ldsb + LDS_TAB);
    if (tid < 16) {
        const int n = (int)__hip_atomic_load(CTLP + CW_CNT + 64 * l + tid, __ATOMIC_RELAXED, __HIP_MEMORY_SCOPE_AGENT);
        tab[tid] = n; tab[40 + tid] = (n + 255) >> 8;
        LDS_WAIT();
        int acc = 0;
#pragma unroll
        for (int e = 0; e < 16; ++e) { const int t = tab[40 + e]; acc += (e < tid) ? t : 0; }
        tab[16 + tid] = acc; if (tid == 15) tab[32] = acc + tab[40 + 15];
    }
    __syncthreads();
}
__device__ __forceinline__ void store_fp8_row(unsigned char* row, int lane, const f32x4 (&v)[4], float sc) {
#pragma unroll
    for (int j = 0; j < 4; ++j) *(unsigned*)(row + 4 * lane + 256 * j) = pk4_fp8(sc * v[j][0], sc * v[j][1], sc * v[j][2], sc * v[j][3]);
}
__device__ __forceinline__ void store_bf16_row(bf16_t* row, int lane, const f32x4 (&v)[4]) {
#pragma unroll
    for (int j = 0; j < 4; ++j) { u32x2 w; w.x = cvt_pk_bf16(v[j][0], v[j][1]); w.y = cvt_pk_bf16(v[j][2], v[j][3]); *(u32x2*)(row + 4 * lane + 256 * j) = w; }
}
__device__ __forceinline__ void moe_combine_row(const LAS int* tab, const unsigned* route, const bf16_t* yb, int lane, int tok, const f32x4 (&G2)[4], f32x4 (&v)[4]) {
    const u32x4 rt = *(const u32x4*)(route + (size_t)tok * 4);
    const int e0 = rt.x >> 15, p0 = rt.x & 32767, e1 = rt.y >> 15, p1 = rt.y & 32767; const float w0 = __uint_as_float(rt.z), w1 = __uint_as_float(rt.w);
    const bf16_t* y0 = yb + (size_t)(tab[16 + e0] * 256 + p0) * DM; const bf16_t* y1 = yb + (size_t)(tab[16 + e1] * 256 + p1) * DM;
#pragma unroll
    for (int j = 0; j < 4; ++j) { const u32x2 a = *(const u32x2*)(y0 + 4 * lane + 256 * j), b = *(const u32x2*)(y1 + 4 * lane + 256 * j);
        v[j][0] += G2[j][0] * (w0 * bflo(a.x) + w1 * bflo(b.x)); v[j][1] += G2[j][1] * (w0 * bfhi(a.x) + w1 * bfhi(b.x));
        v[j][2] += G2[j][2] * (w0 * bflo(a.y) + w1 * bflo(b.y)); v[j][3] += G2[j][3] * (w0 * bfhi(a.y) + w1 * bfhi(b.y)); }
}
__device__ __forceinline__ float row_rstd(const f32x4 (&v)[4]) {
    float s = 0.f;
#pragma unroll
    for (int j = 0; j < 4; ++j) s += (v[j][0] * v[j][0] + v[j][1] * v[j][1]) + (v[j][2] * v[j][2] + v[j][3] * v[j][3]);
    return __builtin_amdgcn_rsqf(wave_sum(s) * (1.0f / DM) + EPS);
}
__device__ __forceinline__ void phase_norm_a(Ctx& C, int l, int rep = 0) {
    PHASE_ENTRY(); const int b = vcu >> 6; const float* mod = WSP(float, WS_MOD);
    const float* xin = INF(0); float* hout = OUTP; bf16_t* h16 = WSP(bf16_t, WS_H16); bf16_t* xnp = WSP(bf16_t, WS_XN); unsigned char* xn8p = WSP(unsigned char, WS_XN8); bf16_t* hnp = WSP(bf16_t, WS_HN); const unsigned* route = WSP(unsigned, WS_ROUTE); const unsigned char* ybp = WSP(unsigned char, WS_YB);
    f32x4 Am[4], Bm[4], G2[4], Ak[4], Bk[4];
#pragma unroll
    for (int j = 0; j < 4; ++j) { const int c = 4 * lane + 256 * j;
        if (l < 4) { const float* ml = mod + (size_t)(l * 4 + b) * 6144; const f32x4 g = *(const f32x4*)(INF(5) + l * DM + c), sc = *(const f32x4*)(ml + 1024 + c); Am[j] = g * (1.0f + sc); Bm[j] = *(const f32x4*)(ml + c); }
        else { Am[j] = *(const f32x4*)(INF(24) + c); Bm[j] = (f32x4){0.f, 0.f, 0.f, 0.f}; }
        if (l > 0 && !rep) G2[j] = *(const f32x4*)(mod + (size_t)((l - 1) * 4 + b) * 6144 + 5 * 1024 + c); else G2[j] = (f32x4){0.f, 0.f, 0.f, 0.f};
        if (l == 2) { const float* mk = mod + 4 * 4 * 6144 + b * 2048; const f32x4 g = *(const f32x4*)(INF(11) + c), sc = *(const f32x4*)(mk + 1024 + c); Ak[j] = g * (1.0f + sc); Bk[j] = *(const f32x4*)(mk + c); }
        else { Ak[j] = Am[j]; Bk[j] = Bm[j]; } }
    if (l > 0) moe_tile_prefix(C, l - 1);
    const LAS int* tab = (const LAS int*)(ldsb + LDS_TAB);
    const int tok0 = vcu * 128 + wave * 16;
    const float* src0 = xin + (size_t)tok0 * DM + 4 * lane; const bf16_t* hsrc0 = h16 + (size_t)tok0 * DM + 4 * lane;
    u32x4 rtl = (u32x4){0u, 0u, 0u, 0u};
    if (l > 0) rtl = *(const u32x4*)(route + (size_t)(tok0 + (lane & 15)) * 4);
    f32x4 vn[4]; u32x2 hn[4]; unsigned ya[4], yb[4]; float wn0 = 0.f, wn1 = 0.f;
#define NA_ISSUE(rr_) do { if (l == 0) { _Pragma("unroll") for (int j = 0; j < 4; ++j) vn[j] = *(const f32x4*)(src0 + (size_t)(rr_) * DM + 256 * j); } \
        else { _Pragma("unroll") for (int j = 0; j < 4; ++j) hn[j] = *(const u32x2*)(hsrc0 + (size_t)(rr_) * DM + 256 * j); } \
        if (l > 0) { const unsigned rx = __builtin_amdgcn_readlane(rtl.x, (rr_)), ry = __builtin_amdgcn_readlane(rtl.y, (rr_)); \
            wn0 = __uint_as_float(__builtin_amdgcn_readlane(rtl.z, (rr_))); wn1 = __uint_as_float(__builtin_amdgcn_readlane(rtl.w, (rr_))); \
            const int e0 = rx >> 15, p0 = rx & 32767, e1 = ry >> 15, p1 = ry & 32767; \
            const unsigned char* y0 = ybp + (size_t)(__builtin_amdgcn_readfirstlane(tab[16 + e0]) * 256 + p0) * DM + 4 * lane; const unsigned char* y1 = ybp + (size_t)(__builtin_amdgcn_readfirstlane(tab[16 + e1]) * 256 + p1) * DM + 4 * lane; \
            _Pragma("unroll") for (int j = 0; j < 4; ++j) { ya[j] = *(const unsigned*)(y0 + 256 * j); yb[j] = *(const unsigned*)(y1 + 256 * j); } } } while (0)
    NA_ISSUE(0);
#pragma unroll 1
    for (int rr = 0; rr < 16; ++rr) {
        const int tok = tok0 + rr; f32x4 v[4];
        if (l == 0) {
#pragma unroll
            for (int j = 0; j < 4; ++j) v[j] = vn[j];
        } else {
#pragma unroll
            for (int j = 0; j < 4; ++j) v[j] = bf4_to_f32(hn[j]); }
        if (l > 0) { const float w0 = wn0 * 0.0625f, w1 = wn1 * 0.0625f;
#pragma unroll
            for (int j = 0; j < 4; ++j) { const int a2 = (int)ya[j], b2 = (int)yb[j];
                v[j][0] += G2[j][0] * (w0 * __builtin_amdgcn_cvt_f32_fp8(a2, 0) + w1 * __builtin_amdgcn_cvt_f32_fp8(b2, 0)); v[j][1] += G2[j][1] * (w0 * __builtin_amdgcn_cvt_f32_fp8(a2, 1) + w1 * __builtin_amdgcn_cvt_f32_fp8(b2, 1));
                v[j][2] += G2[j][2] * (w0 * __builtin_amdgcn_cvt_f32_fp8(a2, 2) + w1 * __builtin_amdgcn_cvt_f32_fp8(b2, 2)); v[j][3] += G2[j][3] * (w0 * __builtin_amdgcn_cvt_f32_fp8(a2, 3) + w1 * __builtin_amdgcn_cvt_f32_fp8(b2, 3)); } }
        if (rr + 1 < 16) NA_ISSUE(rr + 1);
        const float rstd = row_rstd(v);
        if (l < 4) {
            if (l > 0) {
#pragma unroll
                for (int j = 0; j < 4; ++j) { u32x2 w; w.x = cvt_pk_bf16(v[j][0], v[j][1]); w.y = cvt_pk_bf16(v[j][2], v[j][3]); *(u32x2*)(h16 + (size_t)tok * DM + 4 * lane + 256 * j) = w; } }
            f32x4 o[4];
#pragma unroll
            for (int j = 0; j < 4; ++j) o[j] = v[j] * rstd * Am[j] + Bm[j];
            if ((l < 2 && (FP8_R2 & 1) == 0) || (l >= 2 && !FP8_M2)) store_bf16_row(xnp + (size_t)tok * DM, lane, o);
            if (l < 2 || FP8_M2) store_fp8_row(xn8p + (size_t)tok * DM, lane, o, 4.0f);
            if (l == 2) {
#pragma unroll
                for (int j = 0; j < 4; ++j) o[j] = v[j] * rstd * Ak[j] + Bk[j];
                store_bf16_row(hnp + (size_t)tok * DM, lane, o); }
        } else {
#pragma unroll
            for (int j = 0; j < 4; ++j) *(f32x4*)(hout + (size_t)tok * DM + 4 * lane + 256 * j) = v[j] * rstd * Am[j];
        }
    }
#undef NA_ISSUE
}
constexpr int NBR = 4;
template <int CTRL> __device__ __forceinline__ float dpp_add(float v) { return v + dpp_f<CTRL>(v); }
typedef float f32x2_t __attribute__((ext_vector_type(2)));
__device__ __forceinline__ void phase_norm_b(Ctx& C, int l, int rep = 0) {
    PHASE_ENTRY(); const int b = vcu >> 6; const float* ml = WSP(float, WS_MOD) + (size_t)(l * 4 + b) * 6144;
    const bf16_t* hin = WSP(bf16_t, WS_H16); bf16_t* xnp = WSP(bf16_t, WS_XN);
    LAS float* wrT = (LAS float*)ldsb;
    LAS float* lgt = (LAS float*)(ldsb + 65536);
    LAS int* rec_e = (LAS int*)(ldsb + 65536 + 8192);
    LAS float* rec_w = (LAS float*)(ldsb + 65536 + 8192 + 1024);
    LAS int* rec_p = (LAS int*)(ldsb + 65536 + 8192 + 2048);
    LAS int* lcnt = (LAS int*)(ldsb + 65536 + 8192 + 3072);
    LAS int* gbase = (LAS int*)(ldsb + 65536 + 8192 + 3072 + 64);
    for (int i = tid; i < 4096; i += NTHREADS) { const f32x4 w = *(const f32x4*)(INF(19) + (size_t)i * 4); const int col = i >> 2, e4 = (i & 3) * 4;
        wrT[(e4 + 0) * 1024 + col] = 0.25f * w[0]; wrT[(e4 + 1) * 1024 + col] = 0.25f * w[1]; wrT[(e4 + 2) * 1024 + col] = 0.25f * w[2]; wrT[(e4 + 3) * 1024 + col] = 0.25f * w[3]; }
    if (tid < 16) lcnt[tid] = 0;
    f32x4 Am[4], Bm[4];
#pragma unroll
    for (int j = 0; j < 4; ++j) { const int c = 4 * lane + 256 * j; const f32x4 g = *(const f32x4*)(INF(6) + l * DM + c), sc = *(const f32x4*)(ml + 4 * 1024 + c); Am[j] = 4.0f * (g * (1.0f + sc)); Bm[j] = 4.0f * *(const f32x4*)(ml + 3 * 1024 + c); }
    const bf16_t* hrow = hin + (size_t)(vcu * 128 + wave * 16) * DM + 4 * lane;
    __syncthreads();
    u32x2 hn[NBR][4];
#pragma unroll
    for (int i = 0; i < NBR; ++i)
#pragma unroll
        for (int j = 0; j < 4; ++j) hn[i][j] = *(const u32x2*)(hrow + (size_t)i * DM + 256 * j);
#pragma unroll 1
    for (int g = 0; g < 16 / NBR; ++g) {
        asm volatile("" ::: "memory");
        f32x4 v[NBR][4];
#pragma unroll
        for (int i = 0; i < NBR; ++i)
#pragma unroll
            for (int j = 0; j < 4; ++j) v[i][j] = bf4_to_f32(hn[i][j]);
        if (g + 1 < 16 / NBR) {
#pragma unroll
            for (int i = 0; i < NBR; ++i)
#pragma unroll
                for (int j = 0; j < 4; ++j) hn[i][j] = *(const u32x2*)(hrow + (size_t)((g + 1) * NBR + i) * DM + 256 * j);
        }
#pragma unroll
        for (int i = 0; i < NBR; ++i) { const float rstd = row_rstd(v[i]);
#pragma unroll
            for (int j = 0; j < 4; ++j) v[i][j] = v[i][j] * rstd * Am[j] + Bm[j];
            if (!rep) { unsigned char* xr = (unsigned char*)xnp + (size_t)(vcu * 128 + wave * 16 + g * NBR + i) * DM;
#pragma unroll
              for (int j = 0; j < 4; ++j) *(unsigned*)(xr + 4 * lane + 256 * j) = pk4_fp8(v[i][j][0], v[i][j][1], v[i][j][2], v[i][j][3]); } }
        float p[NBR][16];
#pragma unroll
        for (int e = 0; e < 16; ++e) { f32x4 w[4];
#pragma unroll
            for (int j = 0; j < 4; ++j) w[j] = *(const LAS f32x4*)(wrT + e * 1024 + 4 * lane + 256 * j);
            f32x2_t a2[NBR];
#pragma unroll
            for (int i = 0; i < NBR; ++i) a2[i] = (f32x2_t){0.f, 0.f};
#pragma unroll
            for (int j = 0; j < 4; ++j) {
#pragma unroll
                for (int i = 0; i < NBR; ++i) a2[i] = __builtin_elementwise_fma(__builtin_shufflevector(v[i][j], v[i][j], 0, 1), __builtin_shufflevector(w[j], w[j], 0, 1), a2[i]);
#pragma unroll
                for (int i = 0; i < NBR; ++i) a2[i] = __builtin_elementwise_fma(__builtin_shufflevector(v[i][j], v[i][j], 2, 3), __builtin_shufflevector(w[j], w[j], 2, 3), a2[i]); }
#pragma unroll
            for (int i = 0; i < NBR; ++i) { p[i][e] = a2[i][0] + a2[i][1]; asm volatile("" : "+v"(p[i][e])); }
            __builtin_amdgcn_sched_barrier(0); }
#pragma unroll
        for (int i = 0; i < NBR; ++i) {
            float q[8], r[4];
#pragma unroll
            for (int k = 0; k < 8; ++k) { auto t = __builtin_amdgcn_permlane32_swap(__float_as_uint(p[i][k]), __float_as_uint(p[i][k + 8]), false, false); q[k] = __uint_as_float(t[0]) + __uint_as_float(t[1]); }
#pragma unroll
            for (int k = 0; k < 4; ++k) { auto t = __builtin_amdgcn_permlane16_swap(__float_as_uint(q[k]), __float_as_uint(q[k + 4]), false, false); r[k] = __uint_as_float(t[0]) + __uint_as_float(t[1]); }
#pragma unroll
            for (int k = 0; k < 4; ++k) { r[k] = dpp_add<0xB1>(r[k]); r[k] = dpp_add<0x4E>(r[k]); r[k] = dpp_add<0x141>(r[k]); r[k] = dpp_add<0x140>(r[k]); }
            if ((lane & 15) == 0) { const int rho = lane >> 4; *(LAS f32x4*)(lgt + (wave * 16 + g * NBR + i) * 16 + 4 * (rho & 1) + 8 * (rho >> 1)) = (f32x4){r[0], r[1], r[2], r[3]}; }
        }
    }
    LDS_WAIT();
    if (lane < 16) {
        const int rl = wave * 16 + lane; float sc[16], bs[16];
#pragma unroll
        for (int e4 = 0; e4 < 4; ++e4) { const f32x4 lg = *(const LAS f32x4*)(lgt + rl * 16 + e4 * 4); const f32x4 rbv = *(const f32x4*)(INF(20) + e4 * 4);
#pragma unroll
            for (int k = 0; k < 4; ++k) { sc[e4 * 4 + k] = 1.0f / (1.0f + __expf(-lg[k])); bs[e4 * 4 + k] = sc[e4 * 4 + k] + rbv[k]; } }
        float gs[4];
#pragma unroll
        for (int g = 0; g < 4; ++g) { const float a = bs[4 * g], bq = bs[4 * g + 1], c = bs[4 * g + 2], d = bs[4 * g + 3];
            const float h1 = fmaxf(a, bq), l1 = fminf(a, bq), h2 = fmaxf(c, d), l2 = fminf(c, d); gs[g] = fmaxf(h1, h2) + fmaxf(fminf(h1, h2), fmaxf(l1, l2)); }
        int gi = 0; float best = gs[0];
#pragma unroll
        for (int g = 1; g < 4; ++g) if (gs[g] > best) { best = gs[g]; gi = g; }
        float iv[4], uv[4];
#pragma unroll
        for (int k = 0; k < 4; ++k) { iv[k] = gi == 0 ? bs[k] : (gi == 1 ? bs[4 + k] : (gi == 2 ? bs[8 + k] : bs[12 + k])); uv[k] = gi == 0 ? sc[k] : (gi == 1 ? sc[4 + k] : (gi == 2 ? sc[8 + k] : sc[12 + k])); }
        int i1 = 0; float b1 = iv[0];
#pragma unroll
        for (int k = 1; k < 4; ++k) if (iv[k] > b1) { b1 = iv[k]; i1 = k; }
        int i2 = -1; float b2 = 0.f;
#pragma unroll
        for (int k = 0; k < 4; ++k) if (k != i1 && (i2 < 0 || iv[k] > b2)) { b2 = iv[k]; i2 = k; }
        const float u1 = i1 == 0 ? uv[0] : (i1 == 1 ? uv[1] : (i1 == 2 ? uv[2] : uv[3])), u2 = i2 == 0 ? uv[0] : (i2 == 1 ? uv[1] : (i2 == 2 ? uv[2] : uv[3]));
        const float rs = 1.0f / (u1 + u2);
        rec_e[rl * 2] = gi * 4 + i1; rec_e[rl * 2 + 1] = gi * 4 + i2; rec_w[rl * 2] = u1 * rs; rec_w[rl * 2 + 1] = u2 * rs;
    }
    __syncthreads();
    if (rep) return;
    if (tid < 128) { rec_p[tid * 2] = atomicAdd((int*)&lcnt[rec_e[tid * 2]], 1); rec_p[tid * 2 + 1] = atomicAdd((int*)&lcnt[rec_e[tid * 2 + 1]], 1); }
    __syncthreads();
    if (tid < 16) gbase[tid] = (int)__hip_atomic_fetch_add(CTLP + CW_CNT + 64 * l + tid, (unsigned)lcnt[tid], __ATOMIC_RELAXED, __HIP_MEMORY_SCOPE_AGENT);
    __syncthreads();
    if (tid < 128) { const int tok = vcu * 128 + tid, e0 = rec_e[tid * 2], e1 = rec_e[tid * 2 + 1], p0 = gbase[e0] + rec_p[tid * 2], p1 = gbase[e1] + rec_p[tid * 2 + 1];
        int* idx = WSP(int, WS_IDX); idx[e0 * NTOK + p0] = tok; idx[e1 * NTOK + p1] = tok;
        *(u32x4*)(WSP(unsigned, WS_ROUTE) + (size_t)tok * 4) = (u32x4){(unsigned)(e0 << 15 | p0), (unsigned)(e1 << 15 | p1), __float_as_uint(rec_w[tid * 2]), __float_as_uint(rec_w[tid * 2 + 1])}; }
    __syncthreads();
}
__device__ __forceinline__ void phase_prefix(Ctx& C, int rep = 0) {
    PHASE_ENTRY(); const int g = vcu * NTHREADS + tid, dkv = g & 31, v = (g >> 5) & 511, bh = g >> 14, h = bh & 3;
    const float gam = __builtin_amdgcn_exp2f(log2_gamma(h)), gam256 = __builtin_amdgcn_exp2f(256.0f * log2_gamma(h));
    bf16_t* p = WSP(bf16_t, WS_B2T) + (size_t)bh * 32 * 262144 + (size_t)v * 512 + dkv * 8;
    float s[8];
#pragma unroll
    for (int k = 0; k < 8; ++k) s[k] = 0.f;
#pragma unroll 1
    for (int c0 = 0; c0 < 32; c0 += 16) {
        u32x4 kv[16];
#pragma unroll
        for (int i = 0; i < 16; ++i) kv[i] = *(const u32x4*)(p + (size_t)(c0 + i) * 262144);
#pragma unroll
        for (int i = 0; i < 16; ++i) {
            u32x4 o; o.x = cvt_pk_bf16(s[0] * gam, s[1] * gam); o.y = cvt_pk_bf16(s[2] * gam, s[3] * gam); o.z = cvt_pk_bf16(s[4] * gam, s[5] * gam); o.w = cvt_pk_bf16(s[6] * gam, s[7] * gam);
            if (!rep) *(u32x4*)(p + (size_t)(c0 + i) * 262144) = o;
            s[0] = s[0] * gam256 + bflo(kv[i].x); s[1] = s[1] * gam256 + bfhi(kv[i].x); s[2] = s[2] * gam256 + bflo(kv[i].y); s[3] = s[3] * gam256 + bfhi(kv[i].y);
            s[4] = s[4] * gam256 + bflo(kv[i].z); s[5] = s[5] * gam256 + bfhi(kv[i].z); s[6] = s[6] * gam256 + bflo(kv[i].w); s[7] = s[7] * gam256 + bfhi(kv[i].w); }
    }
}
__device__ __forceinline__ void phase_kvfin(Ctx& C) {
    PHASE_ENTRY(); const float* akv = WSP(float, WS_AKV); bf16_t* kpp = WSP(bf16_t, WS_KP); const int* posp = INI(2); const float g0 = INF(13)[2 * lane], g1 = INF(13)[2 * lane + 1];
    const float inv = __builtin_amdgcn_exp2f(-(float)(lane & 31) * (LOG2_THETA / 32.0f));
    for (int rr = 0; rr < 16; ++rr) {
        const int tok = vcu * 128 + wave * 16 + rr; const float* a = akv + (size_t)tok * 256; bf16_t* kp = kpp + (size_t)tok * QKD;
        const f32x2 cv = *(const f32x2*)(a + 2 * lane); const float rstd = __builtin_amdgcn_rsqf(wave_sum(cv[0] * cv[0] + cv[1] * cv[1]) * (1.0f / 128.0f) + EPS);
        if (!ATT_FP8) *(unsigned*)(kp + 2 * lane) = cvt_pk_bf16(cv[0] * rstd * g0, cv[1] * rstd * g1);
        const float x1 = a[128 + (lane & 31)], x2 = a[160 + (lane & 31)]; float s, c; sincos_rad((float)posp[tok] * inv, s, c);
        const float o = lane < 32 ? x1 * c - x2 * s : x1 * s + x2 * c;
        if (!ATT_FP8) kp[128 + lane] = (bf16_t)(cvt_pk_bf16(o, 0.f) & 0xffffu);
#if ATT_FP8
        {
            unsigned char* k8 = WSP(unsigned char, WS_K8) + (size_t)tok * QKD;
            const unsigned ck = pk4_fp8(4.f * cv[0] * rstd * g0, 4.f * cv[1] * rstd * g1, 4.f * o, 0.f);
            *(unsigned short*)(k8 + 2 * lane) = (unsigned short)(ck & 0xffffu); k8[128 + lane] = (unsigned char)((ck >> 16) & 0xffu);
            const int key = tok & 63, c5 = key & 31, slot = 32 * ((c5 >> 2) & 1) + ((c5 & 3) + 4 * (c5 >> 3)) + 16 * (key >> 5);
            unsigned char* vt = WSP(unsigned char, WS_V8T) + (size_t)(tok >> 6) * 8192 + slot;
            vt[(2 * lane) * 64] = (unsigned char)(ck & 0xffu); vt[(2 * lane + 1) * 64] = (unsigned char)((ck >> 8) & 0xffu);
        }
#endif
    }
}
namespace att {
constexpr int SHM_V = 16384, SHM_K = 24576, OFF_V = 0, OFF_K = 2 * SHM_V, OFF_WS = OFF_K + 2 * SHM_K, OFF_Q = OFF_WS + 2048;
constexpr float THR = 24.0f;
#define KSWZ(row, colB) ((row) * 384 + ((colB) ^ ((((row) >> 1) & 7) << 4)))
#define SBAR() __builtin_amdgcn_sched_barrier(0)
__device__ __forceinline__ int crow(int r, int hi) { return (r & 3) + 8 * (r >> 2) + 4 * hi; }
__device__ __forceinline__ void partialSM(f32x16& p0, f32x16& p1, float& m_reg, float& mn, float& alpha) {
    float pmax = p0[0];
#pragma unroll
    for (int r = 1; r < 16; ++r) pmax = fmaxf(pmax, p0[r]);
#pragma unroll
    for (int r = 0; r < 16; ++r) pmax = fmaxf(pmax, p1[r]);
    { auto rr = __builtin_amdgcn_permlane32_swap(__float_as_uint(pmax), __float_as_uint(pmax), false, false); pmax = fmaxf(__uint_as_float(rr[0]), __uint_as_float(rr[1])); }
    if (__builtin_expect(__all(pmax - m_reg <= THR), 1)) { mn = m_reg; alpha = 1.f; }
    else { mn = fmaxf(m_reg, pmax); alpha = __builtin_amdgcn_exp2f(m_reg - mn); m_reg = mn; }
#pragma unroll
    for (int r = 0; r < 16; ++r) p0[r] = p0[r] - mn;
#pragma unroll
    for (int r = 0; r < 16; ++r) p1[r] = p1[r] - mn;
#pragma unroll
    for (int r = 0; r < 16; ++r) p0[r] = __builtin_amdgcn_exp2f(p0[r]);
}
__device__ __forceinline__ void finishSM(f32x16& p0, f32x16& p1, float alpha, float& l_reg, bf16x8& pa0, bf16x8& pa1, bf16x8& pa2, bf16x8& pa3) {
#pragma unroll
    for (int r = 0; r < 16; ++r) p1[r] = __builtin_amdgcn_exp2f(p1[r]);
    float ps = 0;
#pragma unroll
    for (int r = 0; r < 16; ++r) ps += p0[r];
#pragma unroll
    for (int r = 0; r < 16; ++r) ps += p1[r];
    { auto rr = __builtin_amdgcn_permlane32_swap(__float_as_uint(ps), __float_as_uint(ps), false, false); ps = __uint_as_float(rr[0]) + __uint_as_float(rr[1]); }
    l_reg = l_reg * alpha + ps;
#define PK4(P, BASE, OUT) do { unsigned a0 = cvt_pk_bf16(P[BASE + 0], P[BASE + 1]), a1 = cvt_pk_bf16(P[BASE + 2], P[BASE + 3]);   \
    unsigned b0 = cvt_pk_bf16(P[BASE + 4], P[BASE + 5]), b1 = cvt_pk_bf16(P[BASE + 6], P[BASE + 7]);                              \
    auto r0 = __builtin_amdgcn_permlane32_swap(a0, b0, false, false); auto r1 = __builtin_amdgcn_permlane32_swap(a1, b1, false, false); \
    u32x4 w = {r0[0], r1[0], r0[1], r1[1]}; OUT = *reinterpret_cast<bf16x8*>(&w); } while (0)
    PK4(p0, 0, pa0); PK4(p0, 8, pa1); PK4(p1, 0, pa2); PK4(p1, 8, pa3);
#undef PK4
}
template <int BUF> __device__ __forceinline__ void qkt(f32x16& p0, f32x16& p1, const LAS char* const (&kb4)[4], const bf16x8* qr, const LAS char* ql) {
    p0 = f32x16{}; p1 = f32x16{};
#pragma unroll
    for (int d0 = 0; d0 < 12; ++d0) {
        const bf16x8 b0 = *reinterpret_cast<const LAS bf16x8*>(kb4[d0 & 3] + BUF * SHM_K + (d0 >> 2) * 128);
        const bf16x8 b1 = *reinterpret_cast<const LAS bf16x8*>(kb4[d0 & 3] + BUF * SHM_K + (d0 >> 2) * 128 + 32 * 384);
        const bf16x8 qf = d0 < 8 ? qr[d0 < 8 ? d0 : 0] : *reinterpret_cast<const LAS bf16x8*>(ql + (d0 - 8) * 1024);
        p0 = __builtin_amdgcn_mfma_f32_32x32x16_bf16(b0, qf, p0, 0, 0, 0);
        p1 = __builtin_amdgcn_mfma_f32_32x32x16_bf16(b1, qf, p1, 0, 0, 0); }
}
__device__ __forceinline__ int v_st(int k, int c) { const int kk = (k & ~0xC) | ((k & 4) << 1) | ((k & 8) >> 1); return ((kk >> 3) * 4 + (c >> 5)) * 512 + ((kk & 7) * 32 + (c & 31)) * 2; }
__device__ __forceinline__ int v_rd_base(int lane) { return ((lane & 3) << 3) | (((lane >> 2) & 3) << 6) | (((lane >> 4) & 1) << 5) | (((lane >> 5) & 1) << 8); }
constexpr int v_rd_off(int d0, int ks, int half) { return d0 * 512 + ks * 4096 + half * 2048; }
template <int OFF> __device__ __forceinline__ s16x4 tr_read(int vb) { s16x4 r; asm volatile("ds_read_b64_tr_b16 %0, %1 offset:%2" : "=&v"(r) : "v"(vb), "i"(OFF) : "memory"); return r; }
template <int D0> __device__ __forceinline__ void pv_one(f32x16& od, int vb, bf16x8 pa0, bf16x8 pa1, bf16x8 pa2, bf16x8 pa3) {
    const s16x4 l0 = tr_read<v_rd_off(D0, 0, 0)>(vb), h0 = tr_read<v_rd_off(D0, 0, 1)>(vb), l1 = tr_read<v_rd_off(D0, 1, 0)>(vb), h1 = tr_read<v_rd_off(D0, 1, 1)>(vb);
    const s16x4 l2 = tr_read<v_rd_off(D0, 2, 0)>(vb), h2 = tr_read<v_rd_off(D0, 2, 1)>(vb), l3 = tr_read<v_rd_off(D0, 3, 0)>(vb), h3 = tr_read<v_rd_off(D0, 3, 1)>(vb);
    asm volatile("s_waitcnt lgkmcnt(0)" ::: "memory"); SBAR();
#define PK(L, H) (bf16x8){L[0], L[1], L[2], L[3], H[0], H[1], H[2], H[3]}
    od = __builtin_amdgcn_mfma_f32_32x32x16_bf16(pa0, PK(l0, h0), od, 0, 0, 0);
    od = __builtin_amdgcn_mfma_f32_32x32x16_bf16(pa1, PK(l1, h1), od, 0, 0, 0);
    od = __builtin_amdgcn_mfma_f32_32x32x16_bf16(pa2, PK(l2, h2), od, 0, 0, 0);
    od = __builtin_amdgcn_mfma_f32_32x32x16_bf16(pa3, PK(l3, h3), od, 0, 0, 0);
#undef PK
}
__device__ __forceinline__ void pv_d0(f32x16* o, int vb, bf16x8 pa0, bf16x8 pa1, bf16x8 pa2, bf16x8 pa3) {
    pv_one<0>(o[0], vb, pa0, pa1, pa2, pa3); pv_one<1>(o[1], vb, pa0, pa1, pa2, pa3); pv_one<2>(o[2], vb, pa0, pa1, pa2, pa3); pv_one<3>(o[3], vb, pa0, pa1, pa2, pa3);
}
template <bool O8> __device__ __forceinline__ void attn_unit(const bf16_t* __restrict__ Q, const bf16_t* __restrict__ Kp, bf16_t* __restrict__ O, int t0, int kbase, int nt_real, LAS char* lds, int wid) {
    int lane_ = lane_id(); asm volatile("" : "+v"(lane_));
    const int lane = lane_, tid = wid * 64 + lane, r32 = lane & 31, hi = lane >> 5;
    LAS char* V_lds = lds + OFF_V; LAS char* K_lds = lds + OFF_K;
    LAS float* ws = (LAS float*)(lds + OFF_WS) + wid * 64; LAS float* li_l = ws; LAS float* al_l = ws + 32;
    float m_reg = -1e30f, l_reg = 0; f32x16 o[4] = {}; bf16x8 qr[8];
    LAS char* qlds = lds + OFF_Q + wid * 4096 + lane * 16;
    const char* Qs = (const char*)Q + (size_t)t0 * 3072 + wid * (QKD * 2); const unsigned qlo = (unsigned)(r32 * 3072 + hi * 16);
#pragma unroll
    for (int d0 = 0; d0 < 8; ++d0) qr[d0] = *reinterpret_cast<const bf16x8*>(Qs + qlo + d0 * 32);
    __syncthreads();
#pragma unroll
    for (int d0 = 8; d0 < 12; ++d0) *reinterpret_cast<LAS bf16x8*>(qlds + (d0 - 8) * 1024) = *reinterpret_cast<const bf16x8*>(Qs + qlo + d0 * 32);
    const int vb0 = (int)(uintptr_t)V_lds + v_rd_base(lane);
    const LAS char* kb4[4];
#pragma unroll
    for (int q = 0; q < 4; ++q) kb4[q] = K_lds + r32 * 384 + ((q * 32 + hi * 16) ^ (((r32 >> 1) & 7) << 4));
    const int NT = (nt_real + 1) & ~1;
    const bool dummy = (NT != nt_real);
    bf16x8 sr_[1][3];
    const char* Kg = (const char*)(Kp + (size_t)kbase * QKD);
#define SLOAD(s, kt) do { _Pragma("unroll") for (int i = 0; i < 3; ++i) sr_[s][i] = *reinterpret_cast<const bf16x8*>(Kg + (size_t)(kt) * SHM_K + i * 8192 + (unsigned)(tid * 16)); } while (0)
#define SWRITE(b, s) do { int tl_ = lane_id(); asm volatile("" : "+v"(tl_)); tl_ += wid * 64; _Pragma("unroll") for (int i = 0; i < 3; ++i) { const int p_ = tl_ + 512 * i, row_ = p_ / 24, c16_ = p_ - row_ * 24; \
        *(LAS bf16x8*)(K_lds + (b) * SHM_K + KSWZ(row_, c16_ * 16)) = sr_[s][i]; if (c16_ < 16) *(LAS bf16x8*)(V_lds + (b) * SHM_V + v_st(row_, c16_ * 8)) = sr_[s][i]; } } while (0)
#define SWAIT() asm volatile("s_waitcnt vmcnt(0)" ::: "memory")
#define RESC(a) do { if (__any((a) < 1.f)) { if (hi == 0) al_l[r32] = (a); asm volatile("s_waitcnt lgkmcnt(0)" ::: "memory"); \
    _Pragma("unroll") for (int d = 0; d < 4; ++d) _Pragma("unroll") for (int r = 0; r < 16; ++r) o[d][r] *= al_l[crow(r, hi)]; } } while (0)
    f32x16 pA0, pA1, pB0, pB1; float mnA, mnB, alA, alB; bf16x8 pa0, pa1, pa2, pa3;
    SLOAD(0, 0); SWAIT(); SWRITE(0, 0); __syncthreads();
    qkt<0>(pA0, pA1, kb4, qr, qlds); partialSM(pA0, pA1, m_reg, mnA, alA);
    SLOAD(0, 1); SWAIT(); SWRITE(1, 0); __syncthreads();
    for (int j = 1; j + 1 < NT; j += 2) {
        SBAR(); qkt<1>(pB0, pB1, kb4, qr, qlds);
        finishSM(pA0, pA1, alA, l_reg, pa0, pa1, pa2, pa3); SBAR();
        SLOAD(0, j + 1); SBAR();
        pv_d0(o, vb0, pa0, pa1, pa2, pa3); partialSM(pB0, pB1, m_reg, mnB, alB);
        __syncthreads(); SWAIT(); SWRITE(0, 0);
        RESC(alB); __syncthreads();
        SBAR(); qkt<0>(pA0, pA1, kb4, qr, qlds);
        finishSM(pB0, pB1, alB, l_reg, pa0, pa1, pa2, pa3); SBAR();
        SLOAD(0, j + 2); SBAR();
        pv_d0(o, vb0 + SHM_V, pa0, pa1, pa2, pa3); partialSM(pA0, pA1, m_reg, mnA, alA);
        __syncthreads(); SWAIT(); SWRITE(1, 0);
        RESC(alA); __syncthreads();
    }
    SBAR(); qkt<1>(pB0, pB1, kb4, qr, qlds);
    if (dummy) {
#pragma unroll
        for (int r = 0; r < 16; ++r) { pB0[r] = -INFINITY; pB1[r] = -INFINITY; } }
    finishSM(pA0, pA1, alA, l_reg, pa0, pa1, pa2, pa3); SBAR();
    pv_d0(o, vb0, pa0, pa1, pa2, pa3); partialSM(pB0, pB1, m_reg, mnB, alB);
    __syncthreads(); RESC(alB);
    finishSM(pB0, pB1, alB, l_reg, pa0, pa1, pa2, pa3); SBAR();
    pv_d0(o, vb0 + SHM_V, pa0, pa1, pa2, pa3);
    {
        int lanee = lane_id(); asm volatile("" : "+v"(lanee));
        const int wide = wid, r32e = lanee & 31, hie = lanee >> 5;
        LAS float* lie = (LAS float*)(lds + OFF_WS) + wide * 64;
        if (hie == 0) lie[r32e] = l_reg; asm volatile("s_waitcnt lgkmcnt(0)" ::: "memory");
        char* Os = (char*)O + (size_t)t0 * (O8 ? 1024 : 2048) + wide * (O8 ? 128 : 256); const unsigned olo = (unsigned)(r32e * (O8 ? 1 : 2));
#pragma unroll
        for (int r = 0; r < 16; ++r) { const int orow = crow(r, hie); const float rl = __builtin_amdgcn_rcpf(lie[orow]);
#pragma unroll
            for (int d0 = 0; d0 < 4; ++d0) { if constexpr (O8) *(unsigned char*)(Os + olo + (unsigned)(orow * 1024) + d0 * 32) = (unsigned char)(pk4_fp8(16.0f * o[d0][r] * rl, 0.f, 0.f, 0.f) & 0xffu);
                else *(bf16_t*)(Os + olo + (unsigned)(orow * 2048) + d0 * 64) = (bf16_t)(cvt_pk_bf16(o[d0][r] * rl, 0.f) & 0xffffu); } }
    }
#undef SLOAD
#undef SWRITE
#undef SWAIT
#undef RESC
}
constexpr int SLOT = 24576, ROPE_OFF = 16384, NSLOT = 3, OFF_WS2 = NSLOT * SLOT, OFF_Q2 = OFF_WS2 + 2048;
__device__ __forceinline__ unsigned xrow(unsigned row) { return ((row & 3u) << 2) | ((row >> 2) & 3u); }
__device__ __forceinline__ void qkt2(f32x16& p0, f32x16& p1, const unsigned rb, const unsigned rr, const bf16x8* qr, const LAS char* ql) {
    p0 = f32x16{}; p1 = f32x16{};
#pragma unroll
    for (int d0 = 0; d0 < 12; ++d0) {
        const unsigned ad = d0 < 8 ? (rb ^ (unsigned)(d0 << 5)) : (rr ^ (unsigned)((d0 - 8) << 5));
        const bf16x8 b0 = *reinterpret_cast<const LAS bf16x8*>((LAS char*)(uintptr_t)ad);
        const bf16x8 b1 = *reinterpret_cast<const LAS bf16x8*>((LAS char*)(uintptr_t)(ad + (d0 < 8 ? 8192u : 4096u)));
        const bf16x8 qf = qr[d0]; (void)ql;
        p0 = __builtin_amdgcn_mfma_f32_32x32x16_bf16(b0, qf, p0, 0, 0, 0);
        p1 = __builtin_amdgcn_mfma_f32_32x32x16_bf16(b1, qf, p1, 0, 0, 0); }
}
__device__ __forceinline__ s16x4 tr_rd(unsigned ad) { s16x4 r; asm volatile("ds_read_b64_tr_b16 %0, %1" : "=&v"(r) : "v"(ad) : "memory"); return r; }
template <int KS> __device__ __forceinline__ s16x4 tr_rdo(unsigned ad) { s16x4 r; asm volatile("ds_read_b64_tr_b16 %0, %1 offset:%2" : "=&v"(r) : "v"(ad), "i"(KS * 4096) : "memory"); return r; }
struct VStep { s16x4 l[4], h[4]; };
template <int KS> __device__ __forceinline__ void pv_reads_ks(VStep& f, const unsigned bt0, const unsigned bt1) {
    f.l[0] = tr_rdo<KS>(bt0); f.h[0] = tr_rdo<KS>(bt1); f.l[1] = tr_rdo<KS>(bt0 ^ 64u); f.h[1] = tr_rdo<KS>(bt1 ^ 64u);
    f.l[2] = tr_rdo<KS>(bt0 ^ 128u); f.h[2] = tr_rdo<KS>(bt1 ^ 128u); f.l[3] = tr_rdo<KS>(bt0 ^ 192u); f.h[3] = tr_rdo<KS>(bt1 ^ 192u);
}
__device__ __forceinline__ void pv_mma_ks(f32x16* o, const VStep& f, bf16x8 pa) {
#define PK(L, H) (bf16x8){L[0], L[1], L[2], L[3], H[0], H[1], H[2], H[3]}
    o[0] = __builtin_amdgcn_mfma_f32_32x32x16_bf16(pa, PK(f.l[0], f.h[0]), o[0], 0, 0, 0);
    o[1] = __builtin_amdgcn_mfma_f32_32x32x16_bf16(pa, PK(f.l[1], f.h[1]), o[1], 0, 0, 0);
    o[2] = __builtin_amdgcn_mfma_f32_32x32x16_bf16(pa, PK(f.l[2], f.h[2]), o[2], 0, 0, 0);
    o[3] = __builtin_amdgcn_mfma_f32_32x32x16_bf16(pa, PK(f.l[3], f.h[3]), o[3], 0, 0, 0);
#undef PK
}
__device__ __forceinline__ void pv2(f32x16* o, const unsigned bt0, const unsigned bt1, bf16x8 pa0, bf16x8 pa1, bf16x8 pa2, bf16x8 pa3) {
    VStep fa, fb;
    pv_reads_ks<0>(fa, bt0, bt1);
    pv_reads_ks<1>(fb, bt0, bt1); asm volatile("s_waitcnt lgkmcnt(8)" ::: "memory"); SBAR(); pv_mma_ks(o, fa, pa0); SBAR();
    pv_reads_ks<2>(fa, bt0, bt1); asm volatile("s_waitcnt lgkmcnt(8)" ::: "memory"); SBAR(); pv_mma_ks(o, fb, pa1); SBAR();
    pv_reads_ks<3>(fb, bt0, bt1); asm volatile("s_waitcnt lgkmcnt(8)" ::: "memory"); SBAR(); pv_mma_ks(o, fa, pa2); SBAR();
    asm volatile("s_waitcnt lgkmcnt(0)" ::: "memory"); SBAR(); pv_mma_ks(o, fb, pa3);
}
template <bool O8> __device__ __forceinline__ void attn_unit2(const bf16_t* __restrict__ Q, const bf16_t* __restrict__ Kp, bf16_t* __restrict__ O, int t0, int kbase, int nt_real, LAS char* lds, int wid) {
    int lane_ = lane_id(); asm volatile("" : "+v"(lane_));
    const int lane = lane_, r32 = lane & 31, hi = lane >> 5;
    LAS float* ws = (LAS float*)(lds + OFF_WS2) + wid * 64; LAS float* al_l = ws + 32;
    float m_reg = -1e30f, l_reg = 0; f32x16 o[4] = {}; bf16x8 qr[12];
    LAS char* qlds = lds + OFF_Q2 + wid * 4096 + lane * 16;
    const char* Qs = (const char*)Q + (size_t)t0 * 3072 + wid * (QKD * 2); const unsigned qlo = (unsigned)(r32 * 3072 + hi * 16);
#pragma unroll
    for (int d0 = 0; d0 < 12; ++d0) qr[d0] = *reinterpret_cast<const bf16x8*>(Qs + qlo + d0 * 32);
    asm volatile("s_waitcnt vmcnt(0)" ::: "memory");
    __builtin_amdgcn_s_barrier(); asm volatile("" ::: "memory");
    const unsigned lds0 = (unsigned)(uintptr_t)lds;
    const unsigned rb0 = lds0 + 256u * r32 + 16u * ((unsigned)hi ^ xrow(r32));
    const unsigned rr0 = lds0 + ROPE_OFF + 128u * r32 + 16u * ((unsigned)hi ^ ((r32 >> 1) & 7u));
    const unsigned tq = (lane & 15) >> 2, tp = lane & 3, tblk = (lane >> 4) & 1;
    const unsigned bt00 = lds0 + 256u * (8u * hi + tq) + 64u * tq + 16u * ((2u * tblk + (tp >> 1)) ^ (2u * hi)) + 8u * (tp & 1);
    const unsigned bt10 = lds0 + 256u * (8u * hi + 4u + tq) + 64u * tq + 16u * ((2u * tblk + (tp >> 1)) ^ (2u * hi + 1u)) + 8u * (tp & 1);
    unsigned so[3];
    { const unsigned q0 = (unsigned)wid * 64u + lane, q1 = q0 + 512u; const unsigned r0 = q0 >> 4, r1 = q1 >> 4, r2 = q0 >> 3;
      so[0] = r0 * 384u + 16u * ((q0 & 15u) ^ xrow(r0)); so[1] = r1 * 384u + 16u * ((q1 & 15u) ^ xrow(r1)); so[2] = r2 * 384u + 256u + 16u * ((q0 & 7u) ^ ((r2 >> 1) & 7u)); }
    const char* Kg = (const char*)(Kp + (size_t)kbase * QKD);
    const int NT = (nt_real + 1) & ~1; const bool dummy = (NT != nt_real);
#define DMA(kt, sl) do { const char* tb_ = Kg + (size_t)(kt) * SLOT; LAS char* db_ = lds + (sl) + wid * 1024; \
        __builtin_amdgcn_global_load_lds((const unsigned*)(tb_ + so[0]), (LAS unsigned*)(db_), 16, 0, 0); \
        __builtin_amdgcn_global_load_lds((const unsigned*)(tb_ + so[1]), (LAS unsigned*)(db_ + 8192), 16, 0, 0); \
        __builtin_amdgcn_global_load_lds((const unsigned*)(tb_ + so[2]), (LAS unsigned*)(db_ + ROPE_OFF), 16, 0, 0); } while (0)
#define WAITBAR() do { asm volatile("s_waitcnt vmcnt(0) lgkmcnt(0)" ::: "memory"); __builtin_amdgcn_s_barrier(); asm volatile("" ::: "memory"); } while (0)
#define RESC(a) do { if (__any((a) < 1.f)) { if (hi == 0) al_l[r32] = (a); asm volatile("s_waitcnt lgkmcnt(0)" ::: "memory"); \
    _Pragma("unroll") for (int d = 0; d < 4; ++d) _Pragma("unroll") for (int r = 0; r < 16; ++r) o[d][r] *= al_l[crow(r, hi)]; } } while (0)
    f32x16 pA0, pA1, pB0, pB1; float mnA, mnB, alA, alB; bf16x8 pa0, pa1, pa2, pa3;
    int sc = 0, sn = SLOT, sp = 2 * SLOT;
#define ROT() do { const int t_ = sp; sp = sc; sc = sn; sn = t_; } while (0)
    DMA(0, 0);
    WAITBAR(); DMA(1, sn);
    qkt2(pA0, pA1, rb0 + sc, rr0 + sc, qr, qlds); partialSM(pA0, pA1, m_reg, mnA, alA);
    ROT();
#pragma unroll 1
    for (int j = 1; j + 1 < NT; j += 2) {
        WAITBAR(); DMA(j + 1, sn);
        SBAR(); qkt2(pB0, pB1, rb0 + sc, rr0 + sc, qr, qlds);
        finishSM(pA0, pA1, alA, l_reg, pa0, pa1, pa2, pa3); SBAR();
        pv2(o, bt00 + sp, bt10 + sp, pa0, pa1, pa2, pa3); partialSM(pB0, pB1, m_reg, mnB, alB);
        RESC(alB); ROT();
        WAITBAR(); DMA(j + 2, sn);
        SBAR(); qkt2(pA0, pA1, rb0 + sc, rr0 + sc, qr, qlds);
        finishSM(pB0, pB1, alB, l_reg, pa0, pa1, pa2, pa3); SBAR();
        pv2(o, bt00 + sp, bt10 + sp, pa0, pa1, pa2, pa3); partialSM(pA0, pA1, m_reg, mnA, alA);
        RESC(alA); ROT();
    }
    WAITBAR();
    SBAR(); qkt2(pB0, pB1, rb0 + sc, rr0 + sc, qr, qlds);
    if (dummy) {
#pragma unroll
        for (int r = 0; r < 16; ++r) { pB0[r] = -INFINITY; pB1[r] = -INFINITY; } }
    finishSM(pA0, pA1, alA, l_reg, pa0, pa1, pa2, pa3); SBAR();
    pv2(o, bt00 + sp, bt10 + sp, pa0, pa1, pa2, pa3); partialSM(pB0, pB1, m_reg, mnB, alB);
    RESC(alB);
    finishSM(pB0, pB1, alB, l_reg, pa0, pa1, pa2, pa3); SBAR();
    pv2(o, bt00 + sc, bt10 + sc, pa0, pa1, pa2, pa3);
    {
        int lanee = lane_id(); asm volatile("" : "+v"(lanee));
        const int wide = wid, r32e = lanee & 31, hie = lanee >> 5;
        LAS float* lie = (LAS float*)(lds + OFF_WS2) + wide * 64;
        if (hie == 0) lie[r32e] = l_reg; asm volatile("s_waitcnt lgkmcnt(0)" ::: "memory");
        char* Os = (char*)O + (size_t)t0 * (O8 ? 1024 : 2048) + wide * (O8 ? 128 : 256); const unsigned olo = (unsigned)(r32e * (O8 ? 1 : 2));
#pragma unroll
        for (int r = 0; r < 16; ++r) { const int orow = crow(r, hie); const float rl = __builtin_amdgcn_rcpf(lie[orow]);
#pragma unroll
            for (int d0 = 0; d0 < 4; ++d0) { if constexpr (O8) *(unsigned char*)(Os + olo + (unsigned)(orow * 1024) + d0 * 32) = (unsigned char)(pk4_fp8(16.0f * o[d0][r] * rl, 0.f, 0.f, 0.f) & 0xffu);
                else *(bf16_t*)(Os + olo + (unsigned)(orow * 2048) + d0 * 64) = (bf16_t)(cvt_pk_bf16(o[d0][r] * rl, 0.f) & 0xffffu); } }
    }
#undef DMA
#undef WAITBAR
#undef RESC
#undef ROT
}

constexpr int SLOT8 = 20480, V8_OFF = 12288, OFF_WS3 = 3 * SLOT8;
constexpr float THR8 = 12.0f;
typedef int i32x8_t __attribute__((ext_vector_type(8)));
typedef int i32x4_t __attribute__((ext_vector_type(4)));
__device__ __forceinline__ i32x8_t ld32(unsigned a0, unsigned a1) {
    const i32x4_t x = *reinterpret_cast<const LAS i32x4_t*>((LAS char*)(uintptr_t)a0), y = *reinterpret_cast<const LAS i32x4_t*>((LAS char*)(uintptr_t)a1);
    return __builtin_shufflevector(x, y, 0, 1, 2, 3, 4, 5, 6, 7);
}
#define MFMA8(A, B, Cc, SA, SB) __builtin_amdgcn_mfma_scale_f32_32x32x64_f8f6f4(A, B, Cc, 0, 0, 0, SA, 0, SB)
__device__ __forceinline__ void qkt3(f32x16& p0, f32x16& p1, const unsigned k0, const unsigned k1, const i32x8_t* qa) {
    p0 = f32x16{}; p1 = f32x16{};
#pragma unroll
    for (int m = 0; m < 3; ++m) {
        const i32x8_t a0 = ld32(k0 + 64 * m, k1 + 64 * m), a1 = ld32(k0 + 64 * m + 6144, k1 + 64 * m + 6144);
        p0 = MFMA8(a0, qa[m], p0, 0x7d7d7d7d, 0x7c7c7c7c); p1 = MFMA8(a1, qa[m], p1, 0x7d7d7d7d, 0x7c7c7c7c); }
}
__device__ __forceinline__ void partialSM8(f32x16& p0, f32x16& p1, float& m_reg, float& mn, float& alpha, int& esc) {
    float pmax = p0[0];
#pragma unroll
    for (int r = 1; r < 16; ++r) pmax = fmaxf(pmax, p0[r]);
#pragma unroll
    for (int r = 0; r < 16; ++r) pmax = fmaxf(pmax, p1[r]);
    { auto rr = __builtin_amdgcn_permlane32_swap(__float_as_uint(pmax), __float_as_uint(pmax), false, false); pmax = fmaxf(__uint_as_float(rr[0]), __uint_as_float(rr[1])); }
    if (__builtin_expect(__all(pmax - m_reg <= THR8), 1)) { mn = m_reg; alpha = 1.f; }
    else { mn = fmaxf(m_reg, pmax); alpha = __builtin_amdgcn_exp2f(m_reg - mn); m_reg = mn; }
    const float ef = fminf(fmaxf(__builtin_ceilf(pmax - mn), -60.0f), 60.0f);
    esc = (int)ef;
    const float mo = mn + ef - 8.0f;
#pragma unroll
    for (int r = 0; r < 16; ++r) p0[r] = p0[r] - mo;
#pragma unroll
    for (int r = 0; r < 16; ++r) p1[r] = p1[r] - mo;
#pragma unroll
    for (int r = 0; r < 16; ++r) p0[r] = __builtin_amdgcn_exp2f(p0[r]);
}
__device__ __forceinline__ void finishSM8(f32x16& p0, f32x16& p1, float alpha, float& l_reg, i32x8_t& pa, int esc) {
#pragma unroll
    for (int r = 0; r < 16; ++r) p1[r] = __builtin_amdgcn_exp2f(p1[r]);
    float ps = 0;
#pragma unroll
    for (int r = 0; r < 16; ++r) ps += p0[r];
#pragma unroll
    for (int r = 0; r < 16; ++r) ps += p1[r];
    { auto rr = __builtin_amdgcn_permlane32_swap(__float_as_uint(ps), __float_as_uint(ps), false, false); ps = __uint_as_float(rr[0]) + __uint_as_float(rr[1]); }
    l_reg = l_reg * alpha + __builtin_amdgcn_ldexpf(ps, esc);
    pa[0] = (int)pk4_fp8(p0[0], p0[1], p0[2], p0[3]); pa[1] = (int)pk4_fp8(p0[4], p0[5], p0[6], p0[7]); pa[2] = (int)pk4_fp8(p0[8], p0[9], p0[10], p0[11]); pa[3] = (int)pk4_fp8(p0[12], p0[13], p0[14], p0[15]);
    pa[4] = (int)pk4_fp8(p1[0], p1[1], p1[2], p1[3]); pa[5] = (int)pk4_fp8(p1[4], p1[5], p1[6], p1[7]); pa[6] = (int)pk4_fp8(p1[8], p1[9], p1[10], p1[11]); pa[7] = (int)pk4_fp8(p1[12], p1[13], p1[14], p1[15]);
}
__device__ __forceinline__ void pv3(f32x16* o, const unsigned v0, const unsigned v1, const i32x8_t pa, const int esc) {
    const int sa = (127 + esc) * 0x01010101;
    const i32x8_t b0 = ld32(v0, v1), b1 = ld32(v0 + 2048, v1 + 2048), b2 = ld32(v0 + 4096, v1 + 4096), b3 = ld32(v0 + 6144, v1 + 6144);
    o[0] = MFMA8(pa, b0, o[0], sa, 0x7d7d7d7d); o[1] = MFMA8(pa, b1, o[1], sa, 0x7d7d7d7d);
    o[2] = MFMA8(pa, b2, o[2], sa, 0x7d7d7d7d); o[3] = MFMA8(pa, b3, o[3], sa, 0x7d7d7d7d);
}
template <bool O8> __device__ __forceinline__ void attn_unit3(const unsigned char* __restrict__ Q8, const unsigned char* __restrict__ K8, const unsigned char* __restrict__ V8T, bf16_t* __restrict__ O, int t0, int kbase, int nt_real, LAS char* lds, int wid) {
    int lane_ = lane_id(); asm volatile("" : "+v"(lane_));
    const int lane = lane_, r32 = lane & 31, hi = lane >> 5;
    LAS float* ws = (LAS float*)(lds + OFF_WS3) + wid * 64; LAS float* al_l = ws + 32;
    float m_reg = -1e30f, l_reg = 0; f32x16 o[4] = {}; i32x8_t qa[3];
    { const char* Qs = (const char*)Q8 + (size_t)t0 * 1536 + wid * QKD; const unsigned qlo = (unsigned)(r32 * 1536 + hi * 32);
#pragma unroll
      for (int m = 0; m < 3; ++m) { const i32x4_t x = *reinterpret_cast<const i32x4_t*>(Qs + qlo + 64 * m), y = *reinterpret_cast<const i32x4_t*>(Qs + qlo + 64 * m + 16); qa[m] = __builtin_shufflevector(x, y, 0, 1, 2, 3, 4, 5, 6, 7); } }
    asm volatile("s_waitcnt vmcnt(0)" ::: "memory");
    __builtin_amdgcn_s_barrier(); asm volatile("" ::: "memory");
    const unsigned lds0 = (unsigned)(uintptr_t)lds, f = (unsigned)(r32 >> 2) & 3u;
    const unsigned ka0 = lds0 + 192u * r32 + 16u * ((2u * hi) ^ f), ka1 = lds0 + 192u * r32 + 16u * ((2u * hi + 1u) ^ f);
    const unsigned va0 = lds0 + V8_OFF + 64u * r32 + 16u * ((2u * hi) ^ f), va1 = lds0 + V8_OFF + 64u * r32 + 16u * ((2u * hi + 1u) ^ f);
    unsigned so[3];
    { const unsigned s0 = (unsigned)wid * 64u + lane, s1 = s0 + 512u; const unsigned r0 = s0 / 12u, c0 = s0 - r0 * 12u, r1 = s1 / 12u, c1 = s1 - r1 * 12u, dv = s0 >> 2, cv = s0 & 3u;
      so[0] = r0 * 192u + 16u * ((c0 & ~3u) | ((c0 & 3u) ^ ((r0 >> 2) & 3u))); so[1] = r1 * 192u + 16u * ((c1 & ~3u) | ((c1 & 3u) ^ ((r1 >> 2) & 3u))); so[2] = dv * 64u + 16u * (cv ^ ((dv >> 2) & 3u)); }
    const char* Kg = (const char*)K8 + (size_t)kbase * QKD; const char* Vg = (const char*)V8T + (size_t)(kbase >> 6) * 8192;
    const int NT = (nt_real + 1) & ~1; const bool dummy = (NT != nt_real);
#define DMA(kt, sl) do { const char* tk_ = Kg + (size_t)(kt) * 12288; const char* tv_ = Vg + (size_t)(kt) * 8192; LAS char* db_ = lds + (sl) + wid * 1024; \
        __builtin_amdgcn_global_load_lds((const unsigned*)(tk_ + so[0]), (LAS unsigned*)(db_), 16, 0, 0); \
        if (wid < 4) __builtin_amdgcn_global_load_lds((const unsigned*)(tk_ + so[1]), (LAS unsigned*)(db_ + 8192), 16, 0, 0); \
        __builtin_amdgcn_global_load_lds((const unsigned*)(tv_ + so[2]), (LAS unsigned*)(db_ + V8_OFF), 16, 0, 0); } while (0)
#define WAITBAR() do { asm volatile("s_waitcnt vmcnt(0) lgkmcnt(0)" ::: "memory"); __builtin_amdgcn_s_barrier(); asm volatile("" ::: "memory"); } while (0)
#define RESC(a) do { if (__any((a) < 1.f)) { if (hi == 0) al_l[r32] = (a); asm volatile("s_waitcnt lgkmcnt(0)" ::: "memory"); \
    _Pragma("unroll") for (int d = 0; d < 4; ++d) _Pragma("unroll") for (int r = 0; r < 16; ++r) o[d][r] *= al_l[crow(r, hi)]; } } while (0)
    f32x16 pA0, pA1, pB0, pB1; float mnA, mnB, alA, alB; i32x8_t pa; int eA = 0, eB = 0;
    int sc = 0, sn = SLOT8, sp = 2 * SLOT8;
#define ROT() do { const int t_ = sp; sp = sc; sc = sn; sn = t_; } while (0)
    DMA(0, 0);
    WAITBAR(); DMA(1, sn);
    qkt3(pA0, pA1, ka0 + sc, ka1 + sc, qa); partialSM8(pA0, pA1, m_reg, mnA, alA, eA);
    ROT();
#pragma unroll 1
    for (int j = 1; j + 1 < NT; j += 2) {
        WAITBAR(); DMA(j + 1, sn);
        SBAR(); qkt3(pB0, pB1, ka0 + sc, ka1 + sc, qa);
        finishSM8(pA0, pA1, alA, l_reg, pa, eA); SBAR();
        pv3(o, va0 + sp, va1 + sp, pa, eA); partialSM8(pB0, pB1, m_reg, mnB, alB, eB);
        RESC(alB); ROT();
        WAITBAR(); DMA(j + 2, sn);
        SBAR(); qkt3(pA0, pA1, ka0 + sc, ka1 + sc, qa);
        finishSM8(pB0, pB1, alB, l_reg, pa, eB); SBAR();
        pv3(o, va0 + sp, va1 + sp, pa, eB); partialSM8(pA0, pA1, m_reg, mnA, alA, eA);
        RESC(alA); ROT();
    }
    WAITBAR();
    SBAR(); qkt3(pB0, pB1, ka0 + sc, ka1 + sc, qa);
    if (dummy) {
#pragma unroll
        for (int r = 0; r < 16; ++r) { pB0[r] = -INFINITY; pB1[r] = -INFINITY; } }
    finishSM8(pA0, pA1, alA, l_reg, pa, eA); SBAR();
    pv3(o, va0 + sp, va1 + sp, pa, eA); partialSM8(pB0, pB1, m_reg, mnB, alB, eB);
    RESC(alB);
    finishSM8(pB0, pB1, alB, l_reg, pa, eB); SBAR();
    pv3(o, va0 + sc, va1 + sc, pa, eB);
    {   int lanee = lane_id(); asm volatile("" : "+v"(lanee));
        const int wide = wid, r32e = lanee & 31, hie = lanee >> 5;
        LAS float* lie = (LAS float*)(lds + OFF_WS3) + wide * 64;
        if (hie == 0) lie[r32e] = l_reg; asm volatile("s_waitcnt lgkmcnt(0)" ::: "memory");
        char* Os = (char*)O + (size_t)t0 * (O8 ? 1024 : 2048) + wide * (O8 ? 128 : 256); const unsigned olo = (unsigned)(r32e * (O8 ? 1 : 2));
#pragma unroll
        for (int r = 0; r < 16; ++r) { const int orow = crow(r, hie); const float rl = __builtin_amdgcn_rcpf(lie[orow]);
#pragma unroll
            for (int d0 = 0; d0 < 4; ++d0) { if constexpr (O8) *(unsigned char*)(Os + olo + (unsigned)(orow * 1024) + d0 * 32) = (unsigned char)(pk4_fp8(16.0f * o[d0][r] * rl, 0.f, 0.f, 0.f) & 0xffu);
                else *(bf16_t*)(Os + olo + (unsigned)(orow * 2048) + d0 * 64) = (bf16_t)(cvt_pk_bf16(o[d0][r] * rl, 0.f) & 0xffffu); } }
    }
#undef DMA
#undef WAITBAR
#undef RESC
#undef ROT
}


typedef float f32x4_t __attribute__((ext_vector_type(4)));
typedef short s16x2_t __attribute__((ext_vector_type(2)));
__device__ __forceinline__ void partialSM9(f32x16& p0, f32x16& p1, float& m_reg, float& mn, float& alpha, int& esc) {
    float pmax = p0[0];
#pragma unroll
    for (int r = 1; r < 16; ++r) pmax = fmaxf(pmax, p0[r]);
#pragma unroll
    for (int r = 0; r < 16; ++r) pmax = fmaxf(pmax, p1[r]);
    { auto rr = __builtin_amdgcn_permlane32_swap(__float_as_uint(pmax), __float_as_uint(pmax), false, false); pmax = fmaxf(__uint_as_float(rr[0]), __uint_as_float(rr[1])); }
    if (__builtin_expect(__all(pmax - m_reg <= THR8), 1)) { mn = m_reg; alpha = 1.f; }
    else { mn = fmaxf(m_reg, pmax); alpha = __builtin_amdgcn_exp2f(m_reg - mn); m_reg = mn; }
    float ef = fminf(fmaxf(__builtin_ceilf(pmax - mn), -60.0f), 60.0f);
    { auto rr = __builtin_amdgcn_permlane16_swap(__float_as_uint(ef), __float_as_uint(ef), false, false); ef = fmaxf(__uint_as_float(rr[0]), __uint_as_float(rr[1])); }
    esc = (int)ef;
    const float mo = mn + ef - 8.0f;
#pragma unroll
    for (int r = 0; r < 16; ++r) p0[r] = p0[r] - mo;
#pragma unroll
    for (int r = 0; r < 16; ++r) p1[r] = p1[r] - mo;
#pragma unroll
    for (int r = 0; r < 16; ++r) p0[r] = __builtin_amdgcn_exp2f(p0[r]);
}
__device__ __forceinline__ unsigned pk4_fp8t(float a, float b, float c2, float d) { int w = __builtin_amdgcn_cvt_pk_fp8_f32(a, b, __float_as_int(a), false); return (unsigned)__builtin_amdgcn_cvt_pk_fp8_f32(c2, d, w, true); }
__device__ __forceinline__ void finishSM9(f32x16& p0, f32x16& p1, i32x8_t& pa) {
#pragma unroll
    for (int r = 0; r < 16; ++r) p1[r] = __builtin_amdgcn_exp2f(p1[r]);
    pa[0] = (int)pk4_fp8t(p0[0], p0[1], p0[2], p0[3]); pa[1] = (int)pk4_fp8t(p0[4], p0[5], p0[6], p0[7]); pa[2] = (int)pk4_fp8t(p0[8], p0[9], p0[10], p0[11]); pa[3] = (int)pk4_fp8t(p0[12], p0[13], p0[14], p0[15]);
    pa[4] = (int)pk4_fp8t(p1[0], p1[1], p1[2], p1[3]); pa[5] = (int)pk4_fp8t(p1[4], p1[5], p1[6], p1[7]); pa[6] = (int)pk4_fp8t(p1[8], p1[9], p1[10], p1[11]); pa[7] = (int)pk4_fp8t(p1[12], p1[13], p1[14], p1[15]);
}
__device__ __forceinline__ void pv4(f32x16* o, f32x4_t& lacc, const i32x8_t selb, const unsigned v0, const unsigned v1, const i32x8_t pa, const int esc) {
    const int sa = (127 + esc) * 0x01010101;
    const i32x8_t b0 = ld32(v0, v1), b1 = ld32(v0 + 2048, v1 + 2048), b2 = ld32(v0 + 4096, v1 + 4096), b3 = ld32(v0 + 6144, v1 + 6144);
    o[0] = MFMA8(pa, b0, o[0], sa, 0x7d7d7d7d); o[1] = MFMA8(pa, b1, o[1], sa, 0x7d7d7d7d);
    o[2] = MFMA8(pa, b2, o[2], sa, 0x7d7d7d7d); o[3] = MFMA8(pa, b3, o[3], sa, 0x7d7d7d7d);
    lacc = __builtin_amdgcn_mfma_scale_f32_16x16x128_f8f6f4(pa, selb, lacc, 0, 0, 0, sa, 0, 0x7f7f7f7f);
}
template <bool O8> __device__ __forceinline__ void attn_unit5(const unsigned char* __restrict__ Q8, const unsigned char* __restrict__ K8, const unsigned char* __restrict__ V8T, bf16_t* __restrict__ O, int t0, int kbase, int nt_real, LAS char* lds, int wid) {
    int lane_ = lane_id(); asm volatile("" : "+v"(lane_));
    const int lane = lane_, r32 = lane & 31, hi = lane >> 5;
    LAS float* ws = (LAS float*)(lds + OFF_WS3) + wid * 64; LAS float* al_l = ws + 32;
    float m_reg = -1e30f; f32x16 o[4] = {}; i32x8_t qa[3];
    f32x4_t lacc = {0.f, 0.f, 0.f, 0.f}; const int selv = ((lane & 15) < 2 && (((lane >> 4) ^ lane) & 1) == 0) ? 0x38383838 : 0; const i32x8_t selb = {selv, selv, selv, selv, selv, selv, selv, selv};
    const int lrow = (lane & 1) * 16 + 4 * (lane >> 4);
    { const char* Qs = (const char*)Q8 + (size_t)t0 * 1536 + wid * QKD; const unsigned qlo = (unsigned)(r32 * 1536 + hi * 32);
#pragma unroll
      for (int m = 0; m < 3; ++m) { const i32x4_t x = *reinterpret_cast<const i32x4_t*>(Qs + qlo + 64 * m), y = *reinterpret_cast<const i32x4_t*>(Qs + qlo + 64 * m + 16); qa[m] = __builtin_shufflevector(x, y, 0, 1, 2, 3, 4, 5, 6, 7); } }
    asm volatile("s_waitcnt vmcnt(0)" ::: "memory");
    __builtin_amdgcn_s_barrier(); asm volatile("" ::: "memory");
    const unsigned lds0 = (unsigned)(uintptr_t)lds, f = (unsigned)(r32 >> 2) & 3u;
    const unsigned ka0 = lds0 + 192u * r32 + 16u * ((2u * hi) ^ f), ka1 = lds0 + 192u * r32 + 16u * ((2u * hi + 1u) ^ f);
    const unsigned va0 = lds0 + V8_OFF + 64u * r32 + 16u * ((2u * hi) ^ f), va1 = lds0 + V8_OFF + 64u * r32 + 16u * ((2u * hi + 1u) ^ f);
    unsigned so[3];
    { const unsigned s0 = (unsigned)wid * 64u + lane, s1 = s0 + 512u; const unsigned r0 = s0 / 12u, c0 = s0 - r0 * 12u, r1 = s1 / 12u, c1 = s1 - r1 * 12u, dv = s0 >> 2, cv = s0 & 3u;
      so[0] = r0 * 192u + 16u * ((c0 & ~3u) | ((c0 & 3u) ^ ((r0 >> 2) & 3u))); so[1] = r1 * 192u + 16u * ((c1 & ~3u) | ((c1 & 3u) ^ ((r1 >> 2) & 3u))); so[2] = dv * 64u + 16u * (cv ^ ((dv >> 2) & 3u)); }
    const char* Kg = (const char*)K8 + (size_t)kbase * QKD; const char* Vg = (const char*)V8T + (size_t)(kbase >> 6) * 8192;
    const int NT = (nt_real + 1) & ~1; const bool dummy = (NT != nt_real);
#define DMA(kt, sl) do { const char* tk_ = Kg + (size_t)(kt) * 12288; const char* tv_ = Vg + (size_t)(kt) * 8192; LAS char* db_ = lds + (sl) + wid * 1024; \
        __builtin_amdgcn_global_load_lds((const unsigned*)(tk_ + so[0]), (LAS unsigned*)(db_), 16, 0, 0); \
        if (wid < 4) __builtin_amdgcn_global_load_lds((const unsigned*)(tk_ + so[1]), (LAS unsigned*)(db_ + 8192), 16, 0, 0); \
        __builtin_amdgcn_global_load_lds((const unsigned*)(tv_ + so[2]), (LAS unsigned*)(db_ + V8_OFF), 16, 0, 0); } while (0)
#define WAITBAR() do { asm volatile("s_waitcnt vmcnt(0) lgkmcnt(0)" ::: "memory"); __builtin_amdgcn_s_barrier(); asm volatile("" ::: "memory"); } while (0)
#define RESC(a) do { if (__any((a) < 1.f)) { if (hi == 0) al_l[r32] = (a); asm volatile("s_waitcnt lgkmcnt(0)" ::: "memory"); \
    _Pragma("unroll") for (int d = 0; d < 4; ++d) _Pragma("unroll") for (int r = 0; r < 16; ++r) o[d][r] *= al_l[crow(r, hi)]; \
    _Pragma("unroll") for (int r = 0; r < 4; ++r) lacc[r] *= al_l[lrow + r]; } } while (0)
    f32x16 pA0, pA1, pB0, pB1; float mnA, mnB, alA, alB; i32x8_t pa; int eA = 0, eB = 0;
    int sc = 0, sn = SLOT8, sp = 2 * SLOT8;
#define ROT() do { const int t_ = sp; sp = sc; sc = sn; sn = t_; } while (0)
    DMA(0, 0);
    WAITBAR(); DMA(1, sn);
    qkt3(pA0, pA1, ka0 + sc, ka1 + sc, qa); partialSM9(pA0, pA1, m_reg, mnA, alA, eA);
    ROT();
#pragma unroll 1
    for (int j = 1; j + 1 < NT; j += 2) {
        WAITBAR(); DMA(j + 1, sn);
        SBAR(); qkt3(pB0, pB1, ka0 + sc, ka1 + sc, qa);
        finishSM9(pA0, pA1, pa); SBAR();
        pv4(o, lacc, selb, va0 + sp, va1 + sp, pa, eA); partialSM9(pB0, pB1, m_reg, mnB, alB, eB);
        RESC(alB); ROT();
        WAITBAR(); DMA(j + 2, sn);
        SBAR(); qkt3(pA0, pA1, ka0 + sc, ka1 + sc, qa);
        finishSM9(pB0, pB1, pa); SBAR();
        pv4(o, lacc, selb, va0 + sp, va1 + sp, pa, eB); partialSM9(pA0, pA1, m_reg, mnA, alA, eA);
        RESC(alA); ROT();
    }
    WAITBAR();
    SBAR(); qkt3(pB0, pB1, ka0 + sc, ka1 + sc, qa);
    if (dummy) {
#pragma unroll
        for (int r = 0; r < 16; ++r) { pB0[r] = -INFINITY; pB1[r] = -INFINITY; } }
    finishSM9(pA0, pA1, pa); SBAR();
    pv4(o, lacc, selb, va0 + sp, va1 + sp, pa, eA); partialSM9(pB0, pB1, m_reg, mnB, alB, eB);
    RESC(alB);
    finishSM9(pB0, pB1, pa); SBAR();
    pv4(o, lacc, selb, va0 + sc, va1 + sc, pa, eB);
    {   int lanee = lane_id(); asm volatile("" : "+v"(lanee));
        const int wide = wid, r32e = lanee & 31, hie = lanee >> 5;
        LAS float* lie = (LAS float*)(lds + OFF_WS3) + wide * 64;
        if ((lanee & 15) < 2) {
#pragma unroll
            for (int r = 0; r < 4; ++r) lie[(lanee & 1) * 16 + 4 * (lanee >> 4) + r] = lacc[r]; }
        asm volatile("s_waitcnt lgkmcnt(0)" ::: "memory");
        char* Os = (char*)O + (size_t)t0 * (O8 ? 1024 : 2048) + wide * (O8 ? 128 : 256); const unsigned olo = (unsigned)(r32e * (O8 ? 1 : 2));
#pragma unroll
        for (int r = 0; r < 16; ++r) { const int orow = crow(r, hie); const float rl = __builtin_amdgcn_rcpf(lie[orow]);
#pragma unroll
            for (int d0 = 0; d0 < 4; ++d0) { if constexpr (O8) *(unsigned char*)(Os + olo + (unsigned)(orow * 1024) + d0 * 32) = (unsigned char)(pk4_fp8(16.0f * o[d0][r] * rl, 0.f, 0.f, 0.f) & 0xffu);
                else *(bf16_t*)(Os + olo + (unsigned)(orow * 2048) + d0 * 64) = (bf16_t)(cvt_pk_bf16(o[d0][r] * rl, 0.f) & 0xffffu); } }
    }
#undef DMA
#undef WAITBAR
#undef RESC
#undef ROT
}

template <bool O8> __device__ __forceinline__ void attn_unit4(const unsigned char* __restrict__ Q8, const unsigned char* __restrict__ K8, const unsigned char* __restrict__ V8T, bf16_t* __restrict__ O, int t0, int kbase, int NT, LAS char* lds, int wid) {
    int lane_ = lane_id(); asm volatile("" : "+v"(lane_));
    const int lane = lane_, r32 = lane & 31, hi = lane >> 5; const bool trailing = wid >= 4;
    constexpr int OFF_WS4 = 4 * SLOT8;
    LAS float* ws = (LAS float*)(lds + OFF_WS4) + wid * 64; LAS float* al_l = ws + 32;
    float m_reg = -1e30f, l_reg = 0; f32x16 o[4] = {}; i32x8_t qa[3];
    { const char* Qs = (const char*)Q8 + (size_t)t0 * 1536 + wid * QKD; const unsigned qlo = (unsigned)(r32 * 1536 + hi * 32);
#pragma unroll
      for (int m = 0; m < 3; ++m) { const i32x4_t x = *reinterpret_cast<const i32x4_t*>(Qs + qlo + 64 * m), y = *reinterpret_cast<const i32x4_t*>(Qs + qlo + 64 * m + 16); qa[m] = __builtin_shufflevector(x, y, 0, 1, 2, 3, 4, 5, 6, 7); } }
    asm volatile("s_waitcnt vmcnt(0)" ::: "memory");
    __builtin_amdgcn_s_barrier(); asm volatile("" ::: "memory");
    const unsigned lds0 = (unsigned)(uintptr_t)lds, f = (unsigned)(r32 >> 2) & 3u;
    const unsigned ka0 = lds0 + 192u * r32 + 16u * ((2u * hi) ^ f), ka1 = lds0 + 192u * r32 + 16u * ((2u * hi + 1u) ^ f);
    const unsigned va0 = lds0 + V8_OFF + 64u * r32 + 16u * ((2u * hi) ^ f), va1 = lds0 + V8_OFF + 64u * r32 + 16u * ((2u * hi + 1u) ^ f);
    unsigned so[3];
    { const unsigned s0 = (unsigned)wid * 64u + lane, s1 = s0 + 512u; const unsigned r0 = s0 / 12u, c0 = s0 - r0 * 12u, r1 = s1 / 12u, c1 = s1 - r1 * 12u, dv = s0 >> 2, cv = s0 & 3u;
      so[0] = r0 * 192u + 16u * ((c0 & ~3u) | ((c0 & 3u) ^ ((r0 >> 2) & 3u))); so[1] = r1 * 192u + 16u * ((c1 & ~3u) | ((c1 & 3u) ^ ((r1 >> 2) & 3u))); so[2] = dv * 64u + 16u * (cv ^ ((dv >> 2) & 3u)); }
    const char* Kg = (const char*)K8 + (size_t)kbase * QKD; const char* Vg = (const char*)V8T + (size_t)(kbase >> 6) * 8192;
#define DMA(kt) do { const char* tk_ = Kg + (size_t)(kt) * 12288; const char* tv_ = Vg + (size_t)(kt) * 8192; LAS char* db_ = lds + ((kt) & 3) * SLOT8 + wid * 1024; \
        __builtin_amdgcn_global_load_lds((const unsigned*)(tk_ + so[0]), (LAS unsigned*)(db_), 16, 0, 0); \
        if (wid < 4) __builtin_amdgcn_global_load_lds((const unsigned*)(tk_ + so[1]), (LAS unsigned*)(db_ + 8192), 16, 0, 0); \
        __builtin_amdgcn_global_load_lds((const unsigned*)(tv_ + so[2]), (LAS unsigned*)(db_ + V8_OFF), 16, 0, 0); } while (0)
#define WAITT(younger) do { if (younger) { if (wid < 4) asm volatile("s_waitcnt vmcnt(3)" ::: "memory"); else asm volatile("s_waitcnt vmcnt(2)" ::: "memory"); } else asm volatile("s_waitcnt vmcnt(0)" ::: "memory"); } while (0)
#define BAR() do { asm volatile("s_waitcnt lgkmcnt(0)" ::: "memory"); __builtin_amdgcn_s_barrier(); asm volatile("" ::: "memory"); } while (0)
#define RESC(a) do { if (__any((a) < 1.f)) { if (hi == 0) al_l[r32] = (a); asm volatile("s_waitcnt lgkmcnt(0)" ::: "memory"); \
    _Pragma("unroll") for (int d = 0; d < 4; ++d) _Pragma("unroll") for (int r = 0; r < 16; ++r) o[d][r] *= al_l[crow(r, hi)]; } } while (0)
    f32x16 p0, p1; float mn, al; i32x8_t pa = {0, 0, 0, 0, 0, 0, 0, 0}; int esc = 0;
    DMA(0); if (1 < NT) DMA(1);
    if (trailing) { WAITT(1 < NT); BAR(); if (2 < NT) DMA(2); }
#pragma unroll 1
    for (int t = 0; t <= NT; ++t) {
        if (!trailing) { if (t < NT) WAITT(t + 1 < NT); }
        BAR();
        if (!trailing) { if (t + 2 < NT) DMA(t + 2); }
        SBAR();
        if (t >= 1) pv3(o, va0 + ((t - 1) & 3) * SLOT8, va1 + ((t - 1) & 3) * SLOT8, pa, esc);
        if (t == NT) break;
        qkt3(p0, p1, ka0 + (t & 3) * SLOT8, ka1 + (t & 3) * SLOT8, qa);
        SBAR();
        if (trailing) { if (t + 1 < NT) WAITT(t + 2 < NT); }
        BAR();
        if (trailing) { if (t + 3 < NT) DMA(t + 3); }
        partialSM8(p0, p1, m_reg, mn, al, esc);
        RESC(al);
        finishSM8(p0, p1, al, l_reg, pa, esc);
        SBAR();
    }
    if (!trailing) BAR();
    {   int lanee = lane_id(); asm volatile("" : "+v"(lanee));
        const int wide = wid, r32e = lanee & 31, hie = lanee >> 5;
        LAS float* lie = (LAS float*)(lds + OFF_WS4) + wide * 64;
        if (hie == 0) lie[r32e] = l_reg; asm volatile("s_waitcnt lgkmcnt(0)" ::: "memory");
        char* Os = (char*)O + (size_t)t0 * (O8 ? 1024 : 2048) + wide * (O8 ? 128 : 256); const unsigned olo = (unsigned)(r32e * (O8 ? 1 : 2));
#pragma unroll
        for (int r = 0; r < 16; ++r) { const int orow = crow(r, hie); const float rl = __builtin_amdgcn_rcpf(lie[orow]);
#pragma unroll
            for (int d0 = 0; d0 < 4; ++d0) { if constexpr (O8) *(unsigned char*)(Os + olo + (unsigned)(orow * 1024) + d0 * 32) = (unsigned char)(pk4_fp8(16.0f * o[d0][r] * rl, 0.f, 0.f, 0.f) & 0xffu);
                else *(bf16_t*)(Os + olo + (unsigned)(orow * 2048) + d0 * 64) = (bf16_t)(cvt_pk_bf16(o[d0][r] * rl, 0.f) & 0xffffu); } }
    }
#undef DMA
#undef WAITT
#undef BAR
#undef RESC
}
}
struct Args { const void* in[25]; float* out; unsigned char* ws; int lo, hi, l, hf; };
enum { PH_PRO = 0, PH_NA, PH_R2, PH_R3, PH_R4, PH_R5, PH_R6, PH_R7, PH_M2, PH_M3, PH_M4, PH_M5, PH_NB, PH_MOE1, PH_MOE2, PH_COUNT };

__device__ __forceinline__ void make_ctx(Ctx& C, unsigned char* lds_raw) {
    C.ka = (kaptr_t)__builtin_amdgcn_kernarg_segment_ptr(); C.lds = (LAS unsigned char*)lds_raw;
    C.wave = __builtin_amdgcn_readfirstlane((int)threadIdx.x >> 6);
    { const int bx = blockIdx.x; C.vcu = (bx & 7) * (GRID / 8) + (bx >> 3); }
}

template <int PH> __device__ __forceinline__ void run_phase(Ctx& C, const int l, const int hf, const int rep = 0) {
    PHASE_ENTRY(); const int wv = wave;
    LAS unsigned char* lds = ldsb; int bid_ = blockIdx.x; asm volatile("" : "+s"(bid_)); const int bid = bid_; const unsigned LD1K = 2048u;
    const float* gate1 = rep ? (const float*)(WSB + WS_CTL + 512 * 1024) : WSP(float, WS_MOD) + (size_t)l * 4 * 6144 + 2 * 1024;
    const bf16_t* win = WSP(bf16_t, WS_WIN) + (size_t)(l & 1) * 6144 * 1024;
    const bf16_t* xnh = WSP(bf16_t, WS_XN) + (size_t)hf * THALF * DM;
    const int j = l & 1;
    if constexpr (PH == PH_PRO) phase_prologue(C);
    if constexpr (PH == PH_NA) phase_norm_a(C, l, rep);
    if constexpr (PH == PH_R2) {
        constexpr bool FQ = (FP8_R2 & 1) != 0, FV = (FP8_R2 & 2) != 0;
        const char* X16 = (const char*)xnh; const char* X8 = (const char*)(WSP(unsigned char, WS_XN8) + (size_t)hf * THALF * DM);
        const char* W16 = (const char*)win; const char* W8 = (const char*)(WSP(unsigned char, WS_WIN8) + (size_t)(l & 1) * 6144 * 1024);
        { constexpr unsigned LD = FQ ? 1024u : 2048u; constexpr int KP = FQ ? 512 : 1024; constexpr int SW = FQ ? 0x79797979 : 0x7f7f7f7f, SX = FQ ? 0x7d7d7d7d : 0x7f7f7f7f; const char* X = FQ ? X8 : X16; const char* W = FQ ? W8 : W16;
          { SchedStd S; S.T.init(64, 4, GRID, bid); S.A = X; S.B = W; S.sA = 256 * LD; S.sB = 256 * LD;
            EpiRopeQK<0> E{WSP(bf16_t, WS_A2), INI(2), hf, nullptr}; pg8::gemm_phase<EpiRopeQK<0>, SchedStd, false, FQ, SW, SX>(lds, wv, KP, LD, LD, S, E); }
          { SchedStd S; S.T.init(64, 4, GRID, bid); S.A = X; S.B = W + (size_t)1024 * LD; S.sA = 256 * LD; S.sB = 256 * LD;
            EpiRopeQK<1> E{WSP(bf16_t, WS_KR), INI(2), hf, WSP(bf16_t, WS_KT)}; pg8::gemm_phase<EpiRopeQK<1>, SchedStd, false, FQ, SW, SX>(lds, wv, KP, LD, LD, S, E); } }
        { constexpr unsigned LD = FV ? 1024u : 2048u; constexpr int KP = FV ? 512 : 1024; constexpr int SW = FV ? 0x79797979 : 0x7f7f7f7f, SX = FV ? 0x7d7d7d7d : 0x7f7f7f7f; const char* X = FV ? X8 : X16; const char* W = FV ? W8 : W16;
          SchedStd S; S.T.init(8, 64, GRID, bid); S.A = W + (size_t)2048 * LD; S.B = X; S.sA = 256 * LD; S.sB = 256 * LD;
          EpiVT E{WSP(bf16_t, WS_B2T)}; pg8::gemm_phase<EpiVT, SchedStd, false, FV, SW, SX>(lds, wv, KP, LD, LD, S, E); }
    }
    if constexpr (PH == PH_R3) {
        { SchedBatch S{(const char*)WSP(bf16_t, WS_A2), (const char*)WSP(bf16_t, WS_KR), 256 * 1024, 256 * 512, 0, 0, 256, 1, GRID, vcu};
          EpiS E{WSP(bf16_t, WS_A2)}; pg8::gemm_phase<EpiS, SchedBatch, false>(lds, wv, 256, 1024u, 512u, S, E); }
        { SchedBatch S{(const char*)(WSP(bf16_t, WS_B2T) + 256), (const char*)WSP(bf16_t, WS_KT), 512 * 1024, 256 * 512, 256 * 1024, 0, 256, 2, GRID, vcu};
          EpiKV E{WSP(bf16_t, WS_B2T)}; pg8::gemm_phase<EpiKV, SchedBatch, false>(lds, wv, 256, 1024u, 512u, S, E); }
    }
    if constexpr (PH == PH_R4) phase_prefix(C, rep);
    if constexpr (PH == PH_R5) {
        SchedBatch S{(const char*)WSP(bf16_t, WS_A2), (const char*)WSP(bf16_t, WS_B2T), 256 * 1024, 512 * 1024, 0, 256 * 1024, 256, 2, GRID, vcu};
        EpiFin E{WSP(bf16_t, WS_B2T), WSP(float, WS_STATS), rep}; pg8::gemm_phase<EpiFin, SchedBatch, false>(lds, wv, 512, 1024u, 1024u, S, E);
    }
    if constexpr (PH == PH_R6) {
        constexpr bool F8 = FP8_R6 != 0; constexpr unsigned LD = F8 ? 1024u : 2048u; constexpr int KP = F8 ? 512 : 1024; constexpr int SW = F8 ? 0x79797979 : 0x7f7f7f7f, SX = F8 ? 0x7d7d7d7d : 0x7f7f7f7f;
        const char* X = F8 ? (const char*)(WSP(unsigned char, WS_XN8) + (size_t)hf * THALF * DM) : (const char*)xnh;
        const char* W = F8 ? (const char*)(WSP(unsigned char, WS_WIN8) + (size_t)(l & 1) * 6144 * 1024) : (const char*)win;
        SchedStd S; S.T.init(64, 8, GRID, bid); S.A = X; S.B = W + (size_t)4096 * LD; S.sA = 256 * LD; S.sB = 256 * LD;
        EpiGate<FP8_R7 != 0> E{WSP(bf16_t, WS_B2T), WSP(float, WS_STATS), WSP(bf16_t, WS_A2), WSP(unsigned char, WS_ACT8)}; pg8::gemm_phase<EpiGate<FP8_R7 != 0>, SchedStd, false, F8, SW, SX>(lds, wv, KP, LD, LD, S, E);
    }
    if constexpr (PH == PH_R7) {
        constexpr bool F8 = FP8_R7 != 0; constexpr unsigned LD = F8 ? 2048u : 4096u; constexpr int KP = F8 ? 1024 : 2048; constexpr int SW = F8 ? 0x79797979 : 0x7f7f7f7f, SX = F8 ? 0x7d7d7d7d : 0x7f7f7f7f;
        SchedStd S; S.T.init(64, 4, GRID, bid); S.A = F8 ? (const char*)WSP(unsigned char, WS_ACT8) : (const char*)WSP(bf16_t, WS_A2);
        S.B = F8 ? (const char*)(WSP(unsigned char, WS_WOUT8) + (size_t)l * 1024 * 2048) : (const char*)(WSP(bf16_t, WS_WOUT) + (size_t)l * 1024 * 2048); S.sA = 256 * LD; S.sB = 256 * LD;
        EpiResid E{WSP(bf16_t, WS_H16), gate1, hf * THALF, (l == 0 && !rep) ? INF(0) : (const float*)nullptr}; pg8::gemm_phase<EpiResid, SchedStd, false, F8, SW, SX>(lds, wv, KP, LD, LD, S, E);
    }
    if constexpr (PH == PH_M2) {
        { constexpr bool F8 = FP8_M2 != 0; constexpr unsigned LD = F8 ? 1024u : 2048u; constexpr int KP = F8 ? 512 : 1024; constexpr int SW = F8 ? 0x79797979 : 0x7f7f7f7f, SX = F8 ? 0x7d7d7d7d : 0x7f7f7f7f;
          SchedStd S; S.T.init(128, 1, GRID, bid); S.A = F8 ? (const char*)WSP(unsigned char, WS_XN8) : (const char*)WSP(bf16_t, WS_XN);
          S.B = F8 ? (const char*)(WSP(unsigned char, WS_WQA8) + (size_t)j * 256 * 1024) : (const char*)(WSP(bf16_t, WS_WQA) + (size_t)j * 256 * 1024); S.sA = 256 * LD; S.sB = 256 * LD;
          EpiQA E{WSP(bf16_t, WS_QA), WSP(float, WS_SSQ), FP8_M3 ? WSP(unsigned char, WS_QA8) : (unsigned char*)nullptr}; pg8::gemm_phase<EpiQA, SchedStd, false, F8, SW, SX>(lds, wv, KP, LD, LD, S, E); }
        if (l == 2) { SchedStd S; S.T.init(128, 1, GRID, (bid + 128) & 255); S.A = (const char*)WSP(bf16_t, WS_HN); S.B = (const char*)WSP(bf16_t, WS_WKVA); S.sA = 256 * 2048; S.sB = 256 * 2048;
          EpiF32 E{WSP(float, WS_AKV)}; pg8::gemm_phase<EpiF32, SchedStd, false>(lds, wv, 1024, LD1K, LD1K, S, E); }
    }
    if constexpr (PH == PH_M3) {
        if (l == 2) phase_kvfin(C);
        constexpr bool F8 = FP8_M3 != 0; constexpr unsigned LD = F8 ? 256u : 512u; constexpr int KP = F8 ? 128 : 256; constexpr int SW = F8 ? 0x79797979 : 0x7f7f7f7f, SX = F8 ? 0x7d7d7d7d : 0x7f7f7f7f;
        SchedStd S; S.T.init(128, 6, GRID, bid); S.A = F8 ? (const char*)WSP(unsigned char, WS_QA8) : (const char*)WSP(bf16_t, WS_QA);
        S.B = F8 ? (const char*)(WSP(unsigned char, WS_WQB8) + (size_t)j * 1536 * 256) : (const char*)(WSP(bf16_t, WS_WQB) + (size_t)j * 1536 * 256); S.sA = 256 * LD; S.sB = 256 * LD;
        EpiQB<ATT_FP8 != 0> E{WSP(bf16_t, WS_Q), WSP(float, WS_SSQ), INI(2)}; pg8::gemm_phase<EpiQB<ATT_FP8 != 0>, SchedStd, false, F8, SW, SX>(lds, wv, KP, LD, LD, S, E);
    }
    if constexpr (PH == PH_M4) {
        const int b = vcu >> 6, i = vcu & 63;
#pragma unroll 1
        for (int uq = 0; uq < 4; ++uq) { const int cch = (uq < 2) ? (127 - i) : i, half = uq & 1;
            if constexpr (ATT_FP8 != 0) att::attn_unit5<FP8_M5 != 0>(WSP(unsigned char, WS_Q), WSP(unsigned char, WS_K8), WSP(unsigned char, WS_V8T), FP8_M5 ? (bf16_t*)WSP(unsigned char, WS_ACT8) : WSP(bf16_t, WS_OL), b * SEQ + cch * 64 + half * 32, b * SEQ, cch + 1, (LAS char*)lds, wave);
            else att::attn_unit2<FP8_M5 != 0>(WSP(bf16_t, WS_Q), WSP(bf16_t, WS_KP), FP8_M5 ? (bf16_t*)WSP(unsigned char, WS_ACT8) : WSP(bf16_t, WS_OL), b * SEQ + cch * 64 + half * 32, b * SEQ, cch + 1, (LAS char*)lds, wave); }
        __syncthreads();
    }
    if constexpr (PH == PH_M5) {
        constexpr bool F8 = FP8_M5 != 0; constexpr unsigned LD = F8 ? 1024u : 2048u; constexpr int KP = F8 ? 512 : 1024; constexpr int SW = F8 ? 0x79797979 : 0x7f7f7f7f, SX = F8 ? 0x7b7b7b7b : 0x7f7f7f7f;
        SchedStd S; S.T.init(128, 4, GRID, bid); S.A = F8 ? (const char*)WSP(unsigned char, WS_ACT8) : (const char*)WSP(bf16_t, WS_OL);
        S.B = F8 ? (const char*)(WSP(unsigned char, WS_WO8) + (size_t)j * 1024 * 1024) : (const char*)(WSP(bf16_t, WS_WO) + (size_t)j * 1024 * 1024); S.sA = 256 * LD; S.sB = 256 * LD;
        EpiResid E{WSP(bf16_t, WS_H16), gate1, 0, (const float*)nullptr}; pg8::gemm_phase<EpiResid, SchedStd, false, F8, SW, SX>(lds, wv, KP, LD, LD, S, E);
    }
    if constexpr (PH == PH_NB) phase_norm_b(C, l, rep);
    if constexpr (PH == PH_MOE1) {
        moe_tile_prefix(C, l);
        SchedMoE S{(const LAS int*)(lds + LDS_TAB), (const char*)WSP(unsigned char, WS_XN), (const char*)(WSP(unsigned char, WS_WGU) + (size_t)l * 16 * 1024 * 1024), (size_t)1024 * 1024, (size_t)256 * 1024, 0, WSP(int, WS_IDX), GRID, vcu, true};
        EpiGU8 E{WSP(unsigned char, WS_HDN)}; pg8::gemm_phase<EpiGU8, SchedMoE, true, true, 0x79797979, 0x7d7d7d7d>(lds, wv, 512, 1024u, 1024u, S, E);
        if (l < 3 && !rep) moe_convert_tail(C, l + 1, 0, 8192);
    }
    if constexpr (PH == PH_MOE2) {
        moe_tile_prefix(C, l);
        SchedMoE S{(const LAS int*)(lds + LDS_TAB), (const char*)WSP(unsigned char, WS_HDN), (const char*)(WSP(unsigned char, WS_WDN) + (size_t)l * 16 * 1024 * 512), (size_t)1024 * 512, (size_t)256 * 512, (size_t)256 * 512, WSP(int, WS_IDX), GRID, vcu, false};
        EpiPlain8 E{WSP(unsigned char, WS_YB), 1024}; pg8::gemm_phase<EpiPlain8, SchedMoE, false, true, 0x79797979, (int)0x81818181u>(lds, wv, 256, 512u, 512u, S, E);
        if (l < 3 && !rep) moe_convert_tail(C, l + 1, 8192, 16 * 768);
    }
}

template <int PH> __global__ void __launch_bounds__(NTHREADS, 2) phase_kernel(Args args) {
    extern __shared__ __attribute__((aligned(16))) unsigned char lds_raw[];
    Ctx C; make_ctx(C, lds_raw); (void)args;
    run_phase<PH>(C, args.l, args.hf);
}
__global__ void __launch_bounds__(NTHREADS, 2) fwd_kernel(Args args) {
    extern __shared__ __attribute__((aligned(16))) unsigned char lds_raw[];
    Ctx C; make_ctx(C, lds_raw); (void)args;
    if (threadIdx.x < 64) ((LAS unsigned*)(C.lds + LDS_MISC))[threadIdx.x] = 0u;
    __syncthreads();
    XcdBarrier bar = xcd_barrier_post((unsigned*)((unsigned char*)args.ws + WS_CTL) + CW_BAR, (volatile LAS unsigned*)(C.lds + LDS_MISC));
#ifndef TS_KIND
#define TS_KIND 0
#define TS_BLK 0
#define TS_DIV 25.0f
#endif
    unsigned long long ts_acc = 0, ts_t0 = 0; (void)ts_acc; (void)ts_t0;
#if TS_KIND == 1
#define SEAM() do { const unsigned long long a_ = __builtin_amdgcn_s_memrealtime(); xcd_barrier(bar, C.wave); ts_acc += __builtin_amdgcn_s_memrealtime() - a_; } while (0)
#else
#define SEAM() xcd_barrier(bar, C.wave)
#endif
#ifndef PROBE_PH
#define PROBE_PH -1
#define PROBE_N 0
#endif
#define RUNP(PH, l, hf) do { if (TS_KIND == 100 + PH) ts_t0 = __builtin_amdgcn_s_memrealtime(); run_phase<PH>(C, l, hf); if (TS_KIND == 100 + PH) ts_acc += __builtin_amdgcn_s_memrealtime() - ts_t0; if (TS_KIND == 200 + PH) ts_t0 = __builtin_amdgcn_s_memrealtime(); SEAM(); if (TS_KIND == 200 + PH) ts_acc += __builtin_amdgcn_s_memrealtime() - ts_t0; if constexpr (PH == PROBE_PH) { _Pragma("unroll 1") for (int rp_ = 0; rp_ < PROBE_N; ++rp_) { run_phase<PH>(C, l, hf, 1); SEAM(); } } } while (0)
    RUNP(PH_PRO, 0, 0);
    for (int l = 0; l < 4; ++l) {
        RUNP(PH_NA, l, 0);
        if (l < 2) {
            for (int hf = 0; hf < 2; ++hf) { RUNP(PH_R2, l, hf); RUNP(PH_R3, l, hf); RUNP(PH_R4, l, hf); RUNP(PH_R5, l, hf); RUNP(PH_R6, l, hf); RUNP(PH_R7, l, hf); }
        } else { RUNP(PH_M2, l, 0); RUNP(PH_M3, l, 0); RUNP(PH_M4, l, 0); RUNP(PH_M5, l, 0); }
        RUNP(PH_NB, l, 0); RUNP(PH_MOE1, l, 0); RUNP(PH_MOE2, l, 0);
    }
    run_phase<PH_NA>(C, 4, 0);
#if TS_KIND != 0
    __syncthreads();
    if ((int)blockIdx.x == TS_BLK && threadIdx.x == 0) { args.out[TS_BLK == 0 ? 0 : 1] = 3.0f + floorf((float)ts_acc * (0.01f / TS_DIV)); }
    if (TS_BLK != 0 && (int)blockIdx.x == TS_BLK) (void)0;
#endif
#undef RUNP
#undef SEAM
}

template <int PH> static void launch_phase(Args& a, int l, int hf, hipStream_t stream) {
    static bool attr = false;
    if (!attr) { (void)hipFuncSetAttribute((const void*)phase_kernel<PH>, hipFuncAttributeMaxDynamicSharedMemorySize, LDS_BYTES); attr = true; }
    a.l = l; a.hf = hf;
    hipLaunchKernelGGL(phase_kernel<PH>, dim3(GRID), dim3(NTHREADS), LDS_BYTES, stream, a);
}
extern "C" void kernel_launch(void* const* d_in, const int* in_sizes, int n_in, void* d_out, int out_size, void* d_ws, size_t ws_size, hipStream_t stream) {
    static int ok = 0;
    if (ok == 0) {
        if (n_in != 25 || out_size != NTOK * DM || ws_size < WS_END) { fprintf(stderr, "kernel_launch: unexpected problem (n_in %d, out %d, ws %zu < %zu)\n", n_in, out_size, ws_size, (size_t)WS_END); ok = -1; return; }
        int dev = 0, cus = 0;
        if (hipGetDevice(&dev) != hipSuccess || hipDeviceGetAttribute(&cus, hipDeviceAttributeMultiprocessorCount, dev) != hipSuccess || cus < GRID) { fprintf(stderr, "kernel_launch: needs %d CUs, device has %d\n", GRID, cus); ok = -1; return; }
        ok = 1;
    }
    if (ok < 0) return;
    (void)hipMemsetAsync((char*)d_ws + WS_CTL, 0, CTL_BYTES, stream);
    Args a{};
    for (int i = 0; i < 25; ++i) a.in[i] = d_in[i];
    a.out = (float*)d_out; a.ws = (unsigned char*)d_ws; a.lo = 0; a.hi = 0;
#if MK_SINGLE
    static bool attr = false;
    if (!attr) { (void)hipFuncSetAttribute((const void*)fwd_kernel, hipFuncAttributeMaxDynamicSharedMemorySize, LDS_BYTES); attr = true; }
    hipLaunchKernelGGL(fwd_kernel, dim3(GRID), dim3(NTHREADS), LDS_BYTES, stream, a);
    return;
#endif
    launch_phase<PH_PRO>(a, 0, 0, stream);
    for (int l = 0; l < 4; ++l) {
        launch_phase<PH_NA>(a, l, 0, stream);
        if (l < 2) {
            for (int hf = 0; hf < 2; ++hf) {
                launch_phase<PH_R2>(a, l, hf, stream); launch_phase<PH_R3>(a, l, hf, stream); launch_phase<PH_R4>(a, l, hf, stream);
                launch_phase<PH_R5>(a, l, hf, stream); launch_phase<PH_R6>(a, l, hf, stream); launch_phase<PH_R7>(a, l, hf, stream);
            }
        } else {
            launch_phase<PH_M2>(a, l, 0, stream); launch_phase<PH_M3>(a, l, 0, stream); launch_phase<PH_M4>(a, l, 0, stream); launch_phase<PH_M5>(a, l, 0, stream);
        }
        launch_phase<PH_NB>(a, l, 0, stream); launch_phase<PH_MOE1>(a, l, 0, stream); launch_phase<PH_MOE2>(a, l, 0, stream);
    }
    launch_phase<PH_NA>(a, 4, 0, stream);
}
```

```cpp
#include <hip/hip_runtime.h>
#include <cstdio>
#include <cstdint>

#ifndef MK_SINGLE
#define MK_SINGLE 1
#endif
#ifndef FP8_R2
#define FP8_R2 3
#define FP8_R6 1
#define FP8_R7 1
#define FP8_M2 1
#define FP8_M5 1
#define FP8_M3 1
#endif
#ifndef ATT_FP8
#define ATT_FP8 1
#endif
#ifndef MK_CHECK
#define MK_CHECK 0
#endif

#define GAS __attribute__((address_space(1)))
#define LAS __attribute__((address_space(3)))
typedef unsigned short bf16_t;
typedef short bf16x8 __attribute__((ext_vector_type(8)));
typedef short s16x4 __attribute__((ext_vector_type(4)));
typedef float f32x4 __attribute__((ext_vector_type(4)));
typedef float f32x2 __attribute__((ext_vector_type(2)));
typedef float f32x16 __attribute__((ext_vector_type(16)));
typedef unsigned u32x4 __attribute__((ext_vector_type(4)));
typedef unsigned u32x2 __attribute__((ext_vector_type(2)));

constexpr int NB = 4, SEQ = 8192, DM = 1024, NTOK = NB * SEQ, THALF = NTOK / 2;
constexpr int NEXP = 16, DEXP = 512;
constexpr int RH = 4, RDK = 256, RDV = 512, RV = 2048;
constexpr int MH = 8, QLORA = 256, KVL = 128, ROPE = 64, QKD = 192;
constexpr float EPS = 1e-6f;
constexpr int NWAVES = 8, NTHREADS = 512, GRID = 256;
constexpr int MAXSLOTS = 69632;

constexpr size_t MiB = 1u << 20;
constexpr size_t WS_CTL = 0, CTL_BYTES = 1 * MiB;
constexpr size_t WS_MOD = 1 * MiB;
constexpr size_t WS_ROUTE = 2 * MiB;
constexpr size_t WS_SSQ = 3 * MiB;
constexpr size_t WS_STATS = 4 * MiB;
constexpr size_t WS_IDX = 8 * MiB;
constexpr size_t WS_WIN = 10 * MiB;
constexpr size_t WS_WOUT = 34 * MiB;
constexpr size_t WS_WQA = 42 * MiB;
constexpr size_t WS_WKVA = 43 * MiB;
constexpr size_t WS_WQB = 44 * MiB;
constexpr size_t WS_WO = 46 * MiB;
constexpr size_t WS_WGU = 50 * MiB;
constexpr size_t WS_WDN = 178 * MiB;
constexpr size_t WS_XN = 242 * MiB;
constexpr size_t WS_L = 306 * MiB;
constexpr size_t WS_END = 690 * MiB;
constexpr size_t WS_A2 = WS_L, WS_KR = WS_L + 64 * MiB, WS_KT = WS_L + 96 * MiB, WS_B2T = WS_L + 128 * MiB;
constexpr size_t WS_HDN = WS_L, WS_YB = WS_L + 68 * MiB;
constexpr size_t WS_HN = WS_L, WS_QA = WS_L + 64 * MiB, WS_AKV = WS_L + 80 * MiB, WS_Q = WS_L + 112 * MiB, WS_OL = WS_L + 208 * MiB, WS_KP = WS_L + 300 * MiB;
constexpr size_t WS_XN8 = 114 * MiB;
constexpr size_t WS_WIN8 = 146 * MiB;
constexpr size_t WS_WOUT8 = 158 * MiB;
constexpr size_t WS_WQA8 = 162 * MiB;
constexpr size_t WS_WO8 = 163 * MiB;
constexpr size_t WS_QA8 = WS_L + 160 * MiB;
constexpr size_t WS_WQB8 = 46 * MiB;
static_assert(!FP8_M3 || (FP8_M5 && ATT_FP8), "the fp8 q_b buffers overlay regions that are free only with fp8 w_o and fp8 Q");
constexpr size_t WS_ACT8 = 210 * MiB;
constexpr size_t WS_K8 = WS_L + 300 * MiB, WS_V8T = WS_L + 306 * MiB;
constexpr size_t WS_H16 = WS_L + 320 * MiB;
constexpr int CW_BAR = 4096;
constexpr int CW_CNT = 16384;
constexpr int CW_CHK = 32768;

constexpr int LDS_STAGE = 131072;
constexpr int LDS_MISC = LDS_STAGE;
constexpr int LDS_TAB = LDS_STAGE + 256;
constexpr int LDS_BYTES = 147456;

#define LDS_WAIT() asm volatile("s_waitcnt lgkmcnt(0)" ::: "memory")
#define VM_WAIT() asm volatile("s_waitcnt vmcnt(0)" ::: "memory")
__device__ __forceinline__ unsigned cvt_pk_bf16(float lo, float hi) { unsigned r; asm volatile("v_cvt_pk_bf16_f32 %0, %1, %2" : "=v"(r) : "v"(lo), "v"(hi)); return r; }
__device__ __forceinline__ unsigned pk4_fp8(float a, float b, float c2, float d) { int w = __builtin_amdgcn_cvt_pk_fp8_f32(a, b, 0, false); return (unsigned)__builtin_amdgcn_cvt_pk_fp8_f32(c2, d, w, true); }
__device__ __forceinline__ f32x4 bf4_to_f32(u32x2 w) { return (f32x4){__uint_as_float(w.x << 16), __uint_as_float(w.x & 0xffff0000u), __uint_as_float(w.y << 16), __uint_as_float(w.y & 0xffff0000u)}; }
__device__ __forceinline__ float bf2f(unsigned short b) { return __uint_as_float((unsigned)b << 16); }
__device__ __forceinline__ float bflo(unsigned w) { return __uint_as_float(w << 16); }
__device__ __forceinline__ float bfhi(unsigned w) { return __uint_as_float(w & 0xffff0000u); }
template <int CTRL> __device__ __forceinline__ float dpp_f(float v) { return __int_as_float(__builtin_amdgcn_mov_dpp(__float_as_int(v), CTRL, 0xf, 0xf, true)); }
__device__ __forceinline__ float rows_sum(float v) {
    { auto t = __builtin_amdgcn_permlane16_swap(__float_as_uint(v), __float_as_uint(v), false, false); v = __uint_as_float(t[0]) + __uint_as_float(t[1]); }
    { auto t = __builtin_amdgcn_permlane32_swap(__float_as_uint(v), __float_as_uint(v), false, false); v = __uint_as_float(t[0]) + __uint_as_float(t[1]); }
    return v;
}
__device__ __forceinline__ float wave_sum(float v) {
    v += dpp_f<0xB1>(v);
    v += dpp_f<0x4E>(v);
    v += dpp_f<0x141>(v);
    v += dpp_f<0x140>(v);
    return rows_sum(v);
}
__device__ __forceinline__ void sincos_rad(float ang, float& s, float& c) {
    float r = __builtin_amdgcn_fractf(ang * 0.15915494309189535f);
    s = __builtin_amdgcn_sinf(r); c = __builtin_amdgcn_cosf(r);
}
__device__ __forceinline__ float silu_f(float x) { return x * __builtin_amdgcn_rcpf(1.0f + __builtin_amdgcn_exp2f(-1.4426950408889634f * x)); }
__device__ __forceinline__ float log2_gamma(int h) { return h == 0 ? -0.04580368961312479f : (h == 1 ? -0.02272007650008353f : (h == 2 ? -0.011315313227834146f : -0.005646563141142063f)); }
constexpr float LOG2_THETA = 13.287712379549449f;

__device__ __forceinline__ int lane_id() { int r; asm volatile("v_mbcnt_lo_u32_b32 %0, -1, 0\n\tv_mbcnt_hi_u32_b32 %0, -1, %0" : "=v"(r)); return r; }
#define XB_TMO      128
#define XB_XCNT(j)  (256  + 64 * (j))
#define XB_XSUB(j)  (1280 + 64 * (j))
#define XB_XGEN(j)  (2304 + 64 * (j))
#define XB_TOP      3328
#define XB_TOPGEN   3392
#define XCD_BAR_WORDS 3456
#define XB_SPIN_CAP (1u << 18)
__device__ __forceinline__ unsigned xb_ld(unsigned* p)              { return __hip_atomic_load(p, __ATOMIC_RELAXED, __HIP_MEMORY_SCOPE_AGENT); }
__device__ __forceinline__ unsigned xb_add(unsigned* p, unsigned v) { return __hip_atomic_fetch_add(p, v, __ATOMIC_RELAXED, __HIP_MEMORY_SCOPE_AGENT); }
__device__ __forceinline__ unsigned xb_xcc_id() { return (unsigned)__builtin_amdgcn_s_getreg((3 << 11) | 20) & 0xFu; }
#define XB_SPIN(cond, bar) do { unsigned _sp = 0; while (cond) { __builtin_amdgcn_s_sleep(1); \
    if ((++_sp & 255u) == 0u) { if (xb_ld(&(bar)[XB_TMO])) break; if (_sp > XB_SPIN_CAP) { atomicAdd(&(bar)[XB_TMO], 1u); break; } } } } while (0)
struct XcdBarrier { unsigned* bar; unsigned x; volatile LAS unsigned* st; };
__device__ __forceinline__ XcdBarrier xcd_barrier_post(unsigned* bar, volatile LAS unsigned* st) {
    XcdBarrier b; b.bar = bar; b.x = xb_xcc_id(); b.st = st;
    if (threadIdx.x == 0) (void)xb_add(&bar[XB_XCNT(b.x)], 1u);
    return b;
}
__device__ __forceinline__ void xcd_barrier_complete(unsigned* bar, unsigned x, unsigned& nloc, unsigned& nx) {
    const unsigned G = gridDim.x * gridDim.y * gridDim.z;
    unsigned sum, cnt, mine, sp = 0u;
    for (;;) {
        sum = 0u; cnt = 0u; mine = 0u;
#pragma unroll
        for (unsigned j = 0; j < 16; ++j) { const unsigned c = xb_ld(&bar[XB_XCNT(j)]); sum += c; cnt += (c > 0u) ? 1u : 0u; mine = (j == x) ? c : mine; }
        if (sum == G) break;
        __builtin_amdgcn_s_sleep(1);
        if ((++sp & 255u) == 0u) { if (xb_ld(&bar[XB_TMO])) break; if (sp > XB_SPIN_CAP) { atomicAdd(&bar[XB_TMO], 1u); break; } }
    }
    nloc = mine > 0u ? mine : 1u; nx = cnt > 0u ? cnt : 1u;
}
__device__ __forceinline__ void xcd_barrier(const XcdBarrier& b, const int wave) {
    asm volatile("s_waitcnt vmcnt(0)" ::: "memory");
    __syncthreads();
    if (wave == 0 && lane_id() == 0) {
        unsigned* bar = b.bar; unsigned bx = b.x; asm volatile("" : "+s"(bar), "+s"(bx));
        __builtin_amdgcn_s_waitcnt(0);
        unsigned nloc = b.st[0], nx = b.st[1];
        if (nloc == 0u) { xcd_barrier_complete(bar, bx, nloc, nx); b.st[0] = nloc; b.st[1] = nx; }
        const unsigned old = xb_add(&bar[XB_XSUB(bx)], 1u);
        const unsigned gen = old / nloc;
        if (old + 1u == (gen + 1u) * nloc) {
            __builtin_amdgcn_fence(__ATOMIC_RELEASE, "agent");
            asm volatile("s_waitcnt vmcnt(0)" ::: "memory");
            const unsigned og = xb_add(&bar[XB_TOP], 1u);
            const unsigned tg = og / nx;
            if (og + 1u == (tg + 1u) * nx) xb_add(&bar[XB_TOPGEN], 1u);
            else XB_SPIN(xb_ld(&bar[XB_TOPGEN]) == tg, bar);
            __builtin_amdgcn_fence(__ATOMIC_ACQUIRE, "agent");
            xb_add(&bar[XB_XGEN(bx)], 1u);
            asm volatile("s_waitcnt vmcnt(0)" ::: "memory");
        } else {
            XB_SPIN(xb_ld(&bar[XB_XGEN(bx)]) == gen, bar);
            __builtin_amdgcn_fence(__ATOMIC_ACQUIRE, "agent");
            asm volatile("s_waitcnt vmcnt(0)" ::: "memory");
        }
    }
    __syncthreads();
}

namespace pg8 {
constexpr int BM = 256, BK = 64, HALF = 128, HTB = HALF * BK * 2, STAGE_BYTES = 8 * HTB;
__host__ __device__ __forceinline__ int lds_byte(int r, int c) { const int st = (r >> 4) * 2 + (c >> 5), rr = r & 15, cc = c & 31, ob = rr * 64 + cc * 2; return st * 1024 + (ob ^ (((ob >> 9) & 1) << 5)); }
__host__ __device__ __forceinline__ void stage_rc(int b, int& R, int& C) { const int st = b / 1024, sb = b % 1024, swz = sb ^ (((sb >> 9) & 1) << 5); R = (st >> 1) * 16 + swz / 64; C = (st & 1) * 32 + (swz % 64) / 2; }
__host__ __device__ __forceinline__ int perm32(int rho) { const int n = rho >> 4, i = rho & 15; return 8 * (i >> 2) + 4 * n + (i & 3); }

struct Unit { const char* A; const char* B; int pm, pn, aux; };

struct TileOrder {
    int nM, nN, nwg, G, c;
    __device__ void init(int nM_, int nN_, int G_, int c_) { nM = nM_; nN = nN_; nwg = nM * nN; G = G_; c = c_; }
    __device__ bool tile(int i, int& pm, int& pn) const {
        const long L = (long)i * G + c; if (L >= nwg) return false;
        int wgid = (int)L; { const int q = nwg / 8, r = nwg % 8, xcd = wgid % 8, off = wgid / 8; wgid = (xcd < r ? xcd * (q + 1) : r * (q + 1) + (xcd - r) * q) + off; }
        const int nig = 8 * nN, gid = wgid / nig, fm = gid * 8, gsz = (nM - fm) < 8 ? (nM - fm) : 8;
        pm = fm + ((wgid % nig) % gsz); pn = (wgid % nig) / gsz; return true;
    }
};

typedef int i32x8 __attribute__((ext_vector_type(8)));
typedef int i32x4 __attribute__((ext_vector_type(4)));
__device__ __forceinline__ i32x8 cat8(bf16x8 lo, bf16x8 hi) { const i32x4 a = __builtin_bit_cast(i32x4, lo), b = __builtin_bit_cast(i32x4, hi); return __builtin_shufflevector(a, b, 0, 1, 2, 3, 4, 5, 6, 7); }
template <class Epi, class Sched, bool GATHER, bool FP8 = false, int SCW = 0x7f7f7f7f, int SCX = 0x7f7f7f7f>
__device__ __forceinline__ void gemm_phase(LAS unsigned char* lds, const int wid, const int K, const unsigned lda, const unsigned ldb, const Sched& S, const Epi& E) {
    int lane_ = lane_id(); asm volatile("" : "+v"(lane_));
    const int lane = lane_, tid = wid * 64 + lane, wr = wid >> 2, wc = wid & 3, fr = lane & 15, fq = lane >> 4;
    const int nt = K / BK;
    const bool kp2_ = (nt & (nt - 1)) == 0;
    const int rotk = kp2_ ? (int)(__builtin_amdgcn_workgroup_id_x() * 5u + (__builtin_amdgcn_workgroup_id_x() >> 3)) & (nt - 1) : 0;
#define PG8_KT(x) ((size_t)(kp2_ ? (((x) + rotk) & (nt - 1)) : (x)) * kstep)
    unsigned voffA[2], voffB[2]; int RA[2], CA[2];
#pragma unroll
    for (int i = 0; i < 2; ++i) { int R, C; stage_rc(tid * 16 + i * 8192, R, C); const int Rb = Epi::PERM ? ((R & ~31) + perm32(R & 31)) : R;
        RA[i] = R; CA[i] = C; voffA[i] = (unsigned)R * lda + (unsigned)C * 2u; voffB[i] = (unsigned)Rb * ldb + (unsigned)C * 2u; }
    const size_t kstep = (size_t)(BK * 2);
    const size_t hstepA = (size_t)HALF * lda, hstepB = (size_t)HALF * ldb;
    const unsigned ldsw = (unsigned)wid * 1024u;
    const int aoff = lds_byte(wr * 64 + fr, fq * 8), boff = lds_byte(wc * 32 + fr, fq * 8);
#define PG8_SA(b, h) (((b) * 2 + (h)) * HTB)
#define PG8_SB(b, h) ((4 + (b) * 2 + (h)) * HTB)
#define PG8_GLDS(gp, bufoff, i) __builtin_amdgcn_global_load_lds((const unsigned*)(gp), (LAS unsigned*)(lds + (bufoff) + ldsw + (i) * 8192), 16, 0, 0)
#define PG8_STAGE_B(bufoff, gbase) do { _Pragma("unroll") for (int _i = 0; _i < 2; ++_i) PG8_GLDS((const char*)(gbase) + voffB[_i], bufoff, _i); } while (0)
#define PG8_STAGE_A(bufoff, gbase, h, GO) do { _Pragma("unroll") for (int _i = 0; _i < 2; ++_i) { \
        if constexpr (GATHER) PG8_GLDS((const char*)(gbase) + GO[h][_i], bufoff, _i); else PG8_GLDS((const char*)(gbase) + (size_t)(h) * hstepA + voffA[_i], bufoff, _i); } } while (0)
#define PG8_LDA(dst, b, h) do { _Pragma("unroll") for (int m = 0; m < 4; ++m) _Pragma("unroll") for (int k = 0; k < 2; ++k) dst[m][k] = *(const LAS bf16x8*)(lds + PG8_SA(b, h) + aoff + m * 2048 + k * 1024); } while (0)
#define PG8_LDB(dst, b, h) do { _Pragma("unroll") for (int n = 0; n < 2; ++n) _Pragma("unroll") for (int k = 0; k < 2; ++k) dst[n][k] = *(const LAS bf16x8*)(lds + PG8_SB(b, h) + boff + n * 2048 + k * 1024); } while (0)
#define PG8_MFMA8(ACC, W8, X8) asm volatile("v_mfma_scale_f32_16x16x128_f8f6f4 %0, %1, %2, %0, %3, %4 op_sel_hi:[0,0,0]" : "+v"(ACC) : "v"(W8), "v"(X8), "v"(scw_), "v"(scx_))
#define PG8_MMA(ai, bj, At, Bt) do { __builtin_amdgcn_s_setprio(1); if constexpr (FP8) { i32x8 a8_[4], b8_[2]; _Pragma("unroll") for (int m = 0; m < 4; ++m) a8_[m] = cat8(At[m][0], At[m][1]); \
        _Pragma("unroll") for (int n = 0; n < 2; ++n) b8_[n] = cat8(Bt[n][0], Bt[n][1]); asm volatile("s_nop 3" ::: "memory"); \
        _Pragma("unroll") for (int m = 0; m < 4; ++m) _Pragma("unroll") for (int n = 0; n < 2; ++n) PG8_MFMA8(acc[ai][bj][m][n], b8_[n], a8_[m]); } else { \
        _Pragma("unroll") for (int m = 0; m < 4; ++m) _Pragma("unroll") for (int n = 0; n < 2; ++n) _Pragma("unroll") for (int k = 0; k < 2; ++k) \
        acc[ai][bj][m][n] = __builtin_amdgcn_mfma_f32_16x16x32_bf16(Bt[n][k], At[m][k], acc[ai][bj][m][n], 0, 0, 0); } __builtin_amdgcn_s_setprio(0); } while (0)
#define PG8_WAIT_V(n) asm volatile("s_waitcnt vmcnt(" #n ")" ::: "memory")
#define PG8_WAIT_L(n) asm volatile("s_waitcnt lgkmcnt(" #n ")" ::: "memory")
#define PG8_BAR __builtin_amdgcn_s_barrier()
#define PG8_SCHED __builtin_amdgcn_sched_barrier(0)
    Unit cur, nxt; int ui = 0;
    if (!S.next(0, cur)) return;
    int scw_ = SCW, scx_ = SCX; asm volatile("" : "+v"(scw_), "+v"(scx_)); (void)scw_; (void)scx_;
    unsigned goff[2][2] = {{0u, 0u}, {0u, 0u}}, ngoff[2][2] = {{0u, 0u}, {0u, 0u}};
    if constexpr (GATHER) {
#pragma unroll
        for (int h = 0; h < 2; ++h)
#pragma unroll
            for (int i = 0; i < 2; ++i) goff[h][i] = (unsigned)S.tok(cur, h * HALF + RA[i]) * lda + (unsigned)CA[i] * 2u;
    }
    f32x4 acc[2][2][4][2];
#pragma unroll
    for (int a = 0; a < 2; ++a)
#pragma unroll
        for (int b = 0; b < 2; ++b)
#pragma unroll
            for (int m = 0; m < 4; ++m)
#pragma unroll
                for (int n = 0; n < 2; ++n) acc[a][b][m][n] = (f32x4){0.f, 0.f, 0.f, 0.f};
    bf16x8 At[4][2], B0[2][2], B1[2][2];
    const char* cA = cur.A; const char* cB = cur.B;
    PG8_STAGE_B(PG8_SB(0, 0), cB + PG8_KT(0)); PG8_STAGE_B(PG8_SB(0, 1), cB + hstepB + PG8_KT(0)); PG8_STAGE_A(PG8_SA(0, 0), cA + PG8_KT(0), 0, goff); PG8_STAGE_A(PG8_SA(0, 1), cA + PG8_KT(0), 1, goff);
    if (wr == 1) PG8_BAR;
    PG8_WAIT_V(2); PG8_BAR;
    PG8_STAGE_B(PG8_SB(1, 0), cB + PG8_KT(1)); PG8_STAGE_A(PG8_SA(1, 0), cA + PG8_KT(1), 0, goff); PG8_STAGE_B(PG8_SB(1, 1), cB + hstepB + PG8_KT(1));
    PG8_WAIT_V(6); PG8_BAR;
    for (;;) {
        const bool has_next = S.next(ui + 1, nxt);
        const char* nA = has_next ? nxt.A : cA; const char* nB = has_next ? nxt.B : cB;
        if constexpr (GATHER) {
#pragma unroll
            for (int h = 0; h < 2; ++h)
#pragma unroll
                for (int i = 0; i < 2; ++i) ngoff[h][i] = has_next ? (unsigned)S.tok(nxt, h * HALF + RA[i]) * lda + (unsigned)CA[i] * 2u : goff[h][i];
        }
#pragma unroll 1
        for (int t = 0; t < nt; t += 2) {
            const bool last = (t == nt - 2);
            const char* a1 = cA + PG8_KT(t + 1);
            const char* a2 = last ? nA + PG8_KT(0) : cA + PG8_KT(t + 2); const char* b2 = last ? nB + PG8_KT(0) : cB + PG8_KT(t + 2);
            const char* a3 = last ? nA + PG8_KT(1) : cA + PG8_KT(t + 3); const char* b3 = last ? nB + PG8_KT(1) : cB + PG8_KT(t + 3);
            unsigned g2[2][2];
#pragma unroll
            for (int h = 0; h < 2; ++h)
#pragma unroll
                for (int i = 0; i < 2; ++i) g2[h][i] = last ? ngoff[h][i] : goff[h][i];
            PG8_LDB(B0, 0, 0); PG8_LDB(B1, 0, 1); PG8_SCHED; PG8_LDA(At, 0, 0); PG8_STAGE_A(PG8_SA(1, 1), a1, 1, goff);
            PG8_WAIT_V(8); PG8_WAIT_L(0); PG8_BAR; PG8_MMA(0, 0, At, B0); PG8_MMA(0, 1, At, B1); PG8_BAR; PG8_SCHED;
            PG8_LDA(At, 0, 1); PG8_STAGE_B(PG8_SB(0, 0), b2); PG8_STAGE_B(PG8_SB(0, 1), b2 + hstepB); PG8_STAGE_A(PG8_SA(0, 0), a2, 0, g2);
            PG8_WAIT_V(8); PG8_WAIT_L(0); PG8_BAR; PG8_MMA(1, 0, At, B0); PG8_MMA(1, 1, At, B1); PG8_BAR; PG8_SCHED;
            PG8_LDB(B0, 1, 0); PG8_LDB(B1, 1, 1); PG8_SCHED; PG8_LDA(At, 1, 0); PG8_STAGE_A(PG8_SA(0, 1), a2, 1, g2);
            PG8_WAIT_V(8); PG8_WAIT_L(0); PG8_BAR; PG8_MMA(0, 0, At, B0); PG8_MMA(0, 1, At, B1); PG8_BAR; PG8_SCHED;
            PG8_LDA(At, 1, 1); PG8_STAGE_B(PG8_SB(1, 0), b3); PG8_STAGE_B(PG8_SB(1, 1), b3 + hstepB); PG8_STAGE_A(PG8_SA(1, 0), a3, 0, g2);
            PG8_WAIT_V(8); PG8_WAIT_L(0); PG8_BAR; PG8_MMA(1, 0, At, B0); PG8_MMA(1, 1, At, B1); PG8_BAR; PG8_SCHED;
        }
        if (wr == 0) PG8_BAR;
        if constexpr (FP8) asm volatile("s_nop 7\n\ts_nop 7" ::: "memory");
        { int fr2 = fr, fq2 = fq; asm volatile("" : "+v"(fr2), "+v"(fq2)); E(acc, cur, wr, wc, fr2, fq2); }
        if (!has_next) break;
#pragma unroll
        for (int a = 0; a < 2; ++a)
#pragma unroll
            for (int b = 0; b < 2; ++b)
#pragma unroll
                for (int m = 0; m < 4; ++m)
#pragma unroll
                    for (int n = 0; n < 2; ++n) acc[a][b][m][n] = (f32x4){0.f, 0.f, 0.f, 0.f};
        cur = nxt; cA = nA; cB = nB; ++ui;
        if constexpr (GATHER) {
#pragma unroll
            for (int h = 0; h < 2; ++h)
#pragma unroll
                for (int i = 0; i < 2; ++i) goff[h][i] = ngoff[h][i];
        }
        if (wr == 1) PG8_BAR;
    }
    PG8_WAIT_V(0);
    PG8_BAR;
#undef PG8_KT
#undef PG8_SA
#undef PG8_SB
#undef PG8_GLDS
#undef PG8_STAGE_A
#undef PG8_STAGE_B
#undef PG8_LDA
#undef PG8_LDB
#undef PG8_MMA
#undef PG8_MFMA8
#undef PG8_WAIT_V
#undef PG8_WAIT_L
#undef PG8_BAR
#undef PG8_SCHED
}
}
__device__ __forceinline__ const char* uni_ptr(const char* p) {
    unsigned long long v = (unsigned long long)p; unsigned lo = __builtin_amdgcn_readfirstlane((unsigned)v), hi = __builtin_amdgcn_readfirstlane((unsigned)(v >> 32));
    return (const char*)(((unsigned long long)hi << 32) | lo);
}
struct SchedStd {
    pg8::TileOrder T; const char* A; const char* B; size_t sA, sB;
    __device__ __forceinline__ bool next(int i, pg8::Unit& u) const { int pm, pn; if (!T.tile(i, pm, pn)) return false; u.pm = pm; u.pn = pn; u.aux = 0; u.A = A + (size_t)pm * sA; u.B = B + (size_t)pn * sB; return true; }
    __device__ __forceinline__ int tok(const pg8::Unit&, int) const { return 0; }
};
struct SchedBatch {
    const char* A; const char* B; size_t sA, sB, vA, vB; int nunits, nvt, G, c;
    __device__ __forceinline__ bool next(int i, pg8::Unit& u) const { const int L = i * G + c; if (L >= nunits * nvt) return false; const int uu = L / nvt, vt = L % nvt; u.pm = uu; u.pn = vt; u.aux = 0;
        u.A = A + (size_t)uu * sA + (size_t)vt * vA; u.B = B + (size_t)uu * sB + (size_t)vt * vB; return true; }
    __device__ __forceinline__ int tok(const pg8::Unit&, int) const { return 0; }
};
struct SchedMoE {
    const LAS int* tab; const char* A; const char* Bw; size_t sE, sPN, sRT; const int* idx; int G, c; bool gather;
    __device__ __forceinline__ bool next(int i, pg8::Unit& u) const {
        const int L = i * G + c, rt = L >> 2, pn = L & 3;
        const int ntile = __builtin_amdgcn_readfirstlane(tab[32]); if (rt >= ntile) return false;
        int e = 0;
#pragma unroll
        for (int k = 1; k < 16; ++k) e += (rt >= __builtin_amdgcn_readfirstlane(tab[16 + k])) ? 1 : 0;
        e = __builtin_amdgcn_readfirstlane(e);
        u.pm = rt; u.pn = pn; u.aux = e; u.A = gather ? A : A + (size_t)rt * sRT; u.B = Bw + (size_t)e * sE + (size_t)pn * sPN; return true;
    }
    __device__ __forceinline__ int tok(const pg8::Unit& u, int r) const {
        const int e = u.aux, p = (u.pm - __builtin_amdgcn_readfirstlane(tab[16 + e])) * 256 + r, n = __builtin_amdgcn_readfirstlane(tab[e]);
        const int pc = p < n ? p : (n > 0 ? n - 1 : 0), t = idx[e * NTOK + pc];
        return p < n ? t : 0;
    }
};

typedef const f32x4 (&AccRef)[2][2][4][2];
__device__ __forceinline__ int launder(int x) { asm volatile("" : "+v"(x)); return x; }
__device__ __forceinline__ void st8(bf16_t* p, f32x4 v0, f32x4 v1) {
    u32x4 w; w.x = cvt_pk_bf16(v0[0], v0[1]); w.y = cvt_pk_bf16(v0[2], v0[3]); w.z = cvt_pk_bf16(v1[0], v1[1]); w.w = cvt_pk_bf16(v1[2], v1[3]); *(u32x4*)p = w;
}
struct EpiPlain {
    static constexpr bool PERM = true; bf16_t* out; int ld;
    __device__ __forceinline__ void operator()(AccRef acc, const pg8::Unit& u, int wr, int wc, int fr, int fq) const {
#pragma unroll
        for (int ai = 0; ai < 2; ++ai)
#pragma unroll
            for (int m = 0; m < 4; ++m) { const int r = ai * 128 + wr * 64 + m * 16 + fr; bf16_t* rp = out + (size_t)(u.pm * 256 + r) * ld + u.pn * 256 + wc * 32 + fq * 8;
#pragma unroll
                for (int bj = 0; bj < 2; ++bj) st8(rp + bj * 128, acc[ai][bj][m][0], acc[ai][bj][m][1]); }
    }
};
struct EpiPlain8 {
    static constexpr bool PERM = true; unsigned char* out; int ld;
    __device__ __forceinline__ void operator()(AccRef acc, const pg8::Unit& u, int wr, int wc, int fr, int fq) const {
#pragma unroll
        for (int ai = 0; ai < 2; ++ai)
#pragma unroll
            for (int m = 0; m < 4; ++m) { const int r = ai * 128 + wr * 64 + m * 16 + fr; unsigned char* rp = out + (size_t)(u.pm * 256 + r) * ld + u.pn * 256 + wc * 32 + fq * 8;
#pragma unroll
                for (int bj = 0; bj < 2; ++bj) { const f32x4 v0 = acc[ai][bj][m][0], v1 = acc[ai][bj][m][1]; u32x2 w; w.x = pk4_fp8(v0[0], v0[1], v0[2], v0[3]); w.y = pk4_fp8(v1[0], v1[1], v1[2], v1[3]);
                    *(u32x2*)(rp + bj * 128) = w; } }
    }
};
template <int MODE> struct EpiRopeQK {
    static constexpr bool PERM = true; bf16_t* out; const int* pos; int half; bf16_t* outT;
    __device__ __forceinline__ void operator()(AccRef acc, const pg8::Unit& u, int wr, int wc, int fr, int fq) const {
        const int pm = u.pm, h = u.pn, uu = ((pm >> 5) * 4 + h) * 32 + (pm & 31); const float l2g = log2_gamma(h);
        constexpr int LD = MODE == 0 ? 512 : 256;
        float inv[8]; const int f0 = launder(wc * 32 + fq * 8);
#pragma unroll
        for (int k = 0; k < 8; ++k) inv[k] = __builtin_amdgcn_exp2f(-(float)(f0 + k) * (LOG2_THETA / 128.0f)) * 0.15915494309189535f;
        float pp[2][4];
#pragma unroll
        for (int ai = 0; ai < 2; ++ai)
#pragma unroll
            for (int m = 0; m < 4; ++m) pp[ai][m] = (float)pos[half * THALF + pm * 256 + ai * 128 + wr * 64 + m * 16 + fr];
#pragma unroll
        for (int ai = 0; ai < 2; ++ai)
#pragma unroll
            for (int m = 0; m < 4; ++m) { const int r = ai * 128 + wr * 64 + m * 16 + fr; const float p = pp[ai][m];
                const float dec = MODE == 0 ? __builtin_amdgcn_exp2f((float)r * l2g) : __builtin_amdgcn_exp2f(-(float)r * l2g) * 0.0625f;
                f32x4 o1[2], o2[2];
#pragma unroll
                for (int n = 0; n < 2; ++n)
#pragma unroll
                    for (int j = 0; j < 4; ++j) { const float tr = __builtin_amdgcn_fractf(p * inv[n * 4 + j]); const float s = __builtin_amdgcn_sinf(tr) * dec, c = __builtin_amdgcn_cosf(tr) * dec;
                        const float x1 = acc[ai][0][m][n][j], x2 = acc[ai][1][m][n][j];
                        o1[n][j] = x1 * c - x2 * s; o2[n][j] = x1 * s + x2 * c; }
                bf16_t* rp = out + (size_t)uu * (256 * LD) + (size_t)r * LD + wc * 32 + fq * 8;
                st8(rp, o1[0], o1[1]); st8(rp + 128, o2[0], o2[1]);
                if constexpr (MODE == 1) { bf16_t* tp = outT + (size_t)uu * 65536 + (size_t)(wc * 32 + fq * 8) * 256 + r;
#pragma unroll
                    for (int n = 0; n < 2; ++n) { const unsigned a01 = cvt_pk_bf16(o1[n][0], o1[n][1]), a23 = cvt_pk_bf16(o1[n][2], o1[n][3]), b01 = cvt_pk_bf16(o2[n][0], o2[n][1]), b23 = cvt_pk_bf16(o2[n][2], o2[n][3]);
                        tp[(n * 4 + 0) * 256] = (bf16_t)(a01 & 0xffffu); tp[(n * 4 + 1) * 256] = (bf16_t)(a01 >> 16); tp[(n * 4 + 2) * 256] = (bf16_t)(a23 & 0xffffu); tp[(n * 4 + 3) * 256] = (bf16_t)(a23 >> 16);
                        tp[(128 + n * 4 + 0) * 256] = (bf16_t)(b01 & 0xffffu); tp[(128 + n * 4 + 1) * 256] = (bf16_t)(b01 >> 16); tp[(128 + n * 4 + 2) * 256] = (bf16_t)(b23 & 0xffffu); tp[(128 + n * 4 + 3) * 256] = (bf16_t)(b23 >> 16); } }
                __builtin_amdgcn_sched_barrier(0); }
    }
};
struct EpiRopeKT {
    static constexpr bool PERM = true; bf16_t* out; const int* pos; int half;
    __device__ __forceinline__ void operator()(AccRef acc, const pg8::Unit& u, int wr, int wc, int fr, int fq) const {
        const int h = u.pm, pn = u.pn, uu = ((pn >> 5) * 4 + h) * 32 + (pn & 31); const float l2g = log2_gamma(h);
        float pp[2][8], dec[2][8]; const int c00 = launder(wc * 32 + fq * 8), i00 = launder(wr * 64 + fr);
#pragma unroll
        for (int bj = 0; bj < 2; ++bj)
#pragma unroll
            for (int k = 0; k < 8; ++k) { const int c = bj * 128 + c00 + k; pp[bj][k] = (float)pos[half * THALF + pn * 256 + c]; dec[bj][k] = __builtin_amdgcn_exp2f(-(float)c * l2g) * 0.0625f; }
#pragma unroll
        for (int m = 0; m < 4; ++m) { const int i = i00 + m * 16; const float inv = __builtin_amdgcn_exp2f(-(float)i * (LOG2_THETA / 128.0f));
#pragma unroll
            for (int bj = 0; bj < 2; ++bj) { f32x4 o1[2], o2[2];
#pragma unroll
                for (int n = 0; n < 2; ++n)
#pragma unroll
                    for (int j = 0; j < 4; ++j) { float s, c; sincos_rad(pp[bj][n * 4 + j] * inv, s, c); const float x1 = acc[0][bj][m][n][j], x2 = acc[1][bj][m][n][j], d = dec[bj][n * 4 + j];
                        o1[n][j] = (x1 * c - x2 * s) * d; o2[n][j] = (x1 * s + x2 * c) * d; }
                bf16_t* rp = out + (size_t)uu * 65536 + (size_t)i * 256 + bj * 128 + c00;
                st8(rp, o1[0], o1[1]); st8(rp + 128 * 256, o2[0], o2[1]); __builtin_amdgcn_sched_barrier(0); } }
    }
};
struct EpiVT {
    static constexpr bool PERM = true; bf16_t* out;
    __device__ __forceinline__ void operator()(AccRef acc, const pg8::Unit& u, int wr, int wc, int fr, int fq) const {
        const int h = u.pm >> 1, vt = u.pm & 1, pn = u.pn, uu = ((pn >> 5) * 4 + h) * 32 + (pn & 31);
#pragma unroll
        for (int ai = 0; ai < 2; ++ai)
#pragma unroll
            for (int m = 0; m < 4; ++m) { const int r = ai * 128 + wr * 64 + m * 16 + fr; bf16_t* rp = out + (size_t)uu * 262144 + (size_t)(vt * 256 + r) * 512 + 256 + wc * 32 + fq * 8;
#pragma unroll
                for (int bj = 0; bj < 2; ++bj) st8(rp + bj * 128, acc[ai][bj][m][0], acc[ai][bj][m][1]); }
    }
};
struct EpiS {
    static constexpr bool PERM = true; bf16_t* out;
    __device__ __forceinline__ void operator()(AccRef acc, const pg8::Unit& u, int wr, int wc, int fr, int fq) const {
        const int uu = u.pm;
#pragma unroll
        for (int ai = 0; ai < 2; ++ai)
#pragma unroll
            for (int m = 0; m < 4; ++m) { const int r = ai * 128 + wr * 64 + m * 16 + fr; bf16_t* rp = out + (size_t)uu * 131072 + (size_t)r * 512 + 256 + wc * 32 + fq * 8;
#pragma unroll
                for (int bj = 0; bj < 2; ++bj) { const int c0 = bj * 128 + wc * 32 + fq * 8; f32x4 v0 = acc[ai][bj][m][0], v1 = acc[ai][bj][m][1];
#pragma unroll
                    for (int j = 0; j < 4; ++j) { if (c0 + j > r) v0[j] = 0.f; if (c0 + 4 + j > r) v1[j] = 0.f; }
                    st8(rp + bj * 128, v0, v1); } }
    }
};
struct EpiKV {
    static constexpr bool PERM = true; bf16_t* out;
    __device__ __forceinline__ void operator()(AccRef acc, const pg8::Unit& u, int wr, int wc, int fr, int fq) const {
        const int uu = u.pm, vt = u.pn, h = (uu >> 5) & 3; const float sc = __builtin_amdgcn_exp2f(255.0f * log2_gamma(h));
#pragma unroll
        for (int ai = 0; ai < 2; ++ai)
#pragma unroll
            for (int m = 0; m < 4; ++m) { const int r = ai * 128 + wr * 64 + m * 16 + fr; bf16_t* rp = out + (size_t)uu * 262144 + (size_t)(vt * 256 + r) * 512 + wc * 32 + fq * 8;
#pragma unroll
                for (int bj = 0; bj < 2; ++bj) st8(rp + bj * 128, acc[ai][bj][m][0] * sc, acc[ai][bj][m][1] * sc); }
    }
};
struct EpiFin {
    static constexpr bool PERM = true; bf16_t* out; float* stats; int rep;
    __device__ __forceinline__ void operator()(AccRef acc, const pg8::Unit& u, int wr, int wc, int fr, int fq) const {
        const int uu = u.pm, vt = u.pn, bl = uu >> 7, h = (uu >> 5) & 3, ch = uu & 31;
#pragma unroll
        for (int ai = 0; ai < 2; ++ai)
#pragma unroll
            for (int m = 0; m < 4; ++m) { const int r = ai * 128 + wr * 64 + m * 16 + fr; bf16_t* rp = out + (size_t)uu * 262144 + (size_t)(vt * 256 + r) * 512 + wc * 32 + fq * 8;
                float s = 0.f, q = 0.f;
#pragma unroll
                for (int bj = 0; bj < 2; ++bj) { const f32x4 v0 = acc[ai][bj][m][0], v1 = acc[ai][bj][m][1];
                    s += (v0[0] + v0[1]) + (v0[2] + v0[3]) + (v1[0] + v1[1]) + (v1[2] + v1[3]);
                    q += (v0[0] * v0[0] + v0[1] * v0[1]) + (v0[2] * v0[2] + v0[3] * v0[3]) + (v1[0] * v1[0] + v1[1] * v1[1]) + (v1[2] * v1[2] + v1[3] * v1[3]);
                    if (!rep) st8(rp + bj * 128, v0, v1); }
                s = rows_sum(s); q = rows_sum(q);
                const int tokl = bl * SEQ + ch * 256 + r;
                if (fq == 0 && !rep) *(f32x2*)(stats + ((size_t)(tokl * 4 + h) * 8 + vt * 4 + wc) * 2) = (f32x2){s, q}; }
    }
};
__device__ __forceinline__ f32x2 silu2_mul(const f32x2 g, const f32x2 t, const float invk) {
    const f32x2 x = g * (f32x2){-1.4426950408889634f, -1.4426950408889634f};
    f32x2 e; e[0] = __builtin_amdgcn_exp2f(x[0]); e[1] = __builtin_amdgcn_exp2f(x[1]);
    const f32x2 d = __builtin_elementwise_fma(e, (f32x2){invk, invk}, (f32x2){invk, invk});
    f32x2 r; r[0] = __builtin_amdgcn_rcpf(d[0]); r[1] = __builtin_amdgcn_rcpf(d[1]);
    return (g * t) * r;
}
template <bool F8> struct EpiGate {
    static constexpr bool PERM = true; const bf16_t* o; const float* stats; bf16_t* y; unsigned char* y8;
    __device__ __forceinline__ void operator()(AccRef acc, const pg8::Unit& u, int wr, int wc, int fr, int fq) const {
        const int pm = u.pm, h = u.pn >> 1, vt = u.pn & 1, uu = ((pm >> 5) * 4 + h) * 32 + (pm & 31);
        float mean[2][4], rstd[2][4];
        f32x4 (&G)[2][2][4][2] = const_cast<f32x4 (&)[2][2][4][2]>(acc);
#pragma unroll
        for (int ai = 0; ai < 2; ++ai) { f32x4 st[4][4];
#pragma unroll
            for (int m = 0; m < 4; ++m) { const f32x4* sp = (const f32x4*)(stats + (size_t)((pm * 256 + ai * 128 + wr * 64 + m * 16 + fr) * 4 + h) * 16);
#pragma unroll
                for (int k = 0; k < 4; ++k) st[m][k] = sp[k]; }
#pragma unroll
            for (int bj = 0; bj < 2; ++bj)
#pragma unroll
                for (int m = 0; m < 4; ++m)
#pragma unroll
                    for (int n = 0; n < 2; ++n) { const f32x4 g = G[ai][bj][m][n];
                        const f32x2 s0 = silu2_mul((f32x2){g[0], g[1]}, (f32x2){1.0f, 1.0f}, 1.0f), s1 = silu2_mul((f32x2){g[2], g[3]}, (f32x2){1.0f, 1.0f}, 1.0f);
                        G[ai][bj][m][n] = (f32x4){s0[0], s0[1], s1[0], s1[1]}; }
#pragma unroll
            for (int m = 0; m < 4; ++m) { const f32x4 a = st[m][0], b = st[m][1], c = st[m][2], d = st[m][3];
                const float mu = ((a[0] + a[2]) + (b[0] + b[2]) + (c[0] + c[2]) + (d[0] + d[2])) * (1.0f / 512.0f);
                const float ex2 = ((a[1] + a[3]) + (b[1] + b[3]) + (c[1] + c[3]) + (d[1] + d[3])) * (1.0f / 512.0f);
                mean[ai][m] = mu; rstd[ai][m] = __builtin_amdgcn_rsqf(fmaxf(ex2 - mu * mu, 0.f) + EPS); } }
        const bf16_t* ob = o + (size_t)uu * 262144 + (size_t)(vt * 256 + wr * 64 + fr) * 512 + wc * 32 + fq * 8;
        u32x4 on[2] = {*(const u32x4*)(ob), *(const u32x4*)(ob + 128)};
#pragma unroll
        for (int ai = 0; ai < 2; ++ai)
#pragma unroll
            for (int m = 0; m < 4; ++m) { const int r = ai * 128 + wr * 64 + m * 16 + fr, tokl = pm * 256 + r; const float ka = (F8 ? 4.0f : 1.0f) * rstd[ai][m], kb = -mean[ai][m] * ka;
                const u32x4 oc[2] = {on[0], on[1]};
                if (ai * 4 + m < 7) { const int ni = ai * 4 + m + 1, nai = ni >> 2, nm = ni & 3; const bf16_t* np = ob + (size_t)(nai * 128 + nm * 16) * 512; on[0] = *(const u32x4*)(np); on[1] = *(const u32x4*)(np + 128); }
                bf16_t* yp = y + (size_t)tokl * 2048 + h * 512 + vt * 256 + wc * 32 + fq * 8;
#pragma unroll
                for (int bj = 0; bj < 2; ++bj) { const u32x4 ow = oc[bj]; const f32x4 g0 = acc[ai][bj][m][0], g1 = acc[ai][bj][m][1];
                    const f32x2 na = {ka, ka}, nb = {kb, kb};
                    const f32x2 t0 = __builtin_elementwise_fma((f32x2){bflo(ow.x), bfhi(ow.x)}, na, nb), t1 = __builtin_elementwise_fma((f32x2){bflo(ow.y), bfhi(ow.y)}, na, nb);
                    const f32x2 t2 = __builtin_elementwise_fma((f32x2){bflo(ow.z), bfhi(ow.z)}, na, nb), t3 = __builtin_elementwise_fma((f32x2){bflo(ow.w), bfhi(ow.w)}, na, nb);
                    const f32x2 q0 = (f32x2){g0[0], g0[1]} * t0, q1 = (f32x2){g0[2], g0[3]} * t1, q2 = (f32x2){g1[0], g1[1]} * t2, q3 = (f32x2){g1[2], g1[3]} * t3;
                    if constexpr (F8) { u32x2 w; w.x = pk4_fp8(q0[0], q0[1], q1[0], q1[1]); w.y = pk4_fp8(q2[0], q2[1], q3[0], q3[1]);
                        *(u32x2*)(y8 + (size_t)tokl * 2048 + h * 512 + vt * 256 + wc * 32 + fq * 8 + bj * 128) = w; }
                    else st8(yp + bj * 128, (f32x4){q0[0], q0[1], q1[0], q1[1]}, (f32x4){q2[0], q2[1], q3[0], q3[1]}); } }
    }
};
struct EpiResid {
    static constexpr bool PERM = false; bf16_t* h; const float* gate; int tok0; const float* xin;
    __device__ __forceinline__ void operator()(AccRef acc, const pg8::Unit& u, int wr, int wc, int fr, int fq) const {
        const int row0 = tok0 + u.pm * 256 + wr * 64 + fr, b = (tok0 + u.pm * 256) >> 13, c0 = u.pn * 256 + wc * 32 + fq * 4;
        f32x4 gv[2][2];
#pragma unroll
        for (int bj = 0; bj < 2; ++bj)
#pragma unroll
            for (int n = 0; n < 2; ++n) gv[bj][n] = *(const f32x4*)(gate + b * 6144 + c0 + bj * 128 + n * 16);
        if (xin) {
#pragma unroll
            for (int ai = 0; ai < 2; ++ai) { f32x4 s[4][2][2];
#pragma unroll
                for (int m = 0; m < 4; ++m)
#pragma unroll
                    for (int bj = 0; bj < 2; ++bj)
#pragma unroll
                        for (int n = 0; n < 2; ++n) s[m][bj][n] = *(const f32x4*)(xin + (size_t)(row0 + ai * 128 + m * 16) * DM + c0 + bj * 128 + n * 16);
#pragma unroll
                for (int m = 0; m < 4; ++m)
#pragma unroll
                    for (int bj = 0; bj < 2; ++bj)
#pragma unroll
                        for (int n = 0; n < 2; ++n) { const f32x4 r = s[m][bj][n] + gv[bj][n] * acc[ai][bj][m][n]; u32x2 w; w.x = cvt_pk_bf16(r[0], r[1]); w.y = cvt_pk_bf16(r[2], r[3]);
                            *(u32x2*)(h + (size_t)(row0 + ai * 128 + m * 16) * DM + c0 + bj * 128 + n * 16) = w; } }
        } else {
            u32x2 s[2][4][2][2];
#pragma unroll
            for (int ai = 0; ai < 2; ++ai)
#pragma unroll
                for (int m = 0; m < 4; ++m)
#pragma unroll
                    for (int bj = 0; bj < 2; ++bj)
#pragma unroll
                        for (int n = 0; n < 2; ++n) s[ai][m][bj][n] = *(const u32x2*)(h + (size_t)(row0 + ai * 128 + m * 16) * DM + c0 + bj * 128 + n * 16);
#pragma unroll
            for (int ai = 0; ai < 2; ++ai)
#pragma unroll
                for (int m = 0; m < 4; ++m)
#pragma unroll
                    for (int bj = 0; bj < 2; ++bj)
#pragma unroll
                        for (int n = 0; n < 2; ++n) { const f32x4 r = bf4_to_f32(s[ai][m][bj][n]) + gv[bj][n] * acc[ai][bj][m][n]; u32x2 w; w.x = cvt_pk_bf16(r[0], r[1]); w.y = cvt_pk_bf16(r[2], r[3]);
                            *(u32x2*)(h + (size_t)(row0 + ai * 128 + m * 16) * DM + c0 + bj * 128 + n * 16) = w; }
        }
    }
};
struct EpiGU {
    static constexpr bool PERM = true; bf16_t* hdn;
    __device__ __forceinline__ void operator()(AccRef acc, const pg8::Unit& u, int wr, int wc, int fr, int fq) const {
#pragma unroll
        for (int ai = 0; ai < 2; ++ai)
#pragma unroll
            for (int m = 0; m < 4; ++m) { const int r = ai * 128 + wr * 64 + m * 16 + fr; f32x4 o0, o1;
#pragma unroll
                for (int j = 0; j < 4; ++j) { o0[j] = silu_f(acc[ai][0][m][0][j]) * acc[ai][1][m][0][j]; o1[j] = silu_f(acc[ai][0][m][1][j]) * acc[ai][1][m][1][j]; }
                st8(hdn + (size_t)(u.pm * 256 + r) * DEXP + u.pn * 128 + wc * 32 + fq * 8, o0, o1); }
    }
};
struct EpiGU8 {
    static constexpr bool PERM = true; unsigned char* hdn;
    __device__ __forceinline__ void operator()(AccRef acc, const pg8::Unit& u, int wr, int wc, int fr, int fq) const {
#pragma unroll
        for (int ai = 0; ai < 2; ++ai)
#pragma unroll
            for (int m = 0; m < 4; ++m) { const int r = ai * 128 + wr * 64 + m * 16 + fr; f32x4 o0, o1;
#pragma unroll
                for (int j = 0; j < 4; j += 2) {
                    const f32x2 a0 = silu2_mul((f32x2){acc[ai][0][m][0][j], acc[ai][0][m][0][j + 1]}, (f32x2){acc[ai][1][m][0][j], acc[ai][1][m][0][j + 1]}, 0.25f);
                    const f32x2 a1 = silu2_mul((f32x2){acc[ai][0][m][1][j], acc[ai][0][m][1][j + 1]}, (f32x2){acc[ai][1][m][1][j], acc[ai][1][m][1][j + 1]}, 0.25f);
                    o0[j] = a0[0]; o0[j + 1] = a0[1]; o1[j] = a1[0]; o1[j + 1] = a1[1]; }
                u32x2 w; w.x = pk4_fp8(o0[0], o0[1], o0[2], o0[3]); w.y = pk4_fp8(o1[0], o1[1], o1[2], o1[3]);
                *(u32x2*)(hdn + (size_t)(u.pm * 256 + r) * DEXP + u.pn * 128 + wc * 32 + fq * 8) = w; }
    }
};
struct EpiQA {
    static constexpr bool PERM = true; bf16_t* out; float* ssq; unsigned char* out8;
    __device__ __forceinline__ void operator()(AccRef acc, const pg8::Unit& u, int wr, int wc, int fr, int fq) const {
#pragma unroll
        for (int ai = 0; ai < 2; ++ai)
#pragma unroll
            for (int m = 0; m < 4; ++m) { const int row = u.pm * 256 + ai * 128 + wr * 64 + m * 16 + fr; bf16_t* rp = out + (size_t)row * 256 + wc * 32 + fq * 8; float q = 0.f;
#pragma unroll
                for (int bj = 0; bj < 2; ++bj) { const f32x4 v0 = acc[ai][bj][m][0], v1 = acc[ai][bj][m][1];
                    q += (v0[0] * v0[0] + v0[1] * v0[1]) + (v0[2] * v0[2] + v0[3] * v0[3]) + (v1[0] * v1[0] + v1[1] * v1[1]) + (v1[2] * v1[2] + v1[3] * v1[3]);
                    if (out8) { u32x2 w; w.x = pk4_fp8(4.0f * v0[0], 4.0f * v0[1], 4.0f * v0[2], 4.0f * v0[3]); w.y = pk4_fp8(4.0f * v1[0], 4.0f * v1[1], 4.0f * v1[2], 4.0f * v1[3]);
                        *(u32x2*)(out8 + (size_t)row * 256 + wc * 32 + fq * 8 + bj * 128) = w; }
                    else st8(rp + bj * 128, v0, v1); }
                q = rows_sum(q);
                if (fq == 0) ssq[(size_t)row * 4 + wc] = q; }
    }
};
struct EpiF32 {
    static constexpr bool PERM = false; float* out;
    __device__ __forceinline__ void operator()(AccRef acc, const pg8::Unit& u, int wr, int wc, int fr, int fq) const {
#pragma unroll
        for (int ai = 0; ai < 2; ++ai)
#pragma unroll
            for (int m = 0; m < 4; ++m) { const int row = u.pm * 256 + ai * 128 + wr * 64 + m * 16 + fr;
#pragma unroll
                for (int bj = 0; bj < 2; ++bj)
#pragma unroll
                    for (int n = 0; n < 2; ++n) *(f32x4*)(out + (size_t)row * 256 + bj * 128 + wc * 32 + n * 16 + fq * 4) = acc[ai][bj][m][n]; }
    }
};
template <bool Q8> struct EpiQB {
    static constexpr bool PERM = true; bf16_t* Q; const float* ssq; const int* pos;
    __device__ __forceinline__ void operator()(AccRef acc, const pg8::Unit& u, int wr, int wc, int fr, int fq) const {
        constexpr float QS = 0.10411754627697264f;
        const int pn = u.pn;
        float inv[8]; const int f0 = launder(fq * 8);
#pragma unroll
        for (int k = 0; k < 8; ++k) inv[k] = __builtin_amdgcn_exp2f(-(float)(f0 + k) * (LOG2_THETA / 32.0f)) * 0.15915494309189535f;
        float rs8[2][4], pp[2][4];
#pragma unroll
        for (int ai = 0; ai < 2; ++ai)
#pragma unroll
            for (int m = 0; m < 4; ++m) { const int row = u.pm * 256 + ai * 128 + wr * 64 + m * 16 + fr; const f32x4 sq = *(const f32x4*)(ssq + (size_t)row * 4);
                rs8[ai][m] = __builtin_amdgcn_rsqf(((sq[0] + sq[1]) + (sq[2] + sq[3])) * (1.0f / 256.0f) + EPS) * (Q8 ? 8.0f * QS : QS); pp[ai][m] = (float)pos[row]; }
#pragma unroll
        for (int ai = 0; ai < 2; ++ai)
#pragma unroll
            for (int m = 0; m < 4; ++m) { const int row = u.pm * 256 + ai * 128 + wr * 64 + m * 16 + fr; const float rs = rs8[ai][m];
                if (pn < 4) {
#pragma unroll
                    for (int bj = 0; bj < 2; ++bj) { const f32x4 v0 = acc[ai][bj][m][0] * rs, v1 = acc[ai][bj][m][1] * rs;
                        if constexpr (Q8) { u32x2 w; w.x = pk4_fp8(v0[0], v0[1], v0[2], v0[3]); w.y = pk4_fp8(v1[0], v1[1], v1[2], v1[3]); *(u32x2*)((unsigned char*)Q + (size_t)row * 1536 + (2 * pn + bj) * QKD + wc * 32 + fq * 8) = w; }
                        else st8(Q + (size_t)row * 1536 + (2 * pn + bj) * QKD + wc * 32 + fq * 8, v0, v1); }
                } else {
                    const float p = pp[ai][m]; f32x4 o1[2], o2[2];
#pragma unroll
                    for (int n = 0; n < 2; ++n)
#pragma unroll
                        for (int j = 0; j < 4; ++j) { const float tr = __builtin_amdgcn_fractf(p * inv[n * 4 + j]); const float s = __builtin_amdgcn_sinf(tr) * rs, c = __builtin_amdgcn_cosf(tr) * rs;
                            const float x1 = acc[ai][0][m][n][j], x2 = acc[ai][1][m][n][j];
                            o1[n][j] = x1 * c - x2 * s; o2[n][j] = x1 * s + x2 * c; }
                    if constexpr (Q8) { unsigned char* qp = (unsigned char*)Q + (size_t)row * 1536 + (4 * (pn - 4) + wc) * QKD + 128 + fq * 8; u32x2 w;
                        w.x = pk4_fp8(o1[0][0], o1[0][1], o1[0][2], o1[0][3]); w.y = pk4_fp8(o1[1][0], o1[1][1], o1[1][2], o1[1][3]); *(u32x2*)qp = w;
                        w.x = pk4_fp8(o2[0][0], o2[0][1], o2[0][2], o2[0][3]); w.y = pk4_fp8(o2[1][0], o2[1][1], o2[1][2], o2[1][3]); *(u32x2*)(qp + 32) = w; }
                    else { bf16_t* qp = Q + (size_t)row * 1536 + (4 * (pn - 4) + wc) * QKD + 128 + fq * 8;
                        st8(qp, o1[0], o1[1]); st8(qp + 32, o2[0], o2[1]); } } __builtin_amdgcn_sched_barrier(0); }
    }
};

template <class S0, class S1, class S2> struct SchedCat3 {
    S0 s0; S1 s1; S2 s2; int n0, n1;
    __device__ __forceinline__ bool next(int i, pg8::Unit& u) const {
        bool ok; int kind;
        if (i < n0) { ok = s0.next(i, u); kind = 0; } else if (i < n0 + n1) { ok = s1.next(i - n0, u); kind = 1; } else { ok = s2.next(i - n0 - n1, u); kind = 2; }
        u.aux = kind; return ok;
    }
    __device__ __forceinline__ int tok(const pg8::Unit&, int) const { return 0; }
};
template <class E0, class E1, class E2> struct EpiMux3 {
    static constexpr bool PERM = E0::PERM; static_assert(E0::PERM == E1::PERM && E1::PERM == E2::PERM, "one B-row permutation per gemm_phase call");
    E0 e0; E1 e1; E2 e2;
    __device__ __forceinline__ void operator()(AccRef acc, const pg8::Unit& u, int wr, int wc, int fr, int fq) const {
        const int kind = __builtin_amdgcn_readfirstlane(u.aux);
        if (kind == 0) e0(acc, u, wr, wc, fr, fq); else if (kind == 1) e1(acc, u, wr, wc, fr, fq); else e2(acc, u, wr, wc, fr, fq);
    }
};
struct SchedNone { __device__ __forceinline__ bool next(int, pg8::Unit&) const { return false; } __device__ __forceinline__ int tok(const pg8::Unit&, int) const { return 0; } };
struct EpiNone { static constexpr bool PERM = true; __device__ __forceinline__ void operator()(AccRef, const pg8::Unit&, int, int, int, int) const {} };
typedef const char __attribute__((address_space(4)))* kaptr_t;
struct Ctx { kaptr_t ka; LAS unsigned char* lds; int wave, vcu; };
__device__ __forceinline__ const void* ld_ka(kaptr_t ka, int off) { return *(const void* const __attribute__((address_space(4)))*)(ka + off); }
#define INF(k) ((const float*)ld_ka(ka, (k) * 8))
#define INI(k) ((const int*)ld_ka(ka, (k) * 8))
#define OUTP ((float*)ld_ka(ka, 200))
#define WSB ((unsigned char*)ld_ka(ka, 208))
#define CTLP ((unsigned*)(WSB + WS_CTL))
#define PHASE_ENTRY() kaptr_t ka = C.ka; asm volatile("" : "+s"(ka)); int lane_ = lane_id(); asm volatile("" : "+v"(lane_)); int wave_ = C.wave, vcu_ = C.vcu; asm volatile("" : "+s"(wave_), "+s"(vcu_)); \
    const int lane = lane_, wave = wave_, vcu = vcu_, tid = wave * 64 + lane; LAS unsigned char* const ldsb = C.lds; (void)tid; (void)lane; (void)vcu; (void)ldsb
#define WSP(T, off) ((T*)(WSB + (off)))

__device__ __forceinline__ void transpose_block(const float* W, int N, int k0, int n0, bf16_t* dst, int ldd, int drow, LAS float* scr, int lane) {
    (void)scr; const int r = lane >> 3, cg = lane & 7; const float* src = W + (size_t)(k0 + 8 * r) * N + n0 + 4 * cg;
    f32x4 v[8];
#pragma unroll
    for (int i = 0; i < 8; ++i) v[i] = *(const f32x4*)(src + (size_t)i * N);
#pragma unroll
    for (int j = 0; j < 4; ++j) { u32x4 o; o.x = cvt_pk_bf16(v[0][j], v[1][j]); o.y = cvt_pk_bf16(v[2][j], v[3][j]); o.z = cvt_pk_bf16(v[4][j], v[5][j]); o.w = cvt_pk_bf16(v[6][j], v[7][j]);
        *(u32x4*)(dst + (size_t)(drow + 4 * cg + j) * ldd + k0 + 8 * r) = o; }
}
__device__ __forceinline__ void transpose_block_f8(const float* W, int N, int k0, int n0, unsigned char* dst, int ldd, int drow, float sc, LAS float* scr, int lane) {
    (void)scr; const int r = lane >> 3, cg = lane & 7; const float* src = W + (size_t)(k0 + 8 * r) * N + n0 + 4 * cg;
    f32x4 v[8];
#pragma unroll
    for (int i = 0; i < 8; ++i) v[i] = *(const f32x4*)(src + (size_t)i * N);
#pragma unroll
    for (int j = 0; j < 4; ++j) { u32x2 o; o.x = pk4_fp8(sc * v[0][j], sc * v[1][j], sc * v[2][j], sc * v[3][j]); o.y = pk4_fp8(sc * v[4][j], sc * v[5][j], sc * v[6][j], sc * v[7][j]);
        *(u32x2*)(dst + (size_t)(drow + 4 * cg + j) * ldd + k0 + 8 * r) = o; }
}
__device__ __forceinline__ void moe_weight_block(kaptr_t ka, const int le, const int r, LAS float* scr, const int lane) {
    if (r < 512) { const int up = r >> 8, rr = r & 255, kb = rr / 16, nb = rr % 16, n0 = 32 * nb;
        transpose_block_f8((up ? INF(22) : INF(21)) + (size_t)le * 1024 * 512, 512, 64 * kb, n0, WSP(unsigned char, WS_WGU) + (size_t)le * 1024 * 1024, 1024, (n0 >> 7) * 256 + (n0 & 127) + up * 128, 64.0f, scr, lane); }
    else { const int rr = r - 512, kb = rr / 32, nb = rr % 32;
        transpose_block_f8(INF(23) + (size_t)le * 512 * 1024, 1024, 64 * kb, 32 * nb, WSP(unsigned char, WS_WDN) + (size_t)le * 1024 * 512, 512, 32 * nb, 64.0f, scr, lane); }
}
__device__ __forceinline__ void moe_convert_tail(Ctx& C, const int lnext, const int lo, const int hi) {
    PHASE_ENTRY();
    __syncthreads();
    const LAS int* tab = (const LAS int*)(ldsb + LDS_TAB);
    const int total = __builtin_amdgcn_readfirstlane(tab[32]) * 4, rem = total % GRID;
    int nidle = GRID, rank = vcu;
    if (rem != 0 && GRID - rem >= 96) { nidle = GRID - rem; rank = vcu - rem; }
    if (rank < 0) return;
    LAS float* scr = (LAS float*)(ldsb + wave * 16384);
    for (int it = lo + rank * NWAVES + wave; it < hi; it += nidle * NWAVES) moe_weight_block(ka, lnext * 16 + it / 768, it % 768, scr, lane);
}
__device__ __forceinline__ void phase_prologue(Ctx& C) {
    PHASE_ENTRY();
    LAS float* cact = (LAS float*)ldsb;
    LAS float* red = (LAS float*)(ldsb + 16384);
    for (int i = tid; i < 4096; i += NTHREADS) cact[i] = silu_f(INF(1)[i]);
    __syncthreads();
    float* mod = WSP(float, WS_MOD);
    for (int g = vcu; g < 416; g += GRID) {
        const int col = g * 64 + lane; const float* W; int N, cc; const float* bias; float* dst; int dstride;
        if (col < 24576) { const int l = col / 6144; cc = col - l * 6144; W = INF(3) + (size_t)l * 1024 * 6144; N = 6144; bias = INF(4) + l * 6144; dst = mod + (size_t)l * 4 * 6144; dstride = 6144; }
        else { cc = col - 24576; W = INF(9); N = 2048; bias = INF(10); dst = mod + 4 * 4 * 6144; dstride = 2048; }
        float a0 = 0.f, a1 = 0.f, a2 = 0.f, a3 = 0.f;
        const float* wp = W + (size_t)(wave * 128) * N + cc;
#pragma unroll 1
        for (int k0 = 0; k0 < 128; k0 += 32) { float w[32];
#pragma unroll
            for (int i = 0; i < 32; ++i) w[i] = wp[(size_t)(k0 + i) * N];
            asm volatile("" ::: "memory");
#pragma unroll
            for (int i = 0; i < 32; ++i) { const int kk = wave * 128 + k0 + i; a0 += cact[kk] * w[i]; a1 += cact[1024 + kk] * w[i]; a2 += cact[2048 + kk] * w[i]; a3 += cact[3072 + kk] * w[i]; } }
        red[(wave * 4 + 0) * 64 + lane] = a0; red[(wave * 4 + 1) * 64 + lane] = a1; red[(wave * 4 + 2) * 64 + lane] = a2; red[(wave * 4 + 3) * 64 + lane] = a3;
        __syncthreads();
        if (tid < 256) { const int b = tid >> 6, ln = tid & 63; float s = 0.f;
#pragma unroll
            for (int w = 0; w < 8; ++w) s += red[(w * 4 + b) * 64 + ln];
            const int c2 = g * 64 + ln; const int cc2 = c2 < 24576 ? c2 % 6144 : c2 - 24576;
            dst[(size_t)b * dstride + cc2] = s + bias[cc2]; }
        __syncthreads();
    }
    LAS float* scr = (LAS float*)(ldsb + wave * 16384);
    const int gw = vcu * NWAVES + wave, NGW = GRID * NWAVES;
    constexpr int NIT = 8544 + 16 * 768;
    for (int it = gw; it < NIT; it += NGW) {
        if (it < 6144) { const int l = it / 3072, r = it % 3072, kb = r / 192, nb = r % 192;
            const bool need16 = (nb < 64) ? ((FP8_R2 & 1) == 0) : (nb < 128 ? ((FP8_R2 & 2) == 0) : (FP8_R6 == 0)), need8 = (nb < 64) ? ((FP8_R2 & 1) != 0) : (nb < 128 ? ((FP8_R2 & 2) != 0) : (FP8_R6 != 0));
            if (need16) transpose_block(INF(7) + (size_t)l * 1024 * 6144, 6144, 64 * kb, 32 * nb, WSP(bf16_t, WS_WIN) + (size_t)l * 6144 * 1024, 1024, 32 * nb, scr, lane);
            if (need8) transpose_block_f8(INF(7) + (size_t)l * 1024 * 6144, 6144, 64 * kb, 32 * nb, WSP(unsigned char, WS_WIN8) + (size_t)l * 6144 * 1024, 1024, 32 * nb, 64.0f, scr, lane); }
        else if (it < 8192) { const int r0 = it - 6144, l = r0 / 1024, r = r0 % 1024, kb = r / 32, nb = r % 32;
            if (FP8_R7) transpose_block_f8(INF(8) + (size_t)l * 2048 * 1024, 1024, 64 * kb, 32 * nb, WSP(unsigned char, WS_WOUT8) + (size_t)l * 1024 * 2048, 2048, 32 * nb, 64.0f, scr, lane);
            else transpose_block(INF(8) + (size_t)l * 2048 * 1024, 1024, 64 * kb, 32 * nb, WSP(bf16_t, WS_WOUT) + (size_t)l * 1024 * 2048, 2048, 32 * nb, scr, lane); }
        else if (it < 8448) { const int r0 = it - 8192, j = r0 / 128, r = r0 % 128, kb = r / 8, nb = r % 8;
            if (FP8_M2) transpose_block_f8(INF(15) + (size_t)j * 1024 * 256, 256, 64 * kb, 32 * nb, WSP(unsigned char, WS_WQA8) + (size_t)j * 256 * 1024, 1024, 32 * nb, 64.0f, scr, lane);
            else transpose_block(INF(15) + (size_t)j * 1024 * 256, 256, 64 * kb, 32 * nb, WSP(bf16_t, WS_WQA) + (size_t)j * 256 * 1024, 1024, 32 * nb, scr, lane); }
        else if (it < 8544) { const int r = it - 8448, kb = r / 6, nb = r % 6;
            transpose_block(INF(12), 192, 64 * kb, 32 * nb, WSP(bf16_t, WS_WKVA), 1024, 32 * nb, scr, lane); }
        else { const int r0 = it - 8544; moe_weight_block(ka, r0 / 768, r0 % 768, scr, lane); }
    }
    const int gt = vcu * NTHREADS + tid, NGT = GRID * NTHREADS;
    for (int i = gt; i < 64 * 1024 / 8; i += NGT) *(u32x4*)(WSP(bf16_t, WS_WKVA) + 192 * 1024 + (size_t)i * 8) = (u32x4){0u, 0u, 0u, 0u};
    for (int i = gt; i < 2 * 1536 * 256; i += NGT) {
        const int k = i & 255, n = (i >> 8) % 1536, j = i / (1536 * 256);
        const float* wq = INF(17) + ((size_t)j * 256 + k) * 1536; float v;
        if (n < 1024) { const int head = n >> 7, cdim = n & 127; const float* a = wq + head * QKD; const float* b = INF(14) + (size_t)cdim * 2048 + head * 256; float s = 0.f;
#pragma unroll 8
            for (int d = 0; d < 128; d += 4) { const f32x4 av = *(const f32x4*)(a + d), bv = *(const f32x4*)(b + d); s += av[0] * bv[0] + av[1] * bv[1] + av[2] * bv[2] + av[3] * bv[3]; }
            v = s; }
        else { const int np = (n - 1024) & 255, pn = (n - 1024) >> 8, half = np >> 7, wcc = (np & 127) >> 5, ii = np & 31; v = wq[(4 * pn + wcc) * QKD + 128 + half * 32 + ii]; }
        v *= INF(16)[j * 256 + k];
        if (FP8_M3) WSP(unsigned char, WS_WQB8)[i] = (unsigned char)(pk4_fp8(64.0f * v, 0.f, 0.f, 0.f) & 0xffu);
        else WSP(bf16_t, WS_WQB)[i] = (bf16_t)(cvt_pk_bf16(v, 0.f) & 0xffffu);
    }
    for (int it = vcu * NWAVES + wave; it < 2 * 8 * 16 * 8; it += GRID * NWAVES) {
        const int nq = it & 7, cb = (it >> 3) & 15, hh = (it >> 7) & 7, j = it >> 10, n0 = nq * 128 + 2 * lane, c0 = cb * 8;
        const float* a = INF(14) + (size_t)c0 * 2048 + hh * 256 + 128; const float* bq = INF(18) + ((size_t)j * 1024 + hh * 128) * 1024 + n0;
        f32x2 acc[8];
#pragma unroll
        for (int c = 0; c < 8; ++c) acc[c] = (f32x2){0.f, 0.f};
#pragma unroll 8
        for (int v = 0; v < 128; ++v) { const f32x2 bv = *(const f32x2*)(bq + (size_t)v * 1024);
#pragma unroll
            for (int c = 0; c < 8; ++c) acc[c] = acc[c] + bv * a[(size_t)c * 2048 + v]; }
        bf16_t* o = WSP(bf16_t, WS_WO) + ((size_t)j * 1024 + n0) * 1024 + hh * 128 + c0;
#pragma unroll
        for (int q = 0; q < 2; ++q) { u32x4 w; w.x = cvt_pk_bf16(acc[0][q], acc[1][q]); w.y = cvt_pk_bf16(acc[2][q], acc[3][q]); w.z = cvt_pk_bf16(acc[4][q], acc[5][q]); w.w = cvt_pk_bf16(acc[6][q], acc[7][q]);
            if (!FP8_M5) *(u32x4*)(o + (size_t)q * 1024) = w;
            u32x2 w8; w8.x = pk4_fp8(64.f * acc[0][q], 64.f * acc[1][q], 64.f * acc[2][q], 64.f * acc[3][q]); w8.y = pk4_fp8(64.f * acc[4][q], 64.f * acc[5][q], 64.f * acc[6][q], 64.f * acc[7][q]);
            if (FP8_M5) *(u32x2*)(WSP(unsigned char, WS_WO8) + ((size_t)j * 1024 + n0 + q) * 1024 + hh * 128 + c0) = w8; }
    }
}

__device__ __forceinline__ void moe_tile_prefix(Ctx& C, int l) {
    PHASE_ENTRY();
    LAS int* tab = (LAS int*)(ldsb + LDS_TAB);
    if (tid < 16) {
        const int n = (int)__hip_atomic_load(CTLP + CW_CNT + 64 * l + tid, __ATOMIC_RELAXED, __HIP_MEMORY_SCOPE_AGENT);
        tab[tid] = n; tab[40 + tid] = (n + 255) >> 8;
        LDS_WAIT();
        int acc = 0;
#pragma unroll
        for (int e = 0; e < 16; ++e) { const int t = tab[40 + e]; acc += (e < tid) ? t : 0; }
        tab[16 + tid] = acc; if (tid == 15) tab[32] = acc + tab[40 + 15];
    }
    __syncthreads();
}
__device__ __forceinline__ void store_fp8_row(unsigned char* row, int lane, const f32x4 (&v)[4], float sc) {
#pragma unroll
    for (int j = 0; j < 4; ++j) *(unsigned*)(row + 4 * lane + 256 * j) = pk4_fp8(sc * v[j][0], sc * v[j][1], sc * v[j][2], sc * v[j][3]);
}
__device__ __forceinline__ void store_bf16_row(bf16_t* row, int lane, const f32x4 (&v)[4]) {
#pragma unroll
    for (int j = 0; j < 4; ++j) { u32x2 w; w.x = cvt_pk_bf16(v[j][0], v[j][1]); w.y = cvt_pk_bf16(v[j][2], v[j][3]); *(u32x2*)(row + 4 * lane + 256 * j) = w; }
}
__device__ __forceinline__ void moe_combine_row(const LAS int* tab, const unsigned* route, const bf16_t* yb, int lane, int tok, const f32x4 (&G2)[4], f32x4 (&v)[4]) {
    const u32x4 rt = *(const u32x4*)(route + (size_t)tok * 4);
    const int e0 = rt.x >> 15, p0 = rt.x & 32767, e1 = rt.y >> 15, p1 = rt.y & 32767; const float w0 = __uint_as_float(rt.z), w1 = __uint_as_float(rt.w);
    const bf16_t* y0 = yb + (size_t)(tab[16 + e0] * 256 + p0) * DM; const bf16_t* y1 = yb + (size_t)(tab[16 + e1] * 256 + p1) * DM;
#pragma unroll
    for (int j = 0; j < 4; ++j) { const u32x2 a = *(const u32x2*)(y0 + 4 * lane + 256 * j), b = *(const u32x2*)(y1 + 4 * lane + 256 * j);
        v[j][0] += G2[j][0] * (w0 * bflo(a.x) + w1 * bflo(b.x)); v[j][1] += G2[j][1] * (w0 * bfhi(a.x) + w1 * bfhi(b.x));
        v[j][2] += G2[j][2] * (w0 * bflo(a.y) + w1 * bflo(b.y)); v[j][3] += G2[j][3] * (w0 * bfhi(a.y) + w1 * bfhi(b.y)); }
}
__device__ __forceinline__ float row_rstd(const f32x4 (&v)[4]) {
    float s = 0.f;
#pragma unroll
    for (int j = 0; j < 4; ++j) s += (v[j][0] * v[j][0] + v[j][1] * v[j][1]) + (v[j][2] * v[j][2] + v[j][3] * v[j][3]);
    return __builtin_amdgcn_rsqf(wave_sum(s) * (1.0f / DM) + EPS);
}
__device__ __forceinline__ void phase_norm_a(Ctx& C, int l, int rep = 0) {
    PHASE_ENTRY(); const int b = vcu >> 6; const float* mod = WSP(float, WS_MOD);
    const float* xin = INF(0); float* hout = OUTP; bf16_t* h16 = WSP(bf16_t, WS_H16); bf16_t* xnp = WSP(bf16_t, WS_XN); unsigned char* xn8p = WSP(unsigned char, WS_XN8); bf16_t* hnp = WSP(bf16_t, WS_HN); const unsigned* route = WSP(unsigned, WS_ROUTE); const unsigned char* ybp = WSP(unsigned char, WS_YB);
    f32x4 Am[4], Bm[4], G2[4], Ak[4], Bk[4];
#pragma unroll
    for (int j = 0; j < 4; ++j) { const int c = 4 * lane + 256 * j;
        if (l < 4) { const float* ml = mod + (size_t)(l * 4 + b) * 6144; const f32x4 g = *(const f32x4*)(INF(5) + l * DM + c), sc = *(const f32x4*)(ml + 1024 + c); Am[j] = g * (1.0f + sc); Bm[j] = *(const f32x4*)(ml + c); }
        else { Am[j] = *(const f32x4*)(INF(24) + c); Bm[j] = (f32x4){0.f, 0.f, 0.f, 0.f}; }
        if (l > 0 && !rep) G2[j] = *(const f32x4*)(mod + (size_t)((l - 1) * 4 + b) * 6144 + 5 * 1024 + c); else G2[j] = (f32x4){0.f, 0.f, 0.f, 0.f};
        if (l == 2) { const float* mk = mod + 4 * 4 * 6144 + b * 2048; const f32x4 g = *(const f32x4*)(INF(11) + c), sc = *(const f32x4*)(mk + 1024 + c); Ak[j] = g * (1.0f + sc); Bk[j] = *(const f32x4*)(mk + c); }
        else { Ak[j] = Am[j]; Bk[j] = Bm[j]; } }
    if (l > 0) moe_tile_prefix(C, l - 1);
    const LAS int* tab = (const LAS int*)(ldsb + LDS_TAB);
    const int tok0 = vcu * 128 + wave * 16;
    const float* src0 = xin + (size_t)tok0 * DM + 4 * lane; const bf16_t* hsrc0 = h16 + (size_t)tok0 * DM + 4 * lane;
    u32x4 rtl = (u32x4){0u, 0u, 0u, 0u};
    if (l > 0) rtl = *(const u32x4*)(route + (size_t)(tok0 + (lane & 15)) * 4);
    u32x4 rw[4][4]; float wn0[4] = {0.f, 0.f, 0.f, 0.f}, wn1[4] = {0.f, 0.f, 0.f, 0.f};
#define NA_ISSUE(rr_) do { const int S_ = (rr_) & 3; if (l == 0) { _Pragma("unroll") for (int j = 0; j < 4; ++j) rw[S_][j] = *(const u32x4*)(src0 + (size_t)(rr_) * DM + 256 * j); } \
        else { _Pragma("unroll") for (int j = 0; j < 2; ++j) { const u32x2 h0_ = *(const u32x2*)(hsrc0 + (size_t)(rr_) * DM + 512 * j), h1_ = *(const u32x2*)(hsrc0 + (size_t)(rr_) * DM + 512 * j + 256); rw[S_][j] = (u32x4){h0_.x, h0_.y, h1_.x, h1_.y}; } } \
        if (l > 0) { const unsigned rx = __builtin_amdgcn_readlane(rtl.x, (rr_)), ry = __builtin_amdgcn_readlane(rtl.y, (rr_)); \
            wn0[S_] = __uint_as_float(__builtin_amdgcn_readlane(rtl.z, (rr_))); wn1[S_] = __uint_as_float(__builtin_amdgcn_readlane(rtl.w, (rr_))); \
            const int e0 = rx >> 15, p0 = rx & 32767, e1 = ry >> 15, p1 = ry & 32767; \
            const unsigned char* y0 = ybp + (size_t)(__builtin_amdgcn_readfirstlane(tab[16 + e0]) * 256 + p0) * DM + 4 * lane; const unsigned char* y1 = ybp + (size_t)(__builtin_amdgcn_readfirstlane(tab[16 + e1]) * 256 + p1) * DM + 4 * lane; \
            rw[S_][2] = (u32x4){*(const unsigned*)(y0), *(const unsigned*)(y0 + 256), *(const unsigned*)(y0 + 512), *(const unsigned*)(y0 + 768)}; \
            rw[S_][3] = (u32x4){*(const unsigned*)(y1), *(const unsigned*)(y1 + 256), *(const unsigned*)(y1 + 512), *(const unsigned*)(y1 + 768)}; } } while (0)
    NA_ISSUE(0); NA_ISSUE(1); NA_ISSUE(2); NA_ISSUE(3);
#pragma unroll
    for (int rr = 0; rr < 16; ++rr) {
        const int tok = tok0 + rr, S = rr & 3; f32x4 v[4];
        if (l == 0) {
#pragma unroll
            for (int j = 0; j < 4; ++j) v[j] = __builtin_bit_cast(f32x4, rw[S][j]);
        } else {
            v[0] = bf4_to_f32((u32x2){rw[S][0].x, rw[S][0].y}); v[1] = bf4_to_f32((u32x2){rw[S][0].z, rw[S][0].w}); v[2] = bf4_to_f32((u32x2){rw[S][1].x, rw[S][1].y}); v[3] = bf4_to_f32((u32x2){rw[S][1].z, rw[S][1].w}); }
        if (l > 0) { const float w0 = wn0[S] * 0.0625f, w1 = wn1[S] * 0.0625f;
#pragma unroll
            for (int j = 0; j < 4; ++j) { const int a2 = (int)rw[S][2][j], b2 = (int)rw[S][3][j];
                v[j][0] += G2[j][0] * (w0 * __builtin_amdgcn_cvt_f32_fp8(a2, 0) + w1 * __builtin_amdgcn_cvt_f32_fp8(b2, 0)); v[j][1] += G2[j][1] * (w0 * __builtin_amdgcn_cvt_f32_fp8(a2, 1) + w1 * __builtin_amdgcn_cvt_f32_fp8(b2, 1));
                v[j][2] += G2[j][2] * (w0 * __builtin_amdgcn_cvt_f32_fp8(a2, 2) + w1 * __builtin_amdgcn_cvt_f32_fp8(b2, 2)); v[j][3] += G2[j][3] * (w0 * __builtin_amdgcn_cvt_f32_fp8(a2, 3) + w1 * __builtin_amdgcn_cvt_f32_fp8(b2, 3)); } }
        if (rr + 4 < 16) NA_ISSUE(rr + 4);
        asm volatile("" ::: "memory");
        const float rstd = row_rstd(v);
        if (l < 4) {
            if (l > 0) {
#pragma unroll
                for (int j = 0; j < 4; ++j) { u32x2 w; w.x = cvt_pk_bf16(v[j][0], v[j][1]); w.y = cvt_pk_bf16(v[j][2], v[j][3]); *(u32x2*)(h16 + (size_t)tok * DM + 4 * lane + 256 * j) = w; } }
            f32x4 o[4];
#pragma unroll
            for (int j = 0; j < 4; ++j) o[j] = v[j] * rstd * Am[j] + Bm[j];
            if ((l < 2 && (FP8_R2 & 1) == 0) || (l >= 2 && !FP8_M2)) store_bf16_row(xnp + (size_t)tok * DM, lane, o);
            if (l < 2 || FP8_M2) store_fp8_row(xn8p + (size_t)tok * DM, lane, o, 4.0f);
            if (l == 2) {
#pragma unroll
                for (int j = 0; j < 4; ++j) o[j] = v[j] * rstd * Ak[j] + Bk[j];
                store_bf16_row(hnp + (size_t)tok * DM, lane, o); }
        } else {
#pragma unroll
            for (int j = 0; j < 4; ++j) *(f32x4*)(hout + (size_t)tok * DM + 4 * lane + 256 * j) = v[j] * rstd * Am[j];
        }
    }
#undef NA_ISSUE
}
constexpr int NBR = 4;
template <int CTRL> __device__ __forceinline__ float dpp_add(float v) { return v + dpp_f<CTRL>(v); }
typedef float f32x2_t __attribute__((ext_vector_type(2)));
__device__ __forceinline__ void phase_norm_b(Ctx& C, int l, int rep = 0) {
    PHASE_ENTRY(); const int b = vcu >> 6; const float* ml = WSP(float, WS_MOD) + (size_t)(l * 4 + b) * 6144;
    const bf16_t* hin = WSP(bf16_t, WS_H16); bf16_t* xnp = WSP(bf16_t, WS_XN);
    LAS float* wrT = (LAS float*)ldsb;
    LAS float* lgt = (LAS float*)(ldsb + 65536);
    LAS int* rec_e = (LAS int*)(ldsb + 65536 + 8192);
    LAS float* rec_w = (LAS float*)(ldsb + 65536 + 8192 + 1024);
    LAS int* rec_p = (LAS int*)(ldsb + 65536 + 8192 + 2048);
    LAS int* lcnt = (LAS int*)(ldsb + 65536 + 8192 + 3072);
    LAS int* gbase = (LAS int*)(ldsb + 65536 + 8192 + 3072 + 64);
    for (int i = tid; i < 4096; i += NTHREADS) { const f32x4 w = *(const f32x4*)(INF(19) + (size_t)i * 4); const int col = i >> 2, e4 = (i & 3) * 4;
        wrT[(e4 + 0) * 1024 + col] = 0.25f * w[0]; wrT[(e4 + 1) * 1024 + col] = 0.25f * w[1]; wrT[(e4 + 2) * 1024 + col] = 0.25f * w[2]; wrT[(e4 + 3) * 1024 + col] = 0.25f * w[3]; }
    if (tid < 16) lcnt[tid] = 0;
    f32x4 Am[4], Bm[4];
#pragma unroll
    for (int j = 0; j < 4; ++j) { const int c = 4 * lane + 256 * j; const f32x4 g = *(const f32x4*)(INF(6) + l * DM + c), sc = *(const f32x4*)(ml + 4 * 1024 + c); Am[j] = 4.0f * (g * (1.0f + sc)); Bm[j] = 4.0f * *(const f32x4*)(ml + 3 * 1024 + c); }
    const bf16_t* hrow = hin + (size_t)(vcu * 128 + wave * 16) * DM + 4 * lane;
    __syncthreads();
    u32x2 hn[NBR][4];
#pragma unroll
    for (int i = 0; i < NBR; ++i)
#pragma unroll
        for (int j = 0; j < 4; ++j) hn[i][j] = *(const u32x2*)(hrow + (size_t)i * DM + 256 * j);
#pragma unroll 1
    for (int g = 0; g < 16 / NBR; ++g) {
        asm volatile("" ::: "memory");
        f32x4 v[NBR][4];
#pragma unroll
        for (int i = 0; i < NBR; ++i)
#pragma unroll
            for (int j = 0; j < 4; ++j) v[i][j] = bf4_to_f32(hn[i][j]);
        if (g + 1 < 16 / NBR) {
#pragma unroll
            for (int i = 0; i < NBR; ++i)
#pragma unroll
                for (int j = 0; j < 4; ++j) hn[i][j] = *(const u32x2*)(hrow + (size_t)((g + 1) * NBR + i) * DM + 256 * j);
        }
#pragma unroll
        for (int i = 0; i < NBR; ++i) { const float rstd = row_rstd(v[i]);
#pragma unroll
            for (int j = 0; j < 4; ++j) v[i][j] = v[i][j] * rstd * Am[j] + Bm[j];
            if (!rep) { unsigned char* xr = (unsigned char*)xnp + (size_t)(vcu * 128 + wave * 16 + g * NBR + i) * DM;
#pragma unroll
              for (int j = 0; j < 4; ++j) *(unsigned*)(xr + 4 * lane + 256 * j) = pk4_fp8(v[i][j][0], v[i][j][1], v[i][j][2], v[i][j][3]); } }
        float p[NBR][16];
#pragma unroll
        for (int e = 0; e < 16; ++e) { f32x4 w[4];
#pragma unroll
            for (int j = 0; j < 4; ++j) w[j] = *(const LAS f32x4*)(wrT + e * 1024 + 4 * lane + 256 * j);
            f32x2_t a2[NBR];
#pragma unroll
            for (int i = 0; i < NBR; ++i) a2[i] = (f32x2_t){0.f, 0.f};
#pragma unroll
            for (int j = 0; j < 4; ++j) {
#pragma unroll
                for (int i = 0; i < NBR; ++i) a2[i] = __builtin_elementwise_fma(__builtin_shufflevector(v[i][j], v[i][j], 0, 1), __builtin_shufflevector(w[j], w[j], 0, 1), a2[i]);
#pragma unroll
                for (int i = 0; i < NBR; ++i) a2[i] = __builtin_elementwise_fma(__builtin_shufflevector(v[i][j], v[i][j], 2, 3), __builtin_shufflevector(w[j], w[j], 2, 3), a2[i]); }
#pragma unroll
            for (int i = 0; i < NBR; ++i) { p[i][e] = a2[i][0] + a2[i][1]; asm volatile("" : "+v"(p[i][e])); }
            __builtin_amdgcn_sched_barrier(0); }
#pragma unroll
        for (int i = 0; i < NBR; ++i) {
            float q[8], r[4];
#pragma unroll
            for (int k = 0; k < 8; ++k) { auto t = __builtin_amdgcn_permlane32_swap(__float_as_uint(p[i][k]), __float_as_uint(p[i][k + 8]), false, false); q[k] = __uint_as_float(t[0]) + __uint_as_float(t[1]); }
#pragma unroll
            for (int k = 0; k < 4; ++k) { auto t = __builtin_amdgcn_permlane16_swap(__float_as_uint(q[k]), __float_as_uint(q[k + 4]), false, false); r[k] = __uint_as_float(t[0]) + __uint_as_float(t[1]); }
#pragma unroll
            for (int k = 0; k < 4; ++k) { r[k] = dpp_add<0xB1>(r[k]); r[k] = dpp_add<0x4E>(r[k]); r[k] = dpp_add<0x141>(r[k]); r[k] = dpp_add<0x140>(r[k]); }
            if ((lane & 15) == 0) { const int rho = lane >> 4; *(LAS f32x4*)(lgt + (wave * 16 + g * NBR + i) * 16 + 4 * (rho & 1) + 8 * (rho >> 1)) = (f32x4){r[0], r[1], r[2], r[3]}; }
        }
    }
    LDS_WAIT();
    if (lane < 16) {
        const int rl = wave * 16 + lane; float sc[16], bs[16];
#pragma unroll
        for (int e4 = 0; e4 < 4; ++e4) { const f32x4 lg = *(const LAS f32x4*)(lgt + rl * 16 + e4 * 4); const f32x4 rbv = *(const f32x4*)(INF(20) + e4 * 4);
#pragma unroll
            for (int k = 0; k < 4; ++k) { sc[e4 * 4 + k] = 1.0f / (1.0f + __expf(-lg[k])); bs[e4 * 4 + k] = sc[e4 * 4 + k] + rbv[k]; } }
        float gs[4];
#pragma unroll
        for (int g = 0; g < 4; ++g) { const float a = bs[4 * g], bq = bs[4 * g + 1], c = bs[4 * g + 2], d = bs[4 * g + 3];
            const float h1 = fmaxf(a, bq), l1 = fminf(a, bq), h2 = fmaxf(c, d), l2 = fminf(c, d); gs[g] = fmaxf(h1, h2) + fmaxf(fminf(h1, h2), fmaxf(l1, l2)); }
        int gi = 0; float best = gs[0];
#pragma unroll
        for (int g = 1; g < 4; ++g) if (gs[g] > best) { best = gs[g]; gi = g; }
        float iv[4], uv[4];
#pragma unroll
        for (int k = 0; k < 4; ++k) { iv[k] = gi == 0 ? bs[k] : (gi == 1 ? bs[4 + k] : (gi == 2 ? bs[8 + k] : bs[12 + k])); uv[k] = gi == 0 ? sc[k] : (gi == 1 ? sc[4 + k] : (gi == 2 ? sc[8 + k] : sc[12 + k])); }
        int i1 = 0; float b1 = iv[0];
#pragma unroll
        for (int k = 1; k < 4; ++k) if (iv[k] > b1) { b1 = iv[k]; i1 = k; }
        int i2 = -1; float b2 = 0.f;
#pragma unroll
        for (int k = 0; k < 4; ++k) if (k != i1 && (i2 < 0 || iv[k] > b2)) { b2 = iv[k]; i2 = k; }
        const float u1 = i1 == 0 ? uv[0] : (i1 == 1 ? uv[1] : (i1 == 2 ? uv[2] : uv[3])), u2 = i2 == 0 ? uv[0] : (i2 == 1 ? uv[1] : (i2 == 2 ? uv[2] : uv[3]));
        const float rs = 1.0f / (u1 + u2);
        rec_e[rl * 2] = gi * 4 + i1; rec_e[rl * 2 + 1] = gi * 4 + i2; rec_w[rl * 2] = u1 * rs; rec_w[rl * 2 + 1] = u2 * rs;
    }
    __syncthreads();
    if (rep) return;
    if (tid < 128) { rec_p[tid * 2] = atomicAdd((int*)&lcnt[rec_e[tid * 2]], 1); rec_p[tid * 2 + 1] = atomicAdd((int*)&lcnt[rec_e[tid * 2 + 1]], 1); }
    __syncthreads();
    if (tid < 16) gbase[tid] = (int)__hip_atomic_fetch_add(CTLP + CW_CNT + 64 * l + tid, (unsigned)lcnt[tid], __ATOMIC_RELAXED, __HIP_MEMORY_SCOPE_AGENT);
    __syncthreads();
    if (tid < 128) { const int tok = vcu * 128 + tid, e0 = rec_e[tid * 2], e1 = rec_e[tid * 2 + 1], p0 = gbase[e0] + rec_p[tid * 2], p1 = gbase[e1] + rec_p[tid * 2 + 1];
        int* idx = WSP(int, WS_IDX); idx[e0 * NTOK + p0] = tok; idx[e1 * NTOK + p1] = tok;
        *(u32x4*)(WSP(unsigned, WS_ROUTE) + (size_t)tok * 4) = (u32x4){(unsigned)(e0 << 15 | p0), (unsigned)(e1 << 15 | p1), __float_as_uint(rec_w[tid * 2]), __float_as_uint(rec_w[tid * 2 + 1])}; }
    __syncthreads();
}
__device__ __forceinline__ void phase_prefix(Ctx& C, int rep = 0) {
    PHASE_ENTRY(); const int g = vcu * NTHREADS + tid, dkv = g & 31, v = (g >> 5) & 511, bh = g >> 14, h = bh & 3;
    const float gam = __builtin_amdgcn_exp2f(log2_gamma(h)), gam256 = __builtin_amdgcn_exp2f(256.0f * log2_gamma(h));
    bf16_t* p = WSP(bf16_t, WS_B2T) + (size_t)bh * 32 * 262144 + (size_t)v * 512 + dkv * 8;
    float s[8];
#pragma unroll
    for (int k = 0; k < 8; ++k) s[k] = 0.f;
#pragma unroll 1
    for (int c0 = 0; c0 < 32; c0 += 16) {
        u32x4 kv[16];
#pragma unroll
        for (int i = 0; i < 16; ++i) kv[i] = *(const u32x4*)(p + (size_t)(c0 + i) * 262144);
#pragma unroll
        for (int i = 0; i < 16; ++i) {
            u32x4 o; o.x = cvt_pk_bf16(s[0] * gam, s[1] * gam); o.y = cvt_pk_bf16(s[2] * gam, s[3] * gam); o.z = cvt_pk_bf16(s[4] * gam, s[5] * gam); o.w = cvt_pk_bf16(s[6] * gam, s[7] * gam);
            if (!rep) *(u32x4*)(p + (size_t)(c0 + i) * 262144) = o;
            s[0] = s[0] * gam256 + bflo(kv[i].x); s[1] = s[1] * gam256 + bfhi(kv[i].x); s[2] = s[2] * gam256 + bflo(kv[i].y); s[3] = s[3] * gam256 + bfhi(kv[i].y);
            s[4] = s[4] * gam256 + bflo(kv[i].z); s[5] = s[5] * gam256 + bfhi(kv[i].z); s[6] = s[6] * gam256 + bflo(kv[i].w); s[7] = s[7] * gam256 + bfhi(kv[i].w); }
    }
}
__device__ __forceinline__ void phase_kvfin(Ctx& C) {
    PHASE_ENTRY(); const float* akv = WSP(float, WS_AKV); bf16_t* kpp = WSP(bf16_t, WS_KP); const int* posp = INI(2); const float g0 = INF(13)[2 * lane], g1 = INF(13)[2 * lane + 1];
    const float inv = __builtin_amdgcn_exp2f(-(float)(lane & 31) * (LOG2_THETA / 32.0f));
    for (int rr = 0; rr < 16; ++rr) {
        const int tok = vcu * 128 + wave * 16 + rr; const float* a = akv + (size_t)tok * 256; bf16_t* kp = kpp + (size_t)tok * QKD;
        const f32x2 cv = *(const f32x2*)(a + 2 * lane); const float rstd = __builtin_amdgcn_rsqf(wave_sum(cv[0] * cv[0] + cv[1] * cv[1]) * (1.0f / 128.0f) + EPS);
        if (!ATT_FP8) *(unsigned*)(kp + 2 * lane) = cvt_pk_bf16(cv[0] * rstd * g0, cv[1] * rstd * g1);
        const float x1 = a[128 + (lane & 31)], x2 = a[160 + (lane & 31)]; float s, c; sincos_rad((float)posp[tok] * inv, s, c);
        const float o = lane < 32 ? x1 * c - x2 * s : x1 * s + x2 * c;
        if (!ATT_FP8) kp[128 + lane] = (bf16_t)(cvt_pk_bf16(o, 0.f) & 0xffffu);
#if ATT_FP8
        {
            unsigned char* k8 = WSP(unsigned char, WS_K8) + (size_t)tok * QKD;
            const unsigned ck = pk4_fp8(4.f * cv[0] * rstd * g0, 4.f * cv[1] * rstd * g1, 4.f * o, 0.f);
            *(unsigned short*)(k8 + 2 * lane) = (unsigned short)(ck & 0xffffu); k8[128 + lane] = (unsigned char)((ck >> 16) & 0xffu);
            const int key = tok & 63, c5 = key & 31, slot = 32 * ((c5 >> 2) & 1) + ((c5 & 3) + 4 * (c5 >> 3)) + 16 * (key >> 5);
            unsigned char* vt = WSP(unsigned char, WS_V8T) + (size_t)(tok >> 6) * 8192 + slot;
            vt[(2 * lane) * 64] = (unsigned char)(ck & 0xffu); vt[(2 * lane + 1) * 64] = (unsigned char)((ck >> 8) & 0xffu);
        }
#endif
    }
}
namespace att {
constexpr int SHM_V = 16384, SHM_K = 24576, OFF_V = 0, OFF_K = 2 * SHM_V, OFF_WS = OFF_K + 2 * SHM_K, OFF_Q = OFF_WS + 2048;
constexpr float THR = 24.0f;
#define KSWZ(row, colB) ((row) * 384 + ((colB) ^ ((((row) >> 1) & 7) << 4)))
#define SBAR() __builtin_amdgcn_sched_barrier(0)
__device__ __forceinline__ int crow(int r, int hi) { return (r & 3) + 8 * (r >> 2) + 4 * hi; }
__device__ __forceinline__ void partialSM(f32x16& p0, f32x16& p1, float& m_reg, float& mn, float& alpha) {
    float pmax = p0[0];
#pragma unroll
    for (int r = 1; r < 16; ++r) pmax = fmaxf(pmax, p0[r]);
#pragma unroll
    for (int r = 0; r < 16; ++r) pmax = fmaxf(pmax, p1[r]);
    { auto rr = __builtin_amdgcn_permlane32_swap(__float_as_uint(pmax), __float_as_uint(pmax), false, false); pmax = fmaxf(__uint_as_float(rr[0]), __uint_as_float(rr[1])); }
    if (__builtin_expect(__all(pmax - m_reg <= THR), 1)) { mn = m_reg; alpha = 1.f; }
    else { mn = fmaxf(m_reg, pmax); alpha = __builtin_amdgcn_exp2f(m_reg - mn); m_reg = mn; }
#pragma unroll
    for (int r = 0; r < 16; ++r) p0[r] = p0[r] - mn;
#pragma unroll
    for (int r = 0; r < 16; ++r) p1[r] = p1[r] - mn;
#pragma unroll
    for (int r = 0; r < 16; ++r) p0[r] = __builtin_amdgcn_exp2f(p0[r]);
}
__device__ __forceinline__ void finishSM(f32x16& p0, f32x16& p1, float alpha, float& l_reg, bf16x8& pa0, bf16x8& pa1, bf16x8& pa2, bf16x8& pa3) {
#pragma unroll
    for (int r = 0; r < 16; ++r) p1[r] = __builtin_amdgcn_exp2f(p1[r]);
    float ps = 0;
#pragma unroll
    for (int r = 0; r < 16; ++r) ps += p0[r];
#pragma unroll
    for (int r = 0; r < 16; ++r) ps += p1[r];
    { auto rr = __builtin_amdgcn_permlane32_swap(__float_as_uint(ps), __float_as_uint(ps), false, false); ps = __uint_as_float(rr[0]) + __uint_as_float(rr[1]); }
    l_reg = l_reg * alpha + ps;
#define PK4(P, BASE, OUT) do { unsigned a0 = cvt_pk_bf16(P[BASE + 0], P[BASE + 1]), a1 = cvt_pk_bf16(P[BASE + 2], P[BASE + 3]);   \
    unsigned b0 = cvt_pk_bf16(P[BASE + 4], P[BASE + 5]), b1 = cvt_pk_bf16(P[BASE + 6], P[BASE + 7]);                              \
    auto r0 = __builtin_amdgcn_permlane32_swap(a0, b0, false, false); auto r1 = __builtin_amdgcn_permlane32_swap(a1, b1, false, false); \
    u32x4 w = {r0[0], r1[0], r0[1], r1[1]}; OUT = *reinterpret_cast<bf16x8*>(&w); } while (0)
    PK4(p0, 0, pa0); PK4(p0, 8, pa1); PK4(p1, 0, pa2); PK4(p1, 8, pa3);
#undef PK4
}
template <int BUF> __device__ __forceinline__ void qkt(f32x16& p0, f32x16& p1, const LAS char* const (&kb4)[4], const bf16x8* qr, const LAS char* ql) {
    p0 = f32x16{}; p1 = f32x16{};
#pragma unroll
    for (int d0 = 0; d0 < 12; ++d0) {
        const bf16x8 b0 = *reinterpret_cast<const LAS bf16x8*>(kb4[d0 & 3] + BUF * SHM_K + (d0 >> 2) * 128);
        const bf16x8 b1 = *reinterpret_cast<const LAS bf16x8*>(kb4[d0 & 3] + BUF * SHM_K + (d0 >> 2) * 128 + 32 * 384);
        const bf16x8 qf = d0 < 8 ? qr[d0 < 8 ? d0 : 0] : *reinterpret_cast<const LAS bf16x8*>(ql + (d0 - 8) * 1024);
        p0 = __builtin_amdgcn_mfma_f32_32x32x16_bf16(b0, qf, p0, 0, 0, 0);
        p1 = __builtin_amdgcn_mfma_f32_32x32x16_bf16(b1, qf, p1, 0, 0, 0); }
}
__device__ __forceinline__ int v_st(int k, int c) { const int kk = (k & ~0xC) | ((k & 4) << 1) | ((k & 8) >> 1); return ((kk >> 3) * 4 + (c >> 5)) * 512 + ((kk & 7) * 32 + (c & 31)) * 2; }
__device__ __forceinline__ int v_rd_base(int lane) { return ((lane & 3) << 3) | (((lane >> 2) & 3) << 6) | (((lane >> 4) & 1) << 5) | (((lane >> 5) & 1) << 8); }
constexpr int v_rd_off(int d0, int ks, int half) { return d0 * 512 + ks * 4096 + half * 2048; }
template <int OFF> __device__ __forceinline__ s16x4 tr_read(int vb) { s16x4 r; asm volatile("ds_read_b64_tr_b16 %0, %1 offset:%2" : "=&v"(r) : "v"(vb), "i"(OFF) : "memory"); return r; }
template <int D0> __device__ __forceinline__ void pv_one(f32x16& od, int vb, bf16x8 pa0, bf16x8 pa1, bf16x8 pa2, bf16x8 pa3) {
    const s16x4 l0 = tr_read<v_rd_off(D0, 0, 0)>(vb), h0 = tr_read<v_rd_off(D0, 0, 1)>(vb), l1 = tr_read<v_rd_off(D0, 1, 0)>(vb), h1 = tr_read<v_rd_off(D0, 1, 1)>(vb);
    const s16x4 l2 = tr_read<v_rd_off(D0, 2, 0)>(vb), h2 = tr_read<v_rd_off(D0, 2, 1)>(vb), l3 = tr_read<v_rd_off(D0, 3, 0)>(vb), h3 = tr_read<v_rd_off(D0, 3, 1)>(vb);
    asm volatile("s_waitcnt lgkmcnt(0)" ::: "memory"); SBAR();
#define PK(L, H) (bf16x8){L[0], L[1], L[2], L[3], H[0], H[1], H[2], H[3]}
    od = __builtin_amdgcn_mfma_f32_32x32x16_bf16(pa0, PK(l0, h0), od, 0, 0, 0);
    od = __builtin_amdgcn_mfma_f32_32x32x16_bf16(pa1, PK(l1, h1), od, 0, 0, 0);
    od = __builtin_amdgcn_mfma_f32_32x32x16_bf16(pa2, PK(l2, h2), od, 0, 0, 0);
    od = __builtin_amdgcn_mfma_f32_32x32x16_bf16(pa3, PK(l3, h3), od, 0, 0, 0);
#undef PK
}
__device__ __forceinline__ void pv_d0(f32x16* o, int vb, bf16x8 pa0, bf16x8 pa1, bf16x8 pa2, bf16x8 pa3) {
    pv_one<0>(o[0], vb, pa0, pa1, pa2, pa3); pv_one<1>(o[1], vb, pa0, pa1, pa2, pa3); pv_one<2>(o[2], vb, pa0, pa1, pa2, pa3); pv_one<3>(o[3], vb, pa0, pa1, pa2, pa3);
}
template <bool O8> __device__ __forceinline__ void attn_unit(const bf16_t* __restrict__ Q, const bf16_t* __restrict__ Kp, bf16_t* __restrict__ O, int t0, int kbase, int nt_real, LAS char* lds, int wid) {
    int lane_ = lane_id(); asm volatile("" : "+v"(lane_));
    const int lane = lane_, tid = wid * 64 + lane, r32 = lane & 31, hi = lane >> 5;
    LAS char* V_lds = lds + OFF_V; LAS char* K_lds = lds + OFF_K;
    LAS float* ws = (LAS float*)(lds + OFF_WS) + wid * 64; LAS float* li_l = ws; LAS float* al_l = ws + 32;
    float m_reg = -1e30f, l_reg = 0; f32x16 o[4] = {}; bf16x8 qr[8];
    LAS char* qlds = lds + OFF_Q + wid * 4096 + lane * 16;
    const char* Qs = (const char*)Q + (size_t)t0 * 3072 + wid * (QKD * 2); const unsigned qlo = (unsigned)(r32 * 3072 + hi * 16);
#pragma unroll
    for (int d0 = 0; d0 < 8; ++d0) qr[d0] = *reinterpret_cast<const bf16x8*>(Qs + qlo + d0 * 32);
    __syncthreads();
#pragma unroll
    for (int d0 = 8; d0 < 12; ++d0) *reinterpret_cast<LAS bf16x8*>(qlds + (d0 - 8) * 1024) = *reinterpret_cast<const bf16x8*>(Qs + qlo + d0 * 32);
    const int vb0 = (int)(uintptr_t)V_lds + v_rd_base(lane);
    const LAS char* kb4[4];
#pragma unroll
    for (int q = 0; q < 4; ++q) kb4[q] = K_lds + r32 * 384 + ((q * 32 + hi * 16) ^ (((r32 >> 1) & 7) << 4));
    const int NT = (nt_real + 1) & ~1;
    const bool dummy = (NT != nt_real);
    bf16x8 sr_[1][3];
    const char* Kg = (const char*)(Kp + (size_t)kbase * QKD);
#define SLOAD(s, kt) do { _Pragma("unroll") for (int i = 0; i < 3; ++i) sr_[s][i] = *reinterpret_cast<const bf16x8*>(Kg + (size_t)(kt) * SHM_K + i * 8192 + (unsigned)(tid * 16)); } while (0)
#define SWRITE(b, s) do { int tl_ = lane_id(); asm volatile("" : "+v"(tl_)); tl_ += wid * 64; _Pragma("unroll") for (int i = 0; i < 3; ++i) { const int p_ = tl_ + 512 * i, row_ = p_ / 24, c16_ = p_ - row_ * 24; \
        *(LAS bf16x8*)(K_lds + (b) * SHM_K + KSWZ(row_, c16_ * 16)) = sr_[s][i]; if (c16_ < 16) *(LAS bf16x8*)(V_lds + (b) * SHM_V + v_st(row_, c16_ * 8)) = sr_[s][i]; } } while (0)
#define SWAIT() asm volatile("s_waitcnt vmcnt(0)" ::: "memory")
#define RESC(a) do { if (__any((a) < 1.f)) { if (hi == 0) al_l[r32] = (a); asm volatile("s_waitcnt lgkmcnt(0)" ::: "memory"); \
    _Pragma("unroll") for (int d = 0; d < 4; ++d) _Pragma("unroll") for (int r = 0; r < 16; ++r) o[d][r] *= al_l[crow(r, hi)]; } } while (0)
    f32x16 pA0, pA1, pB0, pB1; float mnA, mnB, alA, alB; bf16x8 pa0, pa1, pa2, pa3;
    SLOAD(0, 0); SWAIT(); SWRITE(0, 0); __syncthreads();
    qkt<0>(pA0, pA1, kb4, qr, qlds); partialSM(pA0, pA1, m_reg, mnA, alA);
    SLOAD(0, 1); SWAIT(); SWRITE(1, 0); __syncthreads();
    for (int j = 1; j + 1 < NT; j += 2) {
        SBAR(); qkt<1>(pB0, pB1, kb4, qr, qlds);
        finishSM(pA0, pA1, alA, l_reg, pa0, pa1, pa2, pa3); SBAR();
        SLOAD(0, j + 1); SBAR();
        pv_d0(o, vb0, pa0, pa1, pa2, pa3); partialSM(pB0, pB1, m_reg, mnB, alB);
        __syncthreads(); SWAIT(); SWRITE(0, 0);
        RESC(alB); __syncthreads();
        SBAR(); qkt<0>(pA0, pA1, kb4, qr, qlds);
        finishSM(pB0, pB1, alB, l_reg, pa0, pa1, pa2, pa3); SBAR();
        SLOAD(0, j + 2); SBAR();
        pv_d0(o, vb0 + SHM_V, pa0, pa1, pa2, pa3); partialSM(pA0, pA1, m_reg, mnA, alA);
        __syncthreads(); SWAIT(); SWRITE(1, 0);
        RESC(alA); __syncthreads();
    }
    SBAR(); qkt<1>(pB0, pB1, kb4, qr, qlds);
    if (dummy) {
#pragma unroll
        for (int r = 0; r < 16; ++r) { pB0[r] = -INFINITY; pB1[r] = -INFINITY; } }
    finishSM(pA0, pA1, alA, l_reg, pa0, pa1, pa2, pa3); SBAR();
    pv_d0(o, vb0, pa0, pa1, pa2, pa3); partialSM(pB0, pB1, m_reg, mnB, alB);
    __syncthreads(); RESC(alB);
    finishSM(pB0, pB1, alB, l_reg, pa0, pa1, pa2, pa3); SBAR();
    pv_d0(o, vb0 + SHM_V, pa0, pa1, pa2, pa3);
    {
        int lanee = lane_id(); asm volatile("" : "+v"(lanee));
        const int wide = wid, r32e = lanee & 31, hie = lanee >> 5;
        LAS float* lie = (LAS float*)(lds + OFF_WS) + wide * 64;
        if (hie == 0) lie[r32e] = l_reg; asm volatile("s_waitcnt lgkmcnt(0)" ::: "memory");
        char* Os = (char*)O + (size_t)t0 * (O8 ? 1024 : 2048) + wide * (O8 ? 128 : 256); const unsigned olo = (unsigned)(r32e * (O8 ? 1 : 2));
#pragma unroll
        for (int r = 0; r < 16; ++r) { const int orow = crow(r, hie); const float rl = __builtin_amdgcn_rcpf(lie[orow]);
#pragma unroll
            for (int d0 = 0; d0 < 4; ++d0) { if constexpr (O8) *(unsigned char*)(Os + olo + (unsigned)(orow * 1024) + d0 * 32) = (unsigned char)(pk4_fp8(16.0f * o[d0][r] * rl, 0.f, 0.f, 0.f) & 0xffu);
                else *(bf16_t*)(Os + olo + (unsigned)(orow * 2048) + d0 * 64) = (bf16_t)(cvt_pk_bf16(o[d0][r] * rl, 0.f) & 0xffffu); } }
    }
#undef SLOAD
#undef SWRITE
#undef SWAIT
#undef RESC
}
constexpr int SLOT = 24576, ROPE_OFF = 16384, NSLOT = 3, OFF_WS2 = NSLOT * SLOT, OFF_Q2 = OFF_WS2 + 2048;
__device__ __forceinline__ unsigned xrow(unsigned row) { return ((row & 3u) << 2) | ((row >> 2) & 3u); }
__device__ __forceinline__ void qkt2(f32x16& p0, f32x16& p1, const unsigned rb, const unsigned rr, const bf16x8* qr, const LAS char* ql) {
    p0 = f32x16{}; p1 = f32x16{};
#pragma unroll
    for (int d0 = 0; d0 < 12; ++d0) {
        const unsigned ad = d0 < 8 ? (rb ^ (unsigned)(d0 << 5)) : (rr ^ (unsigned)((d0 - 8) << 5));
        const bf16x8 b0 = *reinterpret_cast<const LAS bf16x8*>((LAS char*)(uintptr_t)ad);
        const bf16x8 b1 = *reinterpret_cast<const LAS bf16x8*>((LAS char*)(uintptr_t)(ad + (d0 < 8 ? 8192u : 4096u)));
        const bf16x8 qf = qr[d0]; (void)ql;
        p0 = __builtin_amdgcn_mfma_f32_32x32x16_bf16(b0, qf, p0, 0, 0, 0);
        p1 = __builtin_amdgcn_mfma_f32_32x32x16_bf16(b1, qf, p1, 0, 0, 0); }
}
__device__ __forceinline__ s16x4 tr_rd(unsigned ad) { s16x4 r; asm volatile("ds_read_b64_tr_b16 %0, %1" : "=&v"(r) : "v"(ad) : "memory"); return r; }
template <int KS> __device__ __forceinline__ s16x4 tr_rdo(unsigned ad) { s16x4 r; asm volatile("ds_read_b64_tr_b16 %0, %1 offset:%2" : "=&v"(r) : "v"(ad), "i"(KS * 4096) : "memory"); return r; }
struct VStep { s16x4 l[4], h[4]; };
template <int KS> __device__ __forceinline__ void pv_reads_ks(VStep& f, const unsigned bt0, const unsigned bt1) {
    f.l[0] = tr_rdo<KS>(bt0); f.h[0] = tr_rdo<KS>(bt1); f.l[1] = tr_rdo<KS>(bt0 ^ 64u); f.h[1] = tr_rdo<KS>(bt1 ^ 64u);
    f.l[2] = tr_rdo<KS>(bt0 ^ 128u); f.h[2] = tr_rdo<KS>(bt1 ^ 128u); f.l[3] = tr_rdo<KS>(bt0 ^ 192u); f.h[3] = tr_rdo<KS>(bt1 ^ 192u);
}
__device__ __forceinline__ void pv_mma_ks(f32x16* o, const VStep& f, bf16x8 pa) {
#define PK(L, H) (bf16x8){L[0], L[1], L[2], L[3], H[0], H[1], H[2], H[3]}
    o[0] = __builtin_amdgcn_mfma_f32_32x32x16_bf16(pa, PK(f.l[0], f.h[0]), o[0], 0, 0, 0);
    o[1] = __builtin_amdgcn_mfma_f32_32x32x16_bf16(pa, PK(f.l[1], f.h[1]), o[1], 0, 0, 0);
    o[2] = __builtin_amdgcn_mfma_f32_32x32x16_bf16(pa, PK(f.l[2], f.h[2]), o[2], 0, 0, 0);
    o[3] = __builtin_amdgcn_mfma_f32_32x32x16_bf16(pa, PK(f.l[3], f.h[3]), o[3], 0, 0, 0);
#undef PK
}
__device__ __forceinline__ void pv2(f32x16* o, const unsigned bt0, const unsigned bt1, bf16x8 pa0, bf16x8 pa1, bf16x8 pa2, bf16x8 pa3) {
    VStep fa, fb;
    pv_reads_ks<0>(fa, bt0, bt1);
    pv_reads_ks<1>(fb, bt0, bt1); asm volatile("s_waitcnt lgkmcnt(8)" ::: "memory"); SBAR(); pv_mma_ks(o, fa, pa0); SBAR();
    pv_reads_ks<2>(fa, bt0, bt1); asm volatile("s_waitcnt lgkmcnt(8)" ::: "memory"); SBAR(); pv_mma_ks(o, fb, pa1); SBAR();
    pv_reads_ks<3>(fb, bt0, bt1); asm volatile("s_waitcnt lgkmcnt(8)" ::: "memory"); SBAR(); pv_mma_ks(o, fa, pa2); SBAR();
    asm volatile("s_waitcnt lgkmcnt(0)" ::: "memory"); SBAR(); pv_mma_ks(o, fb, pa3);
}
template <bool O8> __device__ __forceinline__ void attn_unit2(const bf16_t* __restrict__ Q, const bf16_t* __restrict__ Kp, bf16_t* __restrict__ O, int t0, int kbase, int nt_real, LAS char* lds, int wid) {
    int lane_ = lane_id(); asm volatile("" : "+v"(lane_));
    const int lane = lane_, r32 = lane & 31, hi = lane >> 5;
    LAS float* ws = (LAS float*)(lds + OFF_WS2) + wid * 64; LAS float* al_l = ws + 32;
    float m_reg = -1e30f, l_reg = 0; f32x16 o[4] = {}; bf16x8 qr[12];
    LAS char* qlds = lds + OFF_Q2 + wid * 4096 + lane * 16;
    const char* Qs = (const char*)Q + (size_t)t0 * 3072 + wid * (QKD * 2); const unsigned qlo = (unsigned)(r32 * 3072 + hi * 16);
#pragma unroll
    for (int d0 = 0; d0 < 12; ++d0) qr[d0] = *reinterpret_cast<const bf16x8*>(Qs + qlo + d0 * 32);
    asm volatile("s_waitcnt vmcnt(0)" ::: "memory");
    __builtin_amdgcn_s_barrier(); asm volatile("" ::: "memory");
    const unsigned lds0 = (unsigned)(uintptr_t)lds;
    const unsigned rb0 = lds0 + 256u * r32 + 16u * ((unsigned)hi ^ xrow(r32));
    const unsigned rr0 = lds0 + ROPE_OFF + 128u * r32 + 16u * ((unsigned)hi ^ ((r32 >> 1) & 7u));
    const unsigned tq = (lane & 15) >> 2, tp = lane & 3, tblk = (lane >> 4) & 1;
    const unsigned bt00 = lds0 + 256u * (8u * hi + tq) + 64u * tq + 16u * ((2u * tblk + (tp >> 1)) ^ (2u * hi)) + 8u * (tp & 1);
    const unsigned bt10 = lds0 + 256u * (8u * hi + 4u + tq) + 64u * tq + 16u * ((2u * tblk + (tp >> 1)) ^ (2u * hi + 1u)) + 8u * (tp & 1);
    unsigned so[3];
    { const unsigned q0 = (unsigned)wid * 64u + lane, q1 = q0 + 512u; const unsigned r0 = q0 >> 4, r1 = q1 >> 4, r2 = q0 >> 3;
      so[0] = r0 * 384u + 16u * ((q0 & 15u) ^ xrow(r0)); so[1] = r1 * 384u + 16u * ((q1 & 15u) ^ xrow(r1)); so[2] = r2 * 384u + 256u + 16u * ((q0 & 7u) ^ ((r2 >> 1) & 7u)); }
    const char* Kg = (const char*)(Kp + (size_t)kbase * QKD);
    const int NT = (nt_real + 1) & ~1; const bool dummy = (NT != nt_real);
#define DMA(kt, sl) do { const char* tb_ = Kg + (size_t)(kt) * SLOT; LAS char* db_ = lds + (sl) + wid * 1024; \
        __builtin_amdgcn_global_load_lds((const unsigned*)(tb_ + so[0]), (LAS unsigned*)(db_), 16, 0, 0); \
        __builtin_amdgcn_global_load_lds((const unsigned*)(tb_ + so[1]), (LAS unsigned*)(db_ + 8192), 16, 0, 0); \
        __builtin_amdgcn_global_load_lds((const unsigned*)(tb_ + so[2]), (LAS unsigned*)(db_ + ROPE_OFF), 16, 0, 0); } while (0)
#define WAITBAR() do { asm volatile("s_waitcnt vmcnt(0) lgkmcnt(0)" ::: "memory"); __builtin_amdgcn_s_barrier(); asm volatile("" ::: "memory"); } while (0)
#define RESC(a) do { if (__any((a) < 1.f)) { if (hi == 0) al_l[r32] = (a); asm volatile("s_waitcnt lgkmcnt(0)" ::: "memory"); \
    _Pragma("unroll") for (int d = 0; d < 4; ++d) _Pragma("unroll") for (int r = 0; r < 16; ++r) o[d][r] *= al_l[crow(r, hi)]; } } while (0)
    f32x16 pA0, pA1, pB0, pB1; float mnA, mnB, alA, alB; bf16x8 pa0, pa1, pa2, pa3;
    int sc = 0, sn = SLOT, sp = 2 * SLOT;
#define ROT() do { const int t_ = sp; sp = sc; sc = sn; sn = t_; } while (0)
    DMA(0, 0);
    WAITBAR(); DMA(1, sn);
    qkt2(pA0, pA1, rb0 + sc, rr0 + sc, qr, qlds); partialSM(pA0, pA1, m_reg, mnA, alA);
    ROT();
#pragma unroll 1
    for (int j = 1; j + 1 < NT; j += 2) {
        WAITBAR(); DMA(j + 1, sn);
        SBAR(); qkt2(pB0, pB1, rb0 + sc, rr0 + sc, qr, qlds);
        finishSM(pA0, pA1, alA, l_reg, pa0, pa1, pa2, pa3); SBAR();
        pv2(o, bt00 + sp, bt10 + sp, pa0, pa1, pa2, pa3); partialSM(pB0, pB1, m_reg, mnB, alB);
        RESC(alB); ROT();
        WAITBAR(); DMA(j + 2, sn);
        SBAR(); qkt2(pA0, pA1, rb0 + sc, rr0 + sc, qr, qlds);
        finishSM(pB0, pB1, alB, l_reg, pa0, pa1, pa2, pa3); SBAR();
        pv2(o, bt00 + sp, bt10 + sp, pa0, pa1, pa2, pa3); partialSM(pA0, pA1, m_reg, mnA, alA);
        RESC(alA); ROT();
    }
    WAITBAR();
    SBAR(); qkt2(pB0, pB1, rb0 + sc, rr0 + sc, qr, qlds);
    if (dummy) {
#pragma unroll
        for (int r = 0; r < 16; ++r) { pB0[r] = -INFINITY; pB1[r] = -INFINITY; } }
    finishSM(pA0, pA1, alA, l_reg, pa0, pa1, pa2, pa3); SBAR();
    pv2(o, bt00 + sp, bt10 + sp, pa0, pa1, pa2, pa3); partialSM(pB0, pB1, m_reg, mnB, alB);
    RESC(alB);
    finishSM(pB0, pB1, alB, l_reg, pa0, pa1, pa2, pa3); SBAR();
    pv2(o, bt00 + sc, bt10 + sc, pa0, pa1, pa2, pa3);
    {
        int lanee = lane_id(); asm volatile("" : "+v"(lanee));
        const int wide = wid, r32e = lanee & 31, hie = lanee >> 5;
        LAS float* lie = (LAS float*)(lds + OFF_WS2) + wide * 64;
        if (hie == 0) lie[r32e] = l_reg; asm volatile("s_waitcnt lgkmcnt(0)" ::: "memory");
        char* Os = (char*)O + (size_t)t0 * (O8 ? 1024 : 2048) + wide * (O8 ? 128 : 256); const unsigned olo = (unsigned)(r32e * (O8 ? 1 : 2));
#pragma unroll
        for (int r = 0; r < 16; ++r) { const int orow = crow(r, hie); const float rl = __builtin_amdgcn_rcpf(lie[orow]);
#pragma unroll
            for (int d0 = 0; d0 < 4; ++d0) { if constexpr (O8) *(unsigned char*)(Os + olo + (unsigned)(orow * 1024) + d0 * 32) = (unsigned char)(pk4_fp8(16.0f * o[d0][r] * rl, 0.f, 0.f, 0.f) & 0xffu);
                else *(bf16_t*)(Os + olo + (unsigned)(orow * 2048) + d0 * 64) = (bf16_t)(cvt_pk_bf16(o[d0][r] * rl, 0.f) & 0xffffu); } }
    }
#undef DMA
#undef WAITBAR
#undef RESC
#undef ROT
}

constexpr int SLOT8 = 20480, V8_OFF = 12288, OFF_WS3 = 3 * SLOT8;
constexpr float THR8 = 12.0f;
typedef int i32x8_t __attribute__((ext_vector_type(8)));
typedef int i32x4_t __attribute__((ext_vector_type(4)));
__device__ __forceinline__ i32x8_t ld32(unsigned a0, unsigned a1) {
    const i32x4_t x = *reinterpret_cast<const LAS i32x4_t*>((LAS char*)(uintptr_t)a0), y = *reinterpret_cast<const LAS i32x4_t*>((LAS char*)(uintptr_t)a1);
    return __builtin_shufflevector(x, y, 0, 1, 2, 3, 4, 5, 6, 7);
}
#define MFMA8(A, B, Cc, SA, SB) __builtin_amdgcn_mfma_scale_f32_32x32x64_f8f6f4(A, B, Cc, 0, 0, 0, SA, 0, SB)
__device__ __forceinline__ void qkt3(f32x16& p0, f32x16& p1, const unsigned k0, const unsigned k1, const i32x8_t* qa) {
    p0 = f32x16{}; p1 = f32x16{};
#pragma unroll
    for (int m = 0; m < 3; ++m) {
        const i32x8_t a0 = ld32(k0 + 64 * m, k1 + 64 * m), a1 = ld32(k0 + 64 * m + 6144, k1 + 64 * m + 6144);
        p0 = MFMA8(a0, qa[m], p0, 0x7d7d7d7d, 0x7c7c7c7c); p1 = MFMA8(a1, qa[m], p1, 0x7d7d7d7d, 0x7c7c7c7c); }
}
__device__ __forceinline__ void partialSM8(f32x16& p0, f32x16& p1, float& m_reg, float& mn, float& alpha, int& esc) {
    float pmax = p0[0];
#pragma unroll
    for (int r = 1; r < 16; ++r) pmax = fmaxf(pmax, p0[r]);
#pragma unroll
    for (int r = 0; r < 16; ++r) pmax = fmaxf(pmax, p1[r]);
    { auto rr = __builtin_amdgcn_permlane32_swap(__float_as_uint(pmax), __float_as_uint(pmax), false, false); pmax = fmaxf(__uint_as_float(rr[0]), __uint_as_float(rr[1])); }
    if (__builtin_expect(__all(pmax - m_reg <= THR8), 1)) { mn = m_reg; alpha = 1.f; }
    else { mn = fmaxf(m_reg, pmax); alpha = __builtin_amdgcn_exp2f(m_reg - mn); m_reg = mn; }
    const float ef = fminf(fmaxf(__builtin_ceilf(pmax - mn), -60.0f), 60.0f);
    esc = (int)ef;
    const float mo = mn + ef - 8.0f;
#pragma unroll
    for (int r = 0; r < 16; ++r) p0[r] = p0[r] - mo;
#pragma unroll
    for (int r = 0; r < 16; ++r) p1[r] = p1[r] - mo;
#pragma unroll
    for (int r = 0; r < 16; ++r) p0[r] = __builtin_amdgcn_exp2f(p0[r]);
}
__device__ __forceinline__ void finishSM8(f32x16& p0, f32x16& p1, float alpha, float& l_reg, i32x8_t& pa, int esc) {
#pragma unroll
    for (int r = 0; r < 16; ++r) p1[r] = __builtin_amdgcn_exp2f(p1[r]);
    float ps = 0;
#pragma unroll
    for (int r = 0; r < 16; ++r) ps += p0[r];
#pragma unroll
    for (int r = 0; r < 16; ++r) ps += p1[r];
    { auto rr = __builtin_amdgcn_permlane32_swap(__float_as_uint(ps), __float_as_uint(ps), false, false); ps = __uint_as_float(rr[0]) + __uint_as_float(rr[1]); }
    l_reg = l_reg * alpha + __builtin_amdgcn_ldexpf(ps, esc);
    pa[0] = (int)pk4_fp8(p0[0], p0[1], p0[2], p0[3]); pa[1] = (int)pk4_fp8(p0[4], p0[5], p0[6], p0[7]); pa[2] = (int)pk4_fp8(p0[8], p0[9], p0[10], p0[11]); pa[3] = (int)pk4_fp8(p0[12], p0[13], p0[14], p0[15]);
    pa[4] = (int)pk4_fp8(p1[0], p1[1], p1[2], p1[3]); pa[5] = (int)pk4_fp8(p1[4], p1[5], p1[6], p1[7]); pa[6] = (int)pk4_fp8(p1[8], p1[9], p1[10], p1[11]); pa[7] = (int)pk4_fp8(p1[12], p1[13], p1[14], p1[15]);
}
__device__ __forceinline__ void pv3(f32x16* o, const unsigned v0, const unsigned v1, const i32x8_t pa, const int esc) {
    const int sa = (127 + esc) * 0x01010101;
    const i32x8_t b0 = ld32(v0, v1), b1 = ld32(v0 + 2048, v1 + 2048), b2 = ld32(v0 + 4096, v1 + 4096), b3 = ld32(v0 + 6144, v1 + 6144);
    o[0] = MFMA8(pa, b0, o[0], sa, 0x7d7d7d7d); o[1] = MFMA8(pa, b1, o[1], sa, 0x7d7d7d7d);
    o[2] = MFMA8(pa, b2, o[2], sa, 0x7d7d7d7d); o[3] = MFMA8(pa, b3, o[3], sa, 0x7d7d7d7d);
}
template <bool O8> __device__ __forceinline__ void attn_unit3(const unsigned char* __restrict__ Q8, const unsigned char* __restrict__ K8, const unsigned char* __restrict__ V8T, bf16_t* __restrict__ O, int t0, int kbase, int nt_real, LAS char* lds, int wid) {
    int lane_ = lane_id(); asm volatile("" : "+v"(lane_));
    const int lane = lane_, r32 = lane & 31, hi = lane >> 5;
    LAS float* ws = (LAS float*)(lds + OFF_WS3) + wid * 64; LAS float* al_l = ws + 32;
    float m_reg = -1e30f, l_reg = 0; f32x16 o[4] = {}; i32x8_t qa[3];
    { const char* Qs = (const char*)Q8 + (size_t)t0 * 1536 + wid * QKD; const unsigned qlo = (unsigned)(r32 * 1536 + hi * 32);
#pragma unroll
      for (int m = 0; m < 3; ++m) { const i32x4_t x = *reinterpret_cast<const i32x4_t*>(Qs + qlo + 64 * m), y = *reinterpret_cast<const i32x4_t*>(Qs + qlo + 64 * m + 16); qa[m] = __builtin_shufflevector(x, y, 0, 1, 2, 3, 4, 5, 6, 7); } }
    asm volatile("s_waitcnt vmcnt(0)" ::: "memory");
    __builtin_amdgcn_s_barrier(); asm volatile("" ::: "memory");
    const unsigned lds0 = (unsigned)(uintptr_t)lds, f = (unsigned)(r32 >> 2) & 3u;
    const unsigned ka0 = lds0 + 192u * r32 + 16u * ((2u * hi) ^ f), ka1 = lds0 + 192u * r32 + 16u * ((2u * hi + 1u) ^ f);
    const unsigned va0 = lds0 + V8_OFF + 64u * r32 + 16u * ((2u * hi) ^ f), va1 = lds0 + V8_OFF + 64u * r32 + 16u * ((2u * hi + 1u) ^ f);
    unsigned so[3];
    { const unsigned s0 = (unsigned)wid * 64u + lane, s1 = s0 + 512u; const unsigned r0 = s0 / 12u, c0 = s0 - r0 * 12u, r1 = s1 / 12u, c1 = s1 - r1 * 12u, dv = s0 >> 2, cv = s0 & 3u;
      so[0] = r0 * 192u + 16u * ((c0 & ~3u) | ((c0 & 3u) ^ ((r0 >> 2) & 3u))); so[1] = r1 * 192u + 16u * ((c1 & ~3u) | ((c1 & 3u) ^ ((r1 >> 2) & 3u))); so[2] = dv * 64u + 16u * (cv ^ ((dv >> 2) & 3u)); }
    const char* Kg = (const char*)K8 + (size_t)kbase * QKD; const char* Vg = (const char*)V8T + (size_t)(kbase >> 6) * 8192;
    const int NT = (nt_real + 1) & ~1; const bool dummy = (NT != nt_real);
#define DMA(kt, sl) do { const char* tk_ = Kg + (size_t)(kt) * 12288; const char* tv_ = Vg + (size_t)(kt) * 8192; LAS char* db_ = lds + (sl) + wid * 1024; \
        __builtin_amdgcn_global_load_lds((const unsigned*)(tk_ + so[0]), (LAS unsigned*)(db_), 16, 0, 0); \
        if (wid < 4) __builtin_amdgcn_global_load_lds((const unsigned*)(tk_ + so[1]), (LAS unsigned*)(db_ + 8192), 16, 0, 0); \
        __builtin_amdgcn_global_load_lds((const unsigned*)(tv_ + so[2]), (LAS unsigned*)(db_ + V8_OFF), 16, 0, 0); } while (0)
#define WAITBAR() do { asm volatile("s_waitcnt vmcnt(0) lgkmcnt(0)" ::: "memory"); __builtin_amdgcn_s_barrier(); asm volatile("" ::: "memory"); } while (0)
#define RESC(a) do { if (__any((a) < 1.f)) { if (hi == 0) al_l[r32] = (a); asm volatile("s_waitcnt lgkmcnt(0)" ::: "memory"); \
    _Pragma("unroll") for (int d = 0; d < 4; ++d) _Pragma("unroll") for (int r = 0; r < 16; ++r) o[d][r] *= al_l[crow(r, hi)]; } } while (0)
    f32x16 pA0, pA1, pB0, pB1; float mnA, mnB, alA, alB; i32x8_t pa; int eA = 0, eB = 0;
    int sc = 0, sn = SLOT8, sp = 2 * SLOT8;
#define ROT() do { const int t_ = sp; sp = sc; sc = sn; sn = t_; } while (0)
    DMA(0, 0);
    WAITBAR(); DMA(1, sn);
    qkt3(pA0, pA1, ka0 + sc, ka1 + sc, qa); partialSM8(pA0, pA1, m_reg, mnA, alA, eA);
    ROT();
#pragma unroll 1
    for (int j = 1; j + 1 < NT; j += 2) {
        WAITBAR(); DMA(j + 1, sn);
        SBAR(); qkt3(pB0, pB1, ka0 + sc, ka1 + sc, qa);
        finishSM8(pA0, pA1, alA, l_reg, pa, eA); SBAR();
        pv3(o, va0 + sp, va1 + sp, pa, eA); partialSM8(pB0, pB1, m_reg, mnB, alB, eB);
        RESC(alB); ROT();
        WAITBAR(); DMA(j + 2, sn);
        SBAR(); qkt3(pA0, pA1, ka0 + sc, ka1 + sc, qa);
        finishSM8(pB0, pB1, alB, l_reg, pa, eB); SBAR();
        pv3(o, va0 + sp, va1 + sp, pa, eB); partialSM8(pA0, pA1, m_reg, mnA, alA, eA);
        RESC(alA); ROT();
    }
    WAITBAR();
    SBAR(); qkt3(pB0, pB1, ka0 + sc, ka1 + sc, qa);
    if (dummy) {
#pragma unroll
        for (int r = 0; r < 16; ++r) { pB0[r] = -INFINITY; pB1[r] = -INFINITY; } }
    finishSM8(pA0, pA1, alA, l_reg, pa, eA); SBAR();
    pv3(o, va0 + sp, va1 + sp, pa, eA); partialSM8(pB0, pB1, m_reg, mnB, alB, eB);
    RESC(alB);
    finishSM8(pB0, pB1, alB, l_reg, pa, eB); SBAR();
    pv3(o, va0 + sc, va1 + sc, pa, eB);
    {   int lanee = lane_id(); asm volatile("" : "+v"(lanee));
        const int wide = wid, r32e = lanee & 31, hie = lanee >> 5;
        LAS float* lie = (LAS float*)(lds + OFF_WS3) + wide * 64;
        if (hie == 0) lie[r32e] = l_reg; asm volatile("s_waitcnt lgkmcnt(0)" ::: "memory");
        char* Os = (char*)O + (size_t)t0 * (O8 ? 1024 : 2048) + wide * (O8 ? 128 : 256); const unsigned olo = (unsigned)(r32e * (O8 ? 1 : 2));
#pragma unroll
        for (int r = 0; r < 16; ++r) { const int orow = crow(r, hie); const float rl = __builtin_amdgcn_rcpf(lie[orow]);
#pragma unroll
            for (int d0 = 0; d0 < 4; ++d0) { if constexpr (O8) *(unsigned char*)(Os + olo + (unsigned)(orow * 1024) + d0 * 32) = (unsigned char)(pk4_fp8(16.0f * o[d0][r] * rl, 0.f, 0.f, 0.f) & 0xffu);
                else *(bf16_t*)(Os + olo + (unsigned)(orow * 2048) + d0 * 64) = (bf16_t)(cvt_pk_bf16(o[d0][r] * rl, 0.f) & 0xffffu); } }
    }
#undef DMA
#undef WAITBAR
#undef RESC
#undef ROT
}


typedef float f32x4_t __attribute__((ext_vector_type(4)));
typedef short s16x2_t __attribute__((ext_vector_type(2)));
__device__ __forceinline__ void partialSM9(f32x16& p0, f32x16& p1, float& m_reg, float& mn, float& alpha, int& esc) {
    float pmax = p0[0];
#pragma unroll
    for (int r = 1; r < 16; ++r) pmax = fmaxf(pmax, p0[r]);
#pragma unroll
    for (int r = 0; r < 16; ++r) pmax = fmaxf(pmax, p1[r]);
    { auto rr = __builtin_amdgcn_permlane32_swap(__float_as_uint(pmax), __float_as_uint(pmax), false, false); pmax = fmaxf(__uint_as_float(rr[0]), __uint_as_float(rr[1])); }
    if (__builtin_expect(__all(pmax - m_reg <= THR8), 1)) { mn = m_reg; alpha = 1.f; }
    else { mn = fmaxf(m_reg, pmax); alpha = __builtin_amdgcn_exp2f(m_reg - mn); m_reg = mn; }
    float ef = fminf(fmaxf(__builtin_ceilf(pmax - mn), -60.0f), 60.0f);
    { auto rr = __builtin_amdgcn_permlane16_swap(__float_as_uint(ef), __float_as_uint(ef), false, false); ef = fmaxf(__uint_as_float(rr[0]), __uint_as_float(rr[1])); }
    esc = (int)ef;
    const float mo = mn + ef - 8.0f;
#pragma unroll
    for (int r = 0; r < 16; ++r) p0[r] = p0[r] - mo;
#pragma unroll
    for (int r = 0; r < 16; ++r) p1[r] = p1[r] - mo;
#pragma unroll
    for (int r = 0; r < 16; ++r) p0[r] = __builtin_amdgcn_exp2f(p0[r]);
}
__device__ __forceinline__ unsigned pk4_fp8t(float a, float b, float c2, float d) { int w = __builtin_amdgcn_cvt_pk_fp8_f32(a, b, __float_as_int(a), false); return (unsigned)__builtin_amdgcn_cvt_pk_fp8_f32(c2, d, w, true); }
__device__ __forceinline__ void finishSM9(f32x16& p0, f32x16& p1, i32x8_t& pa) {
#pragma unroll
    for (int r = 0; r < 16; ++r) p1[r] = __builtin_amdgcn_exp2f(p1[r]);
    pa[0] = (int)pk4_fp8t(p0[0], p0[1], p0[2], p0[3]); pa[1] = (int)pk4_fp8t(p0[4], p0[5], p0[6], p0[7]); pa[2] = (int)pk4_fp8t(p0[8], p0[9], p0[10], p0[11]); pa[3] = (int)pk4_fp8t(p0[12], p0[13], p0[14], p0[15]);
    pa[4] = (int)pk4_fp8t(p1[0], p1[1], p1[2], p1[3]); pa[5] = (int)pk4_fp8t(p1[4], p1[5], p1[6], p1[7]); pa[6] = (int)pk4_fp8t(p1[8], p1[9], p1[10], p1[11]); pa[7] = (int)pk4_fp8t(p1[12], p1[13], p1[14], p1[15]);
}
__device__ __forceinline__ void pv4(f32x16* o, f32x4_t& lacc, const i32x8_t selb, const unsigned v0, const unsigned v1, const i32x8_t pa, const int esc) {
    const int sa = (127 + esc) * 0x01010101;
    const i32x8_t b0 = ld32(v0, v1), b1 = ld32(v0 + 2048, v1 + 2048), b2 = ld32(v0 + 4096, v1 + 4096), b3 = ld32(v0 + 6144, v1 + 6144);
    o[0] = MFMA8(pa, b0, o[0], sa, 0x7d7d7d7d); o[1] = MFMA8(pa, b1, o[1], sa, 0x7d7d7d7d);
    o[2] = MFMA8(pa, b2, o[2], sa, 0x7d7d7d7d); o[3] = MFMA8(pa, b3, o[3], sa, 0x7d7d7d7d);
    lacc = __builtin_amdgcn_mfma_scale_f32_16x16x128_f8f6f4(pa, selb, lacc, 0, 0, 0, sa, 0, 0x7f7f7f7f);
}
template <bool O8> __device__ __forceinline__ void attn_unit5(const unsigned char* __restrict__ Q8, const unsigned char* __restrict__ K8, const unsigned char* __restrict__ V8T, bf16_t* __restrict__ O, int t0, int kbase, int nt_real, LAS char* lds, int wid) {
    int lane_ = lane_id(); asm volatile("" : "+v"(lane_));
    const int lane = lane_, r32 = lane & 31, hi = lane >> 5;
    LAS float* ws = (LAS float*)(lds + OFF_WS3) + wid * 64; LAS float* al_l = ws + 32;
    float m_reg = -1e30f; f32x16 o[4] = {}; i32x8_t qa[3];
    f32x4_t lacc = {0.f, 0.f, 0.f, 0.f}; const int selv = ((lane & 15) < 2 && (((lane >> 4) ^ lane) & 1) == 0) ? 0x38383838 : 0; const i32x8_t selb = {selv, selv, selv, selv, selv, selv, selv, selv};
    const int lrow = (lane & 1) * 16 + 4 * (lane >> 4);
    { const char* Qs = (const char*)Q8 + (size_t)t0 * 1536 + wid * QKD; const unsigned qlo = (unsigned)(r32 * 1536 + hi * 32);
#pragma unroll
      for (int m = 0; m < 3; ++m) { const i32x4_t x = *reinterpret_cast<const i32x4_t*>(Qs + qlo + 64 * m), y = *reinterpret_cast<const i32x4_t*>(Qs + qlo + 64 * m + 16); qa[m] = __builtin_shufflevector(x, y, 0, 1, 2, 3, 4, 5, 6, 7); } }
    asm volatile("s_waitcnt vmcnt(0)" ::: "memory");
    __builtin_amdgcn_s_barrier(); asm volatile("" ::: "memory");
    const unsigned lds0 = (unsigned)(uintptr_t)lds, f = (unsigned)(r32 >> 2) & 3u;
    const unsigned ka0 = lds0 + 192u * r32 + 16u * ((2u * hi) ^ f), ka1 = lds0 + 192u * r32 + 16u * ((2u * hi + 1u) ^ f);
    const unsigned va0 = lds0 + V8_OFF + 64u * r32 + 16u * ((2u * hi) ^ f), va1 = lds0 + V8_OFF + 64u * r32 + 16u * ((2u * hi + 1u) ^ f);
    unsigned so[3];
    { const unsigned s0 = (unsigned)wid * 64u + lane, s1 = s0 + 512u; const unsigned r0 = s0 / 12u, c0 = s0 - r0 * 12u, r1 = s1 / 12u, c1 = s1 - r1 * 12u, dv = s0 >> 2, cv = s0 & 3u;
      so[0] = r0 * 192u + 16u * ((c0 & ~3u) | ((c0 & 3u) ^ ((r0 >> 2) & 3u))); so[1] = r1 * 192u + 16u * ((c1 & ~3u) | ((c1 & 3u) ^ ((r1 >> 2) & 3u))); so[2] = dv * 64u + 16u * (cv ^ ((dv >> 2) & 3u)); }
    const char* Kg = (const char*)K8 + (size_t)kbase * QKD; const char* Vg = (const char*)V8T + (size_t)(kbase >> 6) * 8192;
    const int NT = (nt_real + 1) & ~1; const bool dummy = (NT != nt_real);
#define DMA(kt, sl) do { const char* tk_ = Kg + (size_t)(kt) * 12288; const char* tv_ = Vg + (size_t)(kt) * 8192; LAS char* db_ = lds + (sl) + wid * 1024; \
        __builtin_amdgcn_global_load_lds((const unsigned*)(tk_ + so[0]), (LAS unsigned*)(db_), 16, 0, 0); \
        if (wid < 4) __builtin_amdgcn_global_load_lds((const unsigned*)(tk_ + so[1]), (LAS unsigned*)(db_ + 8192), 16, 0, 0); \
        __builtin_amdgcn_global_load_lds((const unsigned*)(tv_ + so[2]), (LAS unsigned*)(db_ + V8_OFF), 16, 0, 0); } while (0)
#define WAITBAR() do { asm volatile("s_waitcnt vmcnt(0) lgkmcnt(0)" ::: "memory"); __builtin_amdgcn_s_barrier(); asm volatile("" ::: "memory"); } while (0)
#define RESC(a) do { if (__any((a) < 1.f)) { if (hi == 0) al_l[r32] = (a); asm volatile("s_waitcnt lgkmcnt(0)" ::: "memory"); \
    _Pragma("unroll") for (int d = 0; d < 4; ++d) _Pragma("unroll") for (int r = 0; r < 16; ++r) o[d][r] *= al_l[crow(r, hi)]; \
    _Pragma("unroll") for (int r = 0; r < 4; ++r) lacc[r] *= al_l[lrow + r]; } } while (0)
    f32x16 pA0, pA1, pB0, pB1; float mnA, mnB, alA, alB; i32x8_t pa; int eA = 0, eB = 0;
    int sc = 0, sn = SLOT8, sp = 2 * SLOT8;
#define ROT() do { const int t_ = sp; sp = sc; sc = sn; sn = t_; } while (0)
    DMA(0, 0);
    WAITBAR(); DMA(1, sn);
    qkt3(pA0, pA1, ka0 + sc, ka1 + sc, qa); partialSM9(pA0, pA1, m_reg, mnA, alA, eA);
    ROT();
#pragma unroll 1
    for (int j = 1; j + 1 < NT; j += 2) {
        WAITBAR(); DMA(j + 1, sn);
        SBAR(); qkt3(pB0, pB1, ka0 + sc, ka1 + sc, qa);
        finishSM9(pA0, pA1, pa); SBAR();
        pv4(o, lacc, selb, va0 + sp, va1 + sp, pa, eA); partialSM9(pB0, pB1, m_reg, mnB, alB, eB);
        RESC(alB); ROT();
        WAITBAR(); DMA(j + 2, sn);
        SBAR(); qkt3(pA0, pA1, ka0 + sc, ka1 + sc, qa);
        finishSM9(pB0, pB1, pa); SBAR();
        pv4(o, lacc, selb, va0 + sp, va1 + sp, pa, eB); partialSM9(pA0, pA1, m_reg, mnA, alA, eA);
        RESC(alA); ROT();
    }
    WAITBAR();
    SBAR(); qkt3(pB0, pB1, ka0 + sc, ka1 + sc, qa);
    if (dummy) {
#pragma unroll
        for (int r = 0; r < 16; ++r) { pB0[r] = -INFINITY; pB1[r] = -INFINITY; } }
    finishSM9(pA0, pA1, pa); SBAR();
    pv4(o, lacc, selb, va0 + sp, va1 + sp, pa, eA); partialSM9(pB0, pB1, m_reg, mnB, alB, eB);
    RESC(alB);
    finishSM9(pB0, pB1, pa); SBAR();
    pv4(o, lacc, selb, va0 + sc, va1 + sc, pa, eB);
    {   int lanee = lane_id(); asm volatile("" : "+v"(lanee));
        const int wide = wid, r32e = lanee & 31, hie = lanee >> 5;
        LAS float* lie = (LAS float*)(lds + OFF_WS3) + wide * 64;
        if ((lanee & 15) < 2) {
#pragma unroll
            for (int r = 0; r < 4; ++r) lie[(lanee & 1) * 16 + 4 * (lanee >> 4) + r] = lacc[r]; }
        asm volatile("s_waitcnt lgkmcnt(0)" ::: "memory");
        char* Os = (char*)O + (size_t)t0 * (O8 ? 1024 : 2048) + wide * (O8 ? 128 : 256); const unsigned olo = (unsigned)(r32e * (O8 ? 1 : 2));
#pragma unroll
        for (int r = 0; r < 16; ++r) { const int orow = crow(r, hie); const float rl = __builtin_amdgcn_rcpf(lie[orow]);
#pragma unroll
            for (int d0 = 0; d0 < 4; ++d0) { if constexpr (O8) *(unsigned char*)(Os + olo + (unsigned)(orow * 1024) + d0 * 32) = (unsigned char)(pk4_fp8(16.0f * o[d0][r] * rl, 0.f, 0.f, 0.f) & 0xffu);
                else *(bf16_t*)(Os + olo + (unsigned)(orow * 2048) + d0 * 64) = (bf16_t)(cvt_pk_bf16(o[d0][r] * rl, 0.f) & 0xffffu); } }
    }
#undef DMA
#undef WAITBAR
#undef RESC
#undef ROT
}

template <bool O8> __device__ __forceinline__ void attn_unit4(const unsigned char* __restrict__ Q8, const unsigned char* __restrict__ K8, const unsigned char* __restrict__ V8T, bf16_t* __restrict__ O, int t0, int kbase, int NT, LAS char* lds, int wid) {
    int lane_ = lane_id(); asm volatile("" : "+v"(lane_));
    const int lane = lane_, r32 = lane & 31, hi = lane >> 5; const bool trailing = wid >= 4;
    constexpr int OFF_WS4 = 4 * SLOT8;
    LAS float* ws = (LAS float*)(lds + OFF_WS4) + wid * 64; LAS float* al_l = ws + 32;
    float m_reg = -1e30f, l_reg = 0; f32x16 o[4] = {}; i32x8_t qa[3];
    { const char* Qs = (const char*)Q8 + (size_t)t0 * 1536 + wid * QKD; const unsigned qlo = (unsigned)(r32 * 1536 + hi * 32);
#pragma unroll
      for (int m = 0; m < 3; ++m) { const i32x4_t x = *reinterpret_cast<const i32x4_t*>(Qs + qlo + 64 * m), y = *reinterpret_cast<const i32x4_t*>(Qs + qlo + 64 * m + 16); qa[m] = __builtin_shufflevector(x, y, 0, 1, 2, 3, 4, 5, 6, 7); } }
    asm volatile("s_waitcnt vmcnt(0)" ::: "memory");
    __builtin_amdgcn_s_barrier(); asm volatile("" ::: "memory");
    const unsigned lds0 = (unsigned)(uintptr_t)lds, f = (unsigned)(r32 >> 2) & 3u;
    const unsigned ka0 = lds0 + 192u * r32 + 16u * ((2u * hi) ^ f), ka1 = lds0 + 192u * r32 + 16u * ((2u * hi + 1u) ^ f);
    const unsigned va0 = lds0 + V8_OFF + 64u * r32 + 16u * ((2u * hi) ^ f), va1 = lds0 + V8_OFF + 64u * r32 + 16u * ((2u * hi + 1u) ^ f);
    unsigned so[3];
    { const unsigned s0 = (unsigned)wid * 64u + lane, s1 = s0 + 512u; const unsigned r0 = s0 / 12u, c0 = s0 - r0 * 12u, r1 = s1 / 12u, c1 = s1 - r1 * 12u, dv = s0 >> 2, cv = s0 & 3u;
      so[0] = r0 * 192u + 16u * ((c0 & ~3u) | ((c0 & 3u) ^ ((r0 >> 2) & 3u))); so[1] = r1 * 192u + 16u * ((c1 & ~3u) | ((c1 & 3u) ^ ((r1 >> 2) & 3u))); so[2] = dv * 64u + 16u * (cv ^ ((dv >> 2) & 3u)); }
    const char* Kg = (const char*)K8 + (size_t)kbase * QKD; const char* Vg = (const char*)V8T + (size_t)(kbase >> 6) * 8192;
#define DMA(kt) do { const char* tk_ = Kg + (size_t)(kt) * 12288; const char* tv_ = Vg + (size_t)(kt) * 8192; LAS char* db_ = lds + ((kt) & 3) * SLOT8 + wid * 1024; \
        __builtin_amdgcn_global_load_lds((const unsigned*)(tk_ + so[0]), (LAS unsigned*)(db_), 16, 0, 0); \
        if (wid < 4) __builtin_amdgcn_global_load_lds((const unsigned*)(tk_ + so[1]), (LAS unsigned*)(db_ + 8192), 16, 0, 0); \
        __builtin_amdgcn_global_load_lds((const unsigned*)(tv_ + so[2]), (LAS unsigned*)(db_ + V8_OFF), 16, 0, 0); } while (0)
#define WAITT(younger) do { if (younger) { if (wid < 4) asm volatile("s_waitcnt vmcnt(3)" ::: "memory"); else asm volatile("s_waitcnt vmcnt(2)" ::: "memory"); } else asm volatile("s_waitcnt vmcnt(0)" ::: "memory"); } while (0)
#define BAR() do { asm volatile("s_waitcnt lgkmcnt(0)" ::: "memory"); __builtin_amdgcn_s_barrier(); asm volatile("" ::: "memory"); } while (0)
#define RESC(a) do { if (__any((a) < 1.f)) { if (hi == 0) al_l[r32] = (a); asm volatile("s_waitcnt lgkmcnt(0)" ::: "memory"); \
    _Pragma("unroll") for (int d = 0; d < 4; ++d) _Pragma("unroll") for (int r = 0; r < 16; ++r) o[d][r] *= al_l[crow(r, hi)]; } } while (0)
    f32x16 p0, p1; float mn, al; i32x8_t pa = {0, 0, 0, 0, 0, 0, 0, 0}; int esc = 0;
    DMA(0); if (1 < NT) DMA(1);
    if (trailing) { WAITT(1 < NT); BAR(); if (2 < NT) DMA(2); }
#pragma unroll 1
    for (int t = 0; t <= NT; ++t) {
        if (!trailing) { if (t < NT) WAITT(t + 1 < NT); }
        BAR();
        if (!trailing) { if (t + 2 < NT) DMA(t + 2); }
        SBAR();
        if (t >= 1) pv3(o, va0 + ((t - 1) & 3) * SLOT8, va1 + ((t - 1) & 3) * SLOT8, pa, esc);
        if (t == NT) break;
        qkt3(p0, p1, ka0 + (t & 3) * SLOT8, ka1 + (t & 3) * SLOT8, qa);
        SBAR();
        if (trailing) { if (t + 1 < NT) WAITT(t + 2 < NT); }
        BAR();
        if (trailing) { if (t + 3 < NT) DMA(t + 3); }
        partialSM8(p0, p1, m_reg, mn, al, esc);
        RESC(al);
        finishSM8(p0, p1, al, l_reg, pa, esc);
        SBAR();
    }
    if (!trailing) BAR();
    {   int lanee = lane_id(); asm volatile("" : "+v"(lanee));
        const int wide = wid, r32e = lanee & 31, hie = lanee >> 5;
        LAS float* lie = (LAS float*)(lds + OFF_WS4) + wide * 64;
        if (hie == 0) lie[r32e] = l_reg; asm volatile("s_waitcnt lgkmcnt(0)" ::: "memory");
        char* Os = (char*)O + (size_t)t0 * (O8 ? 1024 : 2048) + wide * (O8 ? 128 : 256); const unsigned olo = (unsigned)(r32e * (O8 ? 1 : 2));
#pragma unroll
        for (int r = 0; r < 16; ++r) { const int orow = crow(r, hie); const float rl = __builtin_amdgcn_rcpf(lie[orow]);
#pragma unroll
            for (int d0 = 0; d0 < 4; ++d0) { if constexpr (O8) *(unsigned char*)(Os + olo + (unsigned)(orow * 1024) + d0 * 32) = (unsigned char)(pk4_fp8(16.0f * o[d0][r] * rl, 0.f, 0.f, 0.f) & 0xffu);
                else *(bf16_t*)(Os + olo + (unsigned)(orow * 2048) + d0 * 64) = (bf16_t)(cvt_pk_bf16(o[d0][r] * rl, 0.f) & 0xffffu); } }
    }
#undef DMA
#undef WAITT
#undef BAR
#undef RESC
}
}
struct Args { const void* in[25]; float* out; unsigned char* ws; int lo, hi, l, hf; };
enum { PH_PRO = 0, PH_NA, PH_R2, PH_R3, PH_R4, PH_R5, PH_R6, PH_R7, PH_M2, PH_M3, PH_M4, PH_M5, PH_NB, PH_MOE1, PH_MOE2, PH_COUNT };

__device__ __forceinline__ void make_ctx(Ctx& C, unsigned char* lds_raw) {
    C.ka = (kaptr_t)__builtin_amdgcn_kernarg_segment_ptr(); C.lds = (LAS unsigned char*)lds_raw;
    C.wave = __builtin_amdgcn_readfirstlane((int)threadIdx.x >> 6);
    { const int bx = blockIdx.x; C.vcu = (bx & 7) * (GRID / 8) + (bx >> 3); }
}

template <int PH> __device__ __forceinline__ void run_phase(Ctx& C, const int l, const int hf, const int rep = 0) {
    PHASE_ENTRY(); const int wv = wave;
    LAS unsigned char* lds = ldsb; int bid_ = blockIdx.x; asm volatile("" : "+s"(bid_)); const int bid = bid_; const unsigned LD1K = 2048u;
    const float* gate1 = rep ? (const float*)(WSB + WS_CTL + 512 * 1024) : WSP(float, WS_MOD) + (size_t)l * 4 * 6144 + 2 * 1024;
    const bf16_t* win = WSP(bf16_t, WS_WIN) + (size_t)(l & 1) * 6144 * 1024;
    const bf16_t* xnh = WSP(bf16_t, WS_XN) + (size_t)hf * THALF * DM;
    const int j = l & 1;
    if constexpr (PH == PH_PRO) phase_prologue(C);
    if constexpr (PH == PH_NA) phase_norm_a(C, l, rep);
    if constexpr (PH == PH_R2) {
        constexpr bool FQ = (FP8_R2 & 1) != 0, FV = (FP8_R2 & 2) != 0;
        const char* X16 = (const char*)xnh; const char* X8 = (const char*)(WSP(unsigned char, WS_XN8) + (size_t)hf * THALF * DM);
        const char* W16 = (const char*)win; const char* W8 = (const char*)(WSP(unsigned char, WS_WIN8) + (size_t)(l & 1) * 6144 * 1024);
        if constexpr (FQ == FV) {
            constexpr unsigned LD = FQ ? 1024u : 2048u; constexpr int KP = FQ ? 512 : 1024; constexpr int SW = FQ ? 0x79797979 : 0x7f7f7f7f, SX = FQ ? 0x7d7d7d7d : 0x7f7f7f7f; const char* X = FQ ? X8 : X16; const char* W = FQ ? W8 : W16;
            typedef SchedCat3<SchedStd, SchedStd, SchedStd> SC; typedef EpiMux3<EpiRopeQK<0>, EpiRopeQK<1>, EpiVT> EM;
            SC S; S.n0 = 1; S.n1 = 1;
            S.s0.T.init(64, 4, GRID, bid); S.s0.A = X; S.s0.B = W; S.s0.sA = 256 * LD; S.s0.sB = 256 * LD;
            S.s1.T.init(64, 4, GRID, bid); S.s1.A = X; S.s1.B = W + (size_t)1024 * LD; S.s1.sA = 256 * LD; S.s1.sB = 256 * LD;
            S.s2.T.init(8, 64, GRID, bid); S.s2.A = W + (size_t)2048 * LD; S.s2.B = X; S.s2.sA = 256 * LD; S.s2.sB = 256 * LD;
            EM E{EpiRopeQK<0>{WSP(bf16_t, WS_A2), INI(2), hf, nullptr}, EpiRopeQK<1>{WSP(bf16_t, WS_KR), INI(2), hf, WSP(bf16_t, WS_KT)}, EpiVT{WSP(bf16_t, WS_B2T)}};
            pg8::gemm_phase<EM, SC, false, FQ, SW, SX>(lds, wv, KP, LD, LD, S, E);
        } else {
        { constexpr unsigned LD = FQ ? 1024u : 2048u; constexpr int KP = FQ ? 512 : 1024; constexpr int SW = FQ ? 0x79797979 : 0x7f7f7f7f, SX = FQ ? 0x7d7d7d7d : 0x7f7f7f7f; const char* X = FQ ? X8 : X16; const char* W = FQ ? W8 : W16;
          { SchedStd S; S.T.init(64, 4, GRID, bid); S.A = X; S.B = W; S.sA = 256 * LD; S.sB = 256 * LD;
            EpiRopeQK<0> E{WSP(bf16_t, WS_A2), INI(2), hf, nullptr}; pg8::gemm_phase<EpiRopeQK<0>, SchedStd, false, FQ, SW, SX>(lds, wv, KP, LD, LD, S, E); }
          { SchedStd S; S.T.init(64, 4, GRID, bid); S.A = X; S.B = W + (size_t)1024 * LD; S.sA = 256 * LD; S.sB = 256 * LD;
            EpiRopeQK<1> E{WSP(bf16_t, WS_KR), INI(2), hf, WSP(bf16_t, WS_KT)}; pg8::gemm_phase<EpiRopeQK<1>, SchedStd, false, FQ, SW, SX>(lds, wv, KP, LD, LD, S, E); } }
        { constexpr unsigned LD = FV ? 1024u : 2048u; constexpr int KP = FV ? 512 : 1024; constexpr int SW = FV ? 0x79797979 : 0x7f7f7f7f, SX = FV ? 0x7d7d7d7d : 0x7f7f7f7f; const char* X = FV ? X8 : X16; const char* W = FV ? W8 : W16;
          SchedStd S; S.T.init(8, 64, GRID, bid); S.A = W + (size_t)2048 * LD; S.B = X; S.sA = 256 * LD; S.sB = 256 * LD;
          EpiVT E{WSP(bf16_t, WS_B2T)}; pg8::gemm_phase<EpiVT, SchedStd, false, FV, SW, SX>(lds, wv, KP, LD, LD, S, E); }
            }
    }
    if constexpr (PH == PH_R3) {
        typedef SchedCat3<SchedBatch, SchedBatch, SchedNone> SC; typedef EpiMux3<EpiS, EpiKV, EpiNone> EM;
        SC S{SchedBatch{(const char*)WSP(bf16_t, WS_A2), (const char*)WSP(bf16_t, WS_KR), 256 * 1024, 256 * 512, 0, 0, 256, 1, GRID, vcu},
             SchedBatch{(const char*)(WSP(bf16_t, WS_B2T) + 256), (const char*)WSP(bf16_t, WS_KT), 512 * 1024, 256 * 512, 256 * 1024, 0, 256, 2, GRID, vcu}, SchedNone{}, 1, 1 << 20};
        EM E{EpiS{WSP(bf16_t, WS_A2)}, EpiKV{WSP(bf16_t, WS_B2T)}, EpiNone{}};
        pg8::gemm_phase<EM, SC, false>(lds, wv, 256, 1024u, 512u, S, E);
    }
    if constexpr (PH == PH_R4) phase_prefix(C, rep);
    if constexpr (PH == PH_R5) {
        SchedBatch S{(const char*)WSP(bf16_t, WS_A2), (const char*)WSP(bf16_t, WS_B2T), 256 * 1024, 512 * 1024, 0, 256 * 1024, 256, 2, GRID, vcu};
        EpiFin E{WSP(bf16_t, WS_B2T), WSP(float, WS_STATS), rep}; pg8::gemm_phase<EpiFin, SchedBatch, false>(lds, wv, 512, 1024u, 1024u, S, E);
    }
    if constexpr (PH == PH_R6) {
        constexpr bool F8 = FP8_R6 != 0; constexpr unsigned LD = F8 ? 1024u : 2048u; constexpr int KP = F8 ? 512 : 1024; constexpr int SW = F8 ? 0x79797979 : 0x7f7f7f7f, SX = F8 ? 0x7d7d7d7d : 0x7f7f7f7f;
        const char* X = F8 ? (const char*)(WSP(unsigned char, WS_XN8) + (size_t)hf * THALF * DM) : (const char*)xnh;
        const char* W = F8 ? (const char*)(WSP(unsigned char, WS_WIN8) + (size_t)(l & 1) * 6144 * 1024) : (const char*)win;
        SchedStd S; S.T.init(64, 8, GRID, bid); S.A = X; S.B = W + (size_t)4096 * LD; S.sA = 256 * LD; S.sB = 256 * LD;
        EpiGate<FP8_R7 != 0> E{WSP(bf16_t, WS_B2T), WSP(float, WS_STATS), WSP(bf16_t, WS_A2), WSP(unsigned char, WS_ACT8)}; pg8::gemm_phase<EpiGate<FP8_R7 != 0>, SchedStd, false, F8, SW, SX>(lds, wv, KP, LD, LD, S, E);
    }
    if constexpr (PH == PH_R7) {
        constexpr bool F8 = FP8_R7 != 0; constexpr unsigned LD = F8 ? 2048u : 4096u; constexpr int KP = F8 ? 1024 : 2048; constexpr int SW = F8 ? 0x79797979 : 0x7f7f7f7f, SX = F8 ? 0x7d7d7d7d : 0x7f7f7f7f;
        SchedStd S; S.T.init(64, 4, GRID, bid); S.A = F8 ? (const char*)WSP(unsigned char, WS_ACT8) : (const char*)WSP(bf16_t, WS_A2);
        S.B = F8 ? (const char*)(WSP(unsigned char, WS_WOUT8) + (size_t)l * 1024 * 2048) : (const char*)(WSP(bf16_t, WS_WOUT) + (size_t)l * 1024 * 2048); S.sA = 256 * LD; S.sB = 256 * LD;
        EpiResid E{WSP(bf16_t, WS_H16), gate1, hf * THALF, (l == 0 && !rep) ? INF(0) : (const float*)nullptr}; pg8::gemm_phase<EpiResid, SchedStd, false, F8, SW, SX>(lds, wv, KP, LD, LD, S, E);
    }
    if constexpr (PH == PH_M2) {
        { constexpr bool F8 = FP8_M2 != 0; constexpr unsigned LD = F8 ? 1024u : 2048u; constexpr int KP = F8 ? 512 : 1024; constexpr int SW = F8 ? 0x79797979 : 0x7f7f7f7f, SX = F8 ? 0x7d7d7d7d : 0x7f7f7f7f;
          SchedStd S; S.T.init(128, 1, GRID, bid); S.A = F8 ? (const char*)WSP(unsigned char, WS_XN8) : (const char*)WSP(bf16_t, WS_XN);
          S.B = F8 ? (const char*)(WSP(unsigned char, WS_WQA8) + (size_t)j * 256 * 1024) : (const char*)(WSP(bf16_t, WS_WQA) + (size_t)j * 256 * 1024); S.sA = 256 * LD; S.sB = 256 * LD;
          EpiQA E{WSP(bf16_t, WS_QA), WSP(float, WS_SSQ), FP8_M3 ? WSP(unsigned char, WS_QA8) : (unsigned char*)nullptr}; pg8::gemm_phase<EpiQA, SchedStd, false, F8, SW, SX>(lds, wv, KP, LD, LD, S, E); }
        if (l == 2) { SchedStd S; S.T.init(128, 1, GRID, (bid + 128) & 255); S.A = (const char*)WSP(bf16_t, WS_HN); S.B = (const char*)WSP(bf16_t, WS_WKVA); S.sA = 256 * 2048; S.sB = 256 * 2048;
          EpiF32 E{WSP(float, WS_AKV)}; pg8::gemm_phase<EpiF32, SchedStd, false>(lds, wv, 1024, LD1K, LD1K, S, E); }
    }
    if constexpr (PH == PH_M3) {
        if (l == 2) phase_kvfin(C);
        constexpr bool F8 = FP8_M3 != 0; constexpr unsigned LD = F8 ? 256u : 512u; constexpr int KP = F8 ? 128 : 256; constexpr int SW = F8 ? 0x79797979 : 0x7f7f7f7f, SX = F8 ? 0x7d7d7d7d : 0x7f7f7f7f;
        SchedStd S; S.T.init(128, 6, GRID, bid); S.A = F8 ? (const char*)WSP(unsigned char, WS_QA8) : (const char*)WSP(bf16_t, WS_QA);
        S.B = F8 ? (const char*)(WSP(unsigned char, WS_WQB8) + (size_t)j * 1536 * 256) : (const char*)(WSP(bf16_t, WS_WQB) + (size_t)j * 1536 * 256); S.sA = 256 * LD; S.sB = 256 * LD;
        EpiQB<ATT_FP8 != 0> E{WSP(bf16_t, WS_Q), WSP(float, WS_SSQ), INI(2)}; pg8::gemm_phase<EpiQB<ATT_FP8 != 0>, SchedStd, false, F8, SW, SX>(lds, wv, KP, LD, LD, S, E);
    }
    if constexpr (PH == PH_M4) {
        const int b = vcu >> 6, i = vcu & 63;
#pragma unroll 1
        for (int uq = 0; uq < 4; ++uq) { const int cch = (uq < 2) ? (127 - i) : i, half = uq & 1;
            if constexpr (ATT_FP8 != 0) att::attn_unit5<FP8_M5 != 0>(WSP(unsigned char, WS_Q), WSP(unsigned char, WS_K8), WSP(unsigned char, WS_V8T), FP8_M5 ? (bf16_t*)WSP(unsigned char, WS_ACT8) : WSP(bf16_t, WS_OL), b * SEQ + cch * 64 + half * 32, b * SEQ, cch + 1, (LAS char*)lds, wave);
            else att::attn_unit2<FP8_M5 != 0>(WSP(bf16_t, WS_Q), WSP(bf16_t, WS_KP), FP8_M5 ? (bf16_t*)WSP(unsigned char, WS_ACT8) : WSP(bf16_t, WS_OL), b * SEQ + cch * 64 + half * 32, b * SEQ, cch + 1, (LAS char*)lds, wave); }
        __syncthreads();
    }
    if constexpr (PH == PH_M5) {
        constexpr bool F8 = FP8_M5 != 0; constexpr unsigned LD = F8 ? 1024u : 2048u; constexpr int KP = F8 ? 512 : 1024; constexpr int SW = F8 ? 0x79797979 : 0x7f7f7f7f, SX = F8 ? 0x7b7b7b7b : 0x7f7f7f7f;
        SchedStd S; S.T.init(128, 4, GRID, bid); S.A = F8 ? (const char*)WSP(unsigned char, WS_ACT8) : (const char*)WSP(bf16_t, WS_OL);
        S.B = F8 ? (const char*)(WSP(unsigned char, WS_WO8) + (size_t)j * 1024 * 1024) : (const char*)(WSP(bf16_t, WS_WO) + (size_t)j * 1024 * 1024); S.sA = 256 * LD; S.sB = 256 * LD;
        EpiResid E{WSP(bf16_t, WS_H16), gate1, 0, (const float*)nullptr}; pg8::gemm_phase<EpiResid, SchedStd, false, F8, SW, SX>(lds, wv, KP, LD, LD, S, E);
    }
    if constexpr (PH == PH_NB) phase_norm_b(C, l, rep);
    if constexpr (PH == PH_MOE1) {
        moe_tile_prefix(C, l);
        SchedMoE S{(const LAS int*)(lds + LDS_TAB), (const char*)WSP(unsigned char, WS_XN), (const char*)(WSP(unsigned char, WS_WGU) + (size_t)l * 16 * 1024 * 1024), (size_t)1024 * 1024, (size_t)256 * 1024, 0, WSP(int, WS_IDX), GRID, vcu, true};
        EpiGU8 E{WSP(unsigned char, WS_HDN)}; pg8::gemm_phase<EpiGU8, SchedMoE, true, true, 0x79797979, 0x7d7d7d7d>(lds, wv, 512, 1024u, 1024u, S, E);
        if (l < 3 && !rep) moe_convert_tail(C, l + 1, 0, 8192);
    }
    if constexpr (PH == PH_MOE2) {
        moe_tile_prefix(C, l);
        SchedMoE S{(const LAS int*)(lds + LDS_TAB), (const char*)WSP(unsigned char, WS_HDN), (const char*)(WSP(unsigned char, WS_WDN) + (size_t)l * 16 * 1024 * 512), (size_t)1024 * 512, (size_t)256 * 512, (size_t)256 * 512, WSP(int, WS_IDX), GRID, vcu, false};
        EpiPlain8 E{WSP(unsigned char, WS_YB), 1024}; pg8::gemm_phase<EpiPlain8, SchedMoE, false, true, 0x79797979, (int)0x81818181u>(lds, wv, 256, 512u, 512u, S, E);
        if (l < 3 && !rep) moe_convert_tail(C, l + 1, 8192, 16 * 768);
    }
}

template <int PH> __global__ void __launch_bounds__(NTHREADS, 2) phase_kernel(Args args) {
    extern __shared__ __attribute__((aligned(16))) unsigned char lds_raw[];
    Ctx C; make_ctx(C, lds_raw); (void)args;
    run_phase<PH>(C, args.l, args.hf);
}
__global__ void __launch_bounds__(NTHREADS, 2) fwd_kernel(Args args) {
    extern __shared__ __attribute__((aligned(16))) unsigned char lds_raw[];
    Ctx C; make_ctx(C, lds_raw); (void)args;
    if (threadIdx.x < 64) ((LAS unsigned*)(C.lds + LDS_MISC))[threadIdx.x] = 0u;
    __syncthreads();
    XcdBarrier bar = xcd_barrier_post((unsigned*)((unsigned char*)args.ws + WS_CTL) + CW_BAR, (volatile LAS unsigned*)(C.lds + LDS_MISC));
#ifndef TS_KIND
#define TS_KIND 0
#define TS_BLK 0
#define TS_DIV 25.0f
#endif
    unsigned long long ts_acc = 0, ts_t0 = 0; (void)ts_acc; (void)ts_t0;
#if TS_KIND == 1
#define SEAM() do { const unsigned long long a_ = __builtin_amdgcn_s_memrealtime(); xcd_barrier(bar, C.wave); ts_acc += __builtin_amdgcn_s_memrealtime() - a_; } while (0)
#else
#define SEAM() xcd_barrier(bar, C.wave)
#endif
#ifndef PROBE_PH
#define PROBE_PH -1
#define PROBE_N 0
#endif
#define RUNP(PH, l, hf) do { if (TS_KIND == 100 + PH) ts_t0 = __builtin_amdgcn_s_memrealtime(); run_phase<PH>(C, l, hf); if (TS_KIND == 100 + PH) ts_acc += __builtin_amdgcn_s_memrealtime() - ts_t0; if (TS_KIND == 200 + PH) ts_t0 = __builtin_amdgcn_s_memrealtime(); SEAM(); if (TS_KIND == 200 + PH) ts_acc += __builtin_amdgcn_s_memrealtime() - ts_t0; if constexpr (PH == PROBE_PH) { _Pragma("unroll 1") for (int rp_ = 0; rp_ < PROBE_N; ++rp_) { run_phase<PH>(C, l, hf, 1); SEAM(); } } } while (0)
    RUNP(PH_PRO, 0, 0);
    for (int l = 0; l < 4; ++l) {
        RUNP(PH_NA, l, 0);
        if (l < 2) {
            for (int hf = 0; hf < 2; ++hf) { RUNP(PH_R2, l, hf); RUNP(PH_R3, l, hf); RUNP(PH_R4, l, hf); RUNP(PH_R5, l, hf); RUNP(PH_R6, l, hf); RUNP(PH_R7, l, hf); }
        } else { RUNP(PH_M2, l, 0); RUNP(PH_M3, l, 0); RUNP(PH_M4, l, 0); RUNP(PH_M5, l, 0); }
        RUNP(PH_NB, l, 0); RUNP(PH_MOE1, l, 0); RUNP(PH_MOE2, l, 0);
    }
    run_phase<PH_NA>(C, 4, 0);
#if TS_KIND != 0
    __syncthreads();
    if ((int)blockIdx.x == TS_BLK && threadIdx.x == 0) { args.out[TS_BLK == 0 ? 0 : 1] = 3.0f + floorf((float)ts_acc * (0.01f / TS_DIV)); }
    if (TS_BLK != 0 && (int)blockIdx.x == TS_BLK) (void)0;
#endif
#undef RUNP
#undef SEAM
}

template <int PH> static void launch_phase(Args& a, int l, int hf, hipStream_t stream) {
    static bool attr = false;
    if (!attr) { (void)hipFuncSetAttribute((const void*)phase_kernel<PH>, hipFuncAttributeMaxDynamicSharedMemorySize, LDS_BYTES); attr = true; }
    a.l = l; a.hf = hf;
    hipLaunchKernelGGL(phase_kernel<PH>, dim3(GRID), dim3(NTHREADS), LDS_BYTES, stream, a);
}
extern "C" void kernel_launch(void* const* d_in, const int* in_sizes, int n_in, void* d_out, int out_size, void* d_ws, size_t ws_size, hipStream_t stream) {
    static int ok = 0;
    if (ok == 0) {
        if (n_in != 25 || out_size != NTOK * DM || ws_size < WS_END) { fprintf(stderr, "kernel_launch: unexpected problem (n_in %d, out %d, ws %zu < %zu)\n", n_in, out_size, ws_size, (size_t)WS_END); ok = -1; return; }
        int dev = 0, cus = 0;
        if (hipGetDevice(&dev) != hipSuccess || hipDeviceGetAttribute(&cus, hipDeviceAttributeMultiprocessorCount, dev) != hipSuccess || cus < GRID) { fprintf(stderr, "kernel_launch: needs %d CUs, device has %d\n", GRID, cus); ok = -1; return; }
        ok = 1;
    }
    if (ok < 0) return;
    (void)hipMemsetAsync((char*)d_ws + WS_CTL, 0, CTL_BYTES, stream);
    Args a{};
    for (int i = 0; i < 25; ++i) a.in[i] = d_in[i];
    a.out = (float*)d_out; a.ws = (unsigned char*)d_ws; a.lo = 0; a.hi = 0;
#if MK_SINGLE
    static bool attr = false;
    if (!attr) { (void)hipFuncSetAttribute((const void*)fwd_kernel, hipFuncAttributeMaxDynamicSharedMemorySize, LDS_BYTES); attr = true; }
    hipLaunchKernelGGL(fwd_kernel, dim3(GRID), dim3(NTHREADS), LDS_BYTES, stream, a);
    return;
#endif
    launch_phase<PH_PRO>(a, 0, 0, stream);
    for (int l = 0; l < 4; ++l) {
        launch_phase<PH_NA>(a, l, 0, stream);
        if (l < 2) {
            for (int hf = 0; hf < 2; ++hf) {
                launch_phase<PH_R2>(a, l, hf, stream); launch_phase<PH_R3>(a, l, hf, stream); launch_phase<PH_R4>(a, l, hf, stream);
                launch_phase<PH_R5>(a, l, hf, stream); launch_phase<PH_R6>(a, l, hf, stream); launch_phase<PH_R7>(a, l, hf, stream);
            }
        } else {
            launch_phase<PH_M2>(a, l, 0, stream); launch_phase<PH_M3>(a, l, 0, stream); launch_phase<PH_M4>(a, l, 0, stream); launch_phase<PH_M5>(a, l, 0, stream);
        }
        launch_phase<PH_NB>(a, l, 0, stream); launch_phase<PH_MOE1>(a, l, 0, stream); launch_phase<PH_MOE2>(a, l, 0, stream);
    }
    launch_phase<PH_NA>(a, 4, 0, stream);
}
```
